# Optimizing an MI355X kernel written in HIP

```python
import math
import jax
import jax.numpy as jnp
from jax import lax
import numpy as np

D_MODEL = 1024
BATCH = 16
SEQ = 2048
DEPTH = 2
DEC_BATCH = 8
DEC_SEQ = 64
PAST_LEN = 4096

CHUNK = 64
EPS = 1e-6
N_BRANCH = 4
D_BR = 512
D_A = 512
G_A = 4
CH_A = D_A // G_A
MLP_CHUNK = 128
D_B = 512
S5_GROUP = 16
G_B = D_B // S5_GROUP
P_B = 64
H_C = 4
DK_C = 64
DV_C = 128
D_C = H_C * DV_C
GATE_RANK = 16
GATE_TAU = 16.0
H_D = 4
DH_D = 64
D_D = H_D * 2 * DH_D
Q_BLOCK = 128
D_FF = 2816
CONV_W = 3
IN_SPLITS = (D_A, D_A, D_B, H_C * DK_C, H_C * DK_C, D_C, GATE_RANK, D_C,
             H_D * 2 * DH_D, H_D * 2 * DH_D, D_D, N_BRANCH * D_MODEL)
N_IN = sum(IN_SPLITS)

kernel_name = 'hybrid_streaming_encoder_step'


def rms_norm(x, g):
    xf = x.astype(jnp.float32)
    y = xf * lax.rsqrt(jnp.mean(xf * xf, axis=-1, keepdims=True) + EPS)
    return (y * g.astype(jnp.float32)).astype(x.dtype)


def split_in(proj):
    pts, acc = [], 0
    for s in IN_SPLITS[:-1]:
        acc += s
        pts.append(acc)
    return jnp.split(proj, pts, axis=-1)


def gmlp_mix(a_u, a_v, v_g, ws, bs):
    B, T, _ = a_u.shape
    u = jax.nn.gelu(a_u)
    v = rms_norm(jax.nn.gelu(a_v), v_g)
    L = min(MLP_CHUNK, T)
    n = T // L
    causal = jnp.tril(jnp.ones((L, L), dtype=bool))
    w = jnp.where(causal, ws[:, :L, :L], 0)
    vg = v.reshape(B, n, L, G_A, CH_A)
    mixed = jnp.einsum('gts,bnsgc->bntgc', w, vg) + jnp.transpose(bs[:, :L])[None, None, :, :, None]
    return u * mixed.reshape(B, T, D_A), v


def _complex_affine_combine(e1, e2):
    a1r, a1i, b1r, b1i = e1
    a2r, a2i, b2r, b2i = e2
    return (a1r * a2r - a1i * a2i, a1r * a2i + a1i * a2r,
            a2r * b1r - a2i * b1i + b2r, a2r * b1i + a2i * b1r + b2i)


def s5_mix(x, h0_re, h0_im, lam_re, lam_im, log_dt, b_re, b_im, c_re, c_im, d_skip, w_glu, b_glu):
    B, T, _ = x.shape
    f32 = jnp.float32
    xf = x.astype(f32)
    lr, li = lam_re.astype(f32), lam_im.astype(f32)
    dt = jnp.exp(log_dt.astype(f32))[:, None]
    mag = jnp.exp(lr * dt)
    ar, ai = mag * jnp.cos(li * dt), mag * jnp.sin(li * dt)
    den = lr * lr + li * li
    nr, ni = ar - 1.0, ai
    kr, ki = (nr * lr + ni * li) / den, (ni * lr - nr * li) / den
    br_, bi_ = b_re.astype(f32), b_im.astype(f32)
    bbar_re = kr[..., None] * br_ - ki[..., None] * bi_
    bbar_im = kr[..., None] * bi_ + ki[..., None] * br_
    xg = xf.reshape(B, T, G_B, S5_GROUP)
    bu_re = jnp.einsum('gpc,btgc->tbgp', bbar_re, xg)
    bu_im = jnp.einsum('gpc,btgc->tbgp', bbar_im, xg)
    a_re = jnp.broadcast_to(ar[None, None], (T, 1, G_B, P_B))
    a_im = jnp.broadcast_to(ai[None, None], (T, 1, G_B, P_B))
    ca_re, ca_im, s_re, s_im = lax.associative_scan(_complex_affine_combine, (a_re, a_im, bu_re, bu_im), axis=0)
    h0r, h0i = h0_re.astype(f32)[None], h0_im.astype(f32)[None]
    h_re = s_re + ca_re * h0r - ca_im * h0i
    h_im = s_im + ca_re * h0i + ca_im * h0r
    y = (jnp.einsum('gcp,tbgp->btgc', c_re.astype(f32), h_re)
         - jnp.einsum('gcp,tbgp->btgc', c_im.astype(f32), h_im))
    y = y.reshape(B, T, D_B) + d_skip.astype(f32) * xf
    z = jax.nn.gelu(y)
    out = z * jax.nn.sigmoid(z @ w_glu.astype(f32) + b_glu.astype(f32))
    return out.astype(x.dtype), h_re[-1], h_im[-1]


def gla_mix(q, k, v, log_a, S0):
    B, T = q.shape[:2]
    L = min(CHUNK, T)
    n = T // L

    def to_chunks(t):
        return t.reshape(B, n, L, H_C, t.shape[-1]).transpose(1, 0, 3, 2, 4)

    causal = jnp.tril(jnp.ones((L, L), dtype=bool))

    def step(S, inp):
        qc, kc, vc, gc = inp
        b = jnp.cumsum(gc, axis=2)
        qe = qc * jnp.exp(b)
        ke = kc * jnp.exp(-b)
        att = jnp.where(causal, jnp.einsum('bhid,bhjd->bhij', qe, ke), 0.0)
        o = jnp.einsum('bhij,bhjv->bhiv', att, vc) + jnp.einsum('bhid,bhdv->bhiv', qe, S)
        bl = b[:, :, -1:, :]
        S_new = (jnp.exp(bl[:, :, 0, :])[..., None] * S
                 + jnp.einsum('bhjd,bhjv->bhdv', kc * jnp.exp(bl - b), vc))
        return S_new, o

    S_fin, o = lax.scan(step, S0, (to_chunks(q), to_chunks(k), to_chunks(v), to_chunks(log_a)))
    return o.transpose(1, 0, 3, 2, 4).reshape(B, T, H_C, DV_C), S_fin


def diff_core(q, k, v, lam, mask):
    s = jnp.einsum('bqhcd,bkhcd->bhcqk', q, k) * (DH_D ** -0.5)
    if mask is not None:
        s = jnp.where(mask, s, -jnp.inf)
    p = jax.nn.softmax(s, axis=-1)
    att = p[:, :, 0] - lam * p[:, :, 1]
    return jnp.einsum('bhqk,bkhv->bqhv', att, v)


def diff_attn_prompt(q, k, v, lam):
    B, T = q.shape[:2]
    nb = T // Q_BLOCK
    qb = q.reshape(B, nb, Q_BLOCK, H_D, 2, DH_D).transpose(1, 0, 2, 3, 4, 5)
    kchunk = jnp.arange(T) // CHUNK

    def one(args):
        qblk, i = args
        qchunk = (i * Q_BLOCK + jnp.arange(Q_BLOCK)) // CHUNK
        mask = kchunk[None, :] <= qchunk[:, None]
        return diff_core(qblk, k, v, lam, mask)

    o = lax.map(one, (qb, jnp.arange(nb)))
    return o.transpose(1, 0, 2, 3, 4).reshape(B, T, H_D, 2 * DH_D)


def conv_ffn(x, prev, w_up, conv_w, conv_b, w_down):
    T = x.shape[1]
    up = x @ w_up
    hp = jnp.concatenate([prev.astype(up.dtype), up], axis=1)
    c = conv_b + sum(conv_w[j] * hp[:, j:j + T] for j in range(CONV_W))
    gate, val = jnp.split(c, 2, axis=-1)
    return (jax.nn.silu(gate) * val) @ w_down, hp[:, T:]


def trunk_layer(x, pl, layer_idx, st, prompt):
    B, T, _ = x.shape
    f32 = jnp.float32
    h = rms_norm(x, pl['norm1_g'])
    (a_u, a_v, s5_in, c_q, c_k, c_v, c_code, c_r,
     d_q, d_k, d_v, gate_logits) = split_in(h @ pl['w_in'])
    ya, v_rows = gmlp_mix(a_u, a_v, pl['gmlp_v_g'], pl['gmlp_ws'], pl['gmlp_bs'])
    yb, ssm_re, ssm_im = s5_mix(s5_in, st['ssm_re'], st['ssm_im'], pl['s5_lam_re'], pl['s5_lam_im'],
                                pl['s5_log_dt'], pl['s5_b_re'], pl['s5_b_im'], pl['s5_c_re'], pl['s5_c_im'],
                                pl['s5_d'], pl['s5_w_glu'], pl['s5_b_glu'])
    qg = c_q.astype(f32).reshape(B, T, H_C, DK_C) * (DK_C ** -0.5)
    kg = c_k.astype(f32).reshape(B, T, H_C, DK_C)
    vg = c_v.astype(f32).reshape(B, T, H_C, DV_C)
    log_a = jax.nn.log_sigmoid((c_code @ pl['gla_w_alpha'] + pl['gla_b_alpha']).astype(f32)) / GATE_TAU
    og, gla_S = gla_mix(qg, kg, vg, log_a.reshape(B, T, H_C, DK_C), st['gla'].astype(f32))
    yc = (rms_norm(og, pl['gla_norm_g']) * jax.nn.silu(c_r.astype(f32).reshape(B, T, H_C, DV_C)))
    yc = yc.reshape(B, T, D_C).astype(x.dtype)
    lam_init = 0.8 - 0.6 * math.exp(-0.3 * layer_idx)
    dl = pl['diff_lambda'].astype(f32)
    lam = jnp.exp(jnp.sum(dl[0] * dl[1])) - jnp.exp(jnp.sum(dl[2] * dl[3])) + lam_init
    dq = rms_norm(d_q.astype(f32).reshape(B, T, H_D, 2, DH_D), pl['diff_qnorm_g'])
    dk = rms_norm(d_k.astype(f32).reshape(B, T, H_D, 2, DH_D), pl['diff_knorm_g'])
    dv = d_v.astype(f32).reshape(B, T, H_D, 2 * DH_D)
    if prompt:
        od = diff_attn_prompt(dq, dk, dv, lam)
    else:
        k_all = jnp.concatenate([st['k'].astype(f32), dk], axis=1)
        v_all = jnp.concatenate([st['v'].astype(f32), dv], axis=1)
        od = diff_core(dq, k_all, v_all, lam, None)
    yd = (rms_norm(od, pl['diff_subln_g']) * (1.0 - lam_init)).reshape(B, T, D_D).astype(x.dtype)
    gl = (gate_logits + pl['b_gate']).reshape(B, T, N_BRANCH, D_MODEL)
    ys = (ya, yb, yc, yd)
    merged = sum(jax.nn.sigmoid(gl[:, :, b]) * (ys[b] @ pl['w_branch'][b]) for b in range(N_BRANCH))
    x = x + merged @ pl['w_out']
    f, conv_rows = conv_ffn(rms_norm(x, pl['norm2_g']), st['ffn_conv'], pl['ffn_w_up'],
                            pl['ffn_conv_w'], pl['ffn_conv_b'], pl['ffn_w_down'])
    x = x + f
    new = dict(diff_k=dk.astype(x.dtype), diff_v=dv.astype(x.dtype), ssm_re=ssm_re.astype(x.dtype),
               ssm_im=ssm_im.astype(x.dtype), gla=gla_S.astype(x.dtype), ffn_conv=conv_rows,
               gmlp_v=v_rows)
    return x, new


def setup_inputs(seed: int = 0) -> dict:
    key = jax.random.key(seed)
    ks = iter(jax.random.split(key, 64))
    f32 = jnp.float32

    def nrm(shape, scale=1.0):
        return scale * jax.random.normal(next(ks), shape, f32)

    def gain(shape):
        return 1.0 + nrm(shape, 0.02)

    return {
        'x_prompt': nrm((BATCH, SEQ, D_MODEL)),
        'x_sample': nrm((DEC_BATCH, DEC_SEQ, D_MODEL)),
        'cache_diff_k': nrm((DEPTH, DEC_BATCH, PAST_LEN, H_D, 2, DH_D)),
        'cache_diff_v': nrm((DEPTH, DEC_BATCH, PAST_LEN, H_D, 2 * DH_D)),
        'state_ssm_re': nrm((DEPTH, DEC_BATCH, G_B, P_B), 0.1),
        'state_ssm_im': nrm((DEPTH, DEC_BATCH, G_B, P_B), 0.1),
        'state_gla': nrm((DEPTH, DEC_BATCH, H_C, DK_C, DV_C), 0.3),
        'state_ffn_conv': nrm((DEPTH, DEC_BATCH, CONV_W - 1, 2 * D_FF)),
        'norm1_g': gain((DEPTH, D_MODEL)),
        'w_in': nrm((DEPTH, D_MODEL, N_IN), D_MODEL ** -0.5),
        'b_gate': nrm((DEPTH, N_BRANCH * D_MODEL), 0.1),
        'gmlp_v_g': gain((DEPTH, D_A)),
        'gmlp_ws': nrm((DEPTH, G_A, MLP_CHUNK, MLP_CHUNK), 0.5 * MLP_CHUNK ** -0.5),
        'gmlp_bs': 1.0 + nrm((DEPTH, G_A, MLP_CHUNK), 0.1),
        's5_lam_re': -0.5 + nrm((DEPTH, G_B, P_B), 0.01),
        's5_lam_im': jnp.pi * jnp.arange(P_B, dtype=f32) + nrm((DEPTH, G_B, P_B), 0.01),
        's5_log_dt': jax.random.uniform(next(ks), (DEPTH, G_B), f32, math.log(1e-3), math.log(1e-1)),
        's5_b_re': nrm((DEPTH, G_B, P_B, S5_GROUP), (2 * S5_GROUP) ** -0.5),
        's5_b_im': nrm((DEPTH, G_B, P_B, S5_GROUP), (2 * S5_GROUP) ** -0.5),
        's5_c_re': nrm((DEPTH, G_B, S5_GROUP, P_B), P_B ** -0.5),
        's5_c_im': nrm((DEPTH, G_B, S5_GROUP, P_B), P_B ** -0.5),
        's5_d': nrm((DEPTH, D_B)),
        's5_w_glu': nrm((DEPTH, D_B, D_B), D_B ** -0.5),
        's5_b_glu': nrm((DEPTH, D_B), 0.02),
        'gla_w_alpha': nrm((DEPTH, GATE_RANK, H_C * DK_C), GATE_RANK ** -0.5),
        'gla_b_alpha': nrm((DEPTH, H_C * DK_C), 0.1),
        'gla_norm_g': gain((DEPTH, DV_C)),
        'diff_qnorm_g': gain((DEPTH, DH_D)),
        'diff_knorm_g': gain((DEPTH, DH_D)),
        'diff_lambda': nrm((DEPTH, 4, DH_D), 0.1),
        'diff_subln_g': gain((DEPTH, 2 * DH_D)),
        'w_branch': nrm((DEPTH, N_BRANCH, D_BR, D_MODEL), D_BR ** -0.5),
        'w_out': nrm((DEPTH, D_MODEL, D_MODEL), D_MODEL ** -0.5),
        'norm2_g': gain((DEPTH, D_MODEL)),
        'ffn_w_up': nrm((DEPTH, D_MODEL, 2 * D_FF), D_MODEL ** -0.5),
        'ffn_conv_w': nrm((DEPTH, CONV_W, 2 * D_FF), CONV_W ** -0.5),
        'ffn_conv_b': nrm((DEPTH, 2 * D_FF), 0.02),
        'ffn_w_down': nrm((DEPTH, D_FF, D_MODEL), D_FF ** -0.5),
    }


def reference(x_prompt, x_sample, cache_diff_k, cache_diff_v, state_ssm_re, state_ssm_im, state_gla,
              state_ffn_conv, norm1_g, w_in, b_gate, gmlp_v_g, gmlp_ws, gmlp_bs, s5_lam_re, s5_lam_im,
              s5_log_dt, s5_b_re, s5_b_im, s5_c_re, s5_c_im, s5_d, s5_w_glu, s5_b_glu, gla_w_alpha,
              gla_b_alpha, gla_norm_g, diff_qnorm_g, diff_knorm_g, diff_lambda, diff_subln_g, w_branch,
              w_out, norm2_g, ffn_w_up, ffn_conv_w, ffn_conv_b, ffn_w_down):
    params = dict(norm1_g=norm1_g, w_in=w_in, b_gate=b_gate, gmlp_v_g=gmlp_v_g, gmlp_ws=gmlp_ws,
                  gmlp_bs=gmlp_bs, s5_lam_re=s5_lam_re, s5_lam_im=s5_lam_im, s5_log_dt=s5_log_dt,
                  s5_b_re=s5_b_re, s5_b_im=s5_b_im, s5_c_re=s5_c_re, s5_c_im=s5_c_im, s5_d=s5_d,
                  s5_w_glu=s5_w_glu, s5_b_glu=s5_b_glu, gla_w_alpha=gla_w_alpha, gla_b_alpha=gla_b_alpha,
                  gla_norm_g=gla_norm_g, diff_qnorm_g=diff_qnorm_g, diff_knorm_g=diff_knorm_g,
                  diff_lambda=diff_lambda, diff_subln_g=diff_subln_g, w_branch=w_branch, w_out=w_out,
                  norm2_g=norm2_g, ffn_w_up=ffn_w_up, ffn_conv_w=ffn_conv_w, ffn_conv_b=ffn_conv_b,
                  ffn_w_down=ffn_w_down)
    xp, xs = x_prompt, x_sample
    bp = xp.shape[0]
    new_p, new_s = [], []
    for l in range(DEPTH):
        pl = {name: arr[l] for name, arr in params.items()}
        st_p = dict(ssm_re=jnp.zeros((bp, G_B, P_B), jnp.float32),
                    ssm_im=jnp.zeros((bp, G_B, P_B), jnp.float32),
                    gla=jnp.zeros((bp, H_C, DK_C, DV_C), jnp.float32),
                    ffn_conv=jnp.zeros((bp, CONV_W - 1, 2 * D_FF), xp.dtype), k=None, v=None)
        xp, sp = trunk_layer(xp, pl, l, st_p, True)
        st_s = dict(ssm_re=state_ssm_re[l], ssm_im=state_ssm_im[l], gla=state_gla[l],
                    ffn_conv=state_ffn_conv[l], k=cache_diff_k[l], v=cache_diff_v[l])
        xs, ss = trunk_layer(xs, pl, l, st_s, False)
        new_p.append(sp)
        new_s.append(ss)

    def stk(lst, name):
        return jnp.stack([d[name] for d in lst], axis=0)

    return (xp, xs,
            stk(new_p, 'diff_k'), stk(new_p, 'diff_v'), stk(new_p, 'ssm_re'), stk(new_p, 'ssm_im'),
            stk(new_p, 'gla'), stk(new_p, 'ffn_conv'),
            stk(new_s, 'diff_k'), stk(new_s, 'diff_v'), stk(new_s, 'ssm_re'), stk(new_s, 'ssm_im'),
            stk(new_s, 'gla'), stk(new_s, 'ffn_conv'), stk(new_s, 'gmlp_v'))
```

```cpp
#include <hip/hip_runtime.h>
#include <hip/hip_cooperative_groups.h>
#include <cstdio>
namespace cg = cooperative_groups;

#define LAS __attribute__((address_space(3)))
#define DEV __device__ __forceinline__
typedef unsigned short u16;
typedef short bf16x8 __attribute__((ext_vector_type(8)));
typedef float f32x4 __attribute__((ext_vector_type(4)));
typedef float f32x2 __attribute__((ext_vector_type(2)));
typedef unsigned u32x4 __attribute__((ext_vector_type(4)));
typedef unsigned u32x2 __attribute__((ext_vector_type(2)));

constexpr int MTP = 32768, MT = 33280;
constexpr int NINP = 8960;
constexpr int NMIX = 19;
constexpr int GATE0 = 4864;
constexpr float EPS = 1e-6f;
constexpr float LOG2E = 1.4426950408889634f;

constexpr size_t O_Y = 0, O_DKP = 34078720, O_DVP = 67633152, O_SREP = 101187584, O_SIMP = 101253120, O_GLAP = 101318656,
                 O_FCP = 102367232, O_DKS = 102727680, O_DVS = 103251968, O_SRES = 103776256, O_SIMS = 103809024, O_GLAS = 103841792,
                 O_FCS = 104366080, O_GMV = 104546304;

constexpr size_t SZ_H = (size_t)MT * 1024 * 2;
constexpr size_t SZ_HALF = (size_t)MT * 512 * 2;
constexpr size_t W_H = 0;
constexpr size_t W_P1 = W_H + SZ_H;
constexpr size_t W_P2 = W_P1 + SZ_H;
constexpr size_t W_S5 = W_P2 + SZ_H;
constexpr size_t W_GVT = W_S5 + SZ_HALF;
constexpr size_t W_CQ = W_GVT + SZ_HALF;
constexpr size_t W_CK = W_CQ + SZ_HALF / 2;
constexpr size_t W_CVT = W_CK + SZ_HALF / 2;
constexpr size_t W_CODE = W_CVT + SZ_HALF;
constexpr size_t W_DKP = W_CODE + (size_t)MT * 16 * 4;
constexpr size_t W_DKS = W_DKP + (size_t)MTP * 512 * 2;
constexpr size_t W_DVTP = W_DKS + (size_t)8 * 4160 * 512 * 2;
constexpr size_t W_DVTS = W_DVTP + (size_t)MTP * 512 * 2;
constexpr size_t W_ROWSQ = W_DVTS + (size_t)8 * 4160 * 512 * 2;
constexpr size_t W_MISC = W_ROWSQ + (size_t)MT * 4;
constexpr size_t W_WIN = W_MISC + 4096;
constexpr size_t W_WBR = W_WIN + (size_t)NINP * 1024 * 2;
constexpr size_t W_WOUT = W_WBR + (size_t)2 * 1024 * 1024 * 2;
constexpr size_t W_WGLU = W_WOUT + (size_t)1024 * 1024 * 2;
constexpr size_t W_WUP = W_WGLU + (size_t)512 * 512 * 2;
constexpr size_t W_WDN = W_WUP + (size_t)5632 * 1024 * 2;
constexpr size_t W_MFS = W_WDN + (size_t)1024 * 2816 * 2;
constexpr size_t W_BAR = W_MFS + (size_t)512 * 1024 * 4;
constexpr size_t W_END = W_BAR + 16384;
constexpr size_t W_MERGED = W_CQ;
constexpr size_t W_SCR = W_DKP;
constexpr size_t W_ACT = W_P1;
constexpr size_t W_HEAD = W_DVTP;
constexpr size_t W_TAIL = W_HEAD + (size_t)520 * 2 * 5632 * 4;
static_assert(W_TAIL + (size_t)520 * 2 * 5632 * 4 <= W_ROWSQ, "head/tail alias");
static_assert((size_t)MT * 2816 * 2 <= W_CQ - W_P1, "act alias");

struct Params { const float* in[38]; float* out; unsigned char* ws; };
typedef const __attribute__((address_space(4))) Params CP;

DEV int tid_o() { int t = threadIdx.x; asm volatile("" : "+v"(t)); return t; }
DEV int bid_o() { int t = blockIdx.x; asm volatile("" : "+s"(t)); return t; }
DEV float bf2f(u16 v) { return __uint_as_float(((unsigned)v) << 16); }
typedef __bf16 b16x2 __attribute__((ext_vector_type(2)));
DEV unsigned pk2(float lo, float hi) { const f32x2 v = {lo, hi}; const b16x2 r = __builtin_convertvector(v, b16x2); return __builtin_bit_cast(unsigned, r); }
DEV u16 f2bf(float v) { return (u16)(pk2(v, 0.f) & 0xffffu); }
DEV float fsigmoid(float x) { return __builtin_amdgcn_rcpf(1.f + __expf(-x)); }
DEV float fsilu(float x) { return x * fsigmoid(x); }
DEV float fgelu(float x) { return x * fsigmoid(1.5957691216057308f * (x + 0.044715f * x * x * x)); }
DEV float flogsig(float x) { return fminf(x, 0.f) - __logf(1.f + __expf(-fabsf(x))); }
DEV f32x4 mfma16(bf16x8 a, bf16x8 b, f32x4 c) { return __builtin_amdgcn_mfma_f32_16x16x32_bf16(a, b, c, 0, 0, 0); }
DEV u32x2 pk4(f32x4 v) { u32x2 r; r.x = pk2(v[0], v[1]); r.y = pk2(v[2], v[3]); return r; }
DEV float red_fq(float v) { v += __shfl_xor(v, 16); v += __shfl_xor(v, 32); return v; }
DEV float wave_sum(float v) { for (int o = 32; o; o >>= 1) v += __shfl_xor(v, o); return v; }

namespace pg8 {
constexpr int BM = 256, BK = 64, HALF = 128, HTB = HALF * BK * 2, NXCD = 8, WGM = 8;
DEV int lds_byte(int r, int c) { const int st = (r >> 4) * 2 + (c >> 5), rr = r & 15, cc = c & 31, ob = rr * 64 + cc * 2; return st * 1024 + (ob ^ (((ob >> 9) & 1) << 5)); }
DEV void stage_rc(int b, int& R, int& C) { const int st = b / 1024, sb = b % 1024, swz = sb ^ (((sb >> 9) & 1) << 5); R = (st >> 1) * 16 + swz / 64; C = (st & 1) * 32 + (swz % 64) / 2; }
struct GUnit { const char* A; const char* B; int nt, pm, pn, kind; };
struct TileOrder {
    int nM, nN, nwg, G, c;
    DEV void init(int nM_, int nN_, int G_, int c_) { nM = nM_; nN = nN_; nwg = nM * nN; G = G_; c = c_; }
    DEV bool tile(int i, int& pm, int& pn) const {
        const long L = (long)i * G + c; if (L >= nwg) return false;
        int wgid = (int)L; { const int q = nwg / NXCD, r = nwg % NXCD, xcd = wgid % NXCD, off = wgid / NXCD; wgid = (xcd < r ? xcd * (q + 1) : r * (q + 1) + (xcd - r) * q) + off; }
        const int nig = WGM * nN, gid = wgid / nig, fm = gid * WGM, gsz = (nM - fm) < WGM ? (nM - fm) : WGM;
        pm = fm + ((wgid % nig) % gsz); pn = (wgid % nig) / gsz; return true;
    }
};
struct TailSched {
    TileOrder T; const char* A; const char* B; int ld, nt, npiece, ntp;
    DEV bool next(int i, GUnit& u) const { int pm, pn;
        if (T.tile(i, pm, pn)) { u.pm = pm; u.pn = pn; u.kind = 0; u.nt = nt; u.A = A + (size_t)pm * 256 * ld * 2; u.B = B + (size_t)pn * 256 * ld * 2; return true; }
        const int i0 = (T.nwg - T.c + T.G - 1) / T.G; const int j = (i - i0) * T.G + T.c; if (j >= 8 * npiece) return false;
        const int tile = j / npiece, kp = j % npiece; pm = 128 + (tile >> 2); pn = tile & 3; u.pm = pm; u.pn = pn; u.kind = 1; u.nt = ntp;
        u.A = A + (size_t)pm * 256 * ld * 2 + (size_t)kp * ntp * 128; u.B = B + (size_t)pn * 256 * ld * 2 + (size_t)kp * ntp * 128; return true; }
};
struct PlainSched {
    TileOrder T; const char* A; const char* B; int ld, nt;
    DEV bool next(int i, GUnit& u) const { int pm, pn; if (!T.tile(i, pm, pn)) return false; u.pm = pm; u.pn = pn; u.kind = 0; u.nt = nt;
        u.A = A + (size_t)pm * 256 * ld * 2; u.B = B + (size_t)pn * 256 * ld * 2; return true; }
};

template <class Epi, class Sched>
DEV void gemm_phase(LAS unsigned char* lds, const int ld, const Sched& S, const Epi& E) {
    const int tid = tid_o(), wid = __builtin_amdgcn_readfirstlane(tid >> 6), lane = tid & 63, wr = wid >> 2, wc = wid & 3, fr = lane & 15, fq = lane >> 4;
    unsigned voff[2];
#pragma unroll
    for (int i = 0; i < 2; ++i) { int R, C; stage_rc(tid * 16 + i * 8192, R, C); voff[i] = (unsigned)(R * ld + C) * 2u; }
    const size_t kstep = (size_t)(BK * 2);
    const size_t hstep = (size_t)HALF * ld * 2;
    const unsigned ldsw = (unsigned)wid * 1024u;
    const int aoff = lds_byte(wr * 64 + fr, fq * 8), boff = lds_byte(wc * 32 + fr, fq * 8);
#define PG8_SA(b, h) (((b) * 2 + (h)) * HTB)
#define PG8_SB(b, h) ((4 + (b) * 2 + (h)) * HTB)
#define PG8_STAGE(bufoff, gbase) do { _Pragma("unroll") for (int _i = 0; _i < 2; ++_i) \
        __builtin_amdgcn_global_load_lds((const unsigned*)((const char*)(gbase) + voff[_i]), (LAS unsigned*)(lds + (bufoff) + ldsw + _i * 8192), 16, 0, 0); } while (0)
#define PG8_LDA(dst, b, h) do { _Pragma("unroll") for (int m = 0; m < 4; ++m) _Pragma("unroll") for (int k = 0; k < 2; ++k) dst[m][k] = *(const LAS bf16x8*)(lds + PG8_SA(b, h) + aoff + m * 2048 + k * 1024); } while (0)
#define PG8_LDB(dst, b, h) do { _Pragma("unroll") for (int n = 0; n < 2; ++n) _Pragma("unroll") for (int k = 0; k < 2; ++k) dst[n][k] = *(const LAS bf16x8*)(lds + PG8_SB(b, h) + boff + n * 2048 + k * 1024); } while (0)
#define PG8_MMA(ai, bj, At, Bt) do { __builtin_amdgcn_s_setprio(1); _Pragma("unroll") for (int m = 0; m < 4; ++m) _Pragma("unroll") for (int n = 0; n < 2; ++n) _Pragma("unroll") for (int k = 0; k < 2; ++k) \
        acc[ai][bj][m][n] = __builtin_amdgcn_mfma_f32_16x16x32_bf16(Bt[n][k], At[m][k], acc[ai][bj][m][n], 0, 0, 0); __builtin_amdgcn_s_setprio(0); } while (0)
#define PG8_WAIT_V(n) asm volatile("s_waitcnt vmcnt(" #n ")" ::: "memory")
#define PG8_WAIT_L(n) asm volatile("s_waitcnt lgkmcnt(" #n ")" ::: "memory")
#define PG8_BAR __builtin_amdgcn_s_barrier()
#define PG8_SCHED __builtin_amdgcn_sched_barrier(0)
    GUnit cur, nxt; int ui = 0;
    if (!S.next(0, cur)) return;
    f32x4 acc[2][2][4][2];
#pragma unroll
    for (int a = 0; a < 2; ++a)
#pragma unroll
        for (int b = 0; b < 2; ++b)
#pragma unroll
            for (int m = 0; m < 4; ++m)
#pragma unroll
                for (int n = 0; n < 2; ++n) acc[a][b][m][n] = (f32x4){0.f, 0.f, 0.f, 0.f};
    bf16x8 At[4][2], B0[2][2], B1[2][2];
    const char* cA = cur.A; const char* cB = cur.B;
    PG8_STAGE(PG8_SB(0, 0), cB); PG8_STAGE(PG8_SA(0, 0), cA); PG8_STAGE(PG8_SB(0, 1), cB + hstep); PG8_STAGE(PG8_SA(0, 1), cA + hstep);
    if (wr == 1) PG8_BAR;
    PG8_WAIT_V(4); PG8_BAR;
    PG8_STAGE(PG8_SB(1, 0), cB + kstep); PG8_STAGE(PG8_SA(1, 0), cA + kstep); PG8_STAGE(PG8_SB(1, 1), cB + hstep + kstep);
    PG8_WAIT_V(6); PG8_BAR;
    for (;;) {
        const bool has_next = S.next(ui + 1, nxt);
        const char* nA = has_next ? nxt.A : cA; const char* nB = has_next ? nxt.B : cB;
        const int nt = cur.nt;
        for (int t = 0; t < nt; t += 2) {
            const bool last = (t == nt - 2);
            const char* a1 = cA + (size_t)(t + 1) * kstep;
            const char* a2 = last ? nA : cA + (size_t)(t + 2) * kstep; const char* b2 = last ? nB : cB + (size_t)(t + 2) * kstep;
            const char* a3 = a2 + kstep; const char* b3 = b2 + kstep;
            PG8_LDB(B0, 0, 0); PG8_SCHED; PG8_LDA(At, 0, 0); PG8_STAGE(PG8_SA(1, 1), a1 + hstep);
            PG8_WAIT_L(8); PG8_BAR; PG8_WAIT_L(0); PG8_MMA(0, 0, At, B0); PG8_BAR; PG8_SCHED;
            PG8_LDB(B1, 0, 1); PG8_STAGE(PG8_SB(0, 0), b2);
            PG8_BAR; PG8_WAIT_L(0); PG8_MMA(0, 1, At, B1); PG8_BAR;
            PG8_LDA(At, 0, 1); PG8_STAGE(PG8_SA(0, 0), a2);
            PG8_BAR; PG8_WAIT_L(0); PG8_MMA(1, 0, At, B0); PG8_BAR; PG8_SCHED;
            PG8_STAGE(PG8_SB(0, 1), b2 + hstep);
            PG8_WAIT_V(6); PG8_BAR; PG8_MMA(1, 1, At, B1); PG8_BAR;
            PG8_LDB(B0, 1, 0); PG8_SCHED; PG8_LDA(At, 1, 0); PG8_STAGE(PG8_SA(0, 1), a2 + hstep);
            PG8_WAIT_L(8); PG8_BAR; PG8_WAIT_L(0); PG8_MMA(0, 0, At, B0); PG8_BAR; PG8_SCHED;
            PG8_LDB(B1, 1, 1); PG8_STAGE(PG8_SB(1, 0), b3);
            PG8_BAR; PG8_WAIT_L(0); PG8_MMA(0, 1, At, B1); PG8_BAR;
            PG8_LDA(At, 1, 1); PG8_STAGE(PG8_SA(1, 0), a3);
            PG8_BAR; PG8_WAIT_L(0); PG8_MMA(1, 0, At, B0); PG8_BAR; PG8_SCHED;
            PG8_STAGE(PG8_SB(1, 1), b3 + hstep);
            PG8_WAIT_V(6); PG8_BAR; PG8_MMA(1, 1, At, B1); PG8_BAR;
        }
        { int fr_ = fr, fq_ = fq, wr_ = wr, wc_ = wc; asm volatile("" : "+v"(fr_), "+v"(fq_), "+s"(wr_), "+s"(wc_));
          E(acc, cur, wr_, wc_, fr_, fq_); }
        if (!has_next) break;
#pragma unroll
        for (int a = 0; a < 2; ++a)
#pragma unroll
            for (int b = 0; b < 2; ++b)
#pragma unroll
                for (int m = 0; m < 4; ++m)
#pragma unroll
                    for (int n = 0; n < 2; ++n) acc[a][b][m][n] = (f32x4){0.f, 0.f, 0.f, 0.f};
        cur = nxt; cA = nA; cB = nB; ++ui;
    }
    PG8_WAIT_V(0);
    if (wr == 0) PG8_BAR;
    PG8_BAR;
#undef PG8_SA
#undef PG8_SB
#undef PG8_STAGE
#undef PG8_LDA
#undef PG8_LDB
#undef PG8_MMA
#undef PG8_WAIT_V
#undef PG8_WAIT_L
#undef PG8_BAR
#undef PG8_SCHED
}
}
using pg8::GUnit;
typedef f32x4 AccT[2][2][4][2];

#define FOR_AM _Pragma("unroll") for (int ai = 0; ai < 2; ++ai) _Pragma("unroll") for (int m = 0; m < 4; ++m)
#define FOR_BN _Pragma("unroll") for (int bj = 0; bj < 2; ++bj) _Pragma("unroll") for (int n = 0; n < 2; ++n)

struct EpiIn {
    int l; float* out; unsigned char* ws; const float* qg; const float* kg;
    DEV void operator()(const AccT& acc, const GUnit& u, int wr, int wc, int fr, int fq) const {
        const int pn = u.pn; const bool smp = u.pm >= 128;
        const int rowb = u.pm * 256 + wr * 64 + fr;
        const int ct0 = wc * 32 + 4 * fq;
        u16* P1 = (u16*)(ws + W_P1); u16* P2 = (u16*)(ws + W_P2);
        if (pn < 2) {
            FOR_AM { const int row = rowb + ai * 128 + m * 16; FOR_BN { f32x4 v = acc[ai][bj][m][n];
                for (int e = 0; e < 4; ++e) v[e] = fgelu(v[e]);
                *(u32x2*)(P1 + (size_t)row * 1024 + pn * 256 + ct0 + bj * 128 + n * 16) = pk4(v); } }
        } else if (pn < 4 || pn == 8 || pn == 9 || pn == 16 || pn == 17) {
            const int kind = pn < 4 ? 0 : (pn < 10 ? 1 : 2);
            const int cseg = (pn & 1) * 256;
            u16* dstT; int T, toff = 0;
            if (kind == 0) { dstT = (u16*)(ws + W_GVT) + (smp ? (size_t)16 * 512 * 2048 : 0); T = smp ? 64 : 2048; }
            else if (kind == 1) { dstT = (u16*)(ws + W_CVT) + (smp ? (size_t)16 * 512 * 2048 : 0); T = smp ? 64 : 2048; }
            else { dstT = (u16*)(ws + (smp ? W_DVTS : W_DVTP)); T = smp ? 4160 : 2048; toff = smp ? 4096 : 0; }
            float* rowsq = (float*)(ws + W_ROWSQ);
            FOR_AM { const int row = rowb + ai * 128 + m * 16;
                int b, t; if (smp) { const int rs = row - MTP; b = rs >> 6; t = rs & 63; } else { b = row >> 11; t = row & 2047; }
                float ss = 0.f;
                FOR_BN { f32x4 v = acc[ai][bj][m][n]; const int cc = cseg + ct0 + bj * 128 + n * 16;
                    if (kind == 0) { for (int e = 0; e < 4; ++e) { v[e] = fgelu(v[e]); ss += v[e] * v[e]; } }
                    if (kind == 2) { float* o = smp ? out + O_DVS + (size_t)l * 262144 + (size_t)(row - MTP) * 512 + cc : out + O_DVP + (size_t)l * 16777216 + (size_t)row * 512 + cc;
                        *(f32x4*)o = v; }
                    for (int e = 0; e < 4; ++e) dstT[((size_t)b * 512 + cc + e) * T + toff + t] = f2bf(v[e]); }
                if (kind == 0) { ss = red_fq(ss); if (fq == 0) atomicAdd(rowsq + row, ss); } }
        } else if (pn < 6) {
            u16* S5 = (u16*)(ws + W_S5);
            FOR_AM { const int row = rowb + ai * 128 + m * 16; FOR_BN {
                *(u32x2*)(S5 + (size_t)row * 512 + (pn - 4) * 256 + ct0 + bj * 128 + n * 16) = pk4(acc[ai][bj][m][n]); } }
        } else if (pn < 8) {
            u16* D = (u16*)(ws + (pn == 6 ? W_CQ : W_CK)); const float sc = pn == 6 ? 0.125f : 1.f;
            FOR_AM { const int row = rowb + ai * 128 + m * 16; FOR_BN {
                *(u32x2*)(D + (size_t)row * 256 + ct0 + bj * 128 + n * 16) = pk4(acc[ai][bj][m][n] * sc); } }
        } else if (pn < 12) {
            FOR_AM { const int row = rowb + ai * 128 + m * 16; FOR_BN { f32x4 v = acc[ai][bj][m][n];
                for (int e = 0; e < 4; ++e) v[e] = fsilu(v[e]);
                *(u32x2*)(P2 + (size_t)row * 1024 + (pn - 10) * 256 + ct0 + bj * 128 + n * 16) = pk4(v); } }
        } else if (pn < 16) {
            const bool isq = pn < 14; const int hh = 4 * (pn & 1) + wc; const float* g = isq ? qg : kg;
            f32x4 gv[2][2];
            FOR_BN gv[bj][n] = *(const f32x4*)(g + 32 * bj + 16 * n + 4 * fq);
            FOR_AM { const int row = rowb + ai * 128 + m * 16;
                float ss = 0.f;
                FOR_BN { const f32x4 v = acc[ai][bj][m][n]; ss += v[0] * v[0] + v[1] * v[1] + v[2] * v[2] + v[3] * v[3]; }
                ss = red_fq(ss);
                float rs = __builtin_amdgcn_rsqf(ss * (1.f / 64.f) + EPS);
                if (isq) { rs *= 0.125f * LOG2E;
                    FOR_BN { *(u32x2*)(P2 + (size_t)row * 1024 + 512 + hh * 64 + 32 * bj + 16 * n + 4 * fq) = pk4(acc[ai][bj][m][n] * rs * gv[bj][n]); }
                } else {
                    float* o; u16* kb;
                    if (smp) { const int rs_ = row - MTP; o = out + O_DKS + (size_t)l * 262144 + (size_t)rs_ * 512; kb = (u16*)(ws + W_DKS) + ((size_t)(rs_ >> 6) * 4160 + 4096 + (rs_ & 63)) * 512; }
                    else { o = out + O_DKP + (size_t)l * 16777216 + (size_t)row * 512; kb = (u16*)(ws + W_DKP) + (size_t)row * 512; }
                    FOR_BN { const f32x4 v = acc[ai][bj][m][n] * rs * gv[bj][n]; const int d = hh * 64 + 32 * bj + 16 * n + 4 * fq;
                        *(f32x4*)(o + d) = v; *(u32x2*)(kb + d) = pk4(v); } } }
        } else {
            if (wc == 0) { float* C = (float*)(ws + W_CODE);
                FOR_AM { const int row = rowb + ai * 128 + m * 16; *(f32x4*)(C + (size_t)row * 16 + 4 * fq) = acc[ai][0][m][0]; } }
        }
    }
};

struct EpiGlu {
    unsigned char* ws; const float* bias;
    DEV void operator()(const AccT& acc, const GUnit& u, int wr, int wc, int fr, int fq) const {
        const u16* Z = (const u16*)(ws + W_S5); u16* P1 = (u16*)(ws + W_P1);
        const int rowb = u.pm * 256 + wr * 64 + fr, cb = u.pn * 256 + wc * 32 + 4 * fq;
        FOR_AM { const int row = rowb + ai * 128 + m * 16; FOR_BN { const int col = cb + bj * 128 + n * 16;
            const f32x4 bv = *(const f32x4*)(bias + col); const u32x2 zz = *(const u32x2*)(Z + (size_t)row * 512 + col);
            f32x4 z; z[0] = __uint_as_float(zz.x << 16); z[1] = __uint_as_float(zz.x & 0xffff0000u); z[2] = __uint_as_float(zz.y << 16); z[3] = __uint_as_float(zz.y & 0xffff0000u);
            f32x4 v = acc[ai][bj][m][n] + bv;
            for (int e = 0; e < 4; ++e) v[e] = z[e] * fsigmoid(v[e]);
            *(u32x2*)(P1 + (size_t)row * 1024 + 512 + col) = pk4(v); } }
    }
};

struct MergeSched {
    pg8::TileOrder T; unsigned char* ws;
    DEV void fill(GUnit& u, int pm, int pn, int b, int sub) const {
        u.pm = pm; u.pn = pn;
        if (sub) { u.nt = 16; u.A = (const char*)ws + W_H + (size_t)pm * 256 * 2048; u.B = (const char*)ws + W_WIN + (size_t)(GATE0 + b * 1024 + pn * 256) * 2048; }
        else { u.nt = 8; u.A = (const char*)ws + (b < 2 ? W_P1 : W_P2) + (size_t)pm * 256 * 2048 + (b & 1) * 1024;
               u.B = (const char*)ws + W_WBR + (size_t)(b >> 1) * 1024 * 2048 + (size_t)pn * 256 * 2048 + (b & 1) * 1024; }
    }
    DEV bool next(int i, GUnit& u) const {
        int pm, pn;
        if (T.tile(i >> 3, pm, pn)) { const int s = i & 7; u.kind = s; fill(u, pm, pn, s >> 1, s & 1); return true; }
        const int i0 = (T.nwg - T.c + T.G - 1) / T.G; const int jj = i - 8 * i0; const int job = (jj >> 1) * T.G + T.c; if (job >= 32) return false;
        const int tile = job >> 2, b = job & 3; u.kind = 8 + 2 * b + (jj & 1); fill(u, 128 + (tile >> 2), tile & 3, b, jj & 1); return true;
    }
};
struct EpiMerge {
    unsigned char* ws; const float* bgate;
    DEV void operator()(const AccT& acc, const GUnit& u, int wr, int wc, int fr, int fq) const {
        u32x4* sT = (u32x4*)(ws + W_SCR) + (size_t)bid_o() * 16 * 512 + tid_o();
        u32x4* sS = (u32x4*)(ws + W_SCR + (size_t)32 * 1024 * 1024) + (size_t)bid_o() * 16 * 512 + tid_o();
        const int s = u.kind & 7, b = s >> 1; const bool smp = u.kind >= 8;
        if (!(s & 1)) {
#pragma unroll
            for (int q = 0; q < 16; ++q) { const int ai = q >> 3, bj = (q >> 2) & 1, m = q & 3; const u32x2 lo = pk4(acc[ai][bj][m][0]), hi = pk4(acc[ai][bj][m][1]);
                u32x4 w; w.x = lo.x; w.y = lo.y; w.z = hi.x; w.w = hi.y; sT[q * 512] = w; }
        } else {
            u16* MG = (u16*)(ws + W_MERGED);
            const int rowb = u.pm * 256 + wr * 64 + fr, cb = u.pn * 256 + wc * 32 + 4 * fq;
            const bool ldS = b > 0 && !smp;
            u32x4 twq[3], swq[3];
#pragma unroll
            for (int q = 0; q < 2; ++q) { twq[q] = sT[q * 512]; swq[q] = (u32x4){0u, 0u, 0u, 0u}; if (ldS) swq[q] = sS[q * 512]; }
#pragma unroll
            for (int q = 0; q < 16; ++q) { const int ai = q >> 3, bj = (q >> 2) & 1, m = q & 3; __builtin_amdgcn_sched_barrier(0);
                if (q + 2 < 16) { twq[(q + 2) % 3] = sT[(q + 2) * 512]; swq[(q + 2) % 3] = (u32x4){0u, 0u, 0u, 0u}; if (ldS) swq[(q + 2) % 3] = sS[(q + 2) * 512]; }
                const u32x4 tw = twq[q % 3], sw = swq[q % 3];
                const unsigned tws[4] = {tw.x, tw.y, tw.z, tw.w}; const unsigned sws[4] = {sw.x, sw.y, sw.z, sw.w};
                f32x4 r[2];
#pragma unroll
                for (int n = 0; n < 2; ++n) { const int col = cb + bj * 128 + n * 16; const f32x4 bv = *(const f32x4*)(bgate + b * 1024 + col);
                    f32x4 v = acc[ai][bj][m][n] + bv;
#pragma unroll
                    for (int e = 0; e < 4; ++e) { const unsigned tt = tws[n * 2 + (e >> 1)], st = sws[n * 2 + (e >> 1)];
                        const float tv = (e & 1) ? __uint_as_float(tt & 0xffff0000u) : __uint_as_float(tt << 16);
                        const float sv = (e & 1) ? __uint_as_float(st & 0xffff0000u) : __uint_as_float(st << 16);
                        v[e] = fsigmoid(v[e]) * tv + sv; }
                    r[n] = v; }
                if (smp) { float* mf = (float*)(ws + W_MFS) + (size_t)(rowb + ai * 128 + m * 16 - MTP) * 1024 + cb + bj * 128;
#pragma unroll
                    for (int n = 0; n < 2; ++n)
#pragma unroll
                        for (int e = 0; e < 4; ++e) atomicAdd(mf + n * 16 + e, r[n][e]); }
                else if (b < 3) { const u32x2 lo = pk4(r[0]), hi = pk4(r[1]); u32x4 w; w.x = lo.x; w.y = lo.y; w.z = hi.x; w.w = hi.y; sS[q * 512] = w; }
                else { const int row = rowb + ai * 128 + m * 16;
#pragma unroll
                    for (int n = 0; n < 2; ++n) *(u32x2*)(MG + (size_t)row * 1024 + cb + bj * 128 + n * 16) = pk4(r[n]); } }
        }
    }
};

struct EpiRes {
    float* xb; const float* xin_p; const float* xin_s;
    DEV void operator()(const AccT& acc, const GUnit& u, int wr, int wc, int fr, int fq) const {
        const int rowb = u.pm * 256 + wr * 64 + fr, cb = u.pn * 256 + wc * 32 + 4 * fq;
        if (u.kind == 1) {
            FOR_AM { const int row = rowb + ai * 128 + m * 16; FOR_BN { float* d = xb + (size_t)row * 1024 + cb + bj * 128 + n * 16;
#pragma unroll
                for (int e = 0; e < 4; ++e) atomicAdd(d + e, acc[ai][bj][m][n][e]); } }
            return; }
        FOR_AM { const int row = rowb + ai * 128 + m * 16;
            const float* src = xin_p ? (row < MTP ? xin_p + (size_t)row * 1024 : xin_s + (size_t)(row - MTP) * 1024) : xb + (size_t)row * 1024;
            FOR_BN { const int col = cb + bj * 128 + n * 16; *(f32x4*)(xb + (size_t)row * 1024 + col) = *(const f32x4*)(src + col) + acc[ai][bj][m][n]; } }
    }
};

DEV float dpp_prev1(float cur, float prevm) {
    const int o = __builtin_amdgcn_update_dpp(0, __float_as_int(prevm), 0x121, 0xf, 0xf, false);
    return __int_as_float(__builtin_amdgcn_update_dpp(o, __float_as_int(cur), 0x111, 0xf, 0xf, false));
}
DEV float dpp_prev2(float cur, float prevm) {
    const int o = __builtin_amdgcn_update_dpp(0, __float_as_int(prevm), 0x122, 0xf, 0xf, false);
    return __int_as_float(__builtin_amdgcn_update_dpp(o, __float_as_int(cur), 0x112, 0xf, 0xf, false));
}
struct EpiUp {
    unsigned char* ws; const float* cw; const float* cbias;
    DEV void operator()(const AccT& acc, const GUnit& u, int wr, int wc, int fr, int fq) const {
        u16* ACT = (u16*)(ws + W_ACT); float* HEAD = (float*)(ws + W_HEAD); float* TAIL = (float*)(ws + W_TAIL);
        const int f0 = u.pn * 128 + wc * 32 + 4 * fq;
#pragma unroll
        for (int ai = 0; ai < 2; ++ai) {
            const int slab = u.pm * 4 + ai * 2 + wr;
#pragma unroll
            for (int n = 0; n < 2; ++n) { const int f = f0 + n * 16;
                f32x4 w0[2], w1[2], w2[2], bb[2];
#pragma unroll
                for (int bj = 0; bj < 2; ++bj) { const int ff = bj * 2816 + f; w0[bj] = *(const f32x4*)(cw + ff); w1[bj] = *(const f32x4*)(cw + 5632 + ff); w2[bj] = *(const f32x4*)(cw + 11264 + ff); bb[bj] = *(const f32x4*)(cbias + ff); }
#pragma unroll
                for (int m = 0; m < 4; ++m) {
                    f32x4 c[2];
#pragma unroll
                    for (int bj = 0; bj < 2; ++bj) { const f32x4 cur = acc[ai][bj][m][n]; const f32x4 pm_ = acc[ai][bj][m ? m - 1 : 0][n];
#pragma unroll
                        for (int e = 0; e < 4; ++e) { const float p1 = dpp_prev1(cur[e], pm_[e]), p2 = dpp_prev2(cur[e], pm_[e]);
                            c[bj][e] = bb[bj][e] + w2[bj][e] * cur[e] + w1[bj][e] * p1 + w0[bj][e] * p2; } }
                    if (m > 0 || fr >= 2) { f32x4 a; for (int e = 0; e < 4; ++e) a[e] = fsilu(c[0][e]) * c[1][e];
                        *(u32x2*)(ACT + (size_t)(slab * 64 + m * 16 + fr) * 2816 + f) = pk4(a); }
                    if (m == 0 && fr < 2) { for (int bj = 0; bj < 2; ++bj) *(f32x4*)(HEAD + ((size_t)slab * 2 + fr) * 5632 + bj * 2816 + f) = acc[ai][bj][0][n]; }
                    if (m == 3 && fr >= 14) { for (int bj = 0; bj < 2; ++bj) *(f32x4*)(TAIL + ((size_t)slab * 2 + fr - 14) * 5632 + bj * 2816 + f) = acc[ai][bj][3][n]; }
                } } }
    }
};

template <int MAP> DEV int src_col(int j) {
    if (MAP == 0) return j;
    if (MAP == 1) {
        const int tile = j >> 8, tc = j & 255;
        if (tile < 10) return j;
        if (tile < 12) return j + 16;
        if (tile < 16) { const int perm = ((tc >> 5) & 3) * 64 + (tc >> 7) * 32 + (tc & 31); return (tile < 14 ? 3088 : 3600) + (tile & 1) * 256 + perm; }
        if (tile < 18) return j + 16;
        if (tile == 18) return tc < 16 ? 2560 + tc : -1;
        return 4624 + (j - GATE0);
    }
    { const int q = j >> 8, tc = j & 255; return tc < 128 ? 128 * q + tc : 2816 + 128 * q + (tc - 128); }
}
template <int MAP> DEV void conv_T(u16* dst, int dst_ld, int K, int Nd, const float* src, int src_ld, int gt, int GT) {
    const int total = Nd * (K >> 3);
    for (int idx = gt; idx < total; idx += GT) { const int j = idx % Nd, kb = idx / Nd; const int sc = src_col<MAP>(j);
        float v[8];
#pragma unroll
        for (int i = 0; i < 8; ++i) v[i] = sc >= 0 ? src[(size_t)(kb * 8 + i) * src_ld + sc] : 0.f;
        u32x4 w; w.x = pk2(v[0], v[1]); w.y = pk2(v[2], v[3]); w.z = pk2(v[4], v[5]); w.w = pk2(v[6], v[7]);
        *(u32x4*)(dst + (size_t)j * dst_ld + kb * 8) = w; }
}
DEV void norm_rows(const float* xp, const float* xs, const float* g, u16* H) {
    const int tid = tid_o(); const int lane = tid & 63; const int gw = bid_o() * 8 + (tid >> 6), GW = gridDim.x * 8;
    f32x4 gv[4];
#pragma unroll
    for (int i = 0; i < 4; ++i) gv[i] = *(const f32x4*)(g + (lane + 64 * i) * 4);
    for (int row = gw; row < MT; row += GW) {
        const float* src = row < MTP ? xp + (size_t)row * 1024 : xs + (size_t)(row - MTP) * 1024;
        f32x4 v[4]; float ss = 0.f;
#pragma unroll
        for (int i = 0; i < 4; ++i) { v[i] = *(const f32x4*)(src + (lane + 64 * i) * 4); ss += v[i][0] * v[i][0] + v[i][1] * v[i][1] + v[i][2] * v[i][2] + v[i][3] * v[i][3]; }
        ss = wave_sum(ss); const float rs = __builtin_amdgcn_rsqf(ss * (1.f / 1024.f) + EPS);
#pragma unroll
        for (int i = 0; i < 4; ++i) *(u32x2*)(H + (size_t)row * 1024 + (lane + 64 * i) * 4) = pk4(v[i] * rs * gv[i]);
    }
}

DEV void phaseA(CP& p, int l) {
    unsigned char* ws = p.ws;
    const int gt = bid_o() * 512 + tid_o(), GT = gridDim.x * 512;
    conv_T<1>((u16*)(ws + W_WIN), 1024, 1024, NINP, p.in[9] + (size_t)l * 1024 * 8720, 8720, gt, GT);
    for (int b = 0; b < 4; ++b) conv_T<0>((u16*)(ws + W_WBR) + (size_t)(b >> 1) * 1024 * 1024 + (b & 1) * 512, 1024, 512, 1024, p.in[31] + (size_t)(l * 4 + b) * 512 * 1024, 1024, gt, GT);
    conv_T<0>((u16*)(ws + W_WOUT), 1024, 1024, 1024, p.in[32] + (size_t)l * 1024 * 1024, 1024, gt, GT);
    conv_T<0>((u16*)(ws + W_WGLU), 512, 512, 512, p.in[22] + (size_t)l * 512 * 512, 512, gt, GT);
    conv_T<2>((u16*)(ws + W_WUP), 1024, 1024, 5632, p.in[34] + (size_t)l * 1024 * 5632, 5632, gt, GT);
    conv_T<0>((u16*)(ws + W_WDN), 2816, 2816, 1024, p.in[37] + (size_t)l * 2816 * 1024, 1024, gt, GT);
    for (int b = 0; b < 8; ++b) conv_T<0>((u16*)(ws + W_DVTS) + (size_t)b * 512 * 4160, 4160, 4096, 512, p.in[3] + ((size_t)(l * 8 + b) * 4096) * 512, 512, gt, GT);
    {
        const float* ck = p.in[2] + (size_t)l * 8 * 4096 * 512; u16* dk = (u16*)(ws + W_DKS);
        for (int idx = gt; idx < 8 * 4096 * 64; idx += GT) { const int b = idx >> 18, rem = idx & 262143, key = rem >> 6, c8 = (rem & 63) * 8;
            const f32x4 a = *(const f32x4*)(ck + ((size_t)(b * 4096 + key)) * 512 + c8), c = *(const f32x4*)(ck + ((size_t)(b * 4096 + key)) * 512 + c8 + 4);
            u32x4 w; w.x = pk2(a[0], a[1]); w.y = pk2(a[2], a[3]); w.z = pk2(c[0], c[1]); w.w = pk2(c[2], c[3]);
            *(u32x4*)(dk + ((size_t)b * 4160 + key) * 512 + c8) = w; }
    }
    { float* rq = (float*)(ws + W_ROWSQ); for (int i = gt; i < MT; i += GT) rq[i] = 0.f; }
    { f32x4* mf = (f32x4*)(ws + W_MFS); for (int i = gt; i < 512 * 256; i += GT) mf[i] = (f32x4){0.f, 0.f, 0.f, 0.f}; }
    if (l == 0) { const f32x4* xs = (const f32x4*)p.in[1]; f32x4* xo = (f32x4*)(p.out + (size_t)MTP * 1024); for (int i = gt; i < 512 * 256; i += GT) xo[i] = xs[i]; }
    if (gt == 0) {
        unsigned* misc = (unsigned*)(ws + W_MISC); misc[l] = 0u;
        const float* dl = p.in[29] + l * 256; float s1 = 0.f, s2 = 0.f;
        for (int i = 0; i < 64; ++i) { s1 += dl[i] * dl[64 + i]; s2 += dl[128 + i] * dl[192 + i]; }
        const float lam_init = 0.8f - 0.6f * expf(-0.3f * (float)l);
        ((float*)misc)[8 + 2 * l] = expf(s1) - expf(s2) + lam_init; ((float*)misc)[9 + 2 * l] = lam_init;
    }
    if (l == 0) norm_rows(p.in[0], p.in[1], p.in[8], (u16*)(ws + W_H));
    else norm_rows(p.out, p.out + (size_t)MTP * 1024, p.in[8] + 1024, (u16*)(ws + W_H));
}

DEV void attn_item(CP& p, int l, LAS unsigned char* lds, int grp, int b, int h, int qp) {
    unsigned char* ws = p.ws;
    const int tid = tid_o(), w = tid >> 6, lane = tid & 63, fr = lane & 15, fq = lane >> 4, c = w >> 2, qs = w & 3;
    const int Tk = grp ? 4160 : 2048, nkv = grp ? 65 : 2 * qp + 2;
    const int nact = grp ? (qs < 2 ? 65 : 0) : (qs < 2 ? nkv - 1 : nkv);
    const int rowbase = grp ? MTP + b * 64 : b * 2048 + qp * 128;
    const u16* Kb = grp ? (const u16*)(ws + W_DKS) + (size_t)b * 4160 * 512 : (const u16*)(ws + W_DKP) + (size_t)b * 2048 * 512;
    const u16* Vb = grp ? (const u16*)(ws + W_DVTS) + ((size_t)b * 512 + h * 128) * 4160 : (const u16*)(ws + W_DVTP) + ((size_t)b * 512 + h * 128) * 2048;
    u16* P2 = (u16*)(ws + W_P2);
    bf16x8 qf[2][2];
    if (nact > 0) {
#pragma unroll
        for (int r = 0; r < 2; ++r)
#pragma unroll
            for (int kk = 0; kk < 2; ++kk) qf[r][kk] = *(const bf16x8*)(P2 + (size_t)(rowbase + 32 * qs + 16 * r + fr) * 1024 + 512 + h * 128 + c * 64 + kk * 32 + fq * 8);
    } else {
#pragma unroll
        for (int r = 0; r < 2; ++r)
#pragma unroll
            for (int kk = 0; kk < 2; ++kk) qf[r][kk] = (bf16x8){0, 0, 0, 0, 0, 0, 0, 0};
    }
    constexpr int STG = 36864;
    int gK[2], lK[2], gV[2], lV[2];
#pragma unroll
    for (int i = 0; i < 2; ++i) { const int ch = tid + 512 * i; const int key = ch >> 4, part = ch & 15; gK[i] = key * 512 + h * 128 + part * 8; lK[i] = (((part >> 3) * 64 + key) * 72 + (part & 7) * 8) * 2;
        const int v = ch >> 3, kp = (ch & 7) * 8; gV[i] = v * Tk + kp; lV[i] = (128 * 72 + v * 72 + kp) * 2; }
    u32x4 rk[2], rv[2];
#pragma unroll
    for (int i = 0; i < 2; ++i) { rk[i] = *(const u32x4*)(Kb + gK[i]); rv[i] = *(const u32x4*)(Vb + gV[i]); }
#pragma unroll
    for (int i = 0; i < 2; ++i) { *(LAS u32x4*)(lds + lK[i]) = rk[i]; *(LAS u32x4*)(lds + lV[i]) = rv[i]; }
    __syncthreads();
    f32x4 O[2][8];
#pragma unroll
    for (int r = 0; r < 2; ++r)
#pragma unroll
        for (int i = 0; i < 8; ++i) O[r][i] = (f32x4){0.f, 0.f, 0.f, 0.f};
    float mrun[2] = {-1e30f, -1e30f}, lrun[2] = {0.f, 0.f};
    for (int kt = 0; kt < nkv; ++kt) {
        const bool more = kt + 1 < nkv;
        if (more) { const size_t k0 = (size_t)(kt + 1) * 64;
#pragma unroll
            for (int i = 0; i < 2; ++i) { rk[i] = *(const u32x4*)(Kb + k0 * 512 + gK[i]); rv[i] = *(const u32x4*)(Vb + k0 + gV[i]); } }
        if (kt < nact) {
            LAS unsigned char* st = lds + (kt & 1) * STG;
            f32x4 s[2][4];
#pragma unroll
            for (int jt = 0; jt < 4; ++jt) { s[0][jt] = (f32x4){0.f, 0.f, 0.f, 0.f}; s[1][jt] = (f32x4){0.f, 0.f, 0.f, 0.f};
#pragma unroll
                for (int kk = 0; kk < 2; ++kk) { const bf16x8 kf = *(const LAS bf16x8*)(st + ((c * 64 + 16 * jt + fr) * 72 + kk * 32 + fq * 8) * 2);
                    s[0][jt] = mfma16(kf, qf[0][kk], s[0][jt]); s[1][jt] = mfma16(kf, qf[1][kk], s[1][jt]); } }
            bf16x8 pf[2][2];
#pragma unroll
            for (int r = 0; r < 2; ++r) {
                float mt = s[r][0][0];
#pragma unroll
                for (int jt = 0; jt < 4; ++jt)
#pragma unroll
                    for (int e = 0; e < 4; ++e) mt = fmaxf(mt, s[r][jt][e]);
                mt = fmaxf(mt, __shfl_xor(mt, 16)); mt = fmaxf(mt, __shfl_xor(mt, 32));
                const float mnew = fmaxf(mrun[r], mt), alpha = __builtin_amdgcn_exp2f(mrun[r] - mnew); mrun[r] = mnew;
                float ps = 0.f;
#pragma unroll
                for (int jt = 0; jt < 4; ++jt)
#pragma unroll
                    for (int e = 0; e < 4; ++e) { s[r][jt][e] = __builtin_amdgcn_exp2f(s[r][jt][e] - mnew); ps += s[r][jt][e]; }
                lrun[r] = lrun[r] * alpha + ps;
#pragma unroll
                for (int i = 0; i < 8; ++i) O[r][i] *= alpha;
#pragma unroll
                for (int t = 0; t < 2; ++t) { const u32x2 lo = pk4(s[r][2 * t]), hi = pk4(s[r][2 * t + 1]); u32x4 wv; wv.x = lo.x; wv.y = lo.y; wv.z = hi.x; wv.w = hi.y; pf[r][t] = __builtin_bit_cast(bf16x8, wv); }
            }
#pragma unroll
            for (int vt = 0; vt < 8; ++vt)
#pragma unroll
                for (int t = 0; t < 2; ++t) { const LAS unsigned char* vp = st + (128 * 72 + (16 * vt + fr) * 72 + 32 * t + 4 * fq) * 2;
                    const u32x2 a = *(const LAS u32x2*)vp, bq = *(const LAS u32x2*)(vp + 32); u32x4 wv; wv.x = a.x; wv.y = a.y; wv.z = bq.x; wv.w = bq.y;
                    const bf16x8 vf = __builtin_bit_cast(bf16x8, wv);
                    O[0][vt] = mfma16(vf, pf[0][t], O[0][vt]); O[1][vt] = mfma16(vf, pf[1][t], O[1][vt]); }
        }
        if (more) { LAS unsigned char* nx = lds + ((kt + 1) & 1) * STG;
#pragma unroll
            for (int i = 0; i < 2; ++i) { *(LAS u32x4*)(nx + lK[i]) = rk[i]; *(LAS u32x4*)(nx + lV[i]) = rv[i]; } }
        __syncthreads();
    }
    const float lam = ((const float*)(ws + W_MISC))[8 + 2 * l], lam_init = ((const float*)(ws + W_MISC))[9 + 2 * l];
    LAS float* X = (LAS float*)lds;
    float inv[2];
#pragma unroll
    for (int r = 0; r < 2; ++r) inv[r] = __builtin_amdgcn_rcpf(fmaxf(red_fq(lrun[r]), 1e-30f));
    if (c == 1) {
#pragma unroll
        for (int r = 0; r < 2; ++r)
#pragma unroll
            for (int vt = 0; vt < 8; ++vt)
#pragma unroll
                for (int e = 0; e < 4; ++e) X[(qs * 64 + r * 32 + vt * 4 + e) * 64 + lane] = O[r][vt][e] * inv[r] * lam;
    }
    __syncthreads();
    if (c == 0 && nact > 0) {
        const float* g = p.in[30] + l * 128;
#pragma unroll
        for (int r = 0; r < 2; ++r) { float ss = 0.f;
#pragma unroll
            for (int vt = 0; vt < 8; ++vt)
#pragma unroll
                for (int e = 0; e < 4; ++e) { const float d = O[r][vt][e] * inv[r] - X[(qs * 64 + r * 32 + vt * 4 + e) * 64 + lane]; O[r][vt][e] = d; ss += d * d; }
            ss = red_fq(ss); const float rs = __builtin_amdgcn_rsqf(ss * (1.f / 128.f) + EPS) * (1.f - lam_init);
#pragma unroll
            for (int vt = 0; vt < 8; ++vt) { const f32x4 gv = *(const f32x4*)(g + 16 * vt + 4 * fq);
                *(u32x2*)(P2 + (size_t)(rowbase + 32 * qs + 16 * r + fr) * 1024 + 512 + h * 128 + 16 * vt + 4 * fq) = pk4(O[r][vt] * rs * gv); } }
    }
    __syncthreads();
}

DEV void gla_item(CP& p, int l, LAS unsigned char* lds, int grp, int b, int h) {
    unsigned char* ws = p.ws;
    const int tid = tid_o(), w = tid >> 6, lane = tid & 63, fr = lane & 15, fq = lane >> 4;
    const int T = grp ? 64 : 2048, nch = grp ? 1 : 32; const int rowbase = grp ? MTP + b * 64 : b * 2048;
    const u16* CQ = (const u16*)(ws + W_CQ); const u16* CK = (const u16*)(ws + W_CK); const float* CODE = (const float*)(ws + W_CODE);
    const u16* VT = (const u16*)(ws + W_CVT) + (grp ? (size_t)16 * 512 * 2048 : 0) + ((size_t)b * 512 + h * 128) * T;
    u16* P2 = (u16*)(ws + W_P2);
    LAS u16* QE = (LAS u16*)lds; LAS u16* KE = QE + 64 * 72; LAS u16* KDT = KE + 64 * 72; LAS u16* VTl = KDT + 64 * 72;
    LAS u16* PP = VTl + 128 * 72; LAS u16* STb = PP + 64 * 72;
    LAS float* OT = (LAS float*)(STb + 8 * 16 * 72); LAS float* SEG = OT + 64 * 132; LAS float* DEC = SEG + 8 * 64;
    LAS u16* QR = (LAS u16*)(DEC + 64); LAS u16* KR = QR + 64 * 72; LAS float* CD = (LAS float*)(KR + 64 * 72);
    const int d_ = tid & 63, seg = tid >> 6;
    float wa[16];
#pragma unroll
    for (int r = 0; r < 16; ++r) wa[r] = p.in[24][(size_t)l * 16 * 256 + r * 256 + h * 64 + d_];
    const float ba = p.in[25][l * 256 + h * 64 + d_];
    f32x4 S[4];
    if (grp) { const float* s0 = p.in[6] + ((size_t)(l * 8 + b) * 4 + h) * 64 * 128;
#pragma unroll
        for (int dt = 0; dt < 4; ++dt) S[dt] = *(const f32x4*)(s0 + (size_t)(16 * dt + fr) * 128 + 16 * w + 4 * fq); }
    else {
#pragma unroll
        for (int dt = 0; dt < 4; ++dt) S[dt] = (f32x4){0.f, 0.f, 0.f, 0.f}; }
#pragma unroll
    for (int dt = 0; dt < 4; ++dt)
#pragma unroll
        for (int e = 0; e < 4; ++e) STb[(w * 16 + 4 * fq + e) * 72 + 16 * dt + fr] = f2bf(S[dt][e]);
    const float* gng = p.in[26] + l * 128;
    const int tl = tid >> 3, d8 = (tid & 7) * 8;
    u32x4 rq, rkk, rvv[2]; f32x2 rcd;
    {
        rq = *(const u32x4*)(CQ + (size_t)(rowbase + tl) * 256 + h * 64 + d8); rkk = *(const u32x4*)(CK + (size_t)(rowbase + tl) * 256 + h * 64 + d8);
        rcd = *(const f32x2*)(CODE + (size_t)(rowbase + tl) * 16 + (tid & 7) * 2);
#pragma unroll
        for (int i = 0; i < 2; ++i) { const int chn = tid + 512 * i, v = chn >> 3, kp = (chn & 7) * 8; rvv[i] = *(const u32x4*)(VT + (size_t)v * T + kp); }
    }
    for (int ch = 0; ch < nch; ++ch) {
        const int r0 = rowbase + ch * 64;
        *(LAS u32x4*)(QR + tl * 72 + d8) = rq; *(LAS u32x4*)(KR + tl * 72 + d8) = rkk; *(LAS f32x2*)(CD + tl * 16 + (tid & 7) * 2) = rcd;
#pragma unroll
        for (int i = 0; i < 2; ++i) { const int chn = tid + 512 * i, v = chn >> 3, kp = (chn & 7) * 8; *(LAS u32x4*)(VTl + v * 72 + kp) = rvv[i]; }
        if (ch + 1 < nch) { const int r1 = r0 + 64;
            rq = *(const u32x4*)(CQ + (size_t)(r1 + tl) * 256 + h * 64 + d8); rkk = *(const u32x4*)(CK + (size_t)(r1 + tl) * 256 + h * 64 + d8);
            rcd = *(const f32x2*)(CODE + (size_t)(r1 + tl) * 16 + (tid & 7) * 2);
#pragma unroll
            for (int i = 0; i < 2; ++i) { const int chn = tid + 512 * i, v = chn >> 3, kp = (chn & 7) * 8; rvv[i] = *(const u32x4*)(VT + (size_t)v * T + (ch + 1) * 64 + kp); } }
        u16* yp = P2 + (size_t)(r0 + tl) * 1024 + h * 128 + (tid & 7) * 16;
        const u32x4 rr0 = *(const u32x4*)yp, rr1 = *(const u32x4*)(yp + 8);
        __syncthreads();
        float bl[8]; float run = 0.f;
#pragma unroll
        for (int i = 0; i < 8; ++i) { const LAS float* cp = CD + (seg * 8 + i) * 16; float a = ba;
#pragma unroll
            for (int r = 0; r < 16; ++r) a += cp[r] * wa[r];
            run += flogsig(a) * (1.f / 16.f); bl[i] = run; }
        SEG[seg * 64 + d_] = run;
        __syncthreads();
        float off = 0.f, tot = 0.f;
#pragma unroll
        for (int s2 = 0; s2 < 8; ++s2) { const float x = SEG[s2 * 64 + d_]; tot += x; if (s2 < seg) off += x; }
        if (seg == 0) DEC[d_] = __expf(tot);
        { float kd[8];
#pragma unroll
          for (int i = 0; i < 8; ++i) { const int t = seg * 8 + i; const float bb = bl[i] + off;
              const float q = bf2f(QR[t * 72 + d_]), k = bf2f(KR[t * 72 + d_]);
              QE[t * 72 + d_] = f2bf(q * __expf(bb)); KE[t * 72 + d_] = f2bf(k * __expf(-bb)); kd[i] = k * __expf(tot - bb); }
          u32x4 wv; wv.x = pk2(kd[0], kd[1]); wv.y = pk2(kd[2], kd[3]); wv.z = pk2(kd[4], kd[5]); wv.w = pk2(kd[6], kd[7]);
          *(LAS u32x4*)(KDT + d_ * 72 + seg * 8) = wv; }
        __syncthreads();
#pragma unroll
        for (int r = 0; r < 2; ++r) { const int ti = w + 8 * r, jt = ti >> 2, it = ti & 3; f32x4 a = (f32x4){0.f, 0.f, 0.f, 0.f};
            if (jt <= it) {
#pragma unroll
                for (int kk = 0; kk < 2; ++kk) { const bf16x8 kf = *(const LAS bf16x8*)(KE + (16 * jt + fr) * 72 + kk * 32 + fq * 8), qf = *(const LAS bf16x8*)(QE + (16 * it + fr) * 72 + kk * 32 + fq * 8); a = mfma16(kf, qf, a); }
#pragma unroll
                for (int e = 0; e < 4; ++e) if (16 * jt + 4 * fq + e > 16 * it + fr) a[e] = 0.f;
            }
            *(LAS u32x2*)(PP + (16 * it + fr) * 72 + 16 * jt + 4 * fq) = pk4(a); }
        __syncthreads();
        bf16x8 vf[2], sf[2];
#pragma unroll
        for (int t = 0; t < 2; ++t) { vf[t] = *(const LAS bf16x8*)(VTl + (16 * w + fr) * 72 + 32 * t + 8 * fq); sf[t] = *(const LAS bf16x8*)(STb + (w * 16 + fr) * 72 + 32 * t + 8 * fq); }
#pragma unroll
        for (int it = 0; it < 4; ++it) { f32x4 a = (f32x4){0.f, 0.f, 0.f, 0.f};
#pragma unroll
            for (int t = 0; t < 2; ++t) { const bf16x8 pf = *(const LAS bf16x8*)(PP + (16 * it + fr) * 72 + 32 * t + 8 * fq), qf = *(const LAS bf16x8*)(QE + (16 * it + fr) * 72 + 32 * t + 8 * fq);
                a = mfma16(vf[t], pf, a); a = mfma16(sf[t], qf, a); }
            *(LAS f32x4*)(OT + (16 * it + fr) * 132 + 16 * w + 4 * fq) = a; }
#pragma unroll
        for (int dt = 0; dt < 4; ++dt) { S[dt] *= DEC[16 * dt + fr];
#pragma unroll
            for (int t = 0; t < 2; ++t) { const bf16x8 kf = *(const LAS bf16x8*)(KDT + (16 * dt + fr) * 72 + 32 * t + 8 * fq); S[dt] = mfma16(vf[t], kf, S[dt]); }
#pragma unroll
            for (int e = 0; e < 4; ++e) STb[(w * 16 + 4 * fq + e) * 72 + 16 * dt + fr] = f2bf(S[dt][e]); }
        __syncthreads();
        {
            const int i = tid >> 3, vs = tid & 7; f32x4 o[4]; float ss = 0.f;
#pragma unroll
            for (int k = 0; k < 4; ++k) { o[k] = *(const LAS f32x4*)(OT + i * 132 + vs * 16 + 4 * k); ss += o[k][0] * o[k][0] + o[k][1] * o[k][1] + o[k][2] * o[k][2] + o[k][3] * o[k][3]; }
            ss += __shfl_xor(ss, 1); ss += __shfl_xor(ss, 2); ss += __shfl_xor(ss, 4);
            const float rs = __builtin_amdgcn_rsqf(ss * (1.f / 128.f) + EPS);
            const unsigned rw[8] = {rr0.x, rr0.y, rr0.z, rr0.w, rr1.x, rr1.y, rr1.z, rr1.w};
#pragma unroll
            for (int k = 0; k < 4; ++k) { const f32x4 gv = *(const f32x4*)(gng + vs * 16 + 4 * k);
                f32x4 r; r[0] = __uint_as_float(rw[2 * k] << 16); r[1] = __uint_as_float(rw[2 * k] & 0xffff0000u); r[2] = __uint_as_float(rw[2 * k + 1] << 16); r[3] = __uint_as_float(rw[2 * k + 1] & 0xffff0000u);
                *(u32x2*)(yp + 4 * k) = pk4(o[k] * rs * gv * r); }
        }
    }
    float* so = p.out + (grp ? O_GLAS + (size_t)l * 262144 + ((size_t)b * 4 + h) * 8192 : O_GLAP + (size_t)l * 524288 + ((size_t)b * 4 + h) * 8192);
#pragma unroll
    for (int dt = 0; dt < 4; ++dt) *(f32x4*)(so + (size_t)(16 * dt + fr) * 128 + 16 * w + 4 * fq) = S[dt];
    __syncthreads();
}

DEV void s5_item(CP& p, int l, LAS unsigned char* lds, int grp, int b, int gq) {
    unsigned char* ws = p.ws;
    const int tid = tid_o(), w = tid >> 6, lane = tid & 63, fr = lane & 15, fq = lane >> 4;
    const int g = gq * 8 + w; const int T = grp ? 64 : 2048; const int rowbase = grp ? MTP + b * 64 : b * 2048;
    u16* X = (u16*)(ws + W_S5);
    LAS u16* HT = (LAS u16*)lds + w * 32 * 136;
    const float dt = __expf(p.in[16][l * 32 + g]);
    bf16x8 breF[4], bimF[4]; float ar[4], ai[4], a8r[4], a8i[4];
#pragma unroll
    for (int pt = 0; pt < 4; ++pt) { const int pp = 16 * pt + fr; const size_t gp = (size_t)(l * 32 + g) * 64 + pp;
        const float lr = p.in[14][gp], li = p.in[15][gp];
        const float mag = __expf(lr * dt), ang = li * dt * 0.15915494309189535f;
        const float r_ = mag * __builtin_amdgcn_cosf(ang), i_ = mag * __builtin_amdgcn_sinf(ang);
        ar[pt] = r_; ai[pt] = i_;
        float xr = r_, xi = i_;
#pragma unroll
        for (int k = 0; k < 3; ++k) { const float nr2 = xr * xr - xi * xi, ni2 = 2.f * xr * xi; xr = nr2; xi = ni2; }
        a8r[pt] = xr; a8i[pt] = xi;
        const float den = lr * lr + li * li, nr = r_ - 1.f, ni = i_;
        const float kr = (nr * lr + ni * li) / den, ki = (ni * lr - nr * li) / den;
        float vr[8], vi[8];
#pragma unroll
        for (int j = 0; j < 8; ++j) { float br = 0.f, bi = 0.f; if (fq < 2) { br = p.in[17][gp * 16 + fq * 8 + j]; bi = p.in[18][gp * 16 + fq * 8 + j]; }
            vr[j] = kr * br - ki * bi; vi[j] = kr * bi + ki * br; }
        u32x4 wr_, wi_; wr_.x = pk2(vr[0], vr[1]); wr_.y = pk2(vr[2], vr[3]); wr_.z = pk2(vr[4], vr[5]); wr_.w = pk2(vr[6], vr[7]);
        wi_.x = pk2(vi[0], vi[1]); wi_.y = pk2(vi[2], vi[3]); wi_.z = pk2(vi[4], vi[5]); wi_.w = pk2(vi[6], vi[7]);
        breF[pt] = __builtin_bit_cast(bf16x8, wr_); bimF[pt] = __builtin_bit_cast(bf16x8, wi_); }
    bf16x8 cF[4];
#pragma unroll
    for (int ks = 0; ks < 4; ++ks) { float v[8]; const int k0 = 32 * ks + 8 * fq;
#pragma unroll
        for (int j = 0; j < 8; ++j) { const int k = k0 + j; v[j] = k < 64 ? p.in[19][((size_t)(l * 32 + g) * 16 + fr) * 64 + k] : -p.in[20][((size_t)(l * 32 + g) * 16 + fr) * 64 + k - 64]; }
        u32x4 wv; wv.x = pk2(v[0], v[1]); wv.y = pk2(v[2], v[3]); wv.z = pk2(v[4], v[5]); wv.w = pk2(v[6], v[7]); cF[ks] = __builtin_bit_cast(bf16x8, wv); }
    const f32x4 dsk = *(const f32x4*)(p.in[21] + l * 512 + g * 16 + 4 * fq);
    float Hr[4], Hi[4];
#pragma unroll
    for (int pt = 0; pt < 4; ++pt) { if (grp) { const size_t sp = ((size_t)(l * 8 + b) * 32 + g) * 64 + 16 * pt + fr; Hr[pt] = p.in[4][sp]; Hi[pt] = p.in[5][sp]; } else { Hr[pt] = 0.f; Hi[pt] = 0.f; } }
    const int trow = 8 * (fr >> 2) + (fr & 3);
    u32x4 xn[2];
#pragma unroll
    for (int tt = 0; tt < 2; ++tt) { xn[tt] = (u32x4){0u, 0u, 0u, 0u}; if (fq < 2) xn[tt] = *(const u32x4*)(X + (size_t)(rowbase + trow + 4 * tt) * 512 + g * 16 + fq * 8); }
    for (int ch = 0; ch < T / 32; ++ch) {
        const int r0 = rowbase + ch * 32;
        bf16x8 xF[2];
#pragma unroll
        for (int tt = 0; tt < 2; ++tt) xF[tt] = __builtin_bit_cast(bf16x8, xn[tt]);
        if (ch + 1 < T / 32) {
#pragma unroll
            for (int tt = 0; tt < 2; ++tt) if (fq < 2) xn[tt] = *(const u32x4*)(X + (size_t)(r0 + 32 + trow + 4 * tt) * 512 + g * 16 + fq * 8); }
        u32x2 xsk[2];
#pragma unroll
        for (int t2 = 0; t2 < 2; ++t2) xsk[t2] = *(const u32x2*)(X + (size_t)(r0 + 16 * t2 + fr) * 512 + g * 16 + 4 * fq);
        f32x4 bur[2][4], bui[2][4];
#pragma unroll
        for (int tt = 0; tt < 2; ++tt)
#pragma unroll
            for (int pt = 0; pt < 4; ++pt) { bur[tt][pt] = mfma16(xF[tt], breF[pt], (f32x4){0.f, 0.f, 0.f, 0.f}); bui[tt][pt] = mfma16(xF[tt], bimF[pt], (f32x4){0.f, 0.f, 0.f, 0.f}); }
#pragma unroll
        for (int pt = 0; pt < 4; ++pt) {
            float er = 0.f, ei = 0.f;
#pragma unroll
            for (int k = 0; k < 8; ++k) { const float ur = bur[k >> 2][pt][k & 3], ui = bui[k >> 2][pt][k & 3]; const float nr = ar[pt] * er - ai[pt] * ei + ur, ni = ar[pt] * ei + ai[pt] * er + ui; er = nr; ei = ni; }
            float cr = Hr[pt], ci = Hi[pt], mr = cr, mi = ci;
#pragma unroll
            for (int q = 0; q < 4; ++q) { const float Er = __shfl(er, fr + 16 * q), Ei = __shfl(ei, fr + 16 * q);
                const float nr = a8r[pt] * cr - a8i[pt] * ci + Er, ni = a8r[pt] * ci + a8i[pt] * cr + Ei; cr = nr; ci = ni;
                if (q + 1 == fq) { mr = cr; mi = ci; } }
            Hr[pt] = cr; Hi[pt] = ci;
            float hr = mr, hi = mi;
#pragma unroll
            for (int k = 0; k < 8; ++k) { const float ur = bur[k >> 2][pt][k & 3], ui = bui[k >> 2][pt][k & 3]; const float nr = ar[pt] * hr - ai[pt] * hi + ur, ni = ar[pt] * hi + ai[pt] * hr + ui; hr = nr; hi = ni;
                HT[(8 * fq + k) * 136 + 16 * pt + fr] = f2bf(hr); HT[(8 * fq + k) * 136 + 64 + 16 * pt + fr] = f2bf(hi); }
        }
        asm volatile("s_waitcnt lgkmcnt(0)" ::: "memory");
        f32x4 y[2];
#pragma unroll
        for (int t2 = 0; t2 < 2; ++t2) { y[t2] = (f32x4){0.f, 0.f, 0.f, 0.f};
#pragma unroll
            for (int ks = 0; ks < 4; ++ks) { const bf16x8 hf = *(const LAS bf16x8*)(HT + (16 * t2 + fr) * 136 + 32 * ks + 8 * fq); y[t2] = mfma16(cF[ks], hf, y[t2]); } }
#pragma unroll
        for (int t2 = 0; t2 < 2; ++t2) { u16* xp = X + (size_t)(r0 + 16 * t2 + fr) * 512 + g * 16 + 4 * fq; const u32x2 xx = xsk[t2];
            f32x4 xv; xv[0] = __uint_as_float(xx.x << 16); xv[1] = __uint_as_float(xx.x & 0xffff0000u); xv[2] = __uint_as_float(xx.y << 16); xv[3] = __uint_as_float(xx.y & 0xffff0000u);
            f32x4 z = y[t2] + dsk * xv;
#pragma unroll
            for (int e = 0; e < 4; ++e) z[e] = fgelu(z[e]);
            *(u32x2*)xp = pk4(z); }
        asm volatile("" ::: "memory");
    }
    if (fq == 0) { float* ore = p.out + (grp ? O_SRES + (size_t)l * 16384 + ((size_t)b * 32 + g) * 64 : O_SREP + (size_t)l * 32768 + ((size_t)b * 32 + g) * 64);
        float* oim = p.out + (grp ? O_SIMS + (size_t)l * 16384 + ((size_t)b * 32 + g) * 64 : O_SIMP + (size_t)l * 32768 + ((size_t)b * 32 + g) * 64);
#pragma unroll
        for (int pt = 0; pt < 4; ++pt) { ore[16 * pt + fr] = Hr[pt]; oim[16 * pt + fr] = Hi[pt]; } }
    __syncthreads();
}

DEV void gmlp_item(CP& p, int l, LAS unsigned char* lds, int grp, int b, int n, int g) {
    unsigned char* ws = p.ws;
    const int tid = tid_o(), w = tid >> 6, lane = tid & 63, fr = lane & 15, fq = lane >> 4;
    const int L = grp ? 64 : 128, T = grp ? 64 : 2048; const int rowbase = grp ? MTP + b * 64 : b * 2048 + n * 128;
    LAS u16* WT = (LAS u16*)lds; LAS u16* GT = WT + 128 * 136; LAS float* RS = (LAS float*)(GT + 128 * 136);
    const float* rowsq = (const float*)(ws + W_ROWSQ);
    if (tid < L) RS[tid] = __builtin_amdgcn_rsqf(rowsq[rowbase + tid] * (1.f / 512.f) + EPS);
    const u16* GV = (const u16*)(ws + W_GVT) + (grp ? (size_t)16 * 512 * 2048 : 0) + ((size_t)b * 512 + g * 128) * T + (grp ? 0 : n * 128);
    const int cpr = L / 8;
    for (int chn = tid; chn < 128 * cpr; chn += 512) { const int c = chn / cpr, kp = (chn % cpr) * 8; *(LAS u32x4*)(GT + c * 136 + kp) = *(const u32x4*)(GV + (size_t)c * T + kp); }
    __syncthreads();
    const float* wsrc = p.in[12] + (size_t)(l * 4 + g) * 128 * 128;
    for (int idx = tid; idx < L * L; idx += 512) { const int t = idx / L, s = idx % L; const float v = s <= t ? wsrc[t * 128 + s] * RS[s] : 0.f; WT[t * 136 + s] = f2bf(v); }
    __syncthreads();
    const f32x4 gvg = *(const f32x4*)(p.in[11] + l * 512 + g * 128 + 16 * w + 4 * fq);
    u16* P1 = (u16*)(ws + W_P1);
    for (int tt = 0; tt < L / 16; ++tt) { f32x4 a = (f32x4){0.f, 0.f, 0.f, 0.f};
        for (int ks = 0; ks < L / 32; ++ks) { if (32 * ks > 16 * tt + 15) break;
            const bf16x8 gf = *(const LAS bf16x8*)(GT + (16 * w + fr) * 136 + 32 * ks + 8 * fq), wf = *(const LAS bf16x8*)(WT + (16 * tt + fr) * 136 + 32 * ks + 8 * fq); a = mfma16(gf, wf, a); }
        const int t = 16 * tt + fr; const float bsv = p.in[13][(size_t)(l * 4 + g) * 128 + t];
        u16* up = P1 + (size_t)(rowbase + t) * 1024 + g * 128 + 16 * w + 4 * fq; const u32x2 uu = *(const u32x2*)up;
        f32x4 u; u[0] = __uint_as_float(uu.x << 16); u[1] = __uint_as_float(uu.x & 0xffff0000u); u[2] = __uint_as_float(uu.y << 16); u[3] = __uint_as_float(uu.y & 0xffff0000u);
        *(u32x2*)up = pk4(u * (a * gvg + bsv)); }
    if (grp) {
        float* o = p.out + O_GMV + (size_t)l * 262144 + (size_t)b * 64 * 512; const float* gg = p.in[11] + l * 512 + g * 128;
        for (int idx = tid; idx < 64 * 128; idx += 512) { const int t = idx >> 7, c = idx & 127; o[(size_t)t * 512 + g * 128 + c] = bf2f(GT[c * 136 + t]) * RS[t] * gg[c]; }
    }
    __syncthreads();
}

DEV void phaseMix(CP& p, int l, LAS unsigned char* lds) {
    unsigned* ctr = (unsigned*)(p.ws + W_MISC) + l;
    LAS int* slot = (LAS int*)(lds + 160 * 1024 - 16);
    for (;;) {
        if (tid_o() == 0) *slot = (int)atomicAdd(ctr, 1u);
        __syncthreads();
        int it = __builtin_amdgcn_readfirstlane(*slot);
        __syncthreads();
        if (it >= 2304) break;
        int kind, grp = 0, a0, a1, a2 = 0;
        if (it < 64) { kind = 0; a0 = it >> 2; a1 = it & 3; }
        else if (it < 128) { it -= 64; kind = 1; a0 = it >> 2; a1 = it & 3; }
        else if (it < 160) { it -= 128; kind = 2; grp = 1; a0 = it >> 2; a1 = it & 3; }
        else if (it < 1184) { it -= 160; kind = 2; a2 = 15 - (it >> 6); a0 = (it & 63) >> 2; a1 = it & 3; }
        else if (it < 2208) { it -= 1184; kind = 3; a0 = it >> 6; a2 = (it >> 2) & 15; a1 = it & 3; }
        else if (it < 2240) { it -= 2208; kind = 0; grp = 1; a0 = it >> 2; a1 = it & 3; }
        else if (it < 2272) { it -= 2240; kind = 1; grp = 1; a0 = it >> 2; a1 = it & 3; }
        else { it -= 2272; kind = 3; grp = 1; a0 = it >> 2; a1 = it & 3; }
        asm volatile("" : "+s"(kind), "+s"(grp), "+s"(a0), "+s"(a1), "+s"(a2));
        if (kind == 0) {
#ifndef NO_S5
            s5_item(p, l, lds, grp, a0, a1);
#endif
        } else if (kind == 1) {
#ifndef NO_GLA
#ifdef GLA_SAMPLE_ONLY
            if (grp)
#endif
            gla_item(p, l, lds, grp, a0, a1);
#endif
        } else if (kind == 2) {
#ifndef NO_ATT
            attn_item(p, l, lds, grp, a0, a1, a2);
#endif
        } else {
#ifndef NO_GMLP
            gmlp_item(p, l, lds, grp, a0, a2, a1);
#endif
        }
    }
}

DEV void phaseFix(CP& p, int l) {
    unsigned char* ws = p.ws; const int gt = bid_o() * 512 + tid_o(), GT = gridDim.x * 512;
    const float* HEAD = (const float*)(ws + W_HEAD); const float* TAIL = (const float*)(ws + W_TAIL); u16* ACT = (u16*)(ws + W_ACT);
    const float* cw = p.in[35] + (size_t)l * 3 * 5632; const float* cb = p.in[36] + (size_t)l * 5632;
    for (int idx = gt; idx < 520 * 2816; idx += GT) { const int slab = idx / 2816, f = idx % 2816;
        float c0[2], c1[2];
#pragma unroll
        for (int bj = 0; bj < 2; ++bj) { const int ff = bj * 2816 + f; float pm2 = 0.f, pm1 = 0.f;
            if (slab >= 512) { const float* st = p.in[7] + ((size_t)(l * 8 + (slab - 512)) * 2) * 5632; pm2 = st[ff]; pm1 = st[5632 + ff]; }
            else if (slab & 31) { pm2 = TAIL[((size_t)(slab - 1) * 2) * 5632 + ff]; pm1 = TAIL[((size_t)(slab - 1) * 2 + 1) * 5632 + ff]; }
            const float h0 = HEAD[((size_t)slab * 2) * 5632 + ff], h1 = HEAD[((size_t)slab * 2 + 1) * 5632 + ff];
            const float w0 = cw[ff], w1 = cw[5632 + ff], w2 = cw[11264 + ff], bb = cb[ff];
            c0[bj] = bb + w0 * pm2 + w1 * pm1 + w2 * h0; c1[bj] = bb + w0 * pm1 + w1 * h0 + w2 * h1; }
        ACT[(size_t)(slab * 64) * 2816 + f] = f2bf(fsilu(c0[0]) * c0[1]); ACT[(size_t)(slab * 64 + 1) * 2816 + f] = f2bf(fsilu(c1[0]) * c1[1]); }
    for (int idx = gt; idx < 24 * 2 * 5632; idx += GT) { const int bb = idx / 11264, rem = idx % 11264;
        if (bb < 16) p.out[O_FCP + (size_t)l * 180224 + (size_t)bb * 11264 + rem] = TAIL[((size_t)(bb * 32 + 31) * 2) * 5632 + rem];
        else p.out[O_FCS + (size_t)l * 90112 + (size_t)(bb - 16) * 11264 + rem] = TAIL[((size_t)(512 + bb - 16) * 2) * 5632 + rem]; }
}

#define XB_TMO      128
#define XB_XCNT(j)  (256  + 64 * (j))
#define XB_XSUB(j)  (1280 + 64 * (j))
#define XB_XGEN(j)  (2304 + 64 * (j))
#define XB_TOP      3328
#define XB_TOPGEN   3392
#define XCD_BAR_WORDS 3456
#define XB_SPIN_CAP (1u << 18)

__device__ __forceinline__ unsigned xb_ld(unsigned* p)              { return __hip_atomic_load(p, __ATOMIC_RELAXED, __HIP_MEMORY_SCOPE_AGENT); }
__device__ __forceinline__ unsigned xb_add(unsigned* p, unsigned v) { return __hip_atomic_fetch_add(p, v, __ATOMIC_RELAXED, __HIP_MEMORY_SCOPE_AGENT); }
__device__ __forceinline__ unsigned xb_xcc_id() { return (unsigned)__builtin_amdgcn_s_getreg((3 << 11) | 20) & 0xFu; }
#define XB_SPIN(cond, bar) do { unsigned _sp = 0; while (cond) { __builtin_amdgcn_s_sleep(1); \
    if ((++_sp & 255u) == 0u) { if (xb_ld(&(bar)[XB_TMO])) break; if (_sp > XB_SPIN_CAP) { atomicAdd(&(bar)[XB_TMO], 1u); break; } } } } while (0)

struct XcdBarrier {
    unsigned* bar; unsigned x;
    volatile LAS unsigned* st;
};

__device__ __forceinline__ XcdBarrier xcd_barrier_post(unsigned* bar, volatile LAS unsigned* st) {
    XcdBarrier b; b.bar = bar; b.x = xb_xcc_id(); b.st = st;
    if (threadIdx.x == 0) (void)xb_add(&bar[XB_XCNT(b.x)], 1u);
    return b;
}
__device__ __forceinline__ void xcd_barrier_complete(unsigned* bar, unsigned x, unsigned& nloc, unsigned& nx) {
    const unsigned G = gridDim.x * gridDim.y * gridDim.z;
    unsigned sum, cnt, mine, sp = 0u;
    for (;;) {
        sum = 0u; cnt = 0u; mine = 0u;
#pragma unroll
        for (unsigned j = 0; j < 16; ++j) { const unsigned c = xb_ld(&bar[XB_XCNT(j)]); sum += c; cnt += (c > 0u) ? 1u : 0u; mine = (j == x) ? c : mine; }
        if (sum == G) break;
        __builtin_amdgcn_s_sleep(1);
        if ((++sp & 255u) == 0u) { if (xb_ld(&bar[XB_TMO])) break; if (sp > XB_SPIN_CAP) { atomicAdd(&bar[XB_TMO], 1u); break; } }
    }
    nloc = mine > 0u ? mine : 1u; nx = cnt > 0u ? cnt : 1u;
}

__device__ __forceinline__ void xcd_barrier(const XcdBarrier& b) {
    asm volatile("s_waitcnt vmcnt(0)" ::: "memory");
    __syncthreads();
    if (threadIdx.x == 0) {
        unsigned* bar = b.bar;
        __builtin_amdgcn_s_waitcnt(0);
        unsigned nloc = b.st[0], nx = b.st[1];
        if (nloc == 0u) { xcd_barrier_complete(bar, b.x, nloc, nx); b.st[0] = nloc; b.st[1] = nx; }
        const unsigned old = xb_add(&bar[XB_XSUB(b.x)], 1u);
        const unsigned gen = old / nloc;
        if (old + 1u == (gen + 1u) * nloc) {
            __builtin_amdgcn_fence(__ATOMIC_RELEASE, "agent");
            asm volatile("s_waitcnt vmcnt(0)" ::: "memory");
            const unsigned og = xb_add(&bar[XB_TOP], 1u);
            const unsigned tg = og / nx;
            if (og + 1u == (tg + 1u) * nx) xb_add(&bar[XB_TOPGEN], 1u);
            else XB_SPIN(xb_ld(&bar[XB_TOPGEN]) == tg, bar);
            __builtin_amdgcn_fence(__ATOMIC_ACQUIRE, "agent");
            xb_add(&bar[XB_XGEN(b.x)], 1u);
            asm volatile("s_waitcnt vmcnt(0)" ::: "memory");
        } else {
            XB_SPIN(xb_ld(&bar[XB_XGEN(b.x)]) == gen, bar);
            __builtin_amdgcn_fence(__ATOMIC_ACQUIRE, "agent");
            asm volatile("s_waitcnt vmcnt(0)" ::: "memory");
        }
    }
    __syncthreads();
}


__global__ void __launch_bounds__(512, 2) mega(Params p_unused) {
    extern __shared__ __attribute__((aligned(16))) unsigned char smem[];
    LAS unsigned char* lds = (LAS unsigned char*)smem;
    cg::grid_group grid = cg::this_grid();
    volatile LAS unsigned* xb_st = (volatile LAS unsigned*)(lds + 160 * 1024 - 32);
    if (threadIdx.x == 0) { xb_st[0] = 0u; xb_st[1] = 0u; }
    __syncthreads();
    const XcdBarrier xbar = xcd_barrier_post((unsigned*)(((CP*)__builtin_amdgcn_kernarg_segment_ptr())->ws + W_BAR), xb_st);
#define GSYNC() xcd_barrier(xbar)
#pragma unroll 1
    for (int l = 0; l < 2; ++l) {
        CP* pp = (CP*)__builtin_amdgcn_kernarg_segment_ptr(); asm volatile("" : "+s"(pp)); CP& p = *pp; unsigned char* ws = p.ws; const int G = gridDim.x, c = bid_o();
#ifndef SKIP_A
        phaseA(p, l);
#endif
        if (l == 0) grid.sync(); else GSYNC();
#ifndef SKIP_B
        {
            pg8::PlainSched S; S.T.init(130, NMIX, G, c); S.A = (const char*)ws + W_H; S.B = (const char*)ws + W_WIN; S.ld = 1024; S.nt = 16;
            EpiIn E; E.l = l; E.out = p.out; E.ws = ws; E.qg = p.in[27] + l * 64; E.kg = p.in[28] + l * 64;
            pg8::gemm_phase(lds, 1024, S, E);
        }
#endif
        GSYNC();
#ifndef SKIP_C
        phaseMix(p, l, lds);
#endif
        GSYNC();
#ifndef SKIP_D
        {
            pg8::PlainSched S; S.T.init(130, 2, G, c); S.A = (const char*)ws + W_S5; S.B = (const char*)ws + W_WGLU; S.ld = 512; S.nt = 8;
            EpiGlu E; E.ws = ws; E.bias = p.in[23] + l * 512;
            pg8::gemm_phase(lds, 512, S, E);
        }
#endif
        GSYNC();
#ifndef SKIP_E
        {
            MergeSched S; S.T.init(128, 4, G, c); S.ws = ws;
            EpiMerge E; E.ws = ws; E.bgate = p.in[10] + l * 4096;
            pg8::gemm_phase(lds, 1024, S, E);
        }
#endif
        GSYNC();
        {
            const f32x4* mf = (const f32x4*)(ws + W_MFS); u16* mg = (u16*)(ws + W_MERGED) + (size_t)MTP * 1024;
            for (int i = c * 512 + tid_o(); i < 512 * 256; i += G * 512) *(u32x2*)(mg + (size_t)i * 4) = pk4(mf[i]);
        }
        GSYNC();
#ifndef SKIP_F
        {
            pg8::TailSched S; S.T.init(128, 4, G, c); S.A = (const char*)ws + W_MERGED; S.B = (const char*)ws + W_WOUT; S.ld = 1024; S.nt = 16; S.npiece = 4; S.ntp = 4;
            EpiRes E; E.xb = p.out; E.xin_p = l == 0 ? p.in[0] : nullptr; E.xin_s = l == 0 ? p.in[1] : nullptr;
            pg8::gemm_phase(lds, 1024, S, E);
        }
#endif
        GSYNC();
#ifndef SKIP_G
        norm_rows(p.out, p.out + (size_t)MTP * 1024, p.in[33] + l * 1024, (u16*)(ws + W_H));
#endif
        GSYNC();
#ifndef SKIP_H
        {
            pg8::PlainSched S; S.T.init(130, 22, G, c); S.A = (const char*)ws + W_H; S.B = (const char*)ws + W_WUP; S.ld = 1024; S.nt = 16;
            EpiUp E; E.ws = ws; E.cw = p.in[35] + (size_t)l * 3 * 5632; E.cbias = p.in[36] + (size_t)l * 5632;
            pg8::gemm_phase(lds, 1024, S, E);
        }
#endif
        GSYNC();
#ifndef SKIP_I
        phaseFix(p, l);
#endif
        GSYNC();
#ifndef SKIP_J
        {
            pg8::TailSched S; S.T.init(128, 4, G, c); S.A = (const char*)ws + W_ACT; S.B = (const char*)ws + W_WDN; S.ld = 2816; S.nt = 44; S.npiece = 11; S.ntp = 4;
            EpiRes E; E.xb = p.out; E.xin_p = nullptr; E.xin_s = nullptr;
            pg8::gemm_phase(lds, 2816, S, E);
        }
#endif
        GSYNC();
    }
}

extern "C" void kernel_launch(void* const* d_in, const int* in_sizes, int n_in, void* d_out, int out_size, void* d_ws, size_t ws_size, hipStream_t stream) {
    constexpr int LDS_BYTES = 160 * 1024;
    static int grid_blocks = 0;
    if (!grid_blocks) {
        int dev = 0, cus = 0, per_cu = 0;
        hipGetDevice(&dev);
        hipDeviceGetAttribute(&cus, hipDeviceAttributeMultiprocessorCount, dev);
        hipFuncSetAttribute((const void*)mega, hipFuncAttributeMaxDynamicSharedMemorySize, LDS_BYTES);
        hipOccupancyMaxActiveBlocksPerMultiprocessor(&per_cu, (const void*)mega, 512, LDS_BYTES);
        if (per_cu < 1) per_cu = 1;
        grid_blocks = cus * per_cu;
        if (ws_size < W_END) fprintf(stderr, "kernel_launch: workspace too small: %zu < %zu\n", ws_size, (size_t)W_END);
    }
    Params p{};
    for (int i = 0; i < 38; ++i) p.in[i] = (const float*)d_in[i];
    p.out = (float*)d_out; p.ws = (unsigned char*)d_ws;
    (void)hipMemsetAsync((unsigned char*)d_ws + W_BAR, 0, 16384, stream);
    void* args[] = {&p};
    hipError_t e = hipLaunchCooperativeKernel((const void*)mega, dim3(grid_blocks), dim3(512), args, LDS_BYTES, stream);
    if (e != hipSuccess) fprintf(stderr, "cooperative launch failed: %s (grid %d)\n", hipGetErrorString(e), grid_blocks);
}
```

```cpp
#include <hip/hip_runtime.h>
#include <hip/hip_cooperative_groups.h>
#include <cstdio>
namespace cg = cooperative_groups;

#define LAS __attribute__((address_space(3)))
#define DEV __device__ __forceinline__
typedef unsigned short u16;
typedef short bf16x8 __attribute__((ext_vector_type(8)));
typedef float f32x4 __attribute__((ext_vector_type(4)));
typedef float f32x2 __attribute__((ext_vector_type(2)));
typedef unsigned u32x4 __attribute__((ext_vector_type(4)));
typedef unsigned u32x2 __attribute__((ext_vector_type(2)));

constexpr int MTP = 32768, MT = 33280;
constexpr int NINP = 8960;
constexpr int NMIX = 19;
constexpr int GATE0 = 4864;
constexpr float EPS = 1e-6f;
constexpr float LOG2E = 1.4426950408889634f;

constexpr size_t O_Y = 0, O_DKP = 34078720, O_DVP = 67633152, O_SREP = 101187584, O_SIMP = 101253120, O_GLAP = 101318656,
                 O_FCP = 102367232, O_DKS = 102727680, O_DVS = 103251968, O_SRES = 103776256, O_SIMS = 103809024, O_GLAS = 103841792,
                 O_FCS = 104366080, O_GMV = 104546304;

constexpr size_t SZ_H = (size_t)MT * 1024 * 2;
constexpr size_t SZ_HALF = (size_t)MT * 512 * 2;
constexpr size_t W_H = 0;
constexpr size_t W_P1 = W_H + SZ_H;
constexpr size_t W_P2 = W_P1 + SZ_H;
constexpr size_t W_S5 = W_P2 + SZ_H;
constexpr size_t W_GVT = W_S5 + SZ_HALF;
constexpr size_t W_CQ = W_GVT + SZ_HALF;
constexpr size_t W_CK = W_CQ + SZ_HALF / 2;
constexpr size_t W_CVT = W_CK + SZ_HALF / 2;
constexpr size_t W_CODE = W_CVT + SZ_HALF;
constexpr size_t W_DKP = W_CODE + (size_t)MT * 16 * 4;
constexpr size_t W_DKS = W_DKP + (size_t)MTP * 512 * 2;
constexpr size_t W_DVTP = W_DKS + (size_t)8 * 4160 * 512 * 2;
constexpr size_t W_DVTS = W_DVTP + (size_t)MTP * 512 * 2;
constexpr size_t W_ROWSQ = W_DVTS + (size_t)8 * 4160 * 512 * 2;
constexpr size_t W_MISC = W_ROWSQ + (size_t)MT * 4;
constexpr size_t W_WIN = W_MISC + 4096;
constexpr size_t W_WBR = W_WIN + (size_t)NINP * 1024 * 2;
constexpr size_t W_WOUT = W_WBR + (size_t)2 * 1024 * 1024 * 2;
constexpr size_t W_WGLU = W_WOUT + (size_t)1024 * 1024 * 2;
constexpr size_t W_WUP = W_WGLU + (size_t)512 * 512 * 2;
constexpr size_t W_WDN = W_WUP + (size_t)5632 * 1024 * 2;
constexpr size_t W_MFS = W_WDN + (size_t)1024 * 2816 * 2;
constexpr size_t W_BAR = W_MFS + (size_t)512 * 1024 * 4;
constexpr size_t W_WM = W_BAR + 16384;
constexpr size_t W_END = W_WM + (size_t)4 * 128 * 128 * 2;
constexpr size_t W_MERGED = W_CQ;
constexpr size_t W_SCR = W_DKP;
constexpr size_t W_ACT = W_P1;
constexpr size_t W_HEAD = W_DVTP;
constexpr size_t W_TAIL = W_HEAD + (size_t)520 * 2 * 5632 * 4;
static_assert(W_TAIL + (size_t)520 * 2 * 5632 * 4 <= W_ROWSQ, "head/tail alias");
static_assert((size_t)MT * 2816 * 2 <= W_CQ - W_P1, "act alias");

struct Params { const float* in[38]; float* out; unsigned char* ws; };
typedef const __attribute__((address_space(4))) Params CP;

DEV int tid_o() { int t = threadIdx.x; asm volatile("" : "+v"(t)); return t; }
DEV int bid_o() { int t = blockIdx.x; asm volatile("" : "+s"(t)); return t; }
DEV float bf2f(u16 v) { return __uint_as_float(((unsigned)v) << 16); }
typedef __bf16 b16x2 __attribute__((ext_vector_type(2)));
DEV unsigned pk2(float lo, float hi) { const f32x2 v = {lo, hi}; const b16x2 r = __builtin_convertvector(v, b16x2); return __builtin_bit_cast(unsigned, r); }
DEV u16 f2bf(float v) { return (u16)(pk2(v, 0.f) & 0xffffu); }
DEV float fsigmoid(float x) { return __builtin_amdgcn_rcpf(1.f + __expf(-x)); }
DEV float fsilu(float x) { return x * fsigmoid(x); }
DEV float fgelu(float x) { return x * fsigmoid(1.5957691216057308f * (x + 0.044715f * x * x * x)); }
DEV float flogsig(float x) { return fminf(x, 0.f) - __logf(1.f + __expf(-fabsf(x))); }
DEV f32x4 mfma16(bf16x8 a, bf16x8 b, f32x4 c) { return __builtin_amdgcn_mfma_f32_16x16x32_bf16(a, b, c, 0, 0, 0); }
DEV u32x2 pk4(f32x4 v) { u32x2 r; r.x = pk2(v[0], v[1]); r.y = pk2(v[2], v[3]); return r; }
DEV float red_fq(float v) { v += __shfl_xor(v, 16); v += __shfl_xor(v, 32); return v; }
DEV float wave_sum(float v) { for (int o = 32; o; o >>= 1) v += __shfl_xor(v, o); return v; }

namespace pg8 {
constexpr int BM = 256, BK = 64, HALF = 128, HTB = HALF * BK * 2, NXCD = 8, WGM = 8;
DEV int lds_byte(int r, int c) { const int st = (r >> 4) * 2 + (c >> 5), rr = r & 15, cc = c & 31, ob = rr * 64 + cc * 2; return st * 1024 + (ob ^ (((ob >> 9) & 1) << 5)); }
DEV void stage_rc(int b, int& R, int& C) { const int st = b / 1024, sb = b % 1024, swz = sb ^ (((sb >> 9) & 1) << 5); R = (st >> 1) * 16 + swz / 64; C = (st & 1) * 32 + (swz % 64) / 2; }
struct GUnit { const char* A; const char* B; int nt, pm, pn, kind; };
struct TileOrder {
    int nM, nN, nwg, G, c;
    DEV void init(int nM_, int nN_, int G_, int c_) { nM = nM_; nN = nN_; nwg = nM * nN; G = G_; c = c_; }
    DEV bool tile(int i, int& pm, int& pn) const {
        const long L = (long)i * G + c; if (L >= nwg) return false;
        int wgid = (int)L; { const int q = nwg / NXCD, r = nwg % NXCD, xcd = wgid % NXCD, off = wgid / NXCD; wgid = (xcd < r ? xcd * (q + 1) : r * (q + 1) + (xcd - r) * q) + off; }
        const int nig = WGM * nN, gid = wgid / nig, fm = gid * WGM, gsz = (nM - fm) < WGM ? (nM - fm) : WGM;
        pm = fm + ((wgid % nig) % gsz); pn = (wgid % nig) / gsz; return true;
    }
};
struct TailSched {
    TileOrder T; const char* A; const char* B; int ld, nt, npiece, ntp;
    DEV bool next(int i, GUnit& u) const { int pm, pn;
        if (T.tile(i, pm, pn)) { u.pm = pm; u.pn = pn; u.kind = 0; u.nt = nt; u.A = A + (size_t)pm * 256 * ld * 2; u.B = B + (size_t)pn * 256 * ld * 2; return true; }
        const int i0 = (T.nwg - T.c + T.G - 1) / T.G; const int j = (i - i0) * T.G + T.c; if (j >= 8 * npiece) return false;
        const int tile = j / npiece, kp = j % npiece; pm = 128 + (tile >> 2); pn = tile & 3; u.pm = pm; u.pn = pn; u.kind = 1; u.nt = ntp;
        u.A = A + (size_t)pm * 256 * ld * 2 + (size_t)kp * ntp * 128; u.B = B + (size_t)pn * 256 * ld * 2 + (size_t)kp * ntp * 128; return true; }
};
struct PlainSched {
    TileOrder T; const char* A; const char* B; int ld, nt;
    DEV bool next(int i, GUnit& u) const { int pm, pn; if (!T.tile(i, pm, pn)) return false; u.pm = pm; u.pn = pn; u.kind = 0; u.nt = nt;
        u.A = A + (size_t)pm * 256 * ld * 2; u.B = B + (size_t)pn * 256 * ld * 2; return true; }
};

template <class Epi, class Sched>
DEV void gemm_phase(LAS unsigned char* lds, const int ld, const Sched& S, const Epi& E) {
    const int tid = tid_o(), wid = __builtin_amdgcn_readfirstlane(tid >> 6), lane = tid & 63, wr = wid >> 2, wc = wid & 3, fr = lane & 15, fq = lane >> 4;
    unsigned voff[2];
#pragma unroll
    for (int i = 0; i < 2; ++i) { int R, C; stage_rc(tid * 16 + i * 8192, R, C); voff[i] = (unsigned)(R * ld + C) * 2u; }
    const size_t kstep = (size_t)(BK * 2);
    const size_t hstep = (size_t)HALF * ld * 2;
    const unsigned ldsw = (unsigned)wid * 1024u;
    const int aoff = lds_byte(wr * 64 + fr, fq * 8), boff = lds_byte(wc * 32 + fr, fq * 8);
#define PG8_SA(b, h) (((b) * 2 + (h)) * HTB)
#define PG8_SB(b, h) ((4 + (b) * 2 + (h)) * HTB)
#define PG8_STAGE(bufoff, gbase) do { _Pragma("unroll") for (int _i = 0; _i < 2; ++_i) \
        __builtin_amdgcn_global_load_lds((const unsigned*)((const char*)(gbase) + voff[_i]), (LAS unsigned*)(lds + (bufoff) + ldsw + _i * 8192), 16, 0, 0); } while (0)
#define PG8_LDA(dst, b, h) do { _Pragma("unroll") for (int m = 0; m < 4; ++m) _Pragma("unroll") for (int k = 0; k < 2; ++k) dst[m][k] = *(const LAS bf16x8*)(lds + PG8_SA(b, h) + aoff + m * 2048 + k * 1024); } while (0)
#define PG8_LDB(dst, b, h) do { _Pragma("unroll") for (int n = 0; n < 2; ++n) _Pragma("unroll") for (int k = 0; k < 2; ++k) dst[n][k] = *(const LAS bf16x8*)(lds + PG8_SB(b, h) + boff + n * 2048 + k * 1024); } while (0)
#define PG8_MMA(ai, bj, At, Bt) do { __builtin_amdgcn_s_setprio(1); _Pragma("unroll") for (int m = 0; m < 4; ++m) _Pragma("unroll") for (int n = 0; n < 2; ++n) _Pragma("unroll") for (int k = 0; k < 2; ++k) \
        acc[ai][bj][m][n] = __builtin_amdgcn_mfma_f32_16x16x32_bf16(Bt[n][k], At[m][k], acc[ai][bj][m][n], 0, 0, 0); __builtin_amdgcn_s_setprio(0); } while (0)
#define PG8_WAIT_V(n) asm volatile("s_waitcnt vmcnt(" #n ")" ::: "memory")
#define PG8_WAIT_L(n) asm volatile("s_waitcnt lgkmcnt(" #n ")" ::: "memory")
#define PG8_BAR __builtin_amdgcn_s_barrier()
#define PG8_SCHED __builtin_amdgcn_sched_barrier(0)
    GUnit cur, nxt; int ui = 0;
    if (!S.next(0, cur)) return;
    f32x4 acc[2][2][4][2];
#pragma unroll
    for (int a = 0; a < 2; ++a)
#pragma unroll
        for (int b = 0; b < 2; ++b)
#pragma unroll
            for (int m = 0; m < 4; ++m)
#pragma unroll
                for (int n = 0; n < 2; ++n) acc[a][b][m][n] = (f32x4){0.f, 0.f, 0.f, 0.f};
    bf16x8 At[4][2], B0[2][2], B1[2][2];
    const char* cA = cur.A; const char* cB = cur.B;
    PG8_STAGE(PG8_SB(0, 0), cB); PG8_STAGE(PG8_SA(0, 0), cA); PG8_STAGE(PG8_SB(0, 1), cB + hstep); PG8_STAGE(PG8_SA(0, 1), cA + hstep);
    if (wr == 1) PG8_BAR;
    PG8_WAIT_V(4); PG8_BAR;
    PG8_STAGE(PG8_SB(1, 0), cB + kstep); PG8_STAGE(PG8_SA(1, 0), cA + kstep); PG8_STAGE(PG8_SB(1, 1), cB + hstep + kstep);
    PG8_WAIT_V(6); PG8_BAR;
    for (;;) {
        const bool has_next = S.next(ui + 1, nxt);
        const char* nA = has_next ? nxt.A : cA; const char* nB = has_next ? nxt.B : cB;
        const int nt = cur.nt;
        for (int t = 0; t < nt; t += 2) {
            const bool last = (t == nt - 2);
            const char* a1 = cA + (size_t)(t + 1) * kstep;
            const char* a2 = last ? nA : cA + (size_t)(t + 2) * kstep; const char* b2 = last ? nB : cB + (size_t)(t + 2) * kstep;
            const char* a3 = a2 + kstep; const char* b3 = b2 + kstep;
            PG8_LDB(B0, 0, 0); PG8_SCHED; PG8_LDA(At, 0, 0); PG8_STAGE(PG8_SA(1, 1), a1 + hstep);
            PG8_WAIT_L(8); PG8_BAR; PG8_WAIT_L(0); PG8_MMA(0, 0, At, B0); PG8_BAR; PG8_SCHED;
            PG8_LDB(B1, 0, 1); PG8_STAGE(PG8_SB(0, 0), b2);
            PG8_BAR; PG8_WAIT_L(0); PG8_MMA(0, 1, At, B1); PG8_BAR;
            PG8_LDA(At, 0, 1); PG8_STAGE(PG8_SA(0, 0), a2);
            PG8_BAR; PG8_WAIT_L(0); PG8_MMA(1, 0, At, B0); PG8_BAR; PG8_SCHED;
            PG8_STAGE(PG8_SB(0, 1), b2 + hstep);
            PG8_WAIT_V(6); PG8_BAR; PG8_MMA(1, 1, At, B1); PG8_BAR;
            PG8_LDB(B0, 1, 0); PG8_SCHED; PG8_LDA(At, 1, 0); PG8_STAGE(PG8_SA(0, 1), a2 + hstep);
            PG8_WAIT_L(8); PG8_BAR; PG8_WAIT_L(0); PG8_MMA(0, 0, At, B0); PG8_BAR; PG8_SCHED;
            PG8_LDB(B1, 1, 1); PG8_STAGE(PG8_SB(1, 0), b3);
            PG8_BAR; PG8_WAIT_L(0); PG8_MMA(0, 1, At, B1); PG8_BAR;
            PG8_LDA(At, 1, 1); PG8_STAGE(PG8_SA(1, 0), a3);
            PG8_BAR; PG8_WAIT_L(0); PG8_MMA(1, 0, At, B0); PG8_BAR; PG8_SCHED;
            PG8_STAGE(PG8_SB(1, 1), b3 + hstep);
            PG8_WAIT_V(6); PG8_BAR; PG8_MMA(1, 1, At, B1); PG8_BAR;
        }
        { int fr_ = fr, fq_ = fq, wr_ = wr, wc_ = wc; asm volatile("" : "+v"(fr_), "+v"(fq_), "+s"(wr_), "+s"(wc_));
          E(acc, cur, wr_, wc_, fr_, fq_); }
        if (!has_next) break;
#pragma unroll
        for (int a = 0; a < 2; ++a)
#pragma unroll
            for (int b = 0; b < 2; ++b)
#pragma unroll
                for (int m = 0; m < 4; ++m)
#pragma unroll
                    for (int n = 0; n < 2; ++n) acc[a][b][m][n] = (f32x4){0.f, 0.f, 0.f, 0.f};
        cur = nxt; cA = nA; cB = nB; ++ui;
    }
    PG8_WAIT_V(0);
    if (wr == 0) PG8_BAR;
    PG8_BAR;
#undef PG8_SA
#undef PG8_SB
#undef PG8_STAGE
#undef PG8_LDA
#undef PG8_LDB
#undef PG8_MMA
#undef PG8_WAIT_V
#undef PG8_WAIT_L
#undef PG8_BAR
#undef PG8_SCHED
}
}
using pg8::GUnit;
typedef f32x4 AccT[2][2][4][2];

#define FOR_AM _Pragma("unroll") for (int ai = 0; ai < 2; ++ai) _Pragma("unroll") for (int m = 0; m < 4; ++m)
#define FOR_BN _Pragma("unroll") for (int bj = 0; bj < 2; ++bj) _Pragma("unroll") for (int n = 0; n < 2; ++n)

struct EpiIn {
    int l; float* out; unsigned char* ws; const float* qg; const float* kg;
    DEV void operator()(const AccT& acc, const GUnit& u, int wr, int wc, int fr, int fq) const {
        const int pn = u.pn; const bool smp = u.pm >= 128;
        const int rowb = u.pm * 256 + wr * 64 + fr;
        const int ct0 = wc * 32 + 4 * fq;
        u16* P1 = (u16*)(ws + W_P1); u16* P2 = (u16*)(ws + W_P2);
        if (pn < 2) {
            FOR_AM { const int row = rowb + ai * 128 + m * 16; FOR_BN { f32x4 v = acc[ai][bj][m][n];
                for (int e = 0; e < 4; ++e) v[e] = fgelu(v[e]);
                *(u32x2*)(P1 + (size_t)row * 1024 + pn * 256 + ct0 + bj * 128 + n * 16) = pk4(v); } }
        } else if (pn < 4 || pn == 8 || pn == 9 || pn == 16 || pn == 17) {
            const int kind = pn < 4 ? 0 : (pn < 10 ? 1 : 2);
            const int cseg = (pn & 1) * 256;
            u16* dstT; int T, toff = 0;
            if (kind == 0) { dstT = (u16*)(ws + W_GVT) + (smp ? (size_t)16 * 512 * 2048 : 0); T = smp ? 64 : 2048; }
            else if (kind == 1) { dstT = (u16*)(ws + W_CVT) + (smp ? (size_t)16 * 512 * 2048 : 0); T = smp ? 64 : 2048; }
            else { dstT = (u16*)(ws + (smp ? W_DVTS : W_DVTP)); T = smp ? 4160 : 2048; toff = smp ? 4096 : 0; }
            float* rowsq = (float*)(ws + W_ROWSQ);
            FOR_AM { const int row = rowb + ai * 128 + m * 16;
                int b, t; if (smp) { const int rs = row - MTP; b = rs >> 6; t = rs & 63; } else { b = row >> 11; t = row & 2047; }
                float ss = 0.f;
                FOR_BN { f32x4 v = acc[ai][bj][m][n]; const int cc = cseg + ct0 + bj * 128 + n * 16;
                    if (kind == 0) { for (int e = 0; e < 4; ++e) { v[e] = fgelu(v[e]); ss += v[e] * v[e]; } }
                    if (kind == 2) { float* o = smp ? out + O_DVS + (size_t)l * 262144 + (size_t)(row - MTP) * 512 + cc : out + O_DVP + (size_t)l * 16777216 + (size_t)row * 512 + cc;
                        *(f32x4*)o = v; }
                    for (int e = 0; e < 4; ++e) dstT[((size_t)b * 512 + cc + e) * T + toff + t] = f2bf(v[e]); }
                if (kind == 0) { ss = red_fq(ss); if (fq == 0) atomicAdd(rowsq + row, ss); } }
        } else if (pn < 6) {
            u16* S5 = (u16*)(ws + W_S5);
            FOR_AM { const int row = rowb + ai * 128 + m * 16; FOR_BN {
                *(u32x2*)(S5 + (size_t)row * 512 + (pn - 4) * 256 + ct0 + bj * 128 + n * 16) = pk4(acc[ai][bj][m][n]); } }
        } else if (pn < 8) {
            u16* D = (u16*)(ws + (pn == 6 ? W_CQ : W_CK)); const float sc = pn == 6 ? 0.125f : 1.f;
            FOR_AM { const int row = rowb + ai * 128 + m * 16; FOR_BN {
                *(u32x2*)(D + (size_t)row * 256 + ct0 + bj * 128 + n * 16) = pk4(acc[ai][bj][m][n] * sc); } }
        } else if (pn < 12) {
            FOR_AM { const int row = rowb + ai * 128 + m * 16; FOR_BN { f32x4 v = acc[ai][bj][m][n];
                for (int e = 0; e < 4; ++e) v[e] = fsilu(v[e]);
                *(u32x2*)(P2 + (size_t)row * 1024 + (pn - 10) * 256 + ct0 + bj * 128 + n * 16) = pk4(v); } }
        } else if (pn < 16) {
            const bool isq = pn < 14; const int hh = 4 * (pn & 1) + wc; const float* g = isq ? qg : kg;
            f32x4 gv[2][2];
            FOR_BN gv[bj][n] = *(const f32x4*)(g + 32 * bj + 16 * n + 4 * fq);
            FOR_AM { const int row = rowb + ai * 128 + m * 16;
                float ss = 0.f;
                FOR_BN { const f32x4 v = acc[ai][bj][m][n]; ss += v[0] * v[0] + v[1] * v[1] + v[2] * v[2] + v[3] * v[3]; }
                ss = red_fq(ss);
                float rs = __builtin_amdgcn_rsqf(ss * (1.f / 64.f) + EPS);
                if (isq) { rs *= 0.125f * LOG2E;
                    FOR_BN { *(u32x2*)(P2 + (size_t)row * 1024 + 512 + hh * 64 + 32 * bj + 16 * n + 4 * fq) = pk4(acc[ai][bj][m][n] * rs * gv[bj][n]); }
                } else {
                    float* o; u16* kb;
                    if (smp) { const int rs_ = row - MTP; o = out + O_DKS + (size_t)l * 262144 + (size_t)rs_ * 512; kb = (u16*)(ws + W_DKS) + ((size_t)(rs_ >> 6) * 4160 + 4096 + (rs_ & 63)) * 512; }
                    else { o = out + O_DKP + (size_t)l * 16777216 + (size_t)row * 512; kb = (u16*)(ws + W_DKP) + (size_t)row * 512; }
                    FOR_BN { const f32x4 v = acc[ai][bj][m][n] * rs * gv[bj][n]; const int d = hh * 64 + 32 * bj + 16 * n + 4 * fq;
                        *(f32x4*)(o + d) = v; *(u32x2*)(kb + d) = pk4(v); } } }
        } else {
            if (wc == 0) { float* C = (float*)(ws + W_CODE);
                FOR_AM { const int row = rowb + ai * 128 + m * 16; *(f32x4*)(C + (size_t)row * 16 + 4 * fq) = acc[ai][0][m][0]; } }
        }
    }
};

struct EpiGlu {
    unsigned char* ws; const float* bias;
    DEV void operator()(const AccT& acc, const GUnit& u, int wr, int wc, int fr, int fq) const {
        const u16* Z = (const u16*)(ws + W_S5); u16* P1 = (u16*)(ws + W_P1);
        const int rowb = u.pm * 256 + wr * 64 + fr, cb = u.pn * 256 + wc * 32 + 4 * fq;
        FOR_AM { const int row = rowb + ai * 128 + m * 16; FOR_BN { const int col = cb + bj * 128 + n * 16;
            const f32x4 bv = *(const f32x4*)(bias + col); const u32x2 zz = *(const u32x2*)(Z + (size_t)row * 512 + col);
            f32x4 z; z[0] = __uint_as_float(zz.x << 16); z[1] = __uint_as_float(zz.x & 0xffff0000u); z[2] = __uint_as_float(zz.y << 16); z[3] = __uint_as_float(zz.y & 0xffff0000u);
            f32x4 v = acc[ai][bj][m][n] + bv;
            for (int e = 0; e < 4; ++e) v[e] = z[e] * fsigmoid(v[e]);
            *(u32x2*)(P1 + (size_t)row * 1024 + 512 + col) = pk4(v); } }
    }
};

struct MergeSched {
    pg8::TileOrder T; unsigned char* ws;
    DEV void fill(GUnit& u, int pm, int pn, int b, int sub) const {
        u.pm = pm; u.pn = pn;
        if (sub) { u.nt = 16; u.A = (const char*)ws + W_H + (size_t)pm * 256 * 2048; u.B = (const char*)ws + W_WIN + (size_t)(GATE0 + b * 1024 + pn * 256) * 2048; }
        else { u.nt = 8; u.A = (const char*)ws + (b < 2 ? W_P1 : W_P2) + (size_t)pm * 256 * 2048 + (b & 1) * 1024;
               u.B = (const char*)ws + W_WBR + (size_t)(b >> 1) * 1024 * 2048 + (size_t)pn * 256 * 2048 + (b & 1) * 1024; }
    }
    DEV bool next(int i, GUnit& u) const {
        int pm, pn;
        if (T.tile(i >> 3, pm, pn)) { const int s = i & 7; u.kind = s; fill(u, pm, pn, s >> 1, s & 1); return true; }
        const int i0 = (T.nwg - T.c + T.G - 1) / T.G; const int jj = i - 8 * i0; const int job = (jj >> 1) * T.G + T.c; if (job >= 32) return false;
        const int tile = job >> 2, b = job & 3; u.kind = 8 + 2 * b + (jj & 1); fill(u, 128 + (tile >> 2), tile & 3, b, jj & 1); return true;
    }
};
struct EpiMerge {
    unsigned char* ws; const float* bgate;
    DEV void operator()(const AccT& acc, const GUnit& u, int wr, int wc, int fr, int fq) const {
        u32x4* sT = (u32x4*)(ws + W_SCR) + (size_t)bid_o() * 16 * 512 + tid_o();
        u32x4* sS = (u32x4*)(ws + W_SCR + (size_t)32 * 1024 * 1024) + (size_t)bid_o() * 16 * 512 + tid_o();
        const int s = u.kind & 7, b = s >> 1; const bool smp = u.kind >= 8;
        if (!(s & 1)) {
#pragma unroll
            for (int q = 0; q < 16; ++q) { const int ai = q >> 3, bj = (q >> 2) & 1, m = q & 3; const u32x2 lo = pk4(acc[ai][bj][m][0]), hi = pk4(acc[ai][bj][m][1]);
                u32x4 w; w.x = lo.x; w.y = lo.y; w.z = hi.x; w.w = hi.y; sT[q * 512] = w; }
        } else {
            u16* MG = (u16*)(ws + W_MERGED);
            const int rowb = u.pm * 256 + wr * 64 + fr, cb = u.pn * 256 + wc * 32 + 4 * fq;
#pragma unroll
            for (int q = 0; q < 16; ++q) { const int ai = q >> 3, bj = (q >> 2) & 1, m = q & 3; __builtin_amdgcn_sched_barrier(0);
                const u32x4 tw = sT[q * 512]; u32x4 sw = (u32x4){0u, 0u, 0u, 0u}; if (b > 0 && !smp) sw = sS[q * 512];
                const unsigned tws[4] = {tw.x, tw.y, tw.z, tw.w}; const unsigned sws[4] = {sw.x, sw.y, sw.z, sw.w};
                f32x4 r[2];
#pragma unroll
                for (int n = 0; n < 2; ++n) { const int col = cb + bj * 128 + n * 16; const f32x4 bv = *(const f32x4*)(bgate + b * 1024 + col);
                    f32x4 v = acc[ai][bj][m][n] + bv;
#pragma unroll
                    for (int e = 0; e < 4; ++e) { const unsigned tt = tws[n * 2 + (e >> 1)], st = sws[n * 2 + (e >> 1)];
                        const float tv = (e & 1) ? __uint_as_float(tt & 0xffff0000u) : __uint_as_float(tt << 16);
                        const float sv = (e & 1) ? __uint_as_float(st & 0xffff0000u) : __uint_as_float(st << 16);
                        v[e] = fsigmoid(v[e]) * tv + sv; }
                    r[n] = v; }
                if (smp) { float* mf = (float*)(ws + W_MFS) + (size_t)(rowb + ai * 128 + m * 16 - MTP) * 1024 + cb + bj * 128;
#pragma unroll
                    for (int n = 0; n < 2; ++n)
#pragma unroll
                        for (int e = 0; e < 4; ++e) atomicAdd(mf + n * 16 + e, r[n][e]); }
                else if (b < 3) { const u32x2 lo = pk4(r[0]), hi = pk4(r[1]); u32x4 w; w.x = lo.x; w.y = lo.y; w.z = hi.x; w.w = hi.y; sS[q * 512] = w; }
                else { const int row = rowb + ai * 128 + m * 16;
#pragma unroll
                    for (int n = 0; n < 2; ++n) *(u32x2*)(MG + (size_t)row * 1024 + cb + bj * 128 + n * 16) = pk4(r[n]); } }
        }
    }
};

struct EpiRes {
    float* xb; const float* xin_p; const float* xin_s;
    DEV void operator()(const AccT& acc, const GUnit& u, int wr, int wc, int fr, int fq) const {
        const int rowb = u.pm * 256 + wr * 64 + fr, cb = u.pn * 256 + wc * 32 + 4 * fq;
        if (u.kind == 1) {
            FOR_AM { const int row = rowb + ai * 128 + m * 16; FOR_BN { float* d = xb + (size_t)row * 1024 + cb + bj * 128 + n * 16;
#pragma unroll
                for (int e = 0; e < 4; ++e) atomicAdd(d + e, acc[ai][bj][m][n][e]); } }
            return; }
        FOR_AM { const int row = rowb + ai * 128 + m * 16;
            const float* src = xin_p ? (row < MTP ? xin_p + (size_t)row * 1024 : xin_s + (size_t)(row - MTP) * 1024) : xb + (size_t)row * 1024;
            FOR_BN { const int col = cb + bj * 128 + n * 16; *(f32x4*)(xb + (size_t)row * 1024 + col) = *(const f32x4*)(src + col) + acc[ai][bj][m][n]; } }
    }
};

DEV float dpp_prev1(float cur, float prevm) {
    const int o = __builtin_amdgcn_update_dpp(0, __float_as_int(prevm), 0x121, 0xf, 0xf, false);
    return __int_as_float(__builtin_amdgcn_update_dpp(o, __float_as_int(cur), 0x111, 0xf, 0xf, false));
}
DEV float dpp_prev2(float cur, float prevm) {
    const int o = __builtin_amdgcn_update_dpp(0, __float_as_int(prevm), 0x122, 0xf, 0xf, false);
    return __int_as_float(__builtin_amdgcn_update_dpp(o, __float_as_int(cur), 0x112, 0xf, 0xf, false));
}
struct EpiUp {
    unsigned char* ws; const float* cw; const float* cbias;
    DEV void operator()(const AccT& acc, const GUnit& u, int wr, int wc, int fr, int fq) const {
        u16* ACT = (u16*)(ws + W_ACT); float* HEAD = (float*)(ws + W_HEAD); float* TAIL = (float*)(ws + W_TAIL);
        const int f0 = u.pn * 128 + wc * 32 + 4 * fq;
#pragma unroll
        for (int ai = 0; ai < 2; ++ai) {
            const int slab = u.pm * 4 + ai * 2 + wr;
#pragma unroll
            for (int n = 0; n < 2; ++n) { const int f = f0 + n * 16;
                f32x4 w0[2], w1[2], w2[2], bb[2];
#pragma unroll
                for (int bj = 0; bj < 2; ++bj) { const int ff = bj * 2816 + f; w0[bj] = *(const f32x4*)(cw + ff); w1[bj] = *(const f32x4*)(cw + 5632 + ff); w2[bj] = *(const f32x4*)(cw + 11264 + ff); bb[bj] = *(const f32x4*)(cbias + ff); }
#pragma unroll
                for (int m = 0; m < 4; ++m) {
                    f32x4 c[2];
#pragma unroll
                    for (int bj = 0; bj < 2; ++bj) { const f32x4 cur = acc[ai][bj][m][n]; const f32x4 pm_ = acc[ai][bj][m ? m - 1 : 0][n];
#pragma unroll
                        for (int e = 0; e < 4; ++e) { const float p1 = dpp_prev1(cur[e], pm_[e]), p2 = dpp_prev2(cur[e], pm_[e]);
                            c[bj][e] = bb[bj][e] + w2[bj][e] * cur[e] + w1[bj][e] * p1 + w0[bj][e] * p2; } }
                    if (m > 0 || fr >= 2) { f32x4 a; for (int e = 0; e < 4; ++e) a[e] = fsilu(c[0][e]) * c[1][e];
                        *(u32x2*)(ACT + (size_t)(slab * 64 + m * 16 + fr) * 2816 + f) = pk4(a); }
                    if (m == 0 && fr < 2) { for (int bj = 0; bj < 2; ++bj) *(f32x4*)(HEAD + ((size_t)slab * 2 + fr) * 5632 + bj * 2816 + f) = acc[ai][bj][0][n]; }
                    if (m == 3 && fr >= 14) { for (int bj = 0; bj < 2; ++bj) *(f32x4*)(TAIL + ((size_t)slab * 2 + fr - 14) * 5632 + bj * 2816 + f) = acc[ai][bj][3][n]; }
                } } }
    }
};

template <int MAP> DEV int src_col(int j) {
    if (MAP == 0) return j;
    if (MAP == 1) {
        const int tile = j >> 8, tc = j & 255;
        if (tile < 10) return j;
        if (tile < 12) return j + 16;
        if (tile < 16) { const int perm = ((tc >> 5) & 3) * 64 + (tc >> 7) * 32 + (tc & 31); return (tile < 14 ? 3088 : 3600) + (tile & 1) * 256 + perm; }
        if (tile < 18) return j + 16;
        if (tile == 18) return tc < 16 ? 2560 + tc : -1;
        return 4624 + (j - GATE0);
    }
    { const int q = j >> 8, tc = j & 255; return tc < 128 ? 128 * q + tc : 2816 + 128 * q + (tc - 128); }
}
template <int MAP> DEV void conv_T(u16* dst, int dst_ld, int K, int Nd, const float* src, int src_ld, int gt, int GT) {
    const int total = Nd * (K >> 3);
    for (int idx = gt; idx < total; idx += GT) { const int j = idx % Nd, kb = idx / Nd; const int sc = src_col<MAP>(j);
        float v[8];
#pragma unroll
        for (int i = 0; i < 8; ++i) v[i] = sc >= 0 ? src[(size_t)(kb * 8 + i) * src_ld + sc] : 0.f;
        u32x4 w; w.x = pk2(v[0], v[1]); w.y = pk2(v[2], v[3]); w.z = pk2(v[4], v[5]); w.w = pk2(v[6], v[7]);
        *(u32x4*)(dst + (size_t)j * dst_ld + kb * 8) = w; }
}
DEV void norm_rows(const float* xp, const float* xs, const float* g, u16* H) {
    const int tid = tid_o(); const int lane = tid & 63; const int gw = bid_o() * 8 + (tid >> 6), GW = gridDim.x * 8;
    f32x4 gv[4];
#pragma unroll
    for (int i = 0; i < 4; ++i) gv[i] = *(const f32x4*)(g + (lane + 64 * i) * 4);
    for (int row = gw; row < MT; row += GW) {
        const float* src = row < MTP ? xp + (size_t)row * 1024 : xs + (size_t)(row - MTP) * 1024;
        f32x4 v[4]; float ss = 0.f;
#pragma unroll
        for (int i = 0; i < 4; ++i) { v[i] = *(const f32x4*)(src + (lane + 64 * i) * 4); ss += v[i][0] * v[i][0] + v[i][1] * v[i][1] + v[i][2] * v[i][2] + v[i][3] * v[i][3]; }
        ss = wave_sum(ss); const float rs = __builtin_amdgcn_rsqf(ss * (1.f / 1024.f) + EPS);
#pragma unroll
        for (int i = 0; i < 4; ++i) *(u32x2*)(H + (size_t)row * 1024 + (lane + 64 * i) * 4) = pk4(v[i] * rs * gv[i]);
    }
}

DEV void phaseA(CP& p, int l) {
    unsigned char* ws = p.ws;
    const int gt = bid_o() * 512 + tid_o(), GT = gridDim.x * 512;
    conv_T<1>((u16*)(ws + W_WIN), 1024, 1024, NINP, p.in[9] + (size_t)l * 1024 * 8720, 8720, gt, GT);
    for (int b = 0; b < 4; ++b) conv_T<0>((u16*)(ws + W_WBR) + (size_t)(b >> 1) * 1024 * 1024 + (b & 1) * 512, 1024, 512, 1024, p.in[31] + (size_t)(l * 4 + b) * 512 * 1024, 1024, gt, GT);
    conv_T<0>((u16*)(ws + W_WOUT), 1024, 1024, 1024, p.in[32] + (size_t)l * 1024 * 1024, 1024, gt, GT);
    conv_T<0>((u16*)(ws + W_WGLU), 512, 512, 512, p.in[22] + (size_t)l * 512 * 512, 512, gt, GT);
    conv_T<2>((u16*)(ws + W_WUP), 1024, 1024, 5632, p.in[34] + (size_t)l * 1024 * 5632, 5632, gt, GT);
    conv_T<0>((u16*)(ws + W_WDN), 2816, 2816, 1024, p.in[37] + (size_t)l * 2816 * 1024, 1024, gt, GT);
    for (int b = 0; b < 8; ++b) conv_T<0>((u16*)(ws + W_DVTS) + (size_t)b * 512 * 4160, 4160, 4096, 512, p.in[3] + ((size_t)(l * 8 + b) * 4096) * 512, 512, gt, GT);
    {
        const float* ck = p.in[2] + (size_t)l * 8 * 4096 * 512; u16* dk = (u16*)(ws + W_DKS);
        for (int idx = gt; idx < 8 * 4096 * 64; idx += GT) { const int b = idx >> 18, rem = idx & 262143, key = rem >> 6, c8 = (rem & 63) * 8;
            const f32x4 a = *(const f32x4*)(ck + ((size_t)(b * 4096 + key)) * 512 + c8), c = *(const f32x4*)(ck + ((size_t)(b * 4096 + key)) * 512 + c8 + 4);
            u32x4 w; w.x = pk2(a[0], a[1]); w.y = pk2(a[2], a[3]); w.z = pk2(c[0], c[1]); w.w = pk2(c[2], c[3]);
            *(u32x4*)(dk + ((size_t)b * 4160 + key) * 512 + c8) = w; }
    }
    { float* rq = (float*)(ws + W_ROWSQ); for (int i = gt; i < MT; i += GT) rq[i] = 0.f; }
    { const float* wsp = p.in[12] + (size_t)l * 4 * 128 * 128; u16* wm = (u16*)(ws + W_WM); for (int i = gt; i < 4 * 128 * 128; i += GT) { const int t = (i >> 7) & 127, s2 = i & 127; wm[i] = f2bf(s2 <= t ? wsp[i] : 0.f); } }
    { f32x4* mf = (f32x4*)(ws + W_MFS); for (int i = gt; i < 512 * 256; i += GT) mf[i] = (f32x4){0.f, 0.f, 0.f, 0.f}; }
    if (l == 0) { const f32x4* xs = (const f32x4*)p.in[1]; f32x4* xo = (f32x4*)(p.out + (size_t)MTP * 1024); for (int i = gt; i < 512 * 256; i += GT) xo[i] = xs[i]; }
    if (gt == 0) {
        unsigned* misc = (unsigned*)(ws + W_MISC); misc[l] = 0u;
        const float* dl = p.in[29] + l * 256; float s1 = 0.f, s2 = 0.f;
        for (int i = 0; i < 64; ++i) { s1 += dl[i] * dl[64 + i]; s2 += dl[128 + i] * dl[192 + i]; }
        const float lam_init = 0.8f - 0.6f * expf(-0.3f * (float)l);
        ((float*)misc)[8 + 2 * l] = expf(s1) - expf(s2) + lam_init; ((float*)misc)[9 + 2 * l] = lam_init;
    }
    if (l == 0) norm_rows(p.in[0], p.in[1], p.in[8], (u16*)(ws + W_H));
    else norm_rows(p.out, p.out + (size_t)MTP * 1024, p.in[8] + 1024, (u16*)(ws + W_H));
}

DEV void attn_item(CP& p, int l, LAS unsigned char* lds, int grp, int b, int h, int qp) {
    unsigned char* ws = p.ws;
    const int tid = tid_o(), w = tid >> 6, lane = tid & 63, fr = lane & 15, fq = lane >> 4, c = w >> 2, qs = w & 3;
    const int Tk = grp ? 4160 : 2048, nkv = grp ? 65 : 2 * qp + 2;
    const int nact = grp ? (qs < 2 ? 65 : 0) : (qs < 2 ? nkv - 1 : nkv);
    const int rowbase = grp ? MTP + b * 64 : b * 2048 + qp * 128;
    const u16* Kb = grp ? (const u16*)(ws + W_DKS) + (size_t)b * 4160 * 512 : (const u16*)(ws + W_DKP) + (size_t)b * 2048 * 512;
    const u16* Vb = grp ? (const u16*)(ws + W_DVTS) + ((size_t)b * 512 + h * 128) * 4160 : (const u16*)(ws + W_DVTP) + ((size_t)b * 512 + h * 128) * 2048;
    u16* P2 = (u16*)(ws + W_P2);
    bf16x8 qf[2][2];
    if (nact > 0) {
#pragma unroll
        for (int r = 0; r < 2; ++r)
#pragma unroll
            for (int kk = 0; kk < 2; ++kk) qf[r][kk] = *(const bf16x8*)(P2 + (size_t)(rowbase + 32 * qs + 16 * r + fr) * 1024 + 512 + h * 128 + c * 64 + kk * 32 + fq * 8);
    } else {
#pragma unroll
        for (int r = 0; r < 2; ++r)
#pragma unroll
            for (int kk = 0; kk < 2; ++kk) qf[r][kk] = (bf16x8){0, 0, 0, 0, 0, 0, 0, 0};
    }
    constexpr int STG = 36864;
    int gK[2], lK[2], gV[2], lV[2];
#pragma unroll
    for (int i = 0; i < 2; ++i) { const int ch = tid + 512 * i; const int key = ch >> 4, part = ch & 15; gK[i] = key * 512 + h * 128 + part * 8; lK[i] = (((part >> 3) * 64 + key) * 72 + (part & 7) * 8) * 2;
        const int v = ch >> 3, kp = (ch & 7) * 8; gV[i] = v * Tk + kp; lV[i] = (128 * 72 + v * 72 + kp) * 2; }
    u32x4 rk[2], rv[2];
#pragma unroll
    for (int i = 0; i < 2; ++i) { rk[i] = *(const u32x4*)(Kb + gK[i]); rv[i] = *(const u32x4*)(Vb + gV[i]); }
#pragma unroll
    for (int i = 0; i < 2; ++i) { *(LAS u32x4*)(lds + lK[i]) = rk[i]; *(LAS u32x4*)(lds + lV[i]) = rv[i]; }
    __syncthreads();
    f32x4 O[2][8];
#pragma unroll
    for (int r = 0; r < 2; ++r)
#pragma unroll
        for (int i = 0; i < 8; ++i) O[r][i] = (f32x4){0.f, 0.f, 0.f, 0.f};
    float mrun[2] = {-1e30f, -1e30f}, lrun[2] = {0.f, 0.f};
    for (int kt = 0; kt < nkv; ++kt) {
        const bool more = kt + 1 < nkv;
        if (more) { const size_t k0 = (size_t)(kt + 1) * 64;
#pragma unroll
            for (int i = 0; i < 2; ++i) { rk[i] = *(const u32x4*)(Kb + k0 * 512 + gK[i]); rv[i] = *(const u32x4*)(Vb + k0 + gV[i]); } }
        if (kt < nact) {
            LAS unsigned char* st = lds + (kt & 1) * STG;
            f32x4 s[2][4];
#pragma unroll
            for (int jt = 0; jt < 4; ++jt) { s[0][jt] = (f32x4){0.f, 0.f, 0.f, 0.f}; s[1][jt] = (f32x4){0.f, 0.f, 0.f, 0.f};
#pragma unroll
                for (int kk = 0; kk < 2; ++kk) { const bf16x8 kf = *(const LAS bf16x8*)(st + ((c * 64 + 16 * jt + fr) * 72 + kk * 32 + fq * 8) * 2);
                    s[0][jt] = mfma16(kf, qf[0][kk], s[0][jt]); s[1][jt] = mfma16(kf, qf[1][kk], s[1][jt]); } }
            bf16x8 pf[2][2];
#pragma unroll
            for (int r = 0; r < 2; ++r) {
                float mt = s[r][0][0];
#pragma unroll
                for (int jt = 0; jt < 4; ++jt)
#pragma unroll
                    for (int e = 0; e < 4; ++e) mt = fmaxf(mt, s[r][jt][e]);
                mt = fmaxf(mt, __shfl_xor(mt, 16)); mt = fmaxf(mt, __shfl_xor(mt, 32));
                const float mnew = fmaxf(mrun[r], mt), alpha = __builtin_amdgcn_exp2f(mrun[r] - mnew); mrun[r] = mnew;
                float ps = 0.f;
#pragma unroll
                for (int jt = 0; jt < 4; ++jt)
#pragma unroll
                    for (int e = 0; e < 4; ++e) { s[r][jt][e] = __builtin_amdgcn_exp2f(s[r][jt][e] - mnew); ps += s[r][jt][e]; }
                lrun[r] = lrun[r] * alpha + ps;
#pragma unroll
                for (int i = 0; i < 8; ++i) O[r][i] *= alpha;
#pragma unroll
                for (int t = 0; t < 2; ++t) { const u32x2 lo = pk4(s[r][2 * t]), hi = pk4(s[r][2 * t + 1]); u32x4 wv; wv.x = lo.x; wv.y = lo.y; wv.z = hi.x; wv.w = hi.y; pf[r][t] = __builtin_bit_cast(bf16x8, wv); }
            }
#pragma unroll
            for (int vt = 0; vt < 8; ++vt)
#pragma unroll
                for (int t = 0; t < 2; ++t) { const LAS unsigned char* vp = st + (128 * 72 + (16 * vt + fr) * 72 + 32 * t + 4 * fq) * 2;
                    const u32x2 a = *(const LAS u32x2*)vp, bq = *(const LAS u32x2*)(vp + 32); u32x4 wv; wv.x = a.x; wv.y = a.y; wv.z = bq.x; wv.w = bq.y;
                    const bf16x8 vf = __builtin_bit_cast(bf16x8, wv);
                    O[0][vt] = mfma16(vf, pf[0][t], O[0][vt]); O[1][vt] = mfma16(vf, pf[1][t], O[1][vt]); }
        }
        if (more) { LAS unsigned char* nx = lds + ((kt + 1) & 1) * STG;
#pragma unroll
            for (int i = 0; i < 2; ++i) { *(LAS u32x4*)(nx + lK[i]) = rk[i]; *(LAS u32x4*)(nx + lV[i]) = rv[i]; } }
        __syncthreads();
    }
    const float lam = ((const float*)(ws + W_MISC))[8 + 2 * l], lam_init = ((const float*)(ws + W_MISC))[9 + 2 * l];
    LAS float* X = (LAS float*)lds;
    float inv[2];
#pragma unroll
    for (int r = 0; r < 2; ++r) inv[r] = __builtin_amdgcn_rcpf(fmaxf(red_fq(lrun[r]), 1e-30f));
    if (c == 1) {
#pragma unroll
        for (int r = 0; r < 2; ++r)
#pragma unroll
            for (int vt = 0; vt < 8; ++vt)
#pragma unroll
                for (int e = 0; e < 4; ++e) X[(qs * 64 + r * 32 + vt * 4 + e) * 64 + lane] = O[r][vt][e] * inv[r] * lam;
    }
    __syncthreads();
    if (c == 0 && nact > 0) {
        const float* g = p.in[30] + l * 128;
#pragma unroll
        for (int r = 0; r < 2; ++r) { float ss = 0.f;
#pragma unroll
            for (int vt = 0; vt < 8; ++vt)
#pragma unroll
                for (int e = 0; e < 4; ++e) { const float d = O[r][vt][e] * inv[r] - X[(qs * 64 + r * 32 + vt * 4 + e) * 64 + lane]; O[r][vt][e] = d; ss += d * d; }
            ss = red_fq(ss); const float rs = __builtin_amdgcn_rsqf(ss * (1.f / 128.f) + EPS) * (1.f - lam_init);
#pragma unroll
            for (int vt = 0; vt < 8; ++vt) { const f32x4 gv = *(const f32x4*)(g + 16 * vt + 4 * fq);
                *(u32x2*)(P2 + (size_t)(rowbase + 32 * qs + 16 * r + fr) * 1024 + 512 + h * 128 + 16 * vt + 4 * fq) = pk4(O[r][vt] * rs * gv); } }
    }
    __syncthreads();
}

DEV void gla_item(CP& p, int l, LAS unsigned char* lds, int grp, int b, int h) {
    unsigned char* ws = p.ws;
    const int tid = tid_o(), w = tid >> 6, lane = tid & 63, fr = lane & 15, fq = lane >> 4;
    const int T = grp ? 64 : 2048, nch = grp ? 1 : 32; const int rowbase = grp ? MTP + b * 64 : b * 2048;
    const u16* CQ = (const u16*)(ws + W_CQ); const u16* CK = (const u16*)(ws + W_CK); const float* CODE = (const float*)(ws + W_CODE);
    const u16* VT = (const u16*)(ws + W_CVT) + (grp ? (size_t)16 * 512 * 2048 : 0) + ((size_t)b * 512 + h * 128) * T;
    u16* P2 = (u16*)(ws + W_P2);
    LAS u16* QE = (LAS u16*)lds; LAS u16* KE = QE + 64 * 72; LAS u16* KDT = KE + 64 * 72; LAS u16* VTl = KDT + 64 * 72;
    LAS u16* PP = VTl + 128 * 72; LAS u16* STb = PP + 64 * 72;
    LAS float* OT = (LAS float*)(STb + 8 * 16 * 72); LAS float* SEG = OT + 64 * 132; LAS float* DEC = SEG + 8 * 64;
    LAS u16* QR = (LAS u16*)(DEC + 64); LAS u16* KR = QR + 64 * 72; LAS float* CD = (LAS float*)(KR + 64 * 72);
    const int d_ = tid & 63, seg = tid >> 6;
    float wa[16];
#pragma unroll
    for (int r = 0; r < 16; ++r) wa[r] = p.in[24][(size_t)l * 16 * 256 + r * 256 + h * 64 + d_];
    const float ba = p.in[25][l * 256 + h * 64 + d_];
    f32x4 S[4];
    if (grp) { const float* s0 = p.in[6] + ((size_t)(l * 8 + b) * 4 + h) * 64 * 128;
#pragma unroll
        for (int dt = 0; dt < 4; ++dt) S[dt] = *(const f32x4*)(s0 + (size_t)(16 * dt + fr) * 128 + 16 * w + 4 * fq); }
    else {
#pragma unroll
        for (int dt = 0; dt < 4; ++dt) S[dt] = (f32x4){0.f, 0.f, 0.f, 0.f}; }
#pragma unroll
    for (int dt = 0; dt < 4; ++dt)
#pragma unroll
        for (int e = 0; e < 4; ++e) STb[(w * 16 + 4 * fq + e) * 72 + 16 * dt + fr] = f2bf(S[dt][e]);
    const float* gng = p.in[26] + l * 128;
    const int tl = tid >> 3, d8 = (tid & 7) * 8;
    u32x4 rq, rkk, rvv[2]; f32x2 rcd;
    {
        rq = *(const u32x4*)(CQ + (size_t)(rowbase + tl) * 256 + h * 64 + d8); rkk = *(const u32x4*)(CK + (size_t)(rowbase + tl) * 256 + h * 64 + d8);
        rcd = *(const f32x2*)(CODE + (size_t)(rowbase + tl) * 16 + (tid & 7) * 2);
#pragma unroll
        for (int i = 0; i < 2; ++i) { const int chn = tid + 512 * i, v = chn >> 3, kp = (chn & 7) * 8; rvv[i] = *(const u32x4*)(VT + (size_t)v * T + kp); }
    }
    for (int ch = 0; ch < nch; ++ch) {
        const int r0 = rowbase + ch * 64;
        *(LAS u32x4*)(QR + tl * 72 + d8) = rq; *(LAS u32x4*)(KR + tl * 72 + d8) = rkk; *(LAS f32x2*)(CD + tl * 16 + (tid & 7) * 2) = rcd;
#pragma unroll
        for (int i = 0; i < 2; ++i) { const int chn = tid + 512 * i, v = chn >> 3, kp = (chn & 7) * 8; *(LAS u32x4*)(VTl + v * 72 + kp) = rvv[i]; }
        if (ch + 1 < nch) { const int r1 = r0 + 64;
            rq = *(const u32x4*)(CQ + (size_t)(r1 + tl) * 256 + h * 64 + d8); rkk = *(const u32x4*)(CK + (size_t)(r1 + tl) * 256 + h * 64 + d8);
            rcd = *(const f32x2*)(CODE + (size_t)(r1 + tl) * 16 + (tid & 7) * 2);
#pragma unroll
            for (int i = 0; i < 2; ++i) { const int chn = tid + 512 * i, v = chn >> 3, kp = (chn & 7) * 8; rvv[i] = *(const u32x4*)(VT + (size_t)v * T + (ch + 1) * 64 + kp); } }
        u16* yp = P2 + (size_t)(r0 + tl) * 1024 + h * 128 + (tid & 7) * 16;
        const u32x4 rr0 = *(const u32x4*)yp, rr1 = *(const u32x4*)(yp + 8);
        __syncthreads();
        float bl[8]; float run = 0.f;
#pragma unroll
        for (int i = 0; i < 8; ++i) { const LAS float* cp = CD + (seg * 8 + i) * 16; float a = ba;
#pragma unroll
            for (int r = 0; r < 16; ++r) a += cp[r] * wa[r];
            run += flogsig(a) * (1.f / 16.f); bl[i] = run; }
        SEG[seg * 64 + d_] = run;
        __syncthreads();
        float off = 0.f, tot = 0.f;
#pragma unroll
        for (int s2 = 0; s2 < 8; ++s2) { const float x = SEG[s2 * 64 + d_]; tot += x; if (s2 < seg) off += x; }
        if (seg == 0) DEC[d_] = __expf(tot);
        { float kd[8];
#pragma unroll
          for (int i = 0; i < 8; ++i) { const int t = seg * 8 + i; const float bb = bl[i] + off;
              const float q = bf2f(QR[t * 72 + d_]), k = bf2f(KR[t * 72 + d_]);
              QE[t * 72 + d_] = f2bf(q * __expf(bb)); KE[t * 72 + d_] = f2bf(k * __expf(-bb)); kd[i] = k * __expf(tot - bb); }
          u32x4 wv; wv.x = pk2(kd[0], kd[1]); wv.y = pk2(kd[2], kd[3]); wv.z = pk2(kd[4], kd[5]); wv.w = pk2(kd[6], kd[7]);
          *(LAS u32x4*)(KDT + d_ * 72 + seg * 8) = wv; }
        __syncthreads();
#pragma unroll
        for (int r = 0; r < 2; ++r) { const int ti = w + 8 * r, jt = ti >> 2, it = ti & 3; f32x4 a = (f32x4){0.f, 0.f, 0.f, 0.f};
            if (jt <= it) {
#pragma unroll
                for (int kk = 0; kk < 2; ++kk) { const bf16x8 kf = *(const LAS bf16x8*)(KE + (16 * jt + fr) * 72 + kk * 32 + fq * 8), qf = *(const LAS bf16x8*)(QE + (16 * it + fr) * 72 + kk * 32 + fq * 8); a = mfma16(kf, qf, a); }
#pragma unroll
                for (int e = 0; e < 4; ++e) if (16 * jt + 4 * fq + e > 16 * it + fr) a[e] = 0.f;
            }
            *(LAS u32x2*)(PP + (16 * it + fr) * 72 + 16 * jt + 4 * fq) = pk4(a); }
        __syncthreads();
        bf16x8 vf[2], sf[2];
#pragma unroll
        for (int t = 0; t < 2; ++t) { vf[t] = *(const LAS bf16x8*)(VTl + (16 * w + fr) * 72 + 32 * t + 8 * fq); sf[t] = *(const LAS bf16x8*)(STb + (w * 16 + fr) * 72 + 32 * t + 8 * fq); }
#pragma unroll
        for (int it = 0; it < 4; ++it) { f32x4 a = (f32x4){0.f, 0.f, 0.f, 0.f};
#pragma unroll
            for (int t = 0; t < 2; ++t) { const bf16x8 pf = *(const LAS bf16x8*)(PP + (16 * it + fr) * 72 + 32 * t + 8 * fq), qf = *(const LAS bf16x8*)(QE + (16 * it + fr) * 72 + 32 * t + 8 * fq);
                a = mfma16(vf[t], pf, a); a = mfma16(sf[t], qf, a); }
            *(LAS f32x4*)(OT + (16 * it + fr) * 132 + 16 * w + 4 * fq) = a; }
#pragma unroll
        for (int dt = 0; dt < 4; ++dt) { S[dt] *= DEC[16 * dt + fr];
#pragma unroll
            for (int t = 0; t < 2; ++t) { const bf16x8 kf = *(const LAS bf16x8*)(KDT + (16 * dt + fr) * 72 + 32 * t + 8 * fq); S[dt] = mfma16(vf[t], kf, S[dt]); }
#pragma unroll
            for (int e = 0; e < 4; ++e) STb[(w * 16 + 4 * fq + e) * 72 + 16 * dt + fr] = f2bf(S[dt][e]); }
        __syncthreads();
        {
            const int i = tid >> 3, vs = tid & 7; f32x4 o[4]; float ss = 0.f;
#pragma unroll
            for (int k = 0; k < 4; ++k) { o[k] = *(const LAS f32x4*)(OT + i * 132 + vs * 16 + 4 * k); ss += o[k][0] * o[k][0] + o[k][1] * o[k][1] + o[k][2] * o[k][2] + o[k][3] * o[k][3]; }
            ss += __shfl_xor(ss, 1); ss += __shfl_xor(ss, 2); ss += __shfl_xor(ss, 4);
            const float rs = __builtin_amdgcn_rsqf(ss * (1.f / 128.f) + EPS);
            const unsigned rw[8] = {rr0.x, rr0.y, rr0.z, rr0.w, rr1.x, rr1.y, rr1.z, rr1.w};
#pragma unroll
            for (int k = 0; k < 4; ++k) { const f32x4 gv = *(const f32x4*)(gng + vs * 16 + 4 * k);
                f32x4 r; r[0] = __uint_as_float(rw[2 * k] << 16); r[1] = __uint_as_float(rw[2 * k] & 0xffff0000u); r[2] = __uint_as_float(rw[2 * k + 1] << 16); r[3] = __uint_as_float(rw[2 * k + 1] & 0xffff0000u);
                *(u32x2*)(yp + 4 * k) = pk4(o[k] * rs * gv * r); }
        }
    }
    float* so = p.out + (grp ? O_GLAS + (size_t)l * 262144 + ((size_t)b * 4 + h) * 8192 : O_GLAP + (size_t)l * 524288 + ((size_t)b * 4 + h) * 8192);
#pragma unroll
    for (int dt = 0; dt < 4; ++dt) *(f32x4*)(so + (size_t)(16 * dt + fr) * 128 + 16 * w + 4 * fq) = S[dt];
    __syncthreads();
}

DEV void s5_item(CP& p, int l, LAS unsigned char* lds, int grp, int b, int gq) {
    unsigned char* ws = p.ws;
    const int tid = tid_o(), w = tid >> 6, lane = tid & 63, fr = lane & 15, fq = lane >> 4;
    const int g = gq * 8 + w; const int T = grp ? 64 : 2048; const int rowbase = grp ? MTP + b * 64 : b * 2048;
    u16* X = (u16*)(ws + W_S5);
    LAS u16* HT = (LAS u16*)lds + w * 32 * 136;
    const float dt = __expf(p.in[16][l * 32 + g]);
    bf16x8 breF[4], bimF[4]; float ar[4], ai[4], a8r[4], a8i[4];
#pragma unroll
    for (int pt = 0; pt < 4; ++pt) { const int pp = 16 * pt + fr; const size_t gp = (size_t)(l * 32 + g) * 64 + pp;
        const float lr = p.in[14][gp], li = p.in[15][gp];
        const float mag = __expf(lr * dt), ang = li * dt * 0.15915494309189535f;
        const float r_ = mag * __builtin_amdgcn_cosf(ang), i_ = mag * __builtin_amdgcn_sinf(ang);
        ar[pt] = r_; ai[pt] = i_;
        float xr = r_, xi = i_;
#pragma unroll
        for (int k = 0; k < 3; ++k) { const float nr2 = xr * xr - xi * xi, ni2 = 2.f * xr * xi; xr = nr2; xi = ni2; }
        a8r[pt] = xr; a8i[pt] = xi;
        const float den = lr * lr + li * li, nr = r_ - 1.f, ni = i_;
        const float kr = (nr * lr + ni * li) / den, ki = (ni * lr - nr * li) / den;
        float vr[8], vi[8];
#pragma unroll
        for (int j = 0; j < 8; ++j) { float br = 0.f, bi = 0.f; if (fq < 2) { br = p.in[17][gp * 16 + fq * 8 + j]; bi = p.in[18][gp * 16 + fq * 8 + j]; }
            vr[j] = kr * br - ki * bi; vi[j] = kr * bi + ki * br; }
        u32x4 wr_, wi_; wr_.x = pk2(vr[0], vr[1]); wr_.y = pk2(vr[2], vr[3]); wr_.z = pk2(vr[4], vr[5]); wr_.w = pk2(vr[6], vr[7]);
        wi_.x = pk2(vi[0], vi[1]); wi_.y = pk2(vi[2], vi[3]); wi_.z = pk2(vi[4], vi[5]); wi_.w = pk2(vi[6], vi[7]);
        breF[pt] = __builtin_bit_cast(bf16x8, wr_); bimF[pt] = __builtin_bit_cast(bf16x8, wi_); }
    bf16x8 cF[4];
#pragma unroll
    for (int ks = 0; ks < 4; ++ks) { float v[8]; const int k0 = 32 * ks + 8 * fq;
#pragma unroll
        for (int j = 0; j < 8; ++j) { const int k = k0 + j; v[j] = k < 64 ? p.in[19][((size_t)(l * 32 + g) * 16 + fr) * 64 + k] : -p.in[20][((size_t)(l * 32 + g) * 16 + fr) * 64 + k - 64]; }
        u32x4 wv; wv.x = pk2(v[0], v[1]); wv.y = pk2(v[2], v[3]); wv.z = pk2(v[4], v[5]); wv.w = pk2(v[6], v[7]); cF[ks] = __builtin_bit_cast(bf16x8, wv); }
    const f32x4 dsk = *(const f32x4*)(p.in[21] + l * 512 + g * 16 + 4 * fq);
    float Hr[4], Hi[4];
#pragma unroll
    for (int pt = 0; pt < 4; ++pt) { if (grp) { const size_t sp = ((size_t)(l * 8 + b) * 32 + g) * 64 + 16 * pt + fr; Hr[pt] = p.in[4][sp]; Hi[pt] = p.in[5][sp]; } else { Hr[pt] = 0.f; Hi[pt] = 0.f; } }
    const int trow = 8 * (fr >> 2) + (fr & 3);
    u32x4 xn[2];
#pragma unroll
    for (int tt = 0; tt < 2; ++tt) { xn[tt] = (u32x4){0u, 0u, 0u, 0u}; if (fq < 2) xn[tt] = *(const u32x4*)(X + (size_t)(rowbase + trow + 4 * tt) * 512 + g * 16 + fq * 8); }
    for (int ch = 0; ch < T / 32; ++ch) {
        const int r0 = rowbase + ch * 32;
        bf16x8 xF[2];
#pragma unroll
        for (int tt = 0; tt < 2; ++tt) xF[tt] = __builtin_bit_cast(bf16x8, xn[tt]);
        if (ch + 1 < T / 32) {
#pragma unroll
            for (int tt = 0; tt < 2; ++tt) if (fq < 2) xn[tt] = *(const u32x4*)(X + (size_t)(r0 + 32 + trow + 4 * tt) * 512 + g * 16 + fq * 8); }
        u32x2 xsk[2];
#pragma unroll
        for (int t2 = 0; t2 < 2; ++t2) xsk[t2] = *(const u32x2*)(X + (size_t)(r0 + 16 * t2 + fr) * 512 + g * 16 + 4 * fq);
        f32x4 bur[2][4], bui[2][4];
#pragma unroll
        for (int tt = 0; tt < 2; ++tt)
#pragma unroll
            for (int pt = 0; pt < 4; ++pt) { bur[tt][pt] = mfma16(xF[tt], breF[pt], (f32x4){0.f, 0.f, 0.f, 0.f}); bui[tt][pt] = mfma16(xF[tt], bimF[pt], (f32x4){0.f, 0.f, 0.f, 0.f}); }
#pragma unroll
        for (int pt = 0; pt < 4; ++pt) {
            float er = 0.f, ei = 0.f;
#pragma unroll
            for (int k = 0; k < 8; ++k) { const float ur = bur[k >> 2][pt][k & 3], ui = bui[k >> 2][pt][k & 3]; const float nr = ar[pt] * er - ai[pt] * ei + ur, ni = ar[pt] * ei + ai[pt] * er + ui; er = nr; ei = ni; }
            float cr = Hr[pt], ci = Hi[pt], mr = cr, mi = ci;
#pragma unroll
            for (int q = 0; q < 4; ++q) { const float Er = __shfl(er, fr + 16 * q), Ei = __shfl(ei, fr + 16 * q);
                const float nr = a8r[pt] * cr - a8i[pt] * ci + Er, ni = a8r[pt] * ci + a8i[pt] * cr + Ei; cr = nr; ci = ni;
                if (q + 1 == fq) { mr = cr; mi = ci; } }
            Hr[pt] = cr; Hi[pt] = ci;
            float hr = mr, hi = mi;
#pragma unroll
            for (int k = 0; k < 8; ++k) { const float ur = bur[k >> 2][pt][k & 3], ui = bui[k >> 2][pt][k & 3]; const float nr = ar[pt] * hr - ai[pt] * hi + ur, ni = ar[pt] * hi + ai[pt] * hr + ui; hr = nr; hi = ni;
                HT[(8 * fq + k) * 136 + 16 * pt + fr] = f2bf(hr); HT[(8 * fq + k) * 136 + 64 + 16 * pt + fr] = f2bf(hi); }
        }
        asm volatile("s_waitcnt lgkmcnt(0)" ::: "memory");
        f32x4 y[2];
#pragma unroll
        for (int t2 = 0; t2 < 2; ++t2) { y[t2] = (f32x4){0.f, 0.f, 0.f, 0.f};
#pragma unroll
            for (int ks = 0; ks < 4; ++ks) { const bf16x8 hf = *(const LAS bf16x8*)(HT + (16 * t2 + fr) * 136 + 32 * ks + 8 * fq); y[t2] = mfma16(cF[ks], hf, y[t2]); } }
#pragma unroll
        for (int t2 = 0; t2 < 2; ++t2) { u16* xp = X + (size_t)(r0 + 16 * t2 + fr) * 512 + g * 16 + 4 * fq; const u32x2 xx = xsk[t2];
            f32x4 xv; xv[0] = __uint_as_float(xx.x << 16); xv[1] = __uint_as_float(xx.x & 0xffff0000u); xv[2] = __uint_as_float(xx.y << 16); xv[3] = __uint_as_float(xx.y & 0xffff0000u);
            f32x4 z = y[t2] + dsk * xv;
#pragma unroll
            for (int e = 0; e < 4; ++e) z[e] = fgelu(z[e]);
            *(u32x2*)xp = pk4(z); }
        asm volatile("" ::: "memory");
    }
    if (fq == 0) { float* ore = p.out + (grp ? O_SRES + (size_t)l * 16384 + ((size_t)b * 32 + g) * 64 : O_SREP + (size_t)l * 32768 + ((size_t)b * 32 + g) * 64);
        float* oim = p.out + (grp ? O_SIMS + (size_t)l * 16384 + ((size_t)b * 32 + g) * 64 : O_SIMP + (size_t)l * 32768 + ((size_t)b * 32 + g) * 64);
#pragma unroll
        for (int pt = 0; pt < 4; ++pt) { ore[16 * pt + fr] = Hr[pt]; oim[16 * pt + fr] = Hi[pt]; } }
    __syncthreads();
}

DEV void gmlp_item(CP& p, int l, LAS unsigned char* lds, int grp, int b, int n, int g) {
    unsigned char* ws = p.ws;
    const int tid = tid_o(), w = tid >> 6, lane = tid & 63, fr = lane & 15, fq = lane >> 4;
    const int L = grp ? 64 : 128, T = grp ? 64 : 2048; const int rowbase = grp ? MTP + b * 64 : b * 2048 + n * 128;
    LAS u16* WT = (LAS u16*)lds; LAS u16* GT = WT + 128 * 136; LAS float* RS = (LAS float*)(GT + 128 * 136);
    const float* rowsq = (const float*)(ws + W_ROWSQ);
    if (tid < L) RS[tid] = __builtin_amdgcn_rsqf(rowsq[rowbase + tid] * (1.f / 512.f) + EPS);
    const u16* GV = (const u16*)(ws + W_GVT) + (grp ? (size_t)16 * 512 * 2048 : 0) + ((size_t)b * 512 + g * 128) * T + (grp ? 0 : n * 128);
    const u16* WM = (const u16*)(ws + W_WM) + (size_t)g * 128 * 128;
    const int cshift = grp ? 3 : 4, nchunk = 128 << cshift, nwch = L << cshift;
    u16* P1 = (u16*)(ws + W_P1);
    u32x4 gq[4], wq[4];
#pragma unroll
    for (int i = 0; i < 4; ++i) { const int chn = tid + 512 * i; const int cg_ = chn < nchunk ? chn : 0, cw_ = chn < nwch ? chn : 0;
        gq[i] = *(const u32x4*)(GV + (size_t)(cg_ >> cshift) * T + (cg_ & ((1 << cshift) - 1)) * 8);
        wq[i] = *(const u32x4*)(WM + (size_t)(cw_ >> cshift) * 128 + (cw_ & ((1 << cshift) - 1)) * 8); }
    u32x2 uq[8]; float bq[8];
    const int ntt = L >> 4;
#pragma unroll
    for (int tt = 0; tt < 8; ++tt) { const int t = tt < ntt ? 16 * tt + fr : fr; uq[tt] = *(const u32x2*)(P1 + (size_t)(rowbase + t) * 1024 + g * 128 + 16 * w + 4 * fq); bq[tt] = p.in[13][(size_t)(l * 4 + g) * 128 + t]; }
    const f32x4 gvg = *(const f32x4*)(p.in[11] + l * 512 + g * 128 + 16 * w + 4 * fq);
    __syncthreads();
#pragma unroll
    for (int i = 0; i < 4; ++i) { const int chn = tid + 512 * i;
        if (chn < nchunk) { const int c = chn >> cshift, kp = (chn & ((1 << cshift) - 1)) * 8; const unsigned gw[4] = {gq[i].x, gq[i].y, gq[i].z, gq[i].w}; u32x4 o;
            unsigned ow[4];
#pragma unroll
            for (int k = 0; k < 4; ++k) ow[k] = pk2(__uint_as_float(gw[k] << 16) * RS[kp + 2 * k], __uint_as_float(gw[k] & 0xffff0000u) * RS[kp + 2 * k + 1]);
            o.x = ow[0]; o.y = ow[1]; o.z = ow[2]; o.w = ow[3]; *(LAS u32x4*)(GT + c * 136 + kp) = o; }
        if (chn < nwch) { const int t = chn >> cshift, kp = (chn & ((1 << cshift) - 1)) * 8; *(LAS u32x4*)(WT + t * 136 + kp) = wq[i]; } }
    __syncthreads();
#pragma unroll
    for (int tt = 0; tt < 8; ++tt) { if (tt < ntt) { f32x4 a = (f32x4){0.f, 0.f, 0.f, 0.f};
        for (int ks = 0; ks < L / 32; ++ks) { if (32 * ks > 16 * tt + 15) break;
            const bf16x8 gf = *(const LAS bf16x8*)(GT + (16 * w + fr) * 136 + 32 * ks + 8 * fq), wf = *(const LAS bf16x8*)(WT + (16 * tt + fr) * 136 + 32 * ks + 8 * fq); a = mfma16(gf, wf, a); }
        const int t = 16 * tt + fr;
        f32x4 u; u[0] = __uint_as_float(uq[tt].x << 16); u[1] = __uint_as_float(uq[tt].x & 0xffff0000u); u[2] = __uint_as_float(uq[tt].y << 16); u[3] = __uint_as_float(uq[tt].y & 0xffff0000u);
        *(u32x2*)(P1 + (size_t)(rowbase + t) * 1024 + g * 128 + 16 * w + 4 * fq) = pk4(u * (a * gvg + bq[tt])); } }
    if (grp) {
        float* o = p.out + O_GMV + (size_t)l * 262144 + (size_t)b * 64 * 512; const float* gg = p.in[11] + l * 512 + g * 128;
        for (int idx = tid; idx < 64 * 128; idx += 512) { const int t = idx >> 7, c = idx & 127; o[(size_t)t * 512 + g * 128 + c] = bf2f(GT[c * 136 + t]) * gg[c]; }
    }
    __syncthreads();
}

DEV void phaseMix(CP& p, int l, LAS unsigned char* lds) {
    unsigned* ctr = (unsigned*)(p.ws + W_MISC) + l;
    LAS int* slot = (LAS int*)(lds + 160 * 1024 - 16);
    for (;;) {
        if (tid_o() == 0) *slot = (int)atomicAdd(ctr, 1u);
        __syncthreads();
        int it = __builtin_amdgcn_readfirstlane(*slot);
        __syncthreads();
        if (it >= 2304) break;
        int kind, grp = 0, a0, a1, a2 = 0;
        if (it < 64) { kind = 0; a0 = it >> 2; a1 = it & 3; }
        else if (it < 128) { it -= 64; kind = 1; a0 = it >> 2; a1 = it & 3; }
        else if (it < 160) { it -= 128; kind = 2; grp = 1; a0 = it >> 2; a1 = it & 3; }
        else if (it < 1184) { it -= 160; kind = 2; a2 = 15 - (it >> 6); a0 = (it & 63) >> 2; a1 = it & 3; }
        else if (it < 2208) { it -= 1184; kind = 3; a0 = it >> 6; a2 = (it >> 2) & 15; a1 = it & 3; }
        else if (it < 2240) { it -= 2208; kind = 0; grp = 1; a0 = it >> 2; a1 = it & 3; }
        else if (it < 2272) { it -= 2240; kind = 1; grp = 1; a0 = it >> 2; a1 = it & 3; }
        else { it -= 2272; kind = 3; grp = 1; a0 = it >> 2; a1 = it & 3; }
        asm volatile("" : "+s"(kind), "+s"(grp), "+s"(a0), "+s"(a1), "+s"(a2));
        if (kind == 0) {
#ifndef NO_S5
            s5_item(p, l, lds, grp, a0, a1);
#endif
        } else if (kind == 1) {
#ifndef NO_GLA
#ifdef GLA_SAMPLE_ONLY
            if (grp)
#endif
            gla_item(p, l, lds, grp, a0, a1);
#endif
        } else if (kind == 2) {
#ifndef NO_ATT
            attn_item(p, l, lds, grp, a0, a1, a2);
#endif
        } else {
#ifndef NO_GMLP
            gmlp_item(p, l, lds, grp, a0, a2, a1);
#endif
        }
    }
}

DEV void phaseFix(CP& p, int l) {
    unsigned char* ws = p.ws; const int gt = bid_o() * 512 + tid_o(), GT = gridDim.x * 512;
    const float* HEAD = (const float*)(ws + W_HEAD); const float* TAIL = (const float*)(ws + W_TAIL); u16* ACT = (u16*)(ws + W_ACT);
    const float* cw = p.in[35] + (size_t)l * 3 * 5632; const float* cb = p.in[36] + (size_t)l * 5632;
    for (int idx = gt; idx < 520 * 2816; idx += GT) { const int slab = idx / 2816, f = idx % 2816;
        float c0[2], c1[2];
#pragma unroll
        for (int bj = 0; bj < 2; ++bj) { const int ff = bj * 2816 + f; float pm2 = 0.f, pm1 = 0.f;
            if (slab >= 512) { const float* st = p.in[7] + ((size_t)(l * 8 + (slab - 512)) * 2) * 5632; pm2 = st[ff]; pm1 = st[5632 + ff]; }
            else if (slab & 31) { pm2 = TAIL[((size_t)(slab - 1) * 2) * 5632 + ff]; pm1 = TAIL[((size_t)(slab - 1) * 2 + 1) * 5632 + ff]; }
            const float h0 = HEAD[((size_t)slab * 2) * 5632 + ff], h1 = HEAD[((size_t)slab * 2 + 1) * 5632 + ff];
            const float w0 = cw[ff], w1 = cw[5632 + ff], w2 = cw[11264 + ff], bb = cb[ff];
            c0[bj] = bb + w0 * pm2 + w1 * pm1 + w2 * h0; c1[bj] = bb + w0 * pm1 + w1 * h0 + w2 * h1; }
        ACT[(size_t)(slab * 64) * 2816 + f] = f2bf(fsilu(c0[0]) * c0[1]); ACT[(size_t)(slab * 64 + 1) * 2816 + f] = f2bf(fsilu(c1[0]) * c1[1]); }
    for (int idx = gt; idx < 24 * 2 * 5632; idx += GT) { const int bb = idx / 11264, rem = idx % 11264;
        if (bb < 16) p.out[O_FCP + (size_t)l * 180224 + (size_t)bb * 11264 + rem] = TAIL[((size_t)(bb * 32 + 31) * 2) * 5632 + rem];
        else p.out[O_FCS + (size_t)l * 90112 + (size_t)(bb - 16) * 11264 + rem] = TAIL[((size_t)(512 + bb - 16) * 2) * 5632 + rem]; }
}

#define XB_TMO      128
#define XB_XCNT(j)  (256  + 64 * (j))
#define XB_XSUB(j)  (1280 + 64 * (j))
#define XB_XGEN(j)  (2304 + 64 * (j))
#define XB_TOP      3328
#define XB_TOPGEN   3392
#define XCD_BAR_WORDS 3456
#define XB_SPIN_CAP (1u << 18)

__device__ __forceinline__ unsigned xb_ld(unsigned* p)              { return __hip_atomic_load(p, __ATOMIC_RELAXED, __HIP_MEMORY_SCOPE_AGENT); }
__device__ __forceinline__ unsigned xb_add(unsigned* p, unsigned v) { return __hip_atomic_fetch_add(p, v, __ATOMIC_RELAXED, __HIP_MEMORY_SCOPE_AGENT); }
__device__ __forceinline__ unsigned xb_xcc_id() { return (unsigned)__builtin_amdgcn_s_getreg((3 << 11) | 20) & 0xFu; }
#define XB_SPIN(cond, bar) do { unsigned _sp = 0; while (cond) { __builtin_amdgcn_s_sleep(1); \
    if ((++_sp & 255u) == 0u) { if (xb_ld(&(bar)[XB_TMO])) break; if (_sp > XB_SPIN_CAP) { atomicAdd(&(bar)[XB_TMO], 1u); break; } } } } while (0)

struct XcdBarrier {
    unsigned* bar; unsigned x;
    volatile LAS unsigned* st;
};

__device__ __forceinline__ XcdBarrier xcd_barrier_post(unsigned* bar, volatile LAS unsigned* st) {
    XcdBarrier b; b.bar = bar; b.x = xb_xcc_id(); b.st = st;
    if (threadIdx.x == 0) (void)xb_add(&bar[XB_XCNT(b.x)], 1u);
    return b;
}
__device__ __forceinline__ void xcd_barrier_complete(unsigned* bar, unsigned x, unsigned& nloc, unsigned& nx) {
    const unsigned G = gridDim.x * gridDim.y * gridDim.z;
    unsigned sum, cnt, mine, sp = 0u;
    for (;;) {
        sum = 0u; cnt = 0u; mine = 0u;
#pragma unroll
        for (unsigned j = 0; j < 16; ++j) { const unsigned c = xb_ld(&bar[XB_XCNT(j)]); sum += c; cnt += (c > 0u) ? 1u : 0u; mine = (j == x) ? c : mine; }
        if (sum == G) break;
        __builtin_amdgcn_s_sleep(1);
        if ((++sp & 255u) == 0u) { if (xb_ld(&bar[XB_TMO])) break; if (sp > XB_SPIN_CAP) { atomicAdd(&bar[XB_TMO], 1u); break; } }
    }
    nloc = mine > 0u ? mine : 1u; nx = cnt > 0u ? cnt : 1u;
}

__device__ __forceinline__ void xcd_barrier(const XcdBarrier& b) {
    asm volatile("s_waitcnt vmcnt(0)" ::: "memory");
    __syncthreads();
    if (threadIdx.x == 0) {
        unsigned* bar = b.bar;
        __builtin_amdgcn_s_waitcnt(0);
        unsigned nloc = b.st[0], nx = b.st[1];
        if (nloc == 0u) { xcd_barrier_complete(bar, b.x, nloc, nx); b.st[0] = nloc; b.st[1] = nx; }
        const unsigned old = xb_add(&bar[XB_XSUB(b.x)], 1u);
        const unsigned gen = old / nloc;
        if (old + 1u == (gen + 1u) * nloc) {
            __builtin_amdgcn_fence(__ATOMIC_RELEASE, "agent");
            asm volatile("s_waitcnt vmcnt(0)" ::: "memory");
            const unsigned og = xb_add(&bar[XB_TOP], 1u);
            const unsigned tg = og / nx;
            if (og + 1u == (tg + 1u) * nx) xb_add(&bar[XB_TOPGEN], 1u);
            else XB_SPIN(xb_ld(&bar[XB_TOPGEN]) == tg, bar);
            __builtin_amdgcn_fence(__ATOMIC_ACQUIRE, "agent");
            xb_add(&bar[XB_XGEN(b.x)], 1u);
            asm volatile("s_waitcnt vmcnt(0)" ::: "memory");
        } else {
            XB_SPIN(xb_ld(&bar[XB_XGEN(b.x)]) == gen, bar);
            __builtin_amdgcn_fence(__ATOMIC_ACQUIRE, "agent");
            asm volatile("s_waitcnt vmcnt(0)" ::: "memory");
        }
    }
    __syncthreads();
}


__global__ void __launch_bounds__(512, 2) mega(Params p_unused) {
    extern __shared__ __attribute__((aligned(16))) unsigned char smem[];
    LAS unsigned char* lds = (LAS unsigned char*)smem;
    cg::grid_group grid = cg::this_grid();
    volatile LAS unsigned* xb_st = (volatile LAS unsigned*)(lds + 160 * 1024 - 32);
    if (threadIdx.x == 0) { xb_st[0] = 0u; xb_st[1] = 0u; }
    __syncthreads();
    const XcdBarrier xbar = xcd_barrier_post((unsigned*)(((CP*)__builtin_amdgcn_kernarg_segment_ptr())->ws + W_BAR), xb_st);
#define GSYNC() xcd_barrier(xbar)
#pragma unroll 1
    for (int l = 0; l < 2; ++l) {
        CP* pp = (CP*)__builtin_amdgcn_kernarg_segment_ptr(); asm volatile("" : "+s"(pp)); CP& p = *pp; unsigned char* ws = p.ws; const int G = gridDim.x, c = bid_o();
#ifndef SKIP_A
        phaseA(p, l);
#endif
        if (l == 0) grid.sync(); else GSYNC();
#ifndef SKIP_B
        {
            pg8::PlainSched S; S.T.init(130, NMIX, G, c); S.A = (const char*)ws + W_H; S.B = (const char*)ws + W_WIN; S.ld = 1024; S.nt = 16;
            EpiIn E; E.l = l; E.out = p.out; E.ws = ws; E.qg = p.in[27] + l * 64; E.kg = p.in[28] + l * 64;
            pg8::gemm_phase(lds, 1024, S, E);
        }
#endif
        GSYNC();
#ifndef SKIP_C
        phaseMix(p, l, lds);
#endif
        GSYNC();
#ifndef SKIP_D
        {
            pg8::PlainSched S; S.T.init(130, 2, G, c); S.A = (const char*)ws + W_S5; S.B = (const char*)ws + W_WGLU; S.ld = 512; S.nt = 8;
            EpiGlu E; E.ws = ws; E.bias = p.in[23] + l * 512;
            pg8::gemm_phase(lds, 512, S, E);
        }
#endif
        GSYNC();
#ifndef SKIP_E
        {
            MergeSched S; S.T.init(128, 4, G, c); S.ws = ws;
            EpiMerge E; E.ws = ws; E.bgate = p.in[10] + l * 4096;
            pg8::gemm_phase(lds, 1024, S, E);
        }
#endif
        GSYNC();
        {
            const f32x4* mf = (const f32x4*)(ws + W_MFS); u16* mg = (u16*)(ws + W_MERGED) + (size_t)MTP * 1024;
            for (int i = c * 512 + tid_o(); i < 512 * 256; i += G * 512) *(u32x2*)(mg + (size_t)i * 4) = pk4(mf[i]);
        }
        GSYNC();
#ifndef SKIP_F
        {
            pg8::TailSched S; S.T.init(128, 4, G, c); S.A = (const char*)ws + W_MERGED; S.B = (const char*)ws + W_WOUT; S.ld = 1024; S.nt = 16; S.npiece = 4; S.ntp = 4;
            EpiRes E; E.xb = p.out; E.xin_p = l == 0 ? p.in[0] : nullptr; E.xin_s = l == 0 ? p.in[1] : nullptr;
            pg8::gemm_phase(lds, 1024, S, E);
        }
#endif
        GSYNC();
#ifndef SKIP_G
        norm_rows(p.out, p.out + (size_t)MTP * 1024, p.in[33] + l * 1024, (u16*)(ws + W_H));
#endif
        GSYNC();
#ifndef SKIP_H
        {
            pg8::PlainSched S; S.T.init(130, 22, G, c); S.A = (const char*)ws + W_H; S.B = (const char*)ws + W_WUP; S.ld = 1024; S.nt = 16;
            EpiUp E; E.ws = ws; E.cw = p.in[35] + (size_t)l * 3 * 5632; E.cbias = p.in[36] + (size_t)l * 5632;
            pg8::gemm_phase(lds, 1024, S, E);
        }
#endif
        GSYNC();
#ifndef SKIP_I
        phaseFix(p, l);
#endif
        GSYNC();
#ifndef SKIP_J
        {
            pg8::TailSched S; S.T.init(128, 4, G, c); S.A = (const char*)ws + W_ACT; S.B = (const char*)ws + W_WDN; S.ld = 2816; S.nt = 44; S.npiece = 11; S.ntp = 4;
            EpiRes E; E.xb = p.out; E.xin_p = nullptr; E.xin_s = nullptr;
            pg8::gemm_phase(lds, 2816, S, E);
        }
#endif
        GSYNC();
    }
}

extern "C" void kernel_launch(void* const* d_in, const int* in_sizes, int n_in, void* d_out, int out_size, void* d_ws, size_t ws_size, hipStream_t stream) {
    constexpr int LDS_BYTES = 160 * 1024;
    static int grid_blocks = 0;
    if (!grid_blocks) {
        int dev = 0, cus = 0, per_cu = 0;
        hipGetDevice(&dev);
        hipDeviceGetAttribute(&cus, hipDeviceAttributeMultiprocessorCount, dev);
        hipFuncSetAttribute((const void*)mega, hipFuncAttributeMaxDynamicSharedMemorySize, LDS_BYTES);
        hipOccupancyMaxActiveBlocksPerMultiprocessor(&per_cu, (const void*)mega, 512, LDS_BYTES);
        if (per_cu < 1) per_cu = 1;
        grid_blocks = cus * per_cu;
        if (ws_size < W_END) fprintf(stderr, "kernel_launch: workspace too small: %zu < %zu\n", ws_size, (size_t)W_END);
    }
    Params p{};
    for (int i = 0; i < 38; ++i) p.in[i] = (const float*)d_in[i];
    p.out = (float*)d_out; p.ws = (unsigned char*)d_ws;
    (void)hipMemsetAsync((unsigned char*)d_ws + W_BAR, 0, 16384, stream);
    void* args[] = {&p};
    hipError_t e = hipLaunchCooperativeKernel((const void*)mega, dim3(grid_blocks), dim3(512), args, LDS_BYTES, stream);
    if (e != hipSuccess) fprintf(stderr, "cooperative launch failed: %s (grid %d)\n", hipGetErrorString(e), grid_blocks);
}
```

```cpp
#include <hip/hip_runtime.h>
#include <hip/hip_cooperative_groups.h>
#include <cstdio>
namespace cg = cooperative_groups;

#define LAS __attribute__((address_space(3)))
#define DEV __device__ __forceinline__
typedef unsigned short u16;
typedef short bf16x8 __attribute__((ext_vector_type(8)));
typedef float f32x4 __attribute__((ext_vector_type(4)));
typedef float f32x2 __attribute__((ext_vector_type(2)));
typedef unsigned u32x4 __attribute__((ext_vector_type(4)));
typedef unsigned u32x2 __attribute__((ext_vector_type(2)));

constexpr int MTP = 32768, MT = 33280;
constexpr int NINP = 8960;
constexpr int NMIX = 19;
constexpr int GATE0 = 4864;
constexpr float EPS = 1e-6f;
constexpr float LOG2E = 1.4426950408889634f;

constexpr size_t O_Y = 0, O_DKP = 34078720, O_DVP = 67633152, O_SREP = 101187584, O_SIMP = 101253120, O_GLAP = 101318656,
                 O_FCP = 102367232, O_DKS = 102727680, O_DVS = 103251968, O_SRES = 103776256, O_SIMS = 103809024, O_GLAS = 103841792,
                 O_FCS = 104366080, O_GMV = 104546304;

constexpr size_t SZ_H = (size_t)MT * 1024 * 2;
constexpr size_t SZ_HALF = (size_t)MT * 512 * 2;
constexpr size_t W_H = 0;
constexpr size_t W_P1 = W_H + SZ_H;
constexpr size_t W_P2 = W_P1 + SZ_H;
constexpr size_t W_S5 = W_P2 + SZ_H;
constexpr size_t W_GVT = W_S5 + SZ_HALF;
constexpr size_t W_CQ = W_GVT + SZ_HALF;
constexpr size_t W_CK = W_CQ + SZ_HALF / 2;
constexpr size_t W_CVT = W_CK + SZ_HALF / 2;
constexpr size_t W_CODE = W_CVT + SZ_HALF;
constexpr size_t W_DKP = W_CODE + (size_t)MT * 16 * 4;
constexpr size_t W_DKS = W_DKP + (size_t)MTP * 512 * 2;
constexpr size_t W_DVTP = W_DKS + (size_t)8 * 4160 * 512 * 2;
constexpr size_t W_DVTS = W_DVTP + (size_t)MTP * 512 * 2;
constexpr size_t W_ROWSQ = W_DVTS + (size_t)8 * 4160 * 512 * 2;
constexpr size_t W_MISC = W_ROWSQ + (size_t)MT * 4;
constexpr size_t W_WIN = W_MISC + 4096;
constexpr size_t W_WBR = W_WIN + (size_t)NINP * 1024 * 2;
constexpr size_t W_WOUT = W_WBR + (size_t)2 * 1024 * 1024 * 2;
constexpr size_t W_WGLU = W_WOUT + (size_t)1024 * 1024 * 2;
constexpr size_t W_WUP = W_WGLU + (size_t)512 * 512 * 2;
constexpr size_t W_WDN = W_WUP + (size_t)5632 * 1024 * 2;
constexpr size_t W_MFS = W_WDN + (size_t)1024 * 2816 * 2;
constexpr size_t W_BAR = W_MFS + (size_t)512 * 1024 * 4;
constexpr size_t W_WM = W_BAR + 16384;
constexpr size_t W_END = W_WM + (size_t)4 * 128 * 128 * 2;
constexpr size_t W_MERGED = W_CQ;
constexpr size_t W_SCR = W_DKP;
constexpr size_t W_ACT = W_P1;
constexpr size_t W_HEAD = W_DVTP;
constexpr size_t W_TAIL = W_HEAD + (size_t)520 * 2 * 5632 * 4;
static_assert(W_TAIL + (size_t)520 * 2 * 5632 * 4 <= W_ROWSQ, "head/tail alias");
static_assert((size_t)MT * 2816 * 2 <= W_CQ - W_P1, "act alias");

struct Params { const float* in[38]; float* out; unsigned char* ws; };
typedef const __attribute__((address_space(4))) Params CP;

DEV int tid_o() { int t = threadIdx.x; asm volatile("" : "+v"(t)); return t; }
DEV int bid_o() { int t = blockIdx.x; asm volatile("" : "+s"(t)); return t; }
DEV float bf2f(u16 v) { return __uint_as_float(((unsigned)v) << 16); }
typedef __bf16 b16x2 __attribute__((ext_vector_type(2)));
DEV unsigned pk2(float lo, float hi) { const f32x2 v = {lo, hi}; const b16x2 r = __builtin_convertvector(v, b16x2); return __builtin_bit_cast(unsigned, r); }
DEV u16 f2bf(float v) { return (u16)(pk2(v, 0.f) & 0xffffu); }
DEV float fsigmoid(float x) { return __builtin_amdgcn_rcpf(1.f + __expf(-x)); }
DEV float fsilu(float x) { return x * fsigmoid(x); }
DEV float fgelu(float x) { return x * fsigmoid(1.5957691216057308f * (x + 0.044715f * x * x * x)); }
DEV float flogsig(float x) { return fminf(x, 0.f) - __logf(1.f + __expf(-fabsf(x))); }
DEV f32x4 mfma16(bf16x8 a, bf16x8 b, f32x4 c) { return __builtin_amdgcn_mfma_f32_16x16x32_bf16(a, b, c, 0, 0, 0); }
DEV u32x2 pk4(f32x4 v) { u32x2 r; r.x = pk2(v[0], v[1]); r.y = pk2(v[2], v[3]); return r; }
DEV float red_fq(float v) { v += __shfl_xor(v, 16); v += __shfl_xor(v, 32); return v; }
DEV float wave_sum(float v) { for (int o = 32; o; o >>= 1) v += __shfl_xor(v, o); return v; }

namespace pg8 {
constexpr int BM = 256, BK = 64, HALF = 128, HTB = HALF * BK * 2, NXCD = 8, WGM = 8;
DEV int lds_byte(int r, int c) { const int st = (r >> 4) * 2 + (c >> 5), rr = r & 15, cc = c & 31, ob = rr * 64 + cc * 2; return st * 1024 + (ob ^ (((ob >> 9) & 1) << 5)); }
DEV void stage_rc(int b, int& R, int& C) { const int st = b / 1024, sb = b % 1024, swz = sb ^ (((sb >> 9) & 1) << 5); R = (st >> 1) * 16 + swz / 64; C = (st & 1) * 32 + (swz % 64) / 2; }
struct GUnit { const char* A; const char* B; int nt, pm, pn, kind; };
struct TileOrder {
    int nM, nN, nwg, G, c;
    DEV void init(int nM_, int nN_, int G_, int c_) { nM = nM_; nN = nN_; nwg = nM * nN; G = G_; c = c_; }
    DEV bool tile(int i, int& pm, int& pn) const {
        const long L = (long)i * G + c; if (L >= nwg) return false;
        int wgid = (int)L; { const int q = nwg / NXCD, r = nwg % NXCD, xcd = wgid % NXCD, off = wgid / NXCD; wgid = (xcd < r ? xcd * (q + 1) : r * (q + 1) + (xcd - r) * q) + off; }
        const int nig = WGM * nN, gid = wgid / nig, fm = gid * WGM, gsz = (nM - fm) < WGM ? (nM - fm) : WGM;
        pm = fm + ((wgid % nig) % gsz); pn = (wgid % nig) / gsz; return true;
    }
};
struct TailSched {
    TileOrder T; const char* A; const char* B; int ld, nt, npiece, ntp;
    DEV bool next(int i, GUnit& u) const { int pm, pn;
        if (T.tile(i, pm, pn)) { u.pm = pm; u.pn = pn; u.kind = 0; u.nt = nt; u.A = A + (size_t)pm * 256 * ld * 2; u.B = B + (size_t)pn * 256 * ld * 2; return true; }
        const int i0 = (T.nwg - T.c + T.G - 1) / T.G; const int j = (i - i0) * T.G + T.c; if (j >= 8 * npiece) return false;
        const int tile = j / npiece, kp = j % npiece; pm = 128 + (tile >> 2); pn = tile & 3; u.pm = pm; u.pn = pn; u.kind = 1; u.nt = ntp;
        u.A = A + (size_t)pm * 256 * ld * 2 + (size_t)kp * ntp * 128; u.B = B + (size_t)pn * 256 * ld * 2 + (size_t)kp * ntp * 128; return true; }
};
struct PlainSched {
    TileOrder T; const char* A; const char* B; int ld, nt;
    DEV bool next(int i, GUnit& u) const { int pm, pn; if (!T.tile(i, pm, pn)) return false; u.pm = pm; u.pn = pn; u.kind = 0; u.nt = nt;
        u.A = A + (size_t)pm * 256 * ld * 2; u.B = B + (size_t)pn * 256 * ld * 2; return true; }
};

template <class Epi, class Sched>
DEV void gemm_phase(LAS unsigned char* lds, const int ld, const Sched& S, const Epi& E) {
    const int tid = tid_o(), wid = __builtin_amdgcn_readfirstlane(tid >> 6), lane = tid & 63, wr = wid >> 2, wc = wid & 3, fr = lane & 15, fq = lane >> 4;
    unsigned voff[2];
#pragma unroll
    for (int i = 0; i < 2; ++i) { int R, C; stage_rc(tid * 16 + i * 8192, R, C); voff[i] = (unsigned)(R * ld + C) * 2u; }
    const size_t kstep = (size_t)(BK * 2);
    const size_t hstep = (size_t)HALF * ld * 2;
    const unsigned ldsw = (unsigned)wid * 1024u;
    const int aoff = lds_byte(wr * 64 + fr, fq * 8), boff = lds_byte(wc * 32 + fr, fq * 8);
#define PG8_SA(b, h) (((b) * 2 + (h)) * HTB)
#define PG8_SB(b, h) ((4 + (b) * 2 + (h)) * HTB)
#define PG8_STAGE(bufoff, gbase) do { _Pragma("unroll") for (int _i = 0; _i < 2; ++_i) \
        __builtin_amdgcn_global_load_lds((const unsigned*)((const char*)(gbase) + voff[_i]), (LAS unsigned*)(lds + (bufoff) + ldsw + _i * 8192), 16, 0, 0); } while (0)
#define PG8_LDA(dst, b, h) do { _Pragma("unroll") for (int m = 0; m < 4; ++m) _Pragma("unroll") for (int k = 0; k < 2; ++k) dst[m][k] = *(const LAS bf16x8*)(lds + PG8_SA(b, h) + aoff + m * 2048 + k * 1024); } while (0)
#define PG8_LDB(dst, b, h) do { _Pragma("unroll") for (int n = 0; n < 2; ++n) _Pragma("unroll") for (int k = 0; k < 2; ++k) dst[n][k] = *(const LAS bf16x8*)(lds + PG8_SB(b, h) + boff + n * 2048 + k * 1024); } while (0)
#define PG8_MMA(ai, bj, At, Bt) do { __builtin_amdgcn_s_setprio(1); _Pragma("unroll") for (int m = 0; m < 4; ++m) _Pragma("unroll") for (int n = 0; n < 2; ++n) _Pragma("unroll") for (int k = 0; k < 2; ++k) \
        acc[ai][bj][m][n] = __builtin_amdgcn_mfma_f32_16x16x32_bf16(Bt[n][k], At[m][k], acc[ai][bj][m][n], 0, 0, 0); __builtin_amdgcn_s_setprio(0); } while (0)
#define PG8_WAIT_V(n) asm volatile("s_waitcnt vmcnt(" #n ")" ::: "memory")
#define PG8_WAIT_L(n) asm volatile("s_waitcnt lgkmcnt(" #n ")" ::: "memory")
#define PG8_BAR __builtin_amdgcn_s_barrier()
#define PG8_SCHED __builtin_amdgcn_sched_barrier(0)
    GUnit cur, nxt; int ui = 0;
    if (!S.next(0, cur)) return;
    f32x4 acc[2][2][4][2];
#pragma unroll
    for (int a = 0; a < 2; ++a)
#pragma unroll
        for (int b = 0; b < 2; ++b)
#pragma unroll
            for (int m = 0; m < 4; ++m)
#pragma unroll
                for (int n = 0; n < 2; ++n) acc[a][b][m][n] = (f32x4){0.f, 0.f, 0.f, 0.f};
    bf16x8 At[4][2], B0[2][2], B1[2][2];
    const char* cA = cur.A; const char* cB = cur.B;
    PG8_STAGE(PG8_SB(0, 0), cB); PG8_STAGE(PG8_SA(0, 0), cA); PG8_STAGE(PG8_SB(0, 1), cB + hstep); PG8_STAGE(PG8_SA(0, 1), cA + hstep);
    if (wr == 1) PG8_BAR;
    PG8_WAIT_V(4); PG8_BAR;
    PG8_STAGE(PG8_SB(1, 0), cB + kstep); PG8_STAGE(PG8_SA(1, 0), cA + kstep); PG8_STAGE(PG8_SB(1, 1), cB + hstep + kstep);
    PG8_WAIT_V(6); PG8_BAR;
    for (;;) {
        const bool has_next = S.next(ui + 1, nxt);
        const char* nA = has_next ? nxt.A : cA; const char* nB = has_next ? nxt.B : cB;
        const int nt = cur.nt;
        for (int t = 0; t < nt; t += 2) {
            const bool last = (t == nt - 2);
            const char* a1 = cA + (size_t)(t + 1) * kstep;
            const char* a2 = last ? nA : cA + (size_t)(t + 2) * kstep; const char* b2 = last ? nB : cB + (size_t)(t + 2) * kstep;
            const char* a3 = a2 + kstep; const char* b3 = b2 + kstep;
            PG8_LDB(B0, 0, 0); PG8_SCHED; PG8_LDA(At, 0, 0); PG8_STAGE(PG8_SA(1, 1), a1 + hstep);
            PG8_WAIT_L(8); PG8_BAR; PG8_WAIT_L(0); PG8_MMA(0, 0, At, B0); PG8_BAR; PG8_SCHED;
            PG8_LDB(B1, 0, 1); PG8_STAGE(PG8_SB(0, 0), b2);
            PG8_BAR; PG8_WAIT_L(0); PG8_MMA(0, 1, At, B1); PG8_BAR;
            PG8_LDA(At, 0, 1); PG8_STAGE(PG8_SA(0, 0), a2);
            PG8_BAR; PG8_WAIT_L(0); PG8_MMA(1, 0, At, B0); PG8_BAR; PG8_SCHED;
            PG8_STAGE(PG8_SB(0, 1), b2 + hstep);
            PG8_WAIT_V(6); PG8_BAR; PG8_MMA(1, 1, At, B1); PG8_BAR;
            PG8_LDB(B0, 1, 0); PG8_SCHED; PG8_LDA(At, 1, 0); PG8_STAGE(PG8_SA(0, 1), a2 + hstep);
            PG8_WAIT_L(8); PG8_BAR; PG8_WAIT_L(0); PG8_MMA(0, 0, At, B0); PG8_BAR; PG8_SCHED;
            PG8_LDB(B1, 1, 1); PG8_STAGE(PG8_SB(1, 0), b3);
            PG8_BAR; PG8_WAIT_L(0); PG8_MMA(0, 1, At, B1); PG8_BAR;
            PG8_LDA(At, 1, 1); PG8_STAGE(PG8_SA(1, 0), a3);
            PG8_BAR; PG8_WAIT_L(0); PG8_MMA(1, 0, At, B0); PG8_BAR; PG8_SCHED;
            PG8_STAGE(PG8_SB(1, 1), b3 + hstep);
            PG8_WAIT_V(6); PG8_BAR; PG8_MMA(1, 1, At, B1); PG8_BAR;
        }
        { int fr_ = fr, fq_ = fq, wr_ = wr, wc_ = wc; asm volatile("" : "+v"(fr_), "+v"(fq_), "+s"(wr_), "+s"(wc_));
          E(acc, cur, wr_, wc_, fr_, fq_); }
        if (!has_next) break;
#pragma unroll
        for (int a = 0; a < 2; ++a)
#pragma unroll
            for (int b = 0; b < 2; ++b)
#pragma unroll
                for (int m = 0; m < 4; ++m)
#pragma unroll
                    for (int n = 0; n < 2; ++n) acc[a][b][m][n] = (f32x4){0.f, 0.f, 0.f, 0.f};
        cur = nxt; cA = nA; cB = nB; ++ui;
    }
    PG8_WAIT_V(0);
    if (wr == 0) PG8_BAR;
    PG8_BAR;
#undef PG8_SA
#undef PG8_SB
#undef PG8_STAGE
#undef PG8_LDA
#undef PG8_LDB
#undef PG8_MMA
#undef PG8_WAIT_V
#undef PG8_WAIT_L
#undef PG8_BAR
#undef PG8_SCHED
}
}
using pg8::GUnit;
typedef f32x4 AccT[2][2][4][2];

#define FOR_AM _Pragma("unroll") for (int ai = 0; ai < 2; ++ai) _Pragma("unroll") for (int m = 0; m < 4; ++m)
#define FOR_BN _Pragma("unroll") for (int bj = 0; bj < 2; ++bj) _Pragma("unroll") for (int n = 0; n < 2; ++n)

struct EpiIn {
    int l; float* out; unsigned char* ws; const float* qg; const float* kg;
    DEV void operator()(const AccT& acc, const GUnit& u, int wr, int wc, int fr, int fq) const {
        const int pn = u.pn; const bool smp = u.pm >= 128;
        const int rowb = u.pm * 256 + wr * 64 + fr;
        const int ct0 = wc * 32 + 4 * fq;
        u16* P1 = (u16*)(ws + W_P1); u16* P2 = (u16*)(ws + W_P2);
        if (pn < 2) {
            FOR_AM { const int row = rowb + ai * 128 + m * 16; FOR_BN { f32x4 v = acc[ai][bj][m][n];
                for (int e = 0; e < 4; ++e) v[e] = fgelu(v[e]);
                *(u32x2*)(P1 + (size_t)row * 1024 + pn * 256 + ct0 + bj * 128 + n * 16) = pk4(v); } }
        } else if (pn < 4 || pn == 8 || pn == 9 || pn == 16 || pn == 17) {
            const int kind = pn < 4 ? 0 : (pn < 10 ? 1 : 2);
            const int cseg = (pn & 1) * 256;
            u16* dstT; int T, toff = 0;
            if (kind == 0) { dstT = (u16*)(ws + W_GVT) + (smp ? (size_t)16 * 512 * 2048 : 0); T = smp ? 64 : 2048; }
            else if (kind == 1) { dstT = (u16*)(ws + W_CVT) + (smp ? (size_t)16 * 512 * 2048 : 0); T = smp ? 64 : 2048; }
            else { dstT = (u16*)(ws + (smp ? W_DVTS : W_DVTP)); T = smp ? 4160 : 2048; toff = smp ? 4096 : 0; }
            float* rowsq = (float*)(ws + W_ROWSQ);
            FOR_AM { const int row = rowb + ai * 128 + m * 16;
                int b, t; if (smp) { const int rs = row - MTP; b = rs >> 6; t = rs & 63; } else { b = row >> 11; t = row & 2047; }
                float ss = 0.f;
                FOR_BN { f32x4 v = acc[ai][bj][m][n]; const int cc = cseg + ct0 + bj * 128 + n * 16;
                    if (kind == 0) { for (int e = 0; e < 4; ++e) { v[e] = fgelu(v[e]); ss += v[e] * v[e]; } }
                    if (kind == 2) { float* o = smp ? out + O_DVS + (size_t)l * 262144 + (size_t)(row - MTP) * 512 + cc : out + O_DVP + (size_t)l * 16777216 + (size_t)row * 512 + cc;
                        *(f32x4*)o = v; }
                    for (int e = 0; e < 4; ++e) dstT[((size_t)b * 512 + cc + e) * T + toff + t] = f2bf(v[e]); }
                if (kind == 0) { ss = red_fq(ss); if (fq == 0) atomicAdd(rowsq + row, ss); } }
        } else if (pn < 6) {
            u16* S5 = (u16*)(ws + W_S5);
            FOR_AM { const int row = rowb + ai * 128 + m * 16; FOR_BN {
                *(u32x2*)(S5 + (size_t)row * 512 + (pn - 4) * 256 + ct0 + bj * 128 + n * 16) = pk4(acc[ai][bj][m][n]); } }
        } else if (pn < 8) {
            u16* D = (u16*)(ws + (pn == 6 ? W_CQ : W_CK)); const float sc = pn == 6 ? 0.125f : 1.f;
            FOR_AM { const int row = rowb + ai * 128 + m * 16; FOR_BN {
                *(u32x2*)(D + (size_t)row * 256 + ct0 + bj * 128 + n * 16) = pk4(acc[ai][bj][m][n] * sc); } }
        } else if (pn < 12) {
            FOR_AM { const int row = rowb + ai * 128 + m * 16; FOR_BN { f32x4 v = acc[ai][bj][m][n];
                for (int e = 0; e < 4; ++e) v[e] = fsilu(v[e]);
                *(u32x2*)(P2 + (size_t)row * 1024 + (pn - 10) * 256 + ct0 + bj * 128 + n * 16) = pk4(v); } }
        } else if (pn < 16) {
            const bool isq = pn < 14; const int hh = 4 * (pn & 1) + wc; const float* g = isq ? qg : kg;
            f32x4 gv[2][2];
            FOR_BN gv[bj][n] = *(const f32x4*)(g + 32 * bj + 16 * n + 4 * fq);
            FOR_AM { const int row = rowb + ai * 128 + m * 16;
                float ss = 0.f;
                FOR_BN { const f32x4 v = acc[ai][bj][m][n]; ss += v[0] * v[0] + v[1] * v[1] + v[2] * v[2] + v[3] * v[3]; }
                ss = red_fq(ss);
                float rs = __builtin_amdgcn_rsqf(ss * (1.f / 64.f) + EPS);
                if (isq) { rs *= 0.125f * LOG2E;
                    FOR_BN { *(u32x2*)(P2 + (size_t)row * 1024 + 512 + hh * 64 + 32 * bj + 16 * n + 4 * fq) = pk4(acc[ai][bj][m][n] * rs * gv[bj][n]); }
                } else {
                    float* o; u16* kb;
                    if (smp) { const int rs_ = row - MTP; o = out + O_DKS + (size_t)l * 262144 + (size_t)rs_ * 512; kb = (u16*)(ws + W_DKS) + ((size_t)(rs_ >> 6) * 4160 + 4096 + (rs_ & 63)) * 512; }
                    else { o = out + O_DKP + (size_t)l * 16777216 + (size_t)row * 512; kb = (u16*)(ws + W_DKP) + (size_t)row * 512; }
                    FOR_BN { const f32x4 v = acc[ai][bj][m][n] * rs * gv[bj][n]; const int d = hh * 64 + 32 * bj + 16 * n + 4 * fq;
                        *(f32x4*)(o + d) = v; *(u32x2*)(kb + d) = pk4(v); } } }
        } else {
            if (wc == 0) { float* C = (float*)(ws + W_CODE);
                FOR_AM { const int row = rowb + ai * 128 + m * 16; *(f32x4*)(C + (size_t)row * 16 + 4 * fq) = acc[ai][0][m][0]; } }
        }
    }
};

struct EpiGlu {
    unsigned char* ws; const float* bias;
    DEV void operator()(const AccT& acc, const GUnit& u, int wr, int wc, int fr, int fq) const {
        const u16* Z = (const u16*)(ws + W_S5); u16* P1 = (u16*)(ws + W_P1);
        const int rowb = u.pm * 256 + wr * 64 + fr, cb = u.pn * 256 + wc * 32 + 4 * fq;
        FOR_AM { const int row = rowb + ai * 128 + m * 16; FOR_BN { const int col = cb + bj * 128 + n * 16;
            const f32x4 bv = *(const f32x4*)(bias + col); const u32x2 zz = *(const u32x2*)(Z + (size_t)row * 512 + col);
            f32x4 z; z[0] = __uint_as_float(zz.x << 16); z[1] = __uint_as_float(zz.x & 0xffff0000u); z[2] = __uint_as_float(zz.y << 16); z[3] = __uint_as_float(zz.y & 0xffff0000u);
            f32x4 v = acc[ai][bj][m][n] + bv;
            for (int e = 0; e < 4; ++e) v[e] = z[e] * fsigmoid(v[e]);
            *(u32x2*)(P1 + (size_t)row * 1024 + 512 + col) = pk4(v); } }
    }
};

struct MergeSched {
    pg8::TileOrder T; unsigned char* ws;
    DEV void fill(GUnit& u, int pm, int pn, int b, int sub) const {
        u.pm = pm; u.pn = pn;
        if (sub) { u.nt = 16; u.A = (const char*)ws + W_H + (size_t)pm * 256 * 2048; u.B = (const char*)ws + W_WIN + (size_t)(GATE0 + b * 1024 + pn * 256) * 2048; }
        else { u.nt = 8; u.A = (const char*)ws + (b < 2 ? W_P1 : W_P2) + (size_t)pm * 256 * 2048 + (b & 1) * 1024;
               u.B = (const char*)ws + W_WBR + (size_t)(b >> 1) * 1024 * 2048 + (size_t)pn * 256 * 2048 + (b & 1) * 1024; }
    }
    DEV bool next(int i, GUnit& u) const {
        int pm, pn;
        if (T.tile(i >> 3, pm, pn)) { const int s = i & 7; u.kind = s; fill(u, pm, pn, s >> 1, s & 1); return true; }
        const int i0 = (T.nwg - T.c + T.G - 1) / T.G; const int jj = i - 8 * i0; const int job = (jj >> 1) * T.G + T.c; if (job >= 32) return false;
        const int tile = job >> 2, b = job & 3; u.kind = 8 + 2 * b + (jj & 1); fill(u, 128 + (tile >> 2), tile & 3, b, jj & 1); return true;
    }
};
struct EpiMerge {
    unsigned char* ws; const float* bgate;
    DEV void operator()(const AccT& acc, const GUnit& u, int wr, int wc, int fr, int fq) const {
        u32x4* sT = (u32x4*)(ws + W_SCR) + (size_t)bid_o() * 16 * 512 + tid_o();
        u32x4* sS = (u32x4*)(ws + W_SCR + (size_t)32 * 1024 * 1024) + (size_t)bid_o() * 16 * 512 + tid_o();
        const int s = u.kind & 7, b = s >> 1; const bool smp = u.kind >= 8;
        if (!(s & 1)) {
#pragma unroll
            for (int q = 0; q < 16; ++q) { const int ai = q >> 3, bj = (q >> 2) & 1, m = q & 3; const u32x2 lo = pk4(acc[ai][bj][m][0]), hi = pk4(acc[ai][bj][m][1]);
                u32x4 w; w.x = lo.x; w.y = lo.y; w.z = hi.x; w.w = hi.y; sT[q * 512] = w; }
        } else {
            u16* MG = (u16*)(ws + W_MERGED);
            const int rowb = u.pm * 256 + wr * 64 + fr, cb = u.pn * 256 + wc * 32 + 4 * fq;
            f32x4 bvv[2][2];
#pragma unroll
            for (int bj = 0; bj < 2; ++bj)
#pragma unroll
                for (int n = 0; n < 2; ++n) bvv[bj][n] = *(const f32x4*)(bgate + b * 1024 + cb + bj * 128 + n * 16);
#pragma unroll
            for (int q = 0; q < 16; ++q) { const int ai = q >> 3, bj = (q >> 2) & 1, m = q & 3; __builtin_amdgcn_sched_barrier(0);
                const u32x4 tw = sT[q * 512]; u32x4 sw = (u32x4){0u, 0u, 0u, 0u}; if (b > 0 && !smp) sw = sS[q * 512];
                const unsigned tws[4] = {tw.x, tw.y, tw.z, tw.w}; const unsigned sws[4] = {sw.x, sw.y, sw.z, sw.w};
                f32x4 r[2];
#pragma unroll
                for (int n = 0; n < 2; ++n) { const f32x4 bv = bvv[bj][n];
                    f32x4 v = acc[ai][bj][m][n] + bv;
#pragma unroll
                    for (int e = 0; e < 4; ++e) { const unsigned tt = tws[n * 2 + (e >> 1)], st = sws[n * 2 + (e >> 1)];
                        const float tv = (e & 1) ? __uint_as_float(tt & 0xffff0000u) : __uint_as_float(tt << 16);
                        const float sv = (e & 1) ? __uint_as_float(st & 0xffff0000u) : __uint_as_float(st << 16);
                        v[e] = fsigmoid(v[e]) * tv + sv; }
                    r[n] = v; }
                if (smp) { float* mf = (float*)(ws + W_MFS) + (size_t)(rowb + ai * 128 + m * 16 - MTP) * 1024 + cb + bj * 128;
#pragma unroll
                    for (int n = 0; n < 2; ++n)
#pragma unroll
                        for (int e = 0; e < 4; ++e) atomicAdd(mf + n * 16 + e, r[n][e]); }
                else if (b < 3) { const u32x2 lo = pk4(r[0]), hi = pk4(r[1]); u32x4 w; w.x = lo.x; w.y = lo.y; w.z = hi.x; w.w = hi.y; sS[q * 512] = w; }
                else { const int row = rowb + ai * 128 + m * 16;
#pragma unroll
                    for (int n = 0; n < 2; ++n) *(u32x2*)(MG + (size_t)row * 1024 + cb + bj * 128 + n * 16) = pk4(r[n]); } }
        }
    }
};

struct EpiRes {
    float* xb; const float* xin_p; const float* xin_s;
    DEV void operator()(const AccT& acc, const GUnit& u, int wr, int wc, int fr, int fq) const {
        const int rowb = u.pm * 256 + wr * 64 + fr, cb = u.pn * 256 + wc * 32 + 4 * fq;
        if (u.kind == 1) {
            FOR_AM { const int row = rowb + ai * 128 + m * 16; FOR_BN { float* d = xb + (size_t)row * 1024 + cb + bj * 128 + n * 16;
#pragma unroll
                for (int e = 0; e < 4; ++e) atomicAdd(d + e, acc[ai][bj][m][n][e]); } }
            return; }
        FOR_AM { const int row = rowb + ai * 128 + m * 16;
            const float* src = xin_p ? (row < MTP ? xin_p + (size_t)row * 1024 : xin_s + (size_t)(row - MTP) * 1024) : xb + (size_t)row * 1024;
            FOR_BN { const int col = cb + bj * 128 + n * 16; *(f32x4*)(xb + (size_t)row * 1024 + col) = *(const f32x4*)(src + col) + acc[ai][bj][m][n]; } }
    }
};

DEV float dpp_prev1(float cur, float prevm) {
    const int o = __builtin_amdgcn_update_dpp(0, __float_as_int(prevm), 0x121, 0xf, 0xf, false);
    return __int_as_float(__builtin_amdgcn_update_dpp(o, __float_as_int(cur), 0x111, 0xf, 0xf, false));
}
DEV float dpp_prev2(float cur, float prevm) {
    const int o = __builtin_amdgcn_update_dpp(0, __float_as_int(prevm), 0x122, 0xf, 0xf, false);
    return __int_as_float(__builtin_amdgcn_update_dpp(o, __float_as_int(cur), 0x112, 0xf, 0xf, false));
}
struct EpiUp {
    unsigned char* ws; const float* cw; const float* cbias;
    DEV void operator()(const AccT& acc, const GUnit& u, int wr, int wc, int fr, int fq) const {
        u16* ACT = (u16*)(ws + W_ACT); float* HEAD = (float*)(ws + W_HEAD); float* TAIL = (float*)(ws + W_TAIL);
        const int f0 = u.pn * 128 + wc * 32 + 4 * fq;
#pragma unroll
        for (int n = 0; n < 2; ++n) { const int f = f0 + n * 16;
            f32x4 w0[2], w1[2], w2[2], bb[2];
#pragma unroll
            for (int bj = 0; bj < 2; ++bj) { const int ff = bj * 2816 + f; w0[bj] = *(const f32x4*)(cw + ff); w1[bj] = *(const f32x4*)(cw + 5632 + ff); w2[bj] = *(const f32x4*)(cw + 11264 + ff); bb[bj] = *(const f32x4*)(cbias + ff); }
#pragma unroll
            for (int ai = 0; ai < 2; ++ai) {
                const int slab = u.pm * 4 + ai * 2 + wr;
#pragma unroll
                for (int m = 0; m < 4; ++m) {
                    f32x4 c[2];
#pragma unroll
                    for (int bj = 0; bj < 2; ++bj) { const f32x4 cur = acc[ai][bj][m][n]; const f32x4 pm_ = acc[ai][bj][m ? m - 1 : 0][n];
#pragma unroll
                        for (int e = 0; e < 4; ++e) { const float p1 = dpp_prev1(cur[e], pm_[e]), p2 = dpp_prev2(cur[e], pm_[e]);
                            c[bj][e] = bb[bj][e] + w2[bj][e] * cur[e] + w1[bj][e] * p1 + w0[bj][e] * p2; } }
                    if (m > 0 || fr >= 2) { f32x4 a; for (int e = 0; e < 4; ++e) a[e] = fsilu(c[0][e]) * c[1][e];
                        *(u32x2*)(ACT + (size_t)(slab * 64 + m * 16 + fr) * 2816 + f) = pk4(a); }
                    if (m == 0 && fr < 2) { for (int bj = 0; bj < 2; ++bj) *(f32x4*)(HEAD + ((size_t)slab * 2 + fr) * 5632 + bj * 2816 + f) = acc[ai][bj][0][n]; }
                    if (m == 3 && fr >= 14) { for (int bj = 0; bj < 2; ++bj) *(f32x4*)(TAIL + ((size_t)slab * 2 + fr - 14) * 5632 + bj * 2816 + f) = acc[ai][bj][3][n]; }
                } } }
    }
};

template <int MAP> DEV int src_col(int j) {
    if (MAP == 0) return j;
    if (MAP == 1) {
        const int tile = j >> 8, tc = j & 255;
        if (tile < 10) return j;
        if (tile < 12) return j + 16;
        if (tile < 16) { const int perm = ((tc >> 5) & 3) * 64 + (tc >> 7) * 32 + (tc & 31); return (tile < 14 ? 3088 : 3600) + (tile & 1) * 256 + perm; }
        if (tile < 18) return j + 16;
        if (tile == 18) return tc < 16 ? 2560 + tc : -1;
        return 4624 + (j - GATE0);
    }
    { const int q = j >> 8, tc = j & 255; return tc < 128 ? 128 * q + tc : 2816 + 128 * q + (tc - 128); }
}
template <int MAP> DEV void conv_T(u16* dst, int dst_ld, int K, int Nd, const float* src, int src_ld, int gt, int GT) {
    const int total = Nd * (K >> 3);
    for (int idx = gt; idx < total; idx += GT) { const int j = idx % Nd, kb = idx / Nd; const int sc = src_col<MAP>(j);
        float v[8];
#pragma unroll
        for (int i = 0; i < 8; ++i) v[i] = sc >= 0 ? src[(size_t)(kb * 8 + i) * src_ld + sc] : 0.f;
        u32x4 w; w.x = pk2(v[0], v[1]); w.y = pk2(v[2], v[3]); w.z = pk2(v[4], v[5]); w.w = pk2(v[6], v[7]);
        *(u32x4*)(dst + (size_t)j * dst_ld + kb * 8) = w; }
}
DEV void norm_rows(const float* xp, const float* xs, const float* g, u16* H) {
    const int tid = tid_o(); const int lane = tid & 63; const int gw = bid_o() * 8 + (tid >> 6), GW = gridDim.x * 8;
    f32x4 gv[4];
#pragma unroll
    for (int i = 0; i < 4; ++i) gv[i] = *(const f32x4*)(g + (lane + 64 * i) * 4);
    for (int row = gw; row < MT; row += GW) {
        const float* src = row < MTP ? xp + (size_t)row * 1024 : xs + (size_t)(row - MTP) * 1024;
        f32x4 v[4]; float ss = 0.f;
#pragma unroll
        for (int i = 0; i < 4; ++i) { v[i] = *(const f32x4*)(src + (lane + 64 * i) * 4); ss += v[i][0] * v[i][0] + v[i][1] * v[i][1] + v[i][2] * v[i][2] + v[i][3] * v[i][3]; }
        ss = wave_sum(ss); const float rs = __builtin_amdgcn_rsqf(ss * (1.f / 1024.f) + EPS);
#pragma unroll
        for (int i = 0; i < 4; ++i) *(u32x2*)(H + (size_t)row * 1024 + (lane + 64 * i) * 4) = pk4(v[i] * rs * gv[i]);
    }
}

DEV void phaseA(CP& p, int l) {
    unsigned char* ws = p.ws;
    const int gt = bid_o() * 512 + tid_o(), GT = gridDim.x * 512;
    conv_T<1>((u16*)(ws + W_WIN), 1024, 1024, NINP, p.in[9] + (size_t)l * 1024 * 8720, 8720, gt, GT);
    for (int b = 0; b < 4; ++b) conv_T<0>((u16*)(ws + W_WBR) + (size_t)(b >> 1) * 1024 * 1024 + (b & 1) * 512, 1024, 512, 1024, p.in[31] + (size_t)(l * 4 + b) * 512 * 1024, 1024, gt, GT);
    conv_T<0>((u16*)(ws + W_WOUT), 1024, 1024, 1024, p.in[32] + (size_t)l * 1024 * 1024, 1024, gt, GT);
    conv_T<0>((u16*)(ws + W_WGLU), 512, 512, 512, p.in[22] + (size_t)l * 512 * 512, 512, gt, GT);
    conv_T<2>((u16*)(ws + W_WUP), 1024, 1024, 5632, p.in[34] + (size_t)l * 1024 * 5632, 5632, gt, GT);
    conv_T<0>((u16*)(ws + W_WDN), 2816, 2816, 1024, p.in[37] + (size_t)l * 2816 * 1024, 1024, gt, GT);
    for (int b = 0; b < 8; ++b) conv_T<0>((u16*)(ws + W_DVTS) + (size_t)b * 512 * 4160, 4160, 4096, 512, p.in[3] + ((size_t)(l * 8 + b) * 4096) * 512, 512, gt, GT);
    {
        const float* ck = p.in[2] + (size_t)l * 8 * 4096 * 512; u16* dk = (u16*)(ws + W_DKS);
        for (int idx = gt; idx < 8 * 4096 * 64; idx += GT) { const int b = idx >> 18, rem = idx & 262143, key = rem >> 6, c8 = (rem & 63) * 8;
            const f32x4 a = *(const f32x4*)(ck + ((size_t)(b * 4096 + key)) * 512 + c8), c = *(const f32x4*)(ck + ((size_t)(b * 4096 + key)) * 512 + c8 + 4);
            u32x4 w; w.x = pk2(a[0], a[1]); w.y = pk2(a[2], a[3]); w.z = pk2(c[0], c[1]); w.w = pk2(c[2], c[3]);
            *(u32x4*)(dk + ((size_t)b * 4160 + key) * 512 + c8) = w; }
    }
    { float* rq = (float*)(ws + W_ROWSQ); for (int i = gt; i < MT; i += GT) rq[i] = 0.f; }
    { const float* wsp = p.in[12] + (size_t)l * 4 * 128 * 128; u16* wm = (u16*)(ws + W_WM); for (int i = gt; i < 4 * 128 * 128; i += GT) { const int t = (i >> 7) & 127, s2 = i & 127; wm[i] = f2bf(s2 <= t ? wsp[i] : 0.f); } }
    { f32x4* mf = (f32x4*)(ws + W_MFS); for (int i = gt; i < 512 * 256; i += GT) mf[i] = (f32x4){0.f, 0.f, 0.f, 0.f}; }
    if (l == 0) { const f32x4* xs = (const f32x4*)p.in[1]; f32x4* xo = (f32x4*)(p.out + (size_t)MTP * 1024); for (int i = gt; i < 512 * 256; i += GT) xo[i] = xs[i]; }
    if (gt == 0) {
        unsigned* misc = (unsigned*)(ws + W_MISC); misc[l] = 0u;
        const float* dl = p.in[29] + l * 256; float s1 = 0.f, s2 = 0.f;
        for (int i = 0; i < 64; ++i) { s1 += dl[i] * dl[64 + i]; s2 += dl[128 + i] * dl[192 + i]; }
        const float lam_init = 0.8f - 0.6f * expf(-0.3f * (float)l);
        ((float*)misc)[8 + 2 * l] = expf(s1) - expf(s2) + lam_init; ((float*)misc)[9 + 2 * l] = lam_init;
    }
    if (l == 0) norm_rows(p.in[0], p.in[1], p.in[8], (u16*)(ws + W_H));
    else norm_rows(p.out, p.out + (size_t)MTP * 1024, p.in[8] + 1024, (u16*)(ws + W_H));
}

DEV void attn_item(CP& p, int l, LAS unsigned char* lds, int grp, int b, int h, int qp) {
    unsigned char* ws = p.ws;
    const int tid = tid_o(), w = tid >> 6, lane = tid & 63, fr = lane & 15, fq = lane >> 4, c = w >> 2, qs = w & 3;
    const int Tk = grp ? 4160 : 2048, nkv = grp ? 65 : 2 * qp + 2;
    const int nact = grp ? (qs < 2 ? 65 : 0) : (qs < 2 ? nkv - 1 : nkv);
    const int rowbase = grp ? MTP + b * 64 : b * 2048 + qp * 128;
    const u16* Kb = grp ? (const u16*)(ws + W_DKS) + (size_t)b * 4160 * 512 : (const u16*)(ws + W_DKP) + (size_t)b * 2048 * 512;
    const u16* Vb = grp ? (const u16*)(ws + W_DVTS) + ((size_t)b * 512 + h * 128) * 4160 : (const u16*)(ws + W_DVTP) + ((size_t)b * 512 + h * 128) * 2048;
    u16* P2 = (u16*)(ws + W_P2);
    bf16x8 qf[2][2];
    if (nact > 0) {
#pragma unroll
        for (int r = 0; r < 2; ++r)
#pragma unroll
            for (int kk = 0; kk < 2; ++kk) qf[r][kk] = *(const bf16x8*)(P2 + (size_t)(rowbase + 32 * qs + 16 * r + fr) * 1024 + 512 + h * 128 + c * 64 + kk * 32 + fq * 8);
    } else {
#pragma unroll
        for (int r = 0; r < 2; ++r)
#pragma unroll
            for (int kk = 0; kk < 2; ++kk) qf[r][kk] = (bf16x8){0, 0, 0, 0, 0, 0, 0, 0};
    }
    constexpr int STG = 36864;
    int gK[2], lK[2], gV[2], lV[2];
#pragma unroll
    for (int i = 0; i < 2; ++i) { const int ch = tid + 512 * i; const int key = ch >> 4, part = ch & 15; gK[i] = key * 512 + h * 128 + part * 8; lK[i] = (((part >> 3) * 64 + key) * 72 + (part & 7) * 8) * 2;
        const int v = ch >> 3, kp = (ch & 7) * 8; gV[i] = v * Tk + kp; lV[i] = (128 * 72 + v * 72 + kp) * 2; }
    u32x4 rk[2], rv[2];
#pragma unroll
    for (int i = 0; i < 2; ++i) { rk[i] = *(const u32x4*)(Kb + gK[i]); rv[i] = *(const u32x4*)(Vb + gV[i]); }
#pragma unroll
    for (int i = 0; i < 2; ++i) { *(LAS u32x4*)(lds + lK[i]) = rk[i]; *(LAS u32x4*)(lds + lV[i]) = rv[i]; }
    __syncthreads();
    f32x4 O[2][8];
#pragma unroll
    for (int r = 0; r < 2; ++r)
#pragma unroll
        for (int i = 0; i < 8; ++i) O[r][i] = (f32x4){0.f, 0.f, 0.f, 0.f};
    float mrun[2] = {-1e30f, -1e30f}, lrun[2] = {0.f, 0.f};
    for (int kt = 0; kt < nkv; ++kt) {
        const bool more = kt + 1 < nkv;
        if (more) { const size_t k0 = (size_t)(kt + 1) * 64;
#pragma unroll
            for (int i = 0; i < 2; ++i) { rk[i] = *(const u32x4*)(Kb + k0 * 512 + gK[i]); rv[i] = *(const u32x4*)(Vb + k0 + gV[i]); } }
        if (kt < nact) {
            LAS unsigned char* st = lds + (kt & 1) * STG;
            f32x4 s[2][4];
#pragma unroll
            for (int jt = 0; jt < 4; ++jt) { s[0][jt] = (f32x4){0.f, 0.f, 0.f, 0.f}; s[1][jt] = (f32x4){0.f, 0.f, 0.f, 0.f};
#pragma unroll
                for (int kk = 0; kk < 2; ++kk) { const bf16x8 kf = *(const LAS bf16x8*)(st + ((c * 64 + 16 * jt + fr) * 72 + kk * 32 + fq * 8) * 2);
                    s[0][jt] = mfma16(kf, qf[0][kk], s[0][jt]); s[1][jt] = mfma16(kf, qf[1][kk], s[1][jt]); } }
            bf16x8 pf[2][2];
#pragma unroll
            for (int r = 0; r < 2; ++r) {
                float mt = s[r][0][0];
#pragma unroll
                for (int jt = 0; jt < 4; ++jt)
#pragma unroll
                    for (int e = 0; e < 4; ++e) mt = fmaxf(mt, s[r][jt][e]);
                mt = fmaxf(mt, __shfl_xor(mt, 16)); mt = fmaxf(mt, __shfl_xor(mt, 32));
                const float mnew = fmaxf(mrun[r], mt), alpha = __builtin_amdgcn_exp2f(mrun[r] - mnew); mrun[r] = mnew;
                float ps = 0.f;
#pragma unroll
                for (int jt = 0; jt < 4; ++jt)
#pragma unroll
                    for (int e = 0; e < 4; ++e) { s[r][jt][e] = __builtin_amdgcn_exp2f(s[r][jt][e] - mnew); ps += s[r][jt][e]; }
                lrun[r] = lrun[r] * alpha + ps;
#pragma unroll
                for (int i = 0; i < 8; ++i) O[r][i] *= alpha;
#pragma unroll
                for (int t = 0; t < 2; ++t) { const u32x2 lo = pk4(s[r][2 * t]), hi = pk4(s[r][2 * t + 1]); u32x4 wv; wv.x = lo.x; wv.y = lo.y; wv.z = hi.x; wv.w = hi.y; pf[r][t] = __builtin_bit_cast(bf16x8, wv); }
            }
#pragma unroll
            for (int vt = 0; vt < 8; ++vt)
#pragma unroll
                for (int t = 0; t < 2; ++t) { const LAS unsigned char* vp = st + (128 * 72 + (16 * vt + fr) * 72 + 32 * t + 4 * fq) * 2;
                    const u32x2 a = *(const LAS u32x2*)vp, bq = *(const LAS u32x2*)(vp + 32); u32x4 wv; wv.x = a.x; wv.y = a.y; wv.z = bq.x; wv.w = bq.y;
                    const bf16x8 vf = __builtin_bit_cast(bf16x8, wv);
                    O[0][vt] = mfma16(vf, pf[0][t], O[0][vt]); O[1][vt] = mfma16(vf, pf[1][t], O[1][vt]); }
        }
        if (more) { LAS unsigned char* nx = lds + ((kt + 1) & 1) * STG;
#pragma unroll
            for (int i = 0; i < 2; ++i) { *(LAS u32x4*)(nx + lK[i]) = rk[i]; *(LAS u32x4*)(nx + lV[i]) = rv[i]; } }
        __syncthreads();
    }
    const float lam = ((const float*)(ws + W_MISC))[8 + 2 * l], lam_init = ((const float*)(ws + W_MISC))[9 + 2 * l];
    LAS float* X = (LAS float*)lds;
    float inv[2];
#pragma unroll
    for (int r = 0; r < 2; ++r) inv[r] = __builtin_amdgcn_rcpf(fmaxf(red_fq(lrun[r]), 1e-30f));
    if (c == 1) {
#pragma unroll
        for (int r = 0; r < 2; ++r)
#pragma unroll
            for (int vt = 0; vt < 8; ++vt)
#pragma unroll
                for (int e = 0; e < 4; ++e) X[(qs * 64 + r * 32 + vt * 4 + e) * 64 + lane] = O[r][vt][e] * inv[r] * lam;
    }
    __syncthreads();
    if (c == 0 && nact > 0) {
        const float* g = p.in[30] + l * 128;
#pragma unroll
        for (int r = 0; r < 2; ++r) { float ss = 0.f;
#pragma unroll
            for (int vt = 0; vt < 8; ++vt)
#pragma unroll
                for (int e = 0; e < 4; ++e) { const float d = O[r][vt][e] * inv[r] - X[(qs * 64 + r * 32 + vt * 4 + e) * 64 + lane]; O[r][vt][e] = d; ss += d * d; }
            ss = red_fq(ss); const float rs = __builtin_amdgcn_rsqf(ss * (1.f / 128.f) + EPS) * (1.f - lam_init);
#pragma unroll
            for (int vt = 0; vt < 8; ++vt) { const f32x4 gv = *(const f32x4*)(g + 16 * vt + 4 * fq);
                *(u32x2*)(P2 + (size_t)(rowbase + 32 * qs + 16 * r + fr) * 1024 + 512 + h * 128 + 16 * vt + 4 * fq) = pk4(O[r][vt] * rs * gv); } }
    }
    __syncthreads();
}

DEV void gla_item(CP& p, int l, LAS unsigned char* lds, int grp, int b, int h) {
    unsigned char* ws = p.ws;
    const int tid = tid_o(), w = tid >> 6, lane = tid & 63, fr = lane & 15, fq = lane >> 4;
    const int T = grp ? 64 : 2048, nch = grp ? 1 : 32; const int rowbase = grp ? MTP + b * 64 : b * 2048;
    const u16* CQ = (const u16*)(ws + W_CQ); const u16* CK = (const u16*)(ws + W_CK); const float* CODE = (const float*)(ws + W_CODE);
    const u16* VT = (const u16*)(ws + W_CVT) + (grp ? (size_t)16 * 512 * 2048 : 0) + ((size_t)b * 512 + h * 128) * T;
    u16* P2 = (u16*)(ws + W_P2);
    LAS u16* QE = (LAS u16*)lds; LAS u16* KE = QE + 64 * 72; LAS u16* KDT = KE + 64 * 72; LAS u16* VTl = KDT + 64 * 72;
    LAS u16* PP = VTl + 128 * 72; LAS u16* STb = PP + 64 * 72;
    LAS float* OT = (LAS float*)(STb + 8 * 16 * 72); LAS float* SEG = OT + 64 * 132; LAS float* DEC = SEG + 8 * 64;
    LAS u16* QR = (LAS u16*)(DEC + 64); LAS u16* KR = QR + 64 * 72; LAS float* CD = (LAS float*)(KR + 64 * 72);
    const int d_ = tid & 63, seg = tid >> 6;
    float wa[16];
#pragma unroll
    for (int r = 0; r < 16; ++r) wa[r] = p.in[24][(size_t)l * 16 * 256 + r * 256 + h * 64 + d_];
    const float ba = p.in[25][l * 256 + h * 64 + d_];
    f32x4 S[4];
    if (grp) { const float* s0 = p.in[6] + ((size_t)(l * 8 + b) * 4 + h) * 64 * 128;
#pragma unroll
        for (int dt = 0; dt < 4; ++dt) S[dt] = *(const f32x4*)(s0 + (size_t)(16 * dt + fr) * 128 + 16 * w + 4 * fq); }
    else {
#pragma unroll
        for (int dt = 0; dt < 4; ++dt) S[dt] = (f32x4){0.f, 0.f, 0.f, 0.f}; }
#pragma unroll
    for (int dt = 0; dt < 4; ++dt)
#pragma unroll
        for (int e = 0; e < 4; ++e) STb[(w * 16 + 4 * fq + e) * 72 + 16 * dt + fr] = f2bf(S[dt][e]);
    const float* gng = p.in[26] + l * 128;
    const int tl = tid >> 3, d8 = (tid & 7) * 8;
    u32x4 rq, rkk, rvv[2]; f32x2 rcd;
    {
        rq = *(const u32x4*)(CQ + (size_t)(rowbase + tl) * 256 + h * 64 + d8); rkk = *(const u32x4*)(CK + (size_t)(rowbase + tl) * 256 + h * 64 + d8);
        rcd = *(const f32x2*)(CODE + (size_t)(rowbase + tl) * 16 + (tid & 7) * 2);
#pragma unroll
        for (int i = 0; i < 2; ++i) { const int chn = tid + 512 * i, v = chn >> 3, kp = (chn & 7) * 8; rvv[i] = *(const u32x4*)(VT + (size_t)v * T + kp); }
    }
    for (int ch = 0; ch < nch; ++ch) {
        const int r0 = rowbase + ch * 64;
        *(LAS u32x4*)(QR + tl * 72 + d8) = rq; *(LAS u32x4*)(KR + tl * 72 + d8) = rkk; *(LAS f32x2*)(CD + tl * 16 + (tid & 7) * 2) = rcd;
#pragma unroll
        for (int i = 0; i < 2; ++i) { const int chn = tid + 512 * i, v = chn >> 3, kp = (chn & 7) * 8; *(LAS u32x4*)(VTl + v * 72 + kp) = rvv[i]; }
        if (ch + 1 < nch) { const int r1 = r0 + 64;
            rq = *(const u32x4*)(CQ + (size_t)(r1 + tl) * 256 + h * 64 + d8); rkk = *(const u32x4*)(CK + (size_t)(r1 + tl) * 256 + h * 64 + d8);
            rcd = *(const f32x2*)(CODE + (size_t)(r1 + tl) * 16 + (tid & 7) * 2);
#pragma unroll
            for (int i = 0; i < 2; ++i) { const int chn = tid + 512 * i, v = chn >> 3, kp = (chn & 7) * 8; rvv[i] = *(const u32x4*)(VT + (size_t)v * T + (ch + 1) * 64 + kp); } }
        u16* yp = P2 + (size_t)(r0 + tl) * 1024 + h * 128 + (tid & 7) * 16;
        const u32x4 rr0 = *(const u32x4*)yp, rr1 = *(const u32x4*)(yp + 8);
        __syncthreads();
        float bl[8]; float run = 0.f;
#pragma unroll
        for (int i = 0; i < 8; ++i) { const LAS float* cp = CD + (seg * 8 + i) * 16; float a = ba;
#pragma unroll
            for (int r = 0; r < 16; ++r) a += cp[r] * wa[r];
            run += flogsig(a) * (1.f / 16.f); bl[i] = run; }
        SEG[seg * 64 + d_] = run;
        __syncthreads();
        float off = 0.f, tot = 0.f;
#pragma unroll
        for (int s2 = 0; s2 < 8; ++s2) { const float x = SEG[s2 * 64 + d_]; tot += x; if (s2 < seg) off += x; }
        if (seg == 0) DEC[d_] = __expf(tot);
        { float kd[8];
#pragma unroll
          for (int i = 0; i < 8; ++i) { const int t = seg * 8 + i; const float bb = bl[i] + off;
              const float q = bf2f(QR[t * 72 + d_]), k = bf2f(KR[t * 72 + d_]);
              QE[t * 72 + d_] = f2bf(q * __expf(bb)); KE[t * 72 + d_] = f2bf(k * __expf(-bb)); kd[i] = k * __expf(tot - bb); }
          u32x4 wv; wv.x = pk2(kd[0], kd[1]); wv.y = pk2(kd[2], kd[3]); wv.z = pk2(kd[4], kd[5]); wv.w = pk2(kd[6], kd[7]);
          *(LAS u32x4*)(KDT + d_ * 72 + seg * 8) = wv; }
        __syncthreads();
#pragma unroll
        for (int r = 0; r < 2; ++r) { const int ti = w + 8 * r, jt = ti >> 2, it = ti & 3; f32x4 a = (f32x4){0.f, 0.f, 0.f, 0.f};
            if (jt <= it) {
#pragma unroll
                for (int kk = 0; kk < 2; ++kk) { const bf16x8 kf = *(const LAS bf16x8*)(KE + (16 * jt + fr) * 72 + kk * 32 + fq * 8), qf = *(const LAS bf16x8*)(QE + (16 * it + fr) * 72 + kk * 32 + fq * 8); a = mfma16(kf, qf, a); }
#pragma unroll
                for (int e = 0; e < 4; ++e) if (16 * jt + 4 * fq + e > 16 * it + fr) a[e] = 0.f;
            }
            *(LAS u32x2*)(PP + (16 * it + fr) * 72 + 16 * jt + 4 * fq) = pk4(a); }
        __syncthreads();
        bf16x8 vf[2], sf[2];
#pragma unroll
        for (int t = 0; t < 2; ++t) { vf[t] = *(const LAS bf16x8*)(VTl + (16 * w + fr) * 72 + 32 * t + 8 * fq); sf[t] = *(const LAS bf16x8*)(STb + (w * 16 + fr) * 72 + 32 * t + 8 * fq); }
#pragma unroll
        for (int it = 0; it < 4; ++it) { f32x4 a = (f32x4){0.f, 0.f, 0.f, 0.f};
#pragma unroll
            for (int t = 0; t < 2; ++t) { const bf16x8 pf = *(const LAS bf16x8*)(PP + (16 * it + fr) * 72 + 32 * t + 8 * fq), qf = *(const LAS bf16x8*)(QE + (16 * it + fr) * 72 + 32 * t + 8 * fq);
                a = mfma16(vf[t], pf, a); a = mfma16(sf[t], qf, a); }
            *(LAS f32x4*)(OT + (16 * it + fr) * 132 + 16 * w + 4 * fq) = a; }
#pragma unroll
        for (int dt = 0; dt < 4; ++dt) { S[dt] *= DEC[16 * dt + fr];
#pragma unroll
            for (int t = 0; t < 2; ++t) { const bf16x8 kf = *(const LAS bf16x8*)(KDT + (16 * dt + fr) * 72 + 32 * t + 8 * fq); S[dt] = mfma16(vf[t], kf, S[dt]); }
#pragma unroll
            for (int e = 0; e < 4; ++e) STb[(w * 16 + 4 * fq + e) * 72 + 16 * dt + fr] = f2bf(S[dt][e]); }
        __syncthreads();
        {
            const int i = tid >> 3, vs = tid & 7; f32x4 o[4]; float ss = 0.f;
#pragma unroll
            for (int k = 0; k < 4; ++k) { o[k] = *(const LAS f32x4*)(OT + i * 132 + vs * 16 + 4 * k); ss += o[k][0] * o[k][0] + o[k][1] * o[k][1] + o[k][2] * o[k][2] + o[k][3] * o[k][3]; }
            ss += __shfl_xor(ss, 1); ss += __shfl_xor(ss, 2); ss += __shfl_xor(ss, 4);
            const float rs = __builtin_amdgcn_rsqf(ss * (1.f / 128.f) + EPS);
            const unsigned rw[8] = {rr0.x, rr0.y, rr0.z, rr0.w, rr1.x, rr1.y, rr1.z, rr1.w};
#pragma unroll
            for (int k = 0; k < 4; ++k) { const f32x4 gv = *(const f32x4*)(gng + vs * 16 + 4 * k);
                f32x4 r; r[0] = __uint_as_float(rw[2 * k] << 16); r[1] = __uint_as_float(rw[2 * k] & 0xffff0000u); r[2] = __uint_as_float(rw[2 * k + 1] << 16); r[3] = __uint_as_float(rw[2 * k + 1] & 0xffff0000u);
                *(u32x2*)(yp + 4 * k) = pk4(o[k] * rs * gv * r); }
        }
    }
    float* so = p.out + (grp ? O_GLAS + (size_t)l * 262144 + ((size_t)b * 4 + h) * 8192 : O_GLAP + (size_t)l * 524288 + ((size_t)b * 4 + h) * 8192);
#pragma unroll
    for (int dt = 0; dt < 4; ++dt) *(f32x4*)(so + (size_t)(16 * dt + fr) * 128 + 16 * w + 4 * fq) = S[dt];
    __syncthreads();
}

DEV void s5_item(CP& p, int l, LAS unsigned char* lds, int grp, int b, int gq) {
    unsigned char* ws = p.ws;
    const int tid = tid_o(), w = tid >> 6, lane = tid & 63, fr = lane & 15, fq = lane >> 4;
    const int g = gq * 8 + w; const int T = grp ? 64 : 2048; const int rowbase = grp ? MTP + b * 64 : b * 2048;
    u16* X = (u16*)(ws + W_S5);
    LAS u16* HT = (LAS u16*)lds + w * 32 * 136;
    const float dt = __expf(p.in[16][l * 32 + g]);
    bf16x8 breF[4], bimF[4]; float ar[4], ai[4], a8r[4], a8i[4];
#pragma unroll
    for (int pt = 0; pt < 4; ++pt) { const int pp = 16 * pt + fr; const size_t gp = (size_t)(l * 32 + g) * 64 + pp;
        const float lr = p.in[14][gp], li = p.in[15][gp];
        const float mag = __expf(lr * dt), ang = li * dt * 0.15915494309189535f;
        const float r_ = mag * __builtin_amdgcn_cosf(ang), i_ = mag * __builtin_amdgcn_sinf(ang);
        ar[pt] = r_; ai[pt] = i_;
        float xr = r_, xi = i_;
#pragma unroll
        for (int k = 0; k < 3; ++k) { const float nr2 = xr * xr - xi * xi, ni2 = 2.f * xr * xi; xr = nr2; xi = ni2; }
        a8r[pt] = xr; a8i[pt] = xi;
        const float den = lr * lr + li * li, nr = r_ - 1.f, ni = i_;
        const float kr = (nr * lr + ni * li) / den, ki = (ni * lr - nr * li) / den;
        float vr[8], vi[8];
#pragma unroll
        for (int j = 0; j < 8; ++j) { float br = 0.f, bi = 0.f; if (fq < 2) { br = p.in[17][gp * 16 + fq * 8 + j]; bi = p.in[18][gp * 16 + fq * 8 + j]; }
            vr[j] = kr * br - ki * bi; vi[j] = kr * bi + ki * br; }
        u32x4 wr_, wi_; wr_.x = pk2(vr[0], vr[1]); wr_.y = pk2(vr[2], vr[3]); wr_.z = pk2(vr[4], vr[5]); wr_.w = pk2(vr[6], vr[7]);
        wi_.x = pk2(vi[0], vi[1]); wi_.y = pk2(vi[2], vi[3]); wi_.z = pk2(vi[4], vi[5]); wi_.w = pk2(vi[6], vi[7]);
        breF[pt] = __builtin_bit_cast(bf16x8, wr_); bimF[pt] = __builtin_bit_cast(bf16x8, wi_); }
    bf16x8 cF[4];
#pragma unroll
    for (int ks = 0; ks < 4; ++ks) { float v[8]; const int k0 = 32 * ks + 8 * fq;
#pragma unroll
        for (int j = 0; j < 8; ++j) { const int k = k0 + j; v[j] = k < 64 ? p.in[19][((size_t)(l * 32 + g) * 16 + fr) * 64 + k] : -p.in[20][((size_t)(l * 32 + g) * 16 + fr) * 64 + k - 64]; }
        u32x4 wv; wv.x = pk2(v[0], v[1]); wv.y = pk2(v[2], v[3]); wv.z = pk2(v[4], v[5]); wv.w = pk2(v[6], v[7]); cF[ks] = __builtin_bit_cast(bf16x8, wv); }
    const f32x4 dsk = *(const f32x4*)(p.in[21] + l * 512 + g * 16 + 4 * fq);
    float Hr[4], Hi[4];
#pragma unroll
    for (int pt = 0; pt < 4; ++pt) { if (grp) { const size_t sp = ((size_t)(l * 8 + b) * 32 + g) * 64 + 16 * pt + fr; Hr[pt] = p.in[4][sp]; Hi[pt] = p.in[5][sp]; } else { Hr[pt] = 0.f; Hi[pt] = 0.f; } }
    const int trow = 8 * (fr >> 2) + (fr & 3);
    u32x4 xn[2];
#pragma unroll
    for (int tt = 0; tt < 2; ++tt) { xn[tt] = (u32x4){0u, 0u, 0u, 0u}; if (fq < 2) xn[tt] = *(const u32x4*)(X + (size_t)(rowbase + trow + 4 * tt) * 512 + g * 16 + fq * 8); }
    for (int ch = 0; ch < T / 32; ++ch) {
        const int r0 = rowbase + ch * 32;
        bf16x8 xF[2];
#pragma unroll
        for (int tt = 0; tt < 2; ++tt) xF[tt] = __builtin_bit_cast(bf16x8, xn[tt]);
        if (ch + 1 < T / 32) {
#pragma unroll
            for (int tt = 0; tt < 2; ++tt) if (fq < 2) xn[tt] = *(const u32x4*)(X + (size_t)(r0 + 32 + trow + 4 * tt) * 512 + g * 16 + fq * 8); }
        u32x2 xsk[2];
#pragma unroll
        for (int t2 = 0; t2 < 2; ++t2) xsk[t2] = *(const u32x2*)(X + (size_t)(r0 + 16 * t2 + fr) * 512 + g * 16 + 4 * fq);
        f32x4 bur[2][4], bui[2][4];
#pragma unroll
        for (int tt = 0; tt < 2; ++tt)
#pragma unroll
            for (int pt = 0; pt < 4; ++pt) { bur[tt][pt] = mfma16(xF[tt], breF[pt], (f32x4){0.f, 0.f, 0.f, 0.f}); bui[tt][pt] = mfma16(xF[tt], bimF[pt], (f32x4){0.f, 0.f, 0.f, 0.f}); }
#pragma unroll
        for (int pt = 0; pt < 4; ++pt) {
            float er = 0.f, ei = 0.f;
#pragma unroll
            for (int k = 0; k < 8; ++k) { const float ur = bur[k >> 2][pt][k & 3], ui = bui[k >> 2][pt][k & 3]; const float nr = ar[pt] * er - ai[pt] * ei + ur, ni = ar[pt] * ei + ai[pt] * er + ui; er = nr; ei = ni; }
            float cr = Hr[pt], ci = Hi[pt], mr = cr, mi = ci;
#pragma unroll
            for (int q = 0; q < 4; ++q) { const float Er = __shfl(er, fr + 16 * q), Ei = __shfl(ei, fr + 16 * q);
                const float nr = a8r[pt] * cr - a8i[pt] * ci + Er, ni = a8r[pt] * ci + a8i[pt] * cr + Ei; cr = nr; ci = ni;
                if (q + 1 == fq) { mr = cr; mi = ci; } }
            Hr[pt] = cr; Hi[pt] = ci;
            float hr = mr, hi = mi;
#pragma unroll
            for (int k = 0; k < 8; ++k) { const float ur = bur[k >> 2][pt][k & 3], ui = bui[k >> 2][pt][k & 3]; const float nr = ar[pt] * hr - ai[pt] * hi + ur, ni = ar[pt] * hi + ai[pt] * hr + ui; hr = nr; hi = ni;
                HT[(8 * fq + k) * 136 + 16 * pt + fr] = f2bf(hr); HT[(8 * fq + k) * 136 + 64 + 16 * pt + fr] = f2bf(hi); }
        }
        asm volatile("s_waitcnt lgkmcnt(0)" ::: "memory");
        f32x4 y[2];
#pragma unroll
        for (int t2 = 0; t2 < 2; ++t2) { y[t2] = (f32x4){0.f, 0.f, 0.f, 0.f};
#pragma unroll
            for (int ks = 0; ks < 4; ++ks) { const bf16x8 hf = *(const LAS bf16x8*)(HT + (16 * t2 + fr) * 136 + 32 * ks + 8 * fq); y[t2] = mfma16(cF[ks], hf, y[t2]); } }
#pragma unroll
        for (int t2 = 0; t2 < 2; ++t2) { u16* xp = X + (size_t)(r0 + 16 * t2 + fr) * 512 + g * 16 + 4 * fq; const u32x2 xx = xsk[t2];
            f32x4 xv; xv[0] = __uint_as_float(xx.x << 16); xv[1] = __uint_as_float(xx.x & 0xffff0000u); xv[2] = __uint_as_float(xx.y << 16); xv[3] = __uint_as_float(xx.y & 0xffff0000u);
            f32x4 z = y[t2] + dsk * xv;
#pragma unroll
            for (int e = 0; e < 4; ++e) z[e] = fgelu(z[e]);
            *(u32x2*)xp = pk4(z); }
        asm volatile("" ::: "memory");
    }
    if (fq == 0) { float* ore = p.out + (grp ? O_SRES + (size_t)l * 16384 + ((size_t)b * 32 + g) * 64 : O_SREP + (size_t)l * 32768 + ((size_t)b * 32 + g) * 64);
        float* oim = p.out + (grp ? O_SIMS + (size_t)l * 16384 + ((size_t)b * 32 + g) * 64 : O_SIMP + (size_t)l * 32768 + ((size_t)b * 32 + g) * 64);
#pragma unroll
        for (int pt = 0; pt < 4; ++pt) { ore[16 * pt + fr] = Hr[pt]; oim[16 * pt + fr] = Hi[pt]; } }
    __syncthreads();
}

DEV void gmlp_item(CP& p, int l, LAS unsigned char* lds, int grp, int b, int n, int g) {
    unsigned char* ws = p.ws;
    const int tid = tid_o(), w = tid >> 6, lane = tid & 63, fr = lane & 15, fq = lane >> 4;
    const int L = grp ? 64 : 128, T = grp ? 64 : 2048; const int rowbase = grp ? MTP + b * 64 : b * 2048 + n * 128;
    LAS u16* WT = (LAS u16*)lds; LAS u16* GT = WT + 128 * 136; LAS float* RS = (LAS float*)(GT + 128 * 136);
    const float* rowsq = (const float*)(ws + W_ROWSQ);
    if (tid < L) RS[tid] = __builtin_amdgcn_rsqf(rowsq[rowbase + tid] * (1.f / 512.f) + EPS);
    const u16* GV = (const u16*)(ws + W_GVT) + (grp ? (size_t)16 * 512 * 2048 : 0) + ((size_t)b * 512 + g * 128) * T + (grp ? 0 : n * 128);
    const u16* WM = (const u16*)(ws + W_WM) + (size_t)g * 128 * 128;
    const int cshift = grp ? 3 : 4, nchunk = 128 << cshift, nwch = L << cshift;
    u16* P1 = (u16*)(ws + W_P1);
    u32x4 gq[4], wq[4];
#pragma unroll
    for (int i = 0; i < 4; ++i) { const int chn = tid + 512 * i; const int cg_ = chn < nchunk ? chn : 0, cw_ = chn < nwch ? chn : 0;
        gq[i] = *(const u32x4*)(GV + (size_t)(cg_ >> cshift) * T + (cg_ & ((1 << cshift) - 1)) * 8);
        wq[i] = *(const u32x4*)(WM + (size_t)(cw_ >> cshift) * 128 + (cw_ & ((1 << cshift) - 1)) * 8); }
    u32x2 uq[8]; float bq[8];
    const int ntt = L >> 4;
#pragma unroll
    for (int tt = 0; tt < 8; ++tt) { const int t = tt < ntt ? 16 * tt + fr : fr; uq[tt] = *(const u32x2*)(P1 + (size_t)(rowbase + t) * 1024 + g * 128 + 16 * w + 4 * fq); bq[tt] = p.in[13][(size_t)(l * 4 + g) * 128 + t]; }
    const f32x4 gvg = *(const f32x4*)(p.in[11] + l * 512 + g * 128 + 16 * w + 4 * fq);
    __syncthreads();
#pragma unroll
    for (int i = 0; i < 4; ++i) { const int chn = tid + 512 * i;
        if (chn < nchunk) { const int c = chn >> cshift, kp = (chn & ((1 << cshift) - 1)) * 8; const unsigned gw[4] = {gq[i].x, gq[i].y, gq[i].z, gq[i].w}; u32x4 o;
            unsigned ow[4];
#pragma unroll
            for (int k = 0; k < 4; ++k) ow[k] = pk2(__uint_as_float(gw[k] << 16) * RS[kp + 2 * k], __uint_as_float(gw[k] & 0xffff0000u) * RS[kp + 2 * k + 1]);
            o.x = ow[0]; o.y = ow[1]; o.z = ow[2]; o.w = ow[3]; *(LAS u32x4*)(GT + c * 136 + kp) = o; }
        if (chn < nwch) { const int t = chn >> cshift, kp = (chn & ((1 << cshift) - 1)) * 8; *(LAS u32x4*)(WT + t * 136 + kp) = wq[i]; } }
    __syncthreads();
#pragma unroll
    for (int tt = 0; tt < 8; ++tt) { if (tt < ntt) { f32x4 a = (f32x4){0.f, 0.f, 0.f, 0.f};
        for (int ks = 0; ks < L / 32; ++ks) { if (32 * ks > 16 * tt + 15) break;
            const bf16x8 gf = *(const LAS bf16x8*)(GT + (16 * w + fr) * 136 + 32 * ks + 8 * fq), wf = *(const LAS bf16x8*)(WT + (16 * tt + fr) * 136 + 32 * ks + 8 * fq); a = mfma16(gf, wf, a); }
        const int t = 16 * tt + fr;
        f32x4 u; u[0] = __uint_as_float(uq[tt].x << 16); u[1] = __uint_as_float(uq[tt].x & 0xffff0000u); u[2] = __uint_as_float(uq[tt].y << 16); u[3] = __uint_as_float(uq[tt].y & 0xffff0000u);
        *(u32x2*)(P1 + (size_t)(rowbase + t) * 1024 + g * 128 + 16 * w + 4 * fq) = pk4(u * (a * gvg + bq[tt])); } }
    if (grp) {
        float* o = p.out + O_GMV + (size_t)l * 262144 + (size_t)b * 64 * 512; const float* gg = p.in[11] + l * 512 + g * 128;
        for (int idx = tid; idx < 64 * 128; idx += 512) { const int t = idx >> 7, c = idx & 127; o[(size_t)t * 512 + g * 128 + c] = bf2f(GT[c * 136 + t]) * gg[c]; }
    }
    __syncthreads();
}

DEV void phaseMix(CP& p, int l, LAS unsigned char* lds) {
    unsigned* ctr = (unsigned*)(p.ws + W_MISC) + l;
    LAS int* slot = (LAS int*)(lds + 160 * 1024 - 16);
    for (;;) {
        if (tid_o() == 0) *slot = (int)atomicAdd(ctr, 1u);
        __syncthreads();
        int it = __builtin_amdgcn_readfirstlane(*slot);
        __syncthreads();
        if (it >= 2304) break;
        int kind, grp = 0, a0, a1, a2 = 0;
        if (it < 64) { kind = 0; a0 = it >> 2; a1 = it & 3; }
        else if (it < 128) { it -= 64; kind = 1; a0 = it >> 2; a1 = it & 3; }
        else if (it < 160) { it -= 128; kind = 2; grp = 1; a0 = it >> 2; a1 = it & 3; }
        else if (it < 1184) { it -= 160; kind = 2; a2 = 15 - (it >> 6); a0 = (it & 63) >> 2; a1 = it & 3; }
        else if (it < 2208) { it -= 1184; kind = 3; a0 = it >> 6; a2 = (it >> 2) & 15; a1 = it & 3; }
        else if (it < 2240) { it -= 2208; kind = 0; grp = 1; a0 = it >> 2; a1 = it & 3; }
        else if (it < 2272) { it -= 2240; kind = 1; grp = 1; a0 = it >> 2; a1 = it & 3; }
        else { it -= 2272; kind = 3; grp = 1; a0 = it >> 2; a1 = it & 3; }
        asm volatile("" : "+s"(kind), "+s"(grp), "+s"(a0), "+s"(a1), "+s"(a2));
        if (kind == 0) {
#ifndef NO_S5
            s5_item(p, l, lds, grp, a0, a1);
#endif
        } else if (kind == 1) {
#ifndef NO_GLA
#ifdef GLA_SAMPLE_ONLY
            if (grp)
#endif
            gla_item(p, l, lds, grp, a0, a1);
#endif
        } else if (kind == 2) {
#ifndef NO_ATT
            attn_item(p, l, lds, grp, a0, a1, a2);
#endif
        } else {
#ifndef NO_GMLP
            gmlp_item(p, l, lds, grp, a0, a2, a1);
#endif
        }
    }
}

DEV void phaseFix(CP& p, int l) {
    unsigned char* ws = p.ws; const int gt = bid_o() * 512 + tid_o(), GT = gridDim.x * 512;
    const float* HEAD = (const float*)(ws + W_HEAD); const float* TAIL = (const float*)(ws + W_TAIL); u16* ACT = (u16*)(ws + W_ACT);
    const float* cw = p.in[35] + (size_t)l * 3 * 5632; const float* cb = p.in[36] + (size_t)l * 5632;
    for (int idx = gt; idx < 520 * 2816; idx += GT) { const int slab = idx / 2816, f = idx % 2816;
        float c0[2], c1[2];
#pragma unroll
        for (int bj = 0; bj < 2; ++bj) { const int ff = bj * 2816 + f; float pm2 = 0.f, pm1 = 0.f;
            if (slab >= 512) { const float* st = p.in[7] + ((size_t)(l * 8 + (slab - 512)) * 2) * 5632; pm2 = st[ff]; pm1 = st[5632 + ff]; }
            else if (slab & 31) { pm2 = TAIL[((size_t)(slab - 1) * 2) * 5632 + ff]; pm1 = TAIL[((size_t)(slab - 1) * 2 + 1) * 5632 + ff]; }
            const float h0 = HEAD[((size_t)slab * 2) * 5632 + ff], h1 = HEAD[((size_t)slab * 2 + 1) * 5632 + ff];
            const float w0 = cw[ff], w1 = cw[5632 + ff], w2 = cw[11264 + ff], bb = cb[ff];
            c0[bj] = bb + w0 * pm2 + w1 * pm1 + w2 * h0; c1[bj] = bb + w0 * pm1 + w1 * h0 + w2 * h1; }
        ACT[(size_t)(slab * 64) * 2816 + f] = f2bf(fsilu(c0[0]) * c0[1]); ACT[(size_t)(slab * 64 + 1) * 2816 + f] = f2bf(fsilu(c1[0]) * c1[1]); }
    for (int idx = gt; idx < 24 * 2 * 5632; idx += GT) { const int bb = idx / 11264, rem = idx % 11264;
        if (bb < 16) p.out[O_FCP + (size_t)l * 180224 + (size_t)bb * 11264 + rem] = TAIL[((size_t)(bb * 32 + 31) * 2) * 5632 + rem];
        else p.out[O_FCS + (size_t)l * 90112 + (size_t)(bb - 16) * 11264 + rem] = TAIL[((size_t)(512 + bb - 16) * 2) * 5632 + rem]; }
}

#define XB_TMO      128
#define XB_XCNT(j)  (256  + 64 * (j))
#define XB_XSUB(j)  (1280 + 64 * (j))
#define XB_XGEN(j)  (2304 + 64 * (j))
#define XB_TOP      3328
#define XB_TOPGEN   3392
#define XCD_BAR_WORDS 3456
#define XB_SPIN_CAP (1u << 18)

__device__ __forceinline__ unsigned xb_ld(unsigned* p)              { return __hip_atomic_load(p, __ATOMIC_RELAXED, __HIP_MEMORY_SCOPE_AGENT); }
__device__ __forceinline__ unsigned xb_add(unsigned* p, unsigned v) { return __hip_atomic_fetch_add(p, v, __ATOMIC_RELAXED, __HIP_MEMORY_SCOPE_AGENT); }
__device__ __forceinline__ unsigned xb_xcc_id() { return (unsigned)__builtin_amdgcn_s_getreg((3 << 11) | 20) & 0xFu; }
#define XB_SPIN(cond, bar) do { unsigned _sp = 0; while (cond) { __builtin_amdgcn_s_sleep(1); \
    if ((++_sp & 255u) == 0u) { if (xb_ld(&(bar)[XB_TMO])) break; if (_sp > XB_SPIN_CAP) { atomicAdd(&(bar)[XB_TMO], 1u); break; } } } } while (0)

struct XcdBarrier {
    unsigned* bar; unsigned x;
    volatile LAS unsigned* st;
};

__device__ __forceinline__ XcdBarrier xcd_barrier_post(unsigned* bar, volatile LAS unsigned* st) {
    XcdBarrier b; b.bar = bar; b.x = xb_xcc_id(); b.st = st;
    if (threadIdx.x == 0) (void)xb_add(&bar[XB_XCNT(b.x)], 1u);
    return b;
}
__device__ __forceinline__ void xcd_barrier_complete(unsigned* bar, unsigned x, unsigned& nloc, unsigned& nx) {
    const unsigned G = gridDim.x * gridDim.y * gridDim.z;
    unsigned sum, cnt, mine, sp = 0u;
    for (;;) {
        sum = 0u; cnt = 0u; mine = 0u;
#pragma unroll
        for (unsigned j = 0; j < 16; ++j) { const unsigned c = xb_ld(&bar[XB_XCNT(j)]); sum += c; cnt += (c > 0u) ? 1u : 0u; mine = (j == x) ? c : mine; }
        if (sum == G) break;
        __builtin_amdgcn_s_sleep(1);
        if ((++sp & 255u) == 0u) { if (xb_ld(&bar[XB_TMO])) break; if (sp > XB_SPIN_CAP) { atomicAdd(&bar[XB_TMO], 1u); break; } }
    }
    nloc = mine > 0u ? mine : 1u; nx = cnt > 0u ? cnt : 1u;
}

__device__ __forceinline__ void xcd_barrier(const XcdBarrier& b) {
    asm volatile("s_waitcnt vmcnt(0)" ::: "memory");
    __syncthreads();
    if (threadIdx.x == 0) {
        unsigned* bar = b.bar;
        __builtin_amdgcn_s_waitcnt(0);
        unsigned nloc = b.st[0], nx = b.st[1];
        if (nloc == 0u) { xcd_barrier_complete(bar, b.x, nloc, nx); b.st[0] = nloc; b.st[1] = nx; }
        const unsigned old = xb_add(&bar[XB_XSUB(b.x)], 1u);
        const unsigned gen = old / nloc;
        if (old + 1u == (gen + 1u) * nloc) {
            __builtin_amdgcn_fence(__ATOMIC_RELEASE, "agent");
            asm volatile("s_waitcnt vmcnt(0)" ::: "memory");
            const unsigned og = xb_add(&bar[XB_TOP], 1u);
            const unsigned tg = og / nx;
            if (og + 1u == (tg + 1u) * nx) xb_add(&bar[XB_TOPGEN], 1u);
            else XB_SPIN(xb_ld(&bar[XB_TOPGEN]) == tg, bar);
            __builtin_amdgcn_fence(__ATOMIC_ACQUIRE, "agent");
            xb_add(&bar[XB_XGEN(b.x)], 1u);
            asm volatile("s_waitcnt vmcnt(0)" ::: "memory");
        } else {
            XB_SPIN(xb_ld(&bar[XB_XGEN(b.x)]) == gen, bar);
            __builtin_amdgcn_fence(__ATOMIC_ACQUIRE, "agent");
            asm volatile("s_waitcnt vmcnt(0)" ::: "memory");
        }
    }
    __syncthreads();
}


__global__ void __launch_bounds__(512, 2) mega(Params p_unused) {
    extern __shared__ __attribute__((aligned(16))) unsigned char smem[];
    LAS unsigned char* lds = (LAS unsigned char*)smem;
    cg::grid_group grid = cg::this_grid();
    volatile LAS unsigned* xb_st = (volatile LAS unsigned*)(lds + 160 * 1024 - 32);
    if (threadIdx.x == 0) { xb_st[0] = 0u; xb_st[1] = 0u; }
    __syncthreads();
    const XcdBarrier xbar = xcd_barrier_post((unsigned*)(((CP*)__builtin_amdgcn_kernarg_segment_ptr())->ws + W_BAR), xb_st);
#define GSYNC() xcd_barrier(xbar)
#pragma unroll 1
    for (int l = 0; l < 2; ++l) {
        CP* pp = (CP*)__builtin_amdgcn_kernarg_segment_ptr(); asm volatile("" : "+s"(pp)); CP& p = *pp; unsigned char* ws = p.ws; const int G = gridDim.x, c = bid_o();
#ifndef SKIP_A
        phaseA(p, l);
#endif
        if (l == 0) grid.sync(); else GSYNC();
#ifndef SKIP_B
        {
            pg8::PlainSched S; S.T.init(130, NMIX, G, c); S.A = (const char*)ws + W_H; S.B = (const char*)ws + W_WIN; S.ld = 1024; S.nt = 16;
            EpiIn E; E.l = l; E.out = p.out; E.ws = ws; E.qg = p.in[27] + l * 64; E.kg = p.in[28] + l * 64;
            pg8::gemm_phase(lds, 1024, S, E);
        }
#endif
        GSYNC();
#ifndef SKIP_C
        phaseMix(p, l, lds);
#endif
        GSYNC();
#ifndef SKIP_D
        {
            pg8::PlainSched S; S.T.init(130, 2, G, c); S.A = (const char*)ws + W_S5; S.B = (const char*)ws + W_WGLU; S.ld = 512; S.nt = 8;
            EpiGlu E; E.ws = ws; E.bias = p.in[23] + l * 512;
            pg8::gemm_phase(lds, 512, S, E);
        }
#endif
        GSYNC();
#ifndef SKIP_E
        {
            MergeSched S; S.T.init(128, 4, G, c); S.ws = ws;
            EpiMerge E; E.ws = ws; E.bgate = p.in[10] + l * 4096;
            pg8::gemm_phase(lds, 1024, S, E);
        }
#endif
        GSYNC();
        {
            const f32x4* mf = (const f32x4*)(ws + W_MFS); u16* mg = (u16*)(ws + W_MERGED) + (size_t)MTP * 1024;
            for (int i = c * 512 + tid_o(); i < 512 * 256; i += G * 512) *(u32x2*)(mg + (size_t)i * 4) = pk4(mf[i]);
        }
        GSYNC();
#ifndef SKIP_F
        {
            pg8::TailSched S; S.T.init(128, 4, G, c); S.A = (const char*)ws + W_MERGED; S.B = (const char*)ws + W_WOUT; S.ld = 1024; S.nt = 16; S.npiece = 4; S.ntp = 4;
            EpiRes E; E.xb = p.out; E.xin_p = l == 0 ? p.in[0] : nullptr; E.xin_s = l == 0 ? p.in[1] : nullptr;
            pg8::gemm_phase(lds, 1024, S, E);
        }
#endif
        GSYNC();
#ifndef SKIP_G
        norm_rows(p.out, p.out + (size_t)MTP * 1024, p.in[33] + l * 1024, (u16*)(ws + W_H));
#endif
        GSYNC();
#ifndef SKIP_H
        {
            pg8::PlainSched S; S.T.init(130, 22, G, c); S.A = (const char*)ws + W_H; S.B = (const char*)ws + W_WUP; S.ld = 1024; S.nt = 16;
            EpiUp E; E.ws = ws; E.cw = p.in[35] + (size_t)l * 3 * 5632; E.cbias = p.in[36] + (size_t)l * 5632;
            pg8::gemm_phase(lds, 1024, S, E);
        }
#endif
        GSYNC();
#ifndef SKIP_I
        phaseFix(p, l);
#endif
        GSYNC();
#ifndef SKIP_J
        {
            pg8::TailSched S; S.T.init(128, 4, G, c); S.A = (const char*)ws + W_ACT; S.B = (const char*)ws + W_WDN; S.ld = 2816; S.nt = 44; S.npiece = 11; S.ntp = 4;
            EpiRes E; E.xb = p.out; E.xin_p = nullptr; E.xin_s = nullptr;
            pg8::gemm_phase(lds, 2816, S, E);
        }
#endif
        GSYNC();
    }
}

extern "C" void kernel_launch(void* const* d_in, const int* in_sizes, int n_in, void* d_out, int out_size, void* d_ws, size_t ws_size, hipStream_t stream) {
    constexpr int LDS_BYTES = 160 * 1024;
    static int grid_blocks = 0;
    if (!grid_blocks) {
        int dev = 0, cus = 0, per_cu = 0;
        hipGetDevice(&dev);
        hipDeviceGetAttribute(&cus, hipDeviceAttributeMultiprocessorCount, dev);
        hipFuncSetAttribute((const void*)mega, hipFuncAttributeMaxDynamicSharedMemorySize, LDS_BYTES);
        hipOccupancyMaxActiveBlocksPerMultiprocessor(&per_cu, (const void*)mega, 512, LDS_BYTES);
        if (per_cu < 1) per_cu = 1;
        grid_blocks = cus * per_cu;
        if (ws_size < W_END) fprintf(stderr, "kernel_launch: workspace too small: %zu < %zu\n", ws_size, (size_t)W_END);
    }
    Params p{};
    for (int i = 0; i < 38; ++i) p.in[i] = (const float*)d_in[i];
    p.out = (float*)d_out; p.ws = (unsigned char*)d_ws;
    (void)hipMemsetAsync((unsigned char*)d_ws + W_BAR, 0, 16384, stream);
    void* args[] = {&p};
    hipError_t e = hipLaunchCooperativeKernel((const void*)mega, dim3(grid_blocks), dim3(512), args, LDS_BYTES, stream);
    if (e != hipSuccess) fprintf(stderr, "cooperative launch failed: %s (grid %d)\n", hipGetErrorString(e), grid_blocks);
}
```

```cpp
#include <hip/hip_runtime.h>
#include <hip/hip_cooperative_groups.h>
#include <cstdio>
namespace cg = cooperative_groups;

#define LAS __attribute__((address_space(3)))
#define DEV __device__ __forceinline__
typedef unsigned short u16;
typedef short bf16x8 __attribute__((ext_vector_type(8)));
typedef float f32x4 __attribute__((ext_vector_type(4)));
typedef float f32x2 __attribute__((ext_vector_type(2)));
typedef unsigned u32x4 __attribute__((ext_vector_type(4)));
typedef unsigned u32x2 __attribute__((ext_vector_type(2)));

constexpr int MTP = 32768, MT = 33280;
constexpr int NINP = 8960;
constexpr int NMIX = 19;
constexpr int GATE0 = 4864;
constexpr float EPS = 1e-6f;
constexpr float LOG2E = 1.4426950408889634f;

constexpr size_t O_Y = 0, O_DKP = 34078720, O_DVP = 67633152, O_SREP = 101187584, O_SIMP = 101253120, O_GLAP = 101318656,
                 O_FCP = 102367232, O_DKS = 102727680, O_DVS = 103251968, O_SRES = 103776256, O_SIMS = 103809024, O_GLAS = 103841792,
                 O_FCS = 104366080, O_GMV = 104546304;

constexpr size_t SZ_H = (size_t)MT * 1024 * 2;
constexpr size_t SZ_HALF = (size_t)MT * 512 * 2;
constexpr size_t W_H = 0;
constexpr size_t W_P1 = W_H + SZ_H;
constexpr size_t W_P2 = W_P1 + SZ_H;
constexpr size_t W_S5 = W_P2 + SZ_H;
constexpr size_t W_GVT = W_S5 + SZ_HALF;
constexpr size_t W_CQ = W_GVT + SZ_HALF;
constexpr size_t W_CK = W_CQ + SZ_HALF / 2;
constexpr size_t W_CVT = W_CK + SZ_HALF / 2;
constexpr size_t W_CODE = W_CVT + SZ_HALF;
constexpr size_t W_DKP = W_CODE + (size_t)MT * 16 * 4;
constexpr size_t W_DKS = W_DKP + (size_t)MTP * 512 * 2;
constexpr size_t W_DVTP = W_DKS + (size_t)8 * 4160 * 512 * 2;
constexpr size_t W_DVTS = W_DVTP + (size_t)MTP * 512 * 2;
constexpr size_t W_ROWSQ = W_DVTS + (size_t)8 * 4160 * 512 * 2;
constexpr size_t W_MISC = W_ROWSQ + (size_t)MT * 4;
constexpr size_t W_WIN = W_MISC + 4096;
constexpr size_t W_WBR = W_WIN + (size_t)NINP * 1024 * 2;
constexpr size_t W_WOUT = W_WBR + (size_t)2 * 1024 * 1024 * 2;
constexpr size_t W_WGLU = W_WOUT + (size_t)1024 * 1024 * 2;
constexpr size_t W_WUP = W_WGLU + (size_t)512 * 512 * 2;
constexpr size_t W_WDN = W_WUP + (size_t)5632 * 1024 * 2;
constexpr size_t W_MFS = W_WDN + (size_t)1024 * 2816 * 2;
constexpr size_t W_BAR = W_MFS + (size_t)512 * 1024 * 4;
constexpr size_t W_WM = W_BAR + 16384;
constexpr size_t W_RS = W_WM + (size_t)4 * 128 * 128 * 2;
constexpr size_t W_END = W_RS + (size_t)4 * MT * 4;
constexpr size_t W_MERGED = W_CQ;
constexpr size_t W_SCR = W_DKP;
constexpr size_t W_ACT = W_P1;
constexpr size_t W_HEAD = W_DVTP;
constexpr size_t W_TAIL = W_HEAD + (size_t)520 * 2 * 5632 * 4;
static_assert(W_TAIL + (size_t)520 * 2 * 5632 * 4 <= W_ROWSQ, "head/tail alias");
static_assert((size_t)MT * 2816 * 2 <= W_CQ - W_P1, "act alias");

struct Params { const float* in[38]; float* out; unsigned char* ws; };
typedef const __attribute__((address_space(4))) Params CP;

DEV int tid_o() { int t = threadIdx.x; asm volatile("" : "+v"(t)); return t; }
DEV int bid_o() { int t = blockIdx.x; asm volatile("" : "+s"(t)); return t; }
DEV float bf2f(u16 v) { return __uint_as_float(((unsigned)v) << 16); }
typedef __bf16 b16x2 __attribute__((ext_vector_type(2)));
DEV unsigned pk2(float lo, float hi) { const f32x2 v = {lo, hi}; const b16x2 r = __builtin_convertvector(v, b16x2); return __builtin_bit_cast(unsigned, r); }
DEV u16 f2bf(float v) { return (u16)(pk2(v, 0.f) & 0xffffu); }
DEV float fsigmoid(float x) { return __builtin_amdgcn_rcpf(1.f + __expf(-x)); }
DEV float fsilu(float x) { return x * fsigmoid(x); }
DEV float fgelu(float x) { return x * fsigmoid(1.5957691216057308f * (x + 0.044715f * x * x * x)); }
DEV float flogsig(float x) { return fminf(x, 0.f) - __logf(1.f + __expf(-fabsf(x))); }
DEV f32x4 mfma16(bf16x8 a, bf16x8 b, f32x4 c) { return __builtin_amdgcn_mfma_f32_16x16x32_bf16(a, b, c, 0, 0, 0); }
DEV u32x2 pk4(f32x4 v) { u32x2 r; r.x = pk2(v[0], v[1]); r.y = pk2(v[2], v[3]); return r; }
DEV float red_fq(float v) { v += __shfl_xor(v, 16); v += __shfl_xor(v, 32); return v; }
DEV float wave_sum(float v) { for (int o = 32; o; o >>= 1) v += __shfl_xor(v, o); return v; }

namespace pg8 {
constexpr int BM = 256, BK = 64, HALF = 128, HTB = HALF * BK * 2, NXCD = 8, WGM = 8;
DEV int lds_byte(int r, int c) { const int st = (r >> 4) * 2 + (c >> 5), rr = r & 15, cc = c & 31, ob = rr * 64 + cc * 2; return st * 1024 + (ob ^ (((ob >> 9) & 1) << 5)); }
DEV void stage_rc(int b, int& R, int& C) { const int st = b / 1024, sb = b % 1024, swz = sb ^ (((sb >> 9) & 1) << 5); R = (st >> 1) * 16 + swz / 64; C = (st & 1) * 32 + (swz % 64) / 2; }
struct GUnit { const char* A; const char* B; int nt, pm, pn, kind; };
struct TileOrder {
    int nM, nN, nwg, G, c;
    DEV void init(int nM_, int nN_, int G_, int c_) { nM = nM_; nN = nN_; nwg = nM * nN; G = G_; c = c_; }
    DEV bool tile(int i, int& pm, int& pn) const {
        const long L = (long)i * G + c; if (L >= nwg) return false;
        int wgid = (int)L; { const int q = nwg / NXCD, r = nwg % NXCD, xcd = wgid % NXCD, off = wgid / NXCD; wgid = (xcd < r ? xcd * (q + 1) : r * (q + 1) + (xcd - r) * q) + off; }
        const int nig = WGM * nN, gid = wgid / nig, fm = gid * WGM, gsz = (nM - fm) < WGM ? (nM - fm) : WGM;
        pm = fm + ((wgid % nig) % gsz); pn = (wgid % nig) / gsz; return true;
    }
};
struct TailSched {
    TileOrder T; const char* A; const char* B; int ld, nt, npiece, ntp;
    DEV bool next(int i, GUnit& u) const { int pm, pn;
        if (T.tile(i, pm, pn)) { u.pm = pm; u.pn = pn; u.kind = 0; u.nt = nt; u.A = A + (size_t)pm * 256 * ld * 2; u.B = B + (size_t)pn * 256 * ld * 2; return true; }
        const int i0 = (T.nwg - T.c + T.G - 1) / T.G; const int j = (i - i0) * T.G + T.c; if (j >= 8 * npiece) return false;
        const int tile = j / npiece, kp = j % npiece; pm = 128 + (tile >> 2); pn = tile & 3; u.pm = pm; u.pn = pn; u.kind = 1; u.nt = ntp;
        u.A = A + (size_t)pm * 256 * ld * 2 + (size_t)kp * ntp * 128; u.B = B + (size_t)pn * 256 * ld * 2 + (size_t)kp * ntp * 128; return true; }
};
struct PlainSched {
    TileOrder T; const char* A; const char* B; int ld, nt;
    DEV bool next(int i, GUnit& u) const { int pm, pn; if (!T.tile(i, pm, pn)) return false; u.pm = pm; u.pn = pn; u.kind = 0; u.nt = nt;
        u.A = A + (size_t)pm * 256 * ld * 2; u.B = B + (size_t)pn * 256 * ld * 2; return true; }
};

template <class Epi, class Sched>
DEV void gemm_phase(LAS unsigned char* lds, const int ld, const Sched& S, const Epi& E) {
    const int tid = tid_o(), wid = __builtin_amdgcn_readfirstlane(tid >> 6), lane = tid & 63, wr = wid >> 2, wc = wid & 3, fr = lane & 15, fq = lane >> 4;
    unsigned voff[2];
#pragma unroll
    for (int i = 0; i < 2; ++i) { int R, C; stage_rc(tid * 16 + i * 8192, R, C); voff[i] = (unsigned)(R * ld + C) * 2u; }
    const size_t kstep = (size_t)(BK * 2);
    const size_t hstep = (size_t)HALF * ld * 2;
    const unsigned ldsw = (unsigned)wid * 1024u;
    const int aoff = lds_byte(wr * 64 + fr, fq * 8), boff = lds_byte(wc * 32 + fr, fq * 8);
#define PG8_SA(b, h) (((b) * 2 + (h)) * HTB)
#define PG8_SB(b, h) ((4 + (b) * 2 + (h)) * HTB)
#define PG8_STAGE(bufoff, gbase) do { _Pragma("unroll") for (int _i = 0; _i < 2; ++_i) \
        __builtin_amdgcn_global_load_lds((const unsigned*)((const char*)(gbase) + voff[_i]), (LAS unsigned*)(lds + (bufoff) + ldsw + _i * 8192), 16, 0, 0); } while (0)
#define PG8_LDA(dst, b, h) do { _Pragma("unroll") for (int m = 0; m < 4; ++m) _Pragma("unroll") for (int k = 0; k < 2; ++k) dst[m][k] = *(const LAS bf16x8*)(lds + PG8_SA(b, h) + aoff + m * 2048 + k * 1024); } while (0)
#define PG8_LDB(dst, b, h) do { _Pragma("unroll") for (int n = 0; n < 2; ++n) _Pragma("unroll") for (int k = 0; k < 2; ++k) dst[n][k] = *(const LAS bf16x8*)(lds + PG8_SB(b, h) + boff + n * 2048 + k * 1024); } while (0)
#define PG8_MMA(ai, bj, At, Bt) do { __builtin_amdgcn_s_setprio(1); _Pragma("unroll") for (int m = 0; m < 4; ++m) _Pragma("unroll") for (int n = 0; n < 2; ++n) _Pragma("unroll") for (int k = 0; k < 2; ++k) \
        acc[ai][bj][m][n] = __builtin_amdgcn_mfma_f32_16x16x32_bf16(Bt[n][k], At[m][k], acc[ai][bj][m][n], 0, 0, 0); __builtin_amdgcn_s_setprio(0); } while (0)
#define PG8_WAIT_V(n) asm volatile("s_waitcnt vmcnt(" #n ")" ::: "memory")
#define PG8_WAIT_L(n) asm volatile("s_waitcnt lgkmcnt(" #n ")" ::: "memory")
#define PG8_BAR __builtin_amdgcn_s_barrier()
#define PG8_SCHED __builtin_amdgcn_sched_barrier(0)
    GUnit cur, nxt; int ui = 0;
    if (!S.next(0, cur)) return;
    f32x4 acc[2][2][4][2];
#pragma unroll
    for (int a = 0; a < 2; ++a)
#pragma unroll
        for (int b = 0; b < 2; ++b)
#pragma unroll
            for (int m = 0; m < 4; ++m)
#pragma unroll
                for (int n = 0; n < 2; ++n) acc[a][b][m][n] = (f32x4){0.f, 0.f, 0.f, 0.f};
    bf16x8 At[4][2], B0[2][2], B1[2][2];
    const char* cA = cur.A; const char* cB = cur.B;
    PG8_STAGE(PG8_SB(0, 0), cB); PG8_STAGE(PG8_SA(0, 0), cA); PG8_STAGE(PG8_SB(0, 1), cB + hstep); PG8_STAGE(PG8_SA(0, 1), cA + hstep);
    if (wr == 1) PG8_BAR;
    PG8_WAIT_V(4); PG8_BAR;
    PG8_STAGE(PG8_SB(1, 0), cB + kstep); PG8_STAGE(PG8_SA(1, 0), cA + kstep); PG8_STAGE(PG8_SB(1, 1), cB + hstep + kstep);
    PG8_WAIT_V(6); PG8_BAR;
    for (;;) {
        const bool has_next = S.next(ui + 1, nxt);
        const char* nA = has_next ? nxt.A : cA; const char* nB = has_next ? nxt.B : cB;
        const int nt = cur.nt;
        for (int t = 0; t < nt; t += 2) {
            const bool last = (t == nt - 2);
            const char* a1 = cA + (size_t)(t + 1) * kstep;
            const char* a2 = last ? nA : cA + (size_t)(t + 2) * kstep; const char* b2 = last ? nB : cB + (size_t)(t + 2) * kstep;
            const char* a3 = a2 + kstep; const char* b3 = b2 + kstep;
            PG8_LDB(B0, 0, 0); PG8_SCHED; PG8_LDA(At, 0, 0); PG8_STAGE(PG8_SA(1, 1), a1 + hstep);
            PG8_WAIT_L(8); PG8_BAR; PG8_WAIT_L(0); PG8_MMA(0, 0, At, B0); PG8_BAR; PG8_SCHED;
            PG8_LDB(B1, 0, 1); PG8_STAGE(PG8_SB(0, 0), b2);
            PG8_BAR; PG8_WAIT_L(0); PG8_MMA(0, 1, At, B1); PG8_BAR;
            PG8_LDA(At, 0, 1); PG8_STAGE(PG8_SA(0, 0), a2);
            PG8_BAR; PG8_WAIT_L(0); PG8_MMA(1, 0, At, B0); PG8_BAR; PG8_SCHED;
            PG8_STAGE(PG8_SB(0, 1), b2 + hstep);
            PG8_WAIT_V(6); PG8_BAR; PG8_MMA(1, 1, At, B1); PG8_BAR;
            PG8_LDB(B0, 1, 0); PG8_SCHED; PG8_LDA(At, 1, 0); PG8_STAGE(PG8_SA(0, 1), a2 + hstep);
            PG8_WAIT_L(8); PG8_BAR; PG8_WAIT_L(0); PG8_MMA(0, 0, At, B0); PG8_BAR; PG8_SCHED;
            PG8_LDB(B1, 1, 1); PG8_STAGE(PG8_SB(1, 0), b3);
            PG8_BAR; PG8_WAIT_L(0); PG8_MMA(0, 1, At, B1); PG8_BAR;
            PG8_LDA(At, 1, 1); PG8_STAGE(PG8_SA(1, 0), a3);
            PG8_BAR; PG8_WAIT_L(0); PG8_MMA(1, 0, At, B0); PG8_BAR; PG8_SCHED;
            PG8_STAGE(PG8_SB(1, 1), b3 + hstep);
            PG8_WAIT_V(6); PG8_BAR; PG8_MMA(1, 1, At, B1); PG8_BAR;
        }
        { int fr_ = fr, fq_ = fq, wr_ = wr, wc_ = wc; asm volatile("" : "+v"(fr_), "+v"(fq_), "+s"(wr_), "+s"(wc_));
          E(acc, cur, wr_, wc_, fr_, fq_); }
        if (!has_next) break;
#pragma unroll
        for (int a = 0; a < 2; ++a)
#pragma unroll
            for (int b = 0; b < 2; ++b)
#pragma unroll
                for (int m = 0; m < 4; ++m)
#pragma unroll
                    for (int n = 0; n < 2; ++n) acc[a][b][m][n] = (f32x4){0.f, 0.f, 0.f, 0.f};
        cur = nxt; cA = nA; cB = nB; ++ui;
    }
    PG8_WAIT_V(0);
    if (wr == 0) PG8_BAR;
    PG8_BAR;
#undef PG8_SA
#undef PG8_SB
#undef PG8_STAGE
#undef PG8_LDA
#undef PG8_LDB
#undef PG8_MMA
#undef PG8_WAIT_V
#undef PG8_WAIT_L
#undef PG8_BAR
#undef PG8_SCHED
}
}
using pg8::GUnit;
typedef f32x4 AccT[2][2][4][2];

#define FOR_AM _Pragma("unroll") for (int ai = 0; ai < 2; ++ai) _Pragma("unroll") for (int m = 0; m < 4; ++m)
#define FOR_BN _Pragma("unroll") for (int bj = 0; bj < 2; ++bj) _Pragma("unroll") for (int n = 0; n < 2; ++n)

struct EpiIn {
    int l; float* out; unsigned char* ws; const float* qg; const float* kg; const float* rs1;
    DEV void operator()(const AccT& acc, const GUnit& u, int wr, int wc, int fr, int fq) const {
        const int pn = u.pn; const bool smp = u.pm >= 128;
        const int rowb = u.pm * 256 + wr * 64 + fr;
        const int ct0 = wc * 32 + 4 * fq;
        u16* P1 = (u16*)(ws + W_P1); u16* P2 = (u16*)(ws + W_P2);
        float rsx[2][4];
        FOR_AM rsx[ai][m] = __builtin_amdgcn_rsqf(rs1[rowb + ai * 128 + m * 16] * (1.f / 1024.f) + EPS);
        if (pn < 2) {
            FOR_AM { const int row = rowb + ai * 128 + m * 16; FOR_BN { f32x4 v = (acc[ai][bj][m][n] * rsx[ai][m]);
                for (int e = 0; e < 4; ++e) v[e] = fgelu(v[e]);
                *(u32x2*)(P1 + (size_t)row * 1024 + pn * 256 + ct0 + bj * 128 + n * 16) = pk4(v); } }
        } else if (pn < 4 || pn == 8 || pn == 9 || pn == 16 || pn == 17) {
            const int kind = pn < 4 ? 0 : (pn < 10 ? 1 : 2);
            const int cseg = (pn & 1) * 256;
            u16* dstT; int T, toff = 0;
            if (kind == 0) { dstT = (u16*)(ws + W_GVT) + (smp ? (size_t)16 * 512 * 2048 : 0); T = smp ? 64 : 2048; }
            else if (kind == 1) { dstT = (u16*)(ws + W_CVT) + (smp ? (size_t)16 * 512 * 2048 : 0); T = smp ? 64 : 2048; }
            else { dstT = (u16*)(ws + (smp ? W_DVTS : W_DVTP)); T = smp ? 4160 : 2048; toff = smp ? 4096 : 0; }
            float* rowsq = (float*)(ws + W_ROWSQ);
            FOR_AM { const int row = rowb + ai * 128 + m * 16;
                int b, t; if (smp) { const int rs = row - MTP; b = rs >> 6; t = rs & 63; } else { b = row >> 11; t = row & 2047; }
                float ss = 0.f;
                FOR_BN { f32x4 v = (acc[ai][bj][m][n] * rsx[ai][m]); const int cc = cseg + ct0 + bj * 128 + n * 16;
                    if (kind == 0) { for (int e = 0; e < 4; ++e) { v[e] = fgelu(v[e]); ss += v[e] * v[e]; } }
                    if (kind == 2) { float* o = smp ? out + O_DVS + (size_t)l * 262144 + (size_t)(row - MTP) * 512 + cc : out + O_DVP + (size_t)l * 16777216 + (size_t)row * 512 + cc;
                        *(f32x4*)o = v; }
                    for (int e = 0; e < 4; ++e) dstT[((size_t)b * 512 + cc + e) * T + toff + t] = f2bf(v[e]); }
                if (kind == 0) { ss = red_fq(ss); if (fq == 0) atomicAdd(rowsq + row, ss); } }
        } else if (pn < 6) {
            u16* S5 = (u16*)(ws + W_S5);
            FOR_AM { const int row = rowb + ai * 128 + m * 16; FOR_BN {
                *(u32x2*)(S5 + (size_t)row * 512 + (pn - 4) * 256 + ct0 + bj * 128 + n * 16) = pk4((acc[ai][bj][m][n] * rsx[ai][m])); } }
        } else if (pn < 8) {
            u16* D = (u16*)(ws + (pn == 6 ? W_CQ : W_CK)); const float sc = pn == 6 ? 0.125f : 1.f;
            FOR_AM { const int row = rowb + ai * 128 + m * 16; FOR_BN {
                *(u32x2*)(D + (size_t)row * 256 + ct0 + bj * 128 + n * 16) = pk4((acc[ai][bj][m][n] * rsx[ai][m]) * sc); } }
        } else if (pn < 12) {
            FOR_AM { const int row = rowb + ai * 128 + m * 16; FOR_BN { f32x4 v = (acc[ai][bj][m][n] * rsx[ai][m]);
                for (int e = 0; e < 4; ++e) v[e] = fsilu(v[e]);
                *(u32x2*)(P2 + (size_t)row * 1024 + (pn - 10) * 256 + ct0 + bj * 128 + n * 16) = pk4(v); } }
        } else if (pn < 16) {
            const bool isq = pn < 14; const int hh = 4 * (pn & 1) + wc; const float* g = isq ? qg : kg;
            f32x4 gv[2][2];
            FOR_BN gv[bj][n] = *(const f32x4*)(g + 32 * bj + 16 * n + 4 * fq);
            FOR_AM { const int row = rowb + ai * 128 + m * 16;
                float ss = 0.f;
                FOR_BN { const f32x4 v = (acc[ai][bj][m][n] * rsx[ai][m]); ss += v[0] * v[0] + v[1] * v[1] + v[2] * v[2] + v[3] * v[3]; }
                ss = red_fq(ss);
                float rs = __builtin_amdgcn_rsqf(ss * (1.f / 64.f) + EPS);
                if (isq) { rs *= 0.125f * LOG2E;
                    FOR_BN { *(u32x2*)(P2 + (size_t)row * 1024 + 512 + hh * 64 + 32 * bj + 16 * n + 4 * fq) = pk4((acc[ai][bj][m][n] * rsx[ai][m]) * rs * gv[bj][n]); }
                } else {
                    float* o; u16* kb;
                    if (smp) { const int rs_ = row - MTP; o = out + O_DKS + (size_t)l * 262144 + (size_t)rs_ * 512; kb = (u16*)(ws + W_DKS) + ((size_t)(rs_ >> 6) * 4160 + 4096 + (rs_ & 63)) * 512; }
                    else { o = out + O_DKP + (size_t)l * 16777216 + (size_t)row * 512; kb = (u16*)(ws + W_DKP) + (size_t)row * 512; }
                    FOR_BN { const f32x4 v = (acc[ai][bj][m][n] * rsx[ai][m]) * rs * gv[bj][n]; const int d = hh * 64 + 32 * bj + 16 * n + 4 * fq;
                        *(f32x4*)(o + d) = v; *(u32x2*)(kb + d) = pk4(v); } } }
        } else {
            if (wc == 0) { float* C = (float*)(ws + W_CODE);
                FOR_AM { const int row = rowb + ai * 128 + m * 16; *(f32x4*)(C + (size_t)row * 16 + 4 * fq) = acc[ai][0][m][0] * rsx[ai][m]; } }
        }
    }
};

struct EpiGlu {
    unsigned char* ws; const float* bias;
    DEV void operator()(const AccT& acc, const GUnit& u, int wr, int wc, int fr, int fq) const {
        const u16* Z = (const u16*)(ws + W_S5); u16* P1 = (u16*)(ws + W_P1);
        const int rowb = u.pm * 256 + wr * 64 + fr, cb = u.pn * 256 + wc * 32 + 4 * fq;
        FOR_AM { const int row = rowb + ai * 128 + m * 16; FOR_BN { const int col = cb + bj * 128 + n * 16;
            const f32x4 bv = *(const f32x4*)(bias + col); const u32x2 zz = *(const u32x2*)(Z + (size_t)row * 512 + col);
            f32x4 z; z[0] = __uint_as_float(zz.x << 16); z[1] = __uint_as_float(zz.x & 0xffff0000u); z[2] = __uint_as_float(zz.y << 16); z[3] = __uint_as_float(zz.y & 0xffff0000u);
            f32x4 v = acc[ai][bj][m][n] + bv;
            for (int e = 0; e < 4; ++e) v[e] = z[e] * fsigmoid(v[e]);
            *(u32x2*)(P1 + (size_t)row * 1024 + 512 + col) = pk4(v); } }
    }
};

struct MergeSched {
    pg8::TileOrder T; unsigned char* ws;
    DEV void fill(GUnit& u, int pm, int pn, int b, int sub) const {
        u.pm = pm; u.pn = pn;
        if (sub) { u.nt = 16; u.A = (const char*)ws + W_H + (size_t)pm * 256 * 2048; u.B = (const char*)ws + W_WIN + (size_t)(GATE0 + b * 1024 + pn * 256) * 2048; }
        else { u.nt = 8; u.A = (const char*)ws + (b < 2 ? W_P1 : W_P2) + (size_t)pm * 256 * 2048 + (b & 1) * 1024;
               u.B = (const char*)ws + W_WBR + (size_t)(b >> 1) * 1024 * 2048 + (size_t)pn * 256 * 2048 + (b & 1) * 1024; }
    }
    DEV bool next(int i, GUnit& u) const {
        int pm, pn;
        if (T.tile(i >> 3, pm, pn)) { const int s = i & 7; u.kind = s; fill(u, pm, pn, s >> 1, s & 1); return true; }
        const int i0 = (T.nwg - T.c + T.G - 1) / T.G; const int jj = i - 8 * i0; const int job = (jj >> 1) * T.G + T.c; if (job >= 32) return false;
        const int tile = job >> 2, b = job & 3; u.kind = 8 + 2 * b + (jj & 1); fill(u, 128 + (tile >> 2), tile & 3, b, jj & 1); return true;
    }
};
struct EpiMerge {
    unsigned char* ws; const float* bgate; const float* rs1;
    DEV void operator()(const AccT& acc, const GUnit& u, int wr, int wc, int fr, int fq) const {
        u32x4* sT = (u32x4*)(ws + W_SCR) + (size_t)bid_o() * 16 * 512 + tid_o();
        u32x4* sS = (u32x4*)(ws + W_SCR + (size_t)32 * 1024 * 1024) + (size_t)bid_o() * 16 * 512 + tid_o();
        const int s = u.kind & 7, b = s >> 1; const bool smp = u.kind >= 8;
        if (!(s & 1)) {
#pragma unroll
            for (int q = 0; q < 16; ++q) { const int ai = q >> 3, bj = (q >> 2) & 1, m = q & 3; const u32x2 lo = pk4(acc[ai][bj][m][0]), hi = pk4(acc[ai][bj][m][1]);
                u32x4 w; w.x = lo.x; w.y = lo.y; w.z = hi.x; w.w = hi.y; sT[q * 512] = w; }
        } else {
            u16* MG = (u16*)(ws + W_MERGED);
            const int rowb = u.pm * 256 + wr * 64 + fr, cb = u.pn * 256 + wc * 32 + 4 * fq;
            f32x4 bvv[2][2];
#pragma unroll
            for (int bj = 0; bj < 2; ++bj)
#pragma unroll
                for (int n = 0; n < 2; ++n) bvv[bj][n] = *(const f32x4*)(bgate + b * 1024 + cb + bj * 128 + n * 16);
            float rsx[2][4];
            FOR_AM rsx[ai][m] = __builtin_amdgcn_rsqf(rs1[rowb + ai * 128 + m * 16] * (1.f / 1024.f) + EPS);
#pragma unroll
            for (int q = 0; q < 16; ++q) { const int ai = q >> 3, bj = (q >> 2) & 1, m = q & 3; __builtin_amdgcn_sched_barrier(0);
                const u32x4 tw = sT[q * 512]; u32x4 sw = (u32x4){0u, 0u, 0u, 0u}; if (b > 0 && !smp) sw = sS[q * 512];
                const unsigned tws[4] = {tw.x, tw.y, tw.z, tw.w}; const unsigned sws[4] = {sw.x, sw.y, sw.z, sw.w};
                f32x4 r[2];
#pragma unroll
                for (int n = 0; n < 2; ++n) { const f32x4 bv = bvv[bj][n];
                    f32x4 v = acc[ai][bj][m][n] * rsx[ai][m] + bv;
#pragma unroll
                    for (int e = 0; e < 4; ++e) { const unsigned tt = tws[n * 2 + (e >> 1)], st = sws[n * 2 + (e >> 1)];
                        const float tv = (e & 1) ? __uint_as_float(tt & 0xffff0000u) : __uint_as_float(tt << 16);
                        const float sv = (e & 1) ? __uint_as_float(st & 0xffff0000u) : __uint_as_float(st << 16);
                        v[e] = fsigmoid(v[e]) * tv + sv; }
                    r[n] = v; }
                if (smp) { float* mf = (float*)(ws + W_MFS) + (size_t)(rowb + ai * 128 + m * 16 - MTP) * 1024 + cb + bj * 128;
#pragma unroll
                    for (int n = 0; n < 2; ++n)
#pragma unroll
                        for (int e = 0; e < 4; ++e) atomicAdd(mf + n * 16 + e, r[n][e]); }
                else if (b < 3) { const u32x2 lo = pk4(r[0]), hi = pk4(r[1]); u32x4 w; w.x = lo.x; w.y = lo.y; w.z = hi.x; w.w = hi.y; sS[q * 512] = w; }
                else { const int row = rowb + ai * 128 + m * 16;
#pragma unroll
                    for (int n = 0; n < 2; ++n) *(u32x2*)(MG + (size_t)row * 1024 + cb + bj * 128 + n * 16) = pk4(r[n]); } }
        }
    }
};

struct EpiRes {
    const float* xin;
    u16* xb;
    float* yout;
    float* rsacc;
    float* yfull;
    DEV void operator()(const AccT& acc, const GUnit& u, int wr, int wc, int fr, int fq) const {
        const int rowb = u.pm * 256 + wr * 64 + fr, cb = u.pn * 256 + wc * 32 + 4 * fq;
        if (u.kind == 1) {
            FOR_AM { const int row = rowb + ai * 128 + m * 16; FOR_BN { float* d = yfull + (size_t)row * 1024 + cb + bj * 128 + n * 16;
#pragma unroll
                for (int e = 0; e < 4; ++e) atomicAdd(d + e, acc[ai][bj][m][n][e]); } }
            return; }
        FOR_AM { const int row = rowb + ai * 128 + m * 16; float ss = 0.f;
            FOR_BN { const int col = cb + bj * 128 + n * 16; f32x4 x;
                if (xin) x = *(const f32x4*)(xin + (size_t)row * 1024 + col);
                else { const u32x2 xx = *(const u32x2*)(xb + (size_t)row * 1024 + col);
                    x[0] = __uint_as_float(xx.x << 16); x[1] = __uint_as_float(xx.x & 0xffff0000u); x[2] = __uint_as_float(xx.y << 16); x[3] = __uint_as_float(xx.y & 0xffff0000u); }
                const f32x4 v = x + acc[ai][bj][m][n];
                if (yout) *(f32x4*)(yout + (size_t)row * 1024 + col) = v; else *(u32x2*)(xb + (size_t)row * 1024 + col) = pk4(v);
                ss += v[0] * v[0] + v[1] * v[1] + v[2] * v[2] + v[3] * v[3]; }
            if (rsacc) { ss = red_fq(ss); if (fq == 0) atomicAdd(rsacc + row, ss); } }
    }
};

DEV float dpp_prev1(float cur, float prevm) {
    const int o = __builtin_amdgcn_update_dpp(0, __float_as_int(prevm), 0x121, 0xf, 0xf, false);
    return __int_as_float(__builtin_amdgcn_update_dpp(o, __float_as_int(cur), 0x111, 0xf, 0xf, false));
}
DEV float dpp_prev2(float cur, float prevm) {
    const int o = __builtin_amdgcn_update_dpp(0, __float_as_int(prevm), 0x122, 0xf, 0xf, false);
    return __int_as_float(__builtin_amdgcn_update_dpp(o, __float_as_int(cur), 0x112, 0xf, 0xf, false));
}
struct EpiUp {
    unsigned char* ws; const float* cw; const float* cbias; const float* rs2;
    DEV void operator()(const AccT& acc, const GUnit& u, int wr, int wc, int fr, int fq) const {
        u16* ACT = (u16*)(ws + W_ACT); float* HEAD = (float*)(ws + W_HEAD); float* TAIL = (float*)(ws + W_TAIL);
        float rsx[2][4];
        FOR_AM rsx[ai][m] = __builtin_amdgcn_rsqf(rs2[u.pm * 256 + wr * 64 + fr + ai * 128 + m * 16] * (1.f / 1024.f) + EPS);
        const int f0 = u.pn * 128 + wc * 32 + 4 * fq;
#pragma unroll
        for (int n = 0; n < 2; ++n) { const int f = f0 + n * 16;
            f32x4 w0[2], w1[2], w2[2], bb[2];
#pragma unroll
            for (int bj = 0; bj < 2; ++bj) { const int ff = bj * 2816 + f; w0[bj] = *(const f32x4*)(cw + ff); w1[bj] = *(const f32x4*)(cw + 5632 + ff); w2[bj] = *(const f32x4*)(cw + 11264 + ff); bb[bj] = *(const f32x4*)(cbias + ff); }
#pragma unroll
            for (int ai = 0; ai < 2; ++ai) {
                const int slab = u.pm * 4 + ai * 2 + wr;
#pragma unroll
                for (int m = 0; m < 4; ++m) {
                    f32x4 c[2];
#pragma unroll
                    for (int bj = 0; bj < 2; ++bj) { const f32x4 cur = acc[ai][bj][m][n] * rsx[ai][m]; const f32x4 pm_ = acc[ai][bj][m ? m - 1 : 0][n] * rsx[ai][m ? m - 1 : 0];
#pragma unroll
                        for (int e = 0; e < 4; ++e) { const float p1 = dpp_prev1(cur[e], pm_[e]), p2 = dpp_prev2(cur[e], pm_[e]);
                            c[bj][e] = bb[bj][e] + w2[bj][e] * cur[e] + w1[bj][e] * p1 + w0[bj][e] * p2; } }
                    if (m > 0 || fr >= 2) { f32x4 a; for (int e = 0; e < 4; ++e) a[e] = fsilu(c[0][e]) * c[1][e];
                        *(u32x2*)(ACT + (size_t)(slab * 64 + m * 16 + fr) * 2816 + f) = pk4(a); }
                    if (m == 0 && fr < 2) { for (int bj = 0; bj < 2; ++bj) *(f32x4*)(HEAD + ((size_t)slab * 2 + fr) * 5632 + bj * 2816 + f) = acc[ai][bj][0][n] * rsx[ai][0]; }
                    if (m == 3 && fr >= 14) { for (int bj = 0; bj < 2; ++bj) *(f32x4*)(TAIL + ((size_t)slab * 2 + fr - 14) * 5632 + bj * 2816 + f) = acc[ai][bj][3][n] * rsx[ai][3]; }
                } } }
    }
};

template <int MAP> DEV int src_col(int j) {
    if (MAP == 0) return j;
    if (MAP == 1) {
        const int tile = j >> 8, tc = j & 255;
        if (tile < 10) return j;
        if (tile < 12) return j + 16;
        if (tile < 16) { const int perm = ((tc >> 5) & 3) * 64 + (tc >> 7) * 32 + (tc & 31); return (tile < 14 ? 3088 : 3600) + (tile & 1) * 256 + perm; }
        if (tile < 18) return j + 16;
        if (tile == 18) return tc < 16 ? 2560 + tc : -1;
        return 4624 + (j - GATE0);
    }
    { const int q = j >> 8, tc = j & 255; return tc < 128 ? 128 * q + tc : 2816 + 128 * q + (tc - 128); }
}
template <int MAP> DEV void conv_T(u16* dst, int dst_ld, int K, int Nd, const float* src, int src_ld, int gt, int GT, const float* gain = nullptr) {
    const int total = Nd * (K >> 3);
    for (int idx = gt; idx < total; idx += GT) { const int j = idx % Nd, kb = idx / Nd; const int sc = src_col<MAP>(j);
        float v[8];
#pragma unroll
        for (int i = 0; i < 8; ++i) v[i] = sc >= 0 ? src[(size_t)(kb * 8 + i) * src_ld + sc] : 0.f;
        if (gain) {
#pragma unroll
            for (int i = 0; i < 8; ++i) v[i] *= gain[kb * 8 + i]; }
        u32x4 w; w.x = pk2(v[0], v[1]); w.y = pk2(v[2], v[3]); w.z = pk2(v[4], v[5]); w.w = pk2(v[6], v[7]);
        *(u32x4*)(dst + (size_t)j * dst_ld + kb * 8) = w; }
}
DEV void raw_rows(const float* xp, const float* xs, int r0, int r1, u16* XB, float* RS) {
    const int tid = tid_o(); const int lane = tid & 63; const int gw = bid_o() * 8 + (tid >> 6), GW = gridDim.x * 8;
    for (int row = r0 + gw; row < r1; row += GW) {
        const float* src = row < MTP ? xp + (size_t)row * 1024 : xs + (size_t)(row - MTP) * 1024;
        f32x4 v[4]; float ss = 0.f;
#pragma unroll
        for (int i = 0; i < 4; ++i) { v[i] = *(const f32x4*)(src + (lane + 64 * i) * 4); ss += v[i][0] * v[i][0] + v[i][1] * v[i][1] + v[i][2] * v[i][2] + v[i][3] * v[i][3]; }
        ss = wave_sum(ss); if (lane == 0) RS[row] = ss;
#pragma unroll
        for (int i = 0; i < 4; ++i) *(u32x2*)(XB + (size_t)row * 1024 + (lane + 64 * i) * 4) = pk4(v[i]);
    }
}

DEV void phaseA(CP& p, int l) {
    unsigned char* ws = p.ws;
    const int gt = bid_o() * 512 + tid_o(), GT = gridDim.x * 512;
    conv_T<1>((u16*)(ws + W_WIN), 1024, 1024, NINP, p.in[9] + (size_t)l * 1024 * 8720, 8720, gt, GT, p.in[8] + l * 1024);
    for (int b = 0; b < 4; ++b) conv_T<0>((u16*)(ws + W_WBR) + (size_t)(b >> 1) * 1024 * 1024 + (b & 1) * 512, 1024, 512, 1024, p.in[31] + (size_t)(l * 4 + b) * 512 * 1024, 1024, gt, GT);
    conv_T<0>((u16*)(ws + W_WOUT), 1024, 1024, 1024, p.in[32] + (size_t)l * 1024 * 1024, 1024, gt, GT);
    conv_T<0>((u16*)(ws + W_WGLU), 512, 512, 512, p.in[22] + (size_t)l * 512 * 512, 512, gt, GT);
    conv_T<2>((u16*)(ws + W_WUP), 1024, 1024, 5632, p.in[34] + (size_t)l * 1024 * 5632, 5632, gt, GT, p.in[33] + l * 1024);
    conv_T<0>((u16*)(ws + W_WDN), 2816, 2816, 1024, p.in[37] + (size_t)l * 2816 * 1024, 1024, gt, GT);
    for (int b = 0; b < 8; ++b) conv_T<0>((u16*)(ws + W_DVTS) + (size_t)b * 512 * 4160, 4160, 4096, 512, p.in[3] + ((size_t)(l * 8 + b) * 4096) * 512, 512, gt, GT);
    {
        const float* ck = p.in[2] + (size_t)l * 8 * 4096 * 512; u16* dk = (u16*)(ws + W_DKS);
        for (int idx = gt; idx < 8 * 4096 * 64; idx += GT) { const int b = idx >> 18, rem = idx & 262143, key = rem >> 6, c8 = (rem & 63) * 8;
            const f32x4 a = *(const f32x4*)(ck + ((size_t)(b * 4096 + key)) * 512 + c8), c = *(const f32x4*)(ck + ((size_t)(b * 4096 + key)) * 512 + c8 + 4);
            u32x4 w; w.x = pk2(a[0], a[1]); w.y = pk2(a[2], a[3]); w.z = pk2(c[0], c[1]); w.w = pk2(c[2], c[3]);
            *(u32x4*)(dk + ((size_t)b * 4160 + key) * 512 + c8) = w; }
    }
    { float* rq = (float*)(ws + W_ROWSQ); for (int i = gt; i < MT; i += GT) rq[i] = 0.f; }
    { const float* wsp = p.in[12] + (size_t)l * 4 * 128 * 128; u16* wm = (u16*)(ws + W_WM); for (int i = gt; i < 4 * 128 * 128; i += GT) { const int t = (i >> 7) & 127, s2 = i & 127; wm[i] = f2bf(s2 <= t ? wsp[i] : 0.f); } }
    { f32x4* mf = (f32x4*)(ws + W_MFS); for (int i = gt; i < 512 * 256; i += GT) mf[i] = (f32x4){0.f, 0.f, 0.f, 0.f}; }
    if (l == 0) { const f32x4* xs = (const f32x4*)p.in[1]; f32x4* xo = (f32x4*)(p.out + (size_t)MTP * 1024); for (int i = gt; i < 512 * 256; i += GT) xo[i] = xs[i]; }
    if (gt == 0) {
        unsigned* misc = (unsigned*)(ws + W_MISC); misc[l] = 0u;
        const float* dl = p.in[29] + l * 256; float s1 = 0.f, s2 = 0.f;
        for (int i = 0; i < 64; ++i) { s1 += dl[i] * dl[64 + i]; s2 += dl[128 + i] * dl[192 + i]; }
        const float lam_init = 0.8f - 0.6f * expf(-0.3f * (float)l);
        ((float*)misc)[8 + 2 * l] = expf(s1) - expf(s2) + lam_init; ((float*)misc)[9 + 2 * l] = lam_init;
    }
    { float* RS = (float*)(ws + W_RS);
      for (int i = gt; i < MT; i += GT) { RS[(size_t)(l * 2 + 1) * MT + i] = 0.f; if (l == 0) RS[(size_t)2 * MT + i] = 0.f; }
      if (l == 0) raw_rows(p.in[0], p.in[1], 0, MT, (u16*)(ws + W_H), RS);
      else raw_rows(nullptr, p.out + (size_t)MTP * 1024, MTP, MT, (u16*)(ws + W_H), RS + (size_t)2 * MT); }
}

DEV void attn_item(CP& p, int l, LAS unsigned char* lds, int grp, int b, int h, int qp) {
    unsigned char* ws = p.ws;
    const int tid = tid_o(), w = tid >> 6, lane = tid & 63, fr = lane & 15, fq = lane >> 4, c = w >> 2, qs = w & 3;
    const int Tk = grp ? 4160 : 2048, nkv = grp ? 65 : 2 * qp + 2;
    const int nact = grp ? (qs < 2 ? 65 : 0) : (qs < 2 ? nkv - 1 : nkv);
    const int rowbase = grp ? MTP + b * 64 : b * 2048 + qp * 128;
    const u16* Kb = grp ? (const u16*)(ws + W_DKS) + (size_t)b * 4160 * 512 : (const u16*)(ws + W_DKP) + (size_t)b * 2048 * 512;
    const u16* Vb = grp ? (const u16*)(ws + W_DVTS) + ((size_t)b * 512 + h * 128) * 4160 : (const u16*)(ws + W_DVTP) + ((size_t)b * 512 + h * 128) * 2048;
    u16* P2 = (u16*)(ws + W_P2);
    bf16x8 qf[2][2];
    if (nact > 0) {
#pragma unroll
        for (int r = 0; r < 2; ++r)
#pragma unroll
            for (int kk = 0; kk < 2; ++kk) qf[r][kk] = *(const bf16x8*)(P2 + (size_t)(rowbase + 32 * qs + 16 * r + fr) * 1024 + 512 + h * 128 + c * 64 + kk * 32 + fq * 8);
    } else {
#pragma unroll
        for (int r = 0; r < 2; ++r)
#pragma unroll
            for (int kk = 0; kk < 2; ++kk) qf[r][kk] = (bf16x8){0, 0, 0, 0, 0, 0, 0, 0};
    }
    constexpr int STG = 36864;
    int gK[2], lK[2], gV[2], lV[2];
#pragma unroll
    for (int i = 0; i < 2; ++i) { const int ch = tid + 512 * i; const int key = ch >> 4, part = ch & 15; gK[i] = key * 512 + h * 128 + part * 8; lK[i] = (((part >> 3) * 64 + key) * 72 + (part & 7) * 8) * 2;
        const int v = ch >> 3, kp = (ch & 7) * 8; gV[i] = v * Tk + kp; lV[i] = (128 * 72 + v * 72 + kp) * 2; }
    u32x4 rk[2], rv[2];
#pragma unroll
    for (int i = 0; i < 2; ++i) { rk[i] = *(const u32x4*)(Kb + gK[i]); rv[i] = *(const u32x4*)(Vb + gV[i]); }
#pragma unroll
    for (int i = 0; i < 2; ++i) { *(LAS u32x4*)(lds + lK[i]) = rk[i]; *(LAS u32x4*)(lds + lV[i]) = rv[i]; }
    __syncthreads();
    f32x4 O[2][8];
#pragma unroll
    for (int r = 0; r < 2; ++r)
#pragma unroll
        for (int i = 0; i < 8; ++i) O[r][i] = (f32x4){0.f, 0.f, 0.f, 0.f};
    float mrun[2] = {-1e30f, -1e30f}, lrun[2] = {0.f, 0.f};
    for (int kt = 0; kt < nkv; ++kt) {
        const bool more = kt + 1 < nkv;
        if (more) { const size_t k0 = (size_t)(kt + 1) * 64;
#pragma unroll
            for (int i = 0; i < 2; ++i) { rk[i] = *(const u32x4*)(Kb + k0 * 512 + gK[i]); rv[i] = *(const u32x4*)(Vb + k0 + gV[i]); } }
        if (kt < nact) {
            LAS unsigned char* st = lds + (kt & 1) * STG;
            f32x4 s[2][4];
#pragma unroll
            for (int jt = 0; jt < 4; ++jt) { s[0][jt] = (f32x4){0.f, 0.f, 0.f, 0.f}; s[1][jt] = (f32x4){0.f, 0.f, 0.f, 0.f};
#pragma unroll
                for (int kk = 0; kk < 2; ++kk) { const bf16x8 kf = *(const LAS bf16x8*)(st + ((c * 64 + 16 * jt + fr) * 72 + kk * 32 + fq * 8) * 2);
                    s[0][jt] = mfma16(kf, qf[0][kk], s[0][jt]); s[1][jt] = mfma16(kf, qf[1][kk], s[1][jt]); } }
            bf16x8 pf[2][2];
#pragma unroll
            for (int r = 0; r < 2; ++r) {
                float mt = s[r][0][0];
#pragma unroll
                for (int jt = 0; jt < 4; ++jt)
#pragma unroll
                    for (int e = 0; e < 4; ++e) mt = fmaxf(mt, s[r][jt][e]);
                mt = fmaxf(mt, __shfl_xor(mt, 16)); mt = fmaxf(mt, __shfl_xor(mt, 32));
                const float mnew = fmaxf(mrun[r], mt), alpha = __builtin_amdgcn_exp2f(mrun[r] - mnew); mrun[r] = mnew;
                float ps = 0.f;
#pragma unroll
                for (int jt = 0; jt < 4; ++jt)
#pragma unroll
                    for (int e = 0; e < 4; ++e) { s[r][jt][e] = __builtin_amdgcn_exp2f(s[r][jt][e] - mnew); ps += s[r][jt][e]; }
                lrun[r] = lrun[r] * alpha + ps;
#pragma unroll
                for (int i = 0; i < 8; ++i) O[r][i] *= alpha;
#pragma unroll
                for (int t = 0; t < 2; ++t) { const u32x2 lo = pk4(s[r][2 * t]), hi = pk4(s[r][2 * t + 1]); u32x4 wv; wv.x = lo.x; wv.y = lo.y; wv.z = hi.x; wv.w = hi.y; pf[r][t] = __builtin_bit_cast(bf16x8, wv); }
            }
#pragma unroll
            for (int vt = 0; vt < 8; ++vt)
#pragma unroll
                for (int t = 0; t < 2; ++t) { const LAS unsigned char* vp = st + (128 * 72 + (16 * vt + fr) * 72 + 32 * t + 4 * fq) * 2;
                    const u32x2 a = *(const LAS u32x2*)vp, bq = *(const LAS u32x2*)(vp + 32); u32x4 wv; wv.x = a.x; wv.y = a.y; wv.z = bq.x; wv.w = bq.y;
                    const bf16x8 vf = __builtin_bit_cast(bf16x8, wv);
                    O[0][vt] = mfma16(vf, pf[0][t], O[0][vt]); O[1][vt] = mfma16(vf, pf[1][t], O[1][vt]); }
        }
        if (more) { LAS unsigned char* nx = lds + ((kt + 1) & 1) * STG;
#pragma unroll
            for (int i = 0; i < 2; ++i) { *(LAS u32x4*)(nx + lK[i]) = rk[i]; *(LAS u32x4*)(nx + lV[i]) = rv[i]; } }
        __syncthreads();
    }
    const float lam = ((const float*)(ws + W_MISC))[8 + 2 * l], lam_init = ((const float*)(ws + W_MISC))[9 + 2 * l];
    LAS float* X = (LAS float*)lds;
    float inv[2];
#pragma unroll
    for (int r = 0; r < 2; ++r) inv[r] = __builtin_amdgcn_rcpf(fmaxf(red_fq(lrun[r]), 1e-30f));
    if (c == 1) {
#pragma unroll
        for (int r = 0; r < 2; ++r)
#pragma unroll
            for (int vt = 0; vt < 8; ++vt)
#pragma unroll
                for (int e = 0; e < 4; ++e) X[(qs * 64 + r * 32 + vt * 4 + e) * 64 + lane] = O[r][vt][e] * inv[r] * lam;
    }
    __syncthreads();
    if (c == 0 && nact > 0) {
        const float* g = p.in[30] + l * 128;
#pragma unroll
        for (int r = 0; r < 2; ++r) { float ss = 0.f;
#pragma unroll
            for (int vt = 0; vt < 8; ++vt)
#pragma unroll
                for (int e = 0; e < 4; ++e) { const float d = O[r][vt][e] * inv[r] - X[(qs * 64 + r * 32 + vt * 4 + e) * 64 + lane]; O[r][vt][e] = d; ss += d * d; }
            ss = red_fq(ss); const float rs = __builtin_amdgcn_rsqf(ss * (1.f / 128.f) + EPS) * (1.f - lam_init);
#pragma unroll
            for (int vt = 0; vt < 8; ++vt) { const f32x4 gv = *(const f32x4*)(g + 16 * vt + 4 * fq);
                *(u32x2*)(P2 + (size_t)(rowbase + 32 * qs + 16 * r + fr) * 1024 + 512 + h * 128 + 16 * vt + 4 * fq) = pk4(O[r][vt] * rs * gv); } }
    }
    __syncthreads();
}

DEV void gla_item(CP& p, int l, LAS unsigned char* lds, int grp, int b, int h) {
    unsigned char* ws = p.ws;
    const int tid = tid_o(), w = tid >> 6, lane = tid & 63, fr = lane & 15, fq = lane >> 4;
    const int T = grp ? 64 : 2048, nch = grp ? 1 : 32; const int rowbase = grp ? MTP + b * 64 : b * 2048;
    const u16* CQ = (const u16*)(ws + W_CQ); const u16* CK = (const u16*)(ws + W_CK); const float* CODE = (const float*)(ws + W_CODE);
    const u16* VT = (const u16*)(ws + W_CVT) + (grp ? (size_t)16 * 512 * 2048 : 0) + ((size_t)b * 512 + h * 128) * T;
    u16* P2 = (u16*)(ws + W_P2);
    LAS u16* QE = (LAS u16*)lds; LAS u16* KE = QE + 64 * 72; LAS u16* KDT = KE + 64 * 72; LAS u16* VTl = KDT + 64 * 72;
    LAS u16* PP = VTl + 128 * 72; LAS u16* STb = PP + 64 * 72;
    LAS float* OT = (LAS float*)(STb + 8 * 16 * 72); LAS float* SEG = OT + 64 * 132; LAS float* DEC = SEG + 8 * 64;
    LAS u16* QR = (LAS u16*)(DEC + 64); LAS u16* KR = QR + 64 * 72; LAS float* CD = (LAS float*)(KR + 64 * 72);
    const int d_ = tid & 63, seg = tid >> 6;
    float wa[16];
#pragma unroll
    for (int r = 0; r < 16; ++r) wa[r] = p.in[24][(size_t)l * 16 * 256 + r * 256 + h * 64 + d_];
    const float ba = p.in[25][l * 256 + h * 64 + d_];
    f32x4 S[4];
    if (grp) { const float* s0 = p.in[6] + ((size_t)(l * 8 + b) * 4 + h) * 64 * 128;
#pragma unroll
        for (int dt = 0; dt < 4; ++dt) S[dt] = *(const f32x4*)(s0 + (size_t)(16 * dt + fr) * 128 + 16 * w + 4 * fq); }
    else {
#pragma unroll
        for (int dt = 0; dt < 4; ++dt) S[dt] = (f32x4){0.f, 0.f, 0.f, 0.f}; }
#pragma unroll
    for (int dt = 0; dt < 4; ++dt)
#pragma unroll
        for (int e = 0; e < 4; ++e) STb[(w * 16 + 4 * fq + e) * 72 + 16 * dt + fr] = f2bf(S[dt][e]);
    const float* gng = p.in[26] + l * 128;
    const int tl = tid >> 3, d8 = (tid & 7) * 8;
    u32x4 rq, rkk, rvv[2]; f32x2 rcd;
    {
        rq = *(const u32x4*)(CQ + (size_t)(rowbase + tl) * 256 + h * 64 + d8); rkk = *(const u32x4*)(CK + (size_t)(rowbase + tl) * 256 + h * 64 + d8);
        rcd = *(const f32x2*)(CODE + (size_t)(rowbase + tl) * 16 + (tid & 7) * 2);
#pragma unroll
        for (int i = 0; i < 2; ++i) { const int chn = tid + 512 * i, v = chn >> 3, kp = (chn & 7) * 8; rvv[i] = *(const u32x4*)(VT + (size_t)v * T + kp); }
    }
    for (int ch = 0; ch < nch; ++ch) {
        const int r0 = rowbase + ch * 64;
        *(LAS u32x4*)(QR + tl * 72 + d8) = rq; *(LAS u32x4*)(KR + tl * 72 + d8) = rkk; *(LAS f32x2*)(CD + tl * 16 + (tid & 7) * 2) = rcd;
#pragma unroll
        for (int i = 0; i < 2; ++i) { const int chn = tid + 512 * i, v = chn >> 3, kp = (chn & 7) * 8; *(LAS u32x4*)(VTl + v * 72 + kp) = rvv[i]; }
        if (ch + 1 < nch) { const int r1 = r0 + 64;
            rq = *(const u32x4*)(CQ + (size_t)(r1 + tl) * 256 + h * 64 + d8); rkk = *(const u32x4*)(CK + (size_t)(r1 + tl) * 256 + h * 64 + d8);
            rcd = *(const f32x2*)(CODE + (size_t)(r1 + tl) * 16 + (tid & 7) * 2);
#pragma unroll
            for (int i = 0; i < 2; ++i) { const int chn = tid + 512 * i, v = chn >> 3, kp = (chn & 7) * 8; rvv[i] = *(const u32x4*)(VT + (size_t)v * T + (ch + 1) * 64 + kp); } }
        u16* yp = P2 + (size_t)(r0 + tl) * 1024 + h * 128 + (tid & 7) * 16;
        const u32x4 rr0 = *(const u32x4*)yp, rr1 = *(const u32x4*)(yp + 8);
        __syncthreads();
        float bl[8]; float run = 0.f;
#pragma unroll
        for (int i = 0; i < 8; ++i) { const LAS float* cp = CD + (seg * 8 + i) * 16; float a = ba;
#pragma unroll
            for (int r = 0; r < 16; ++r) a += cp[r] * wa[r];
            run += flogsig(a) * (1.f / 16.f); bl[i] = run; }
        SEG[seg * 64 + d_] = run;
        __syncthreads();
        float off = 0.f, tot = 0.f;
#pragma unroll
        for (int s2 = 0; s2 < 8; ++s2) { const float x = SEG[s2 * 64 + d_]; tot += x; if (s2 < seg) off += x; }
        if (seg == 0) DEC[d_] = __expf(tot);
        { float kd[8];
#pragma unroll
          for (int i = 0; i < 8; ++i) { const int t = seg * 8 + i; const float bb = bl[i] + off;
              const float q = bf2f(QR[t * 72 + d_]), k = bf2f(KR[t * 72 + d_]);
              QE[t * 72 + d_] = f2bf(q * __expf(bb)); KE[t * 72 + d_] = f2bf(k * __expf(-bb)); kd[i] = k * __expf(tot - bb); }
          u32x4 wv; wv.x = pk2(kd[0], kd[1]); wv.y = pk2(kd[2], kd[3]); wv.z = pk2(kd[4], kd[5]); wv.w = pk2(kd[6], kd[7]);
          *(LAS u32x4*)(KDT + d_ * 72 + seg * 8) = wv; }
        __syncthreads();
#pragma unroll
        for (int r = 0; r < 2; ++r) { const int ti = w + 8 * r, jt = ti >> 2, it = ti & 3; f32x4 a = (f32x4){0.f, 0.f, 0.f, 0.f};
            if (jt <= it) {
#pragma unroll
                for (int kk = 0; kk < 2; ++kk) { const bf16x8 kf = *(const LAS bf16x8*)(KE + (16 * jt + fr) * 72 + kk * 32 + fq * 8), qf = *(const LAS bf16x8*)(QE + (16 * it + fr) * 72 + kk * 32 + fq * 8); a = mfma16(kf, qf, a); }
#pragma unroll
                for (int e = 0; e < 4; ++e) if (16 * jt + 4 * fq + e > 16 * it + fr) a[e] = 0.f;
            }
            *(LAS u32x2*)(PP + (16 * it + fr) * 72 + 16 * jt + 4 * fq) = pk4(a); }
        __syncthreads();
        bf16x8 vf[2], sf[2];
#pragma unroll
        for (int t = 0; t < 2; ++t) { vf[t] = *(const LAS bf16x8*)(VTl + (16 * w + fr) * 72 + 32 * t + 8 * fq); sf[t] = *(const LAS bf16x8*)(STb + (w * 16 + fr) * 72 + 32 * t + 8 * fq); }
#pragma unroll
        for (int it = 0; it < 4; ++it) { f32x4 a = (f32x4){0.f, 0.f, 0.f, 0.f};
#pragma unroll
            for (int t = 0; t < 2; ++t) { const bf16x8 pf = *(const LAS bf16x8*)(PP + (16 * it + fr) * 72 + 32 * t + 8 * fq), qf = *(const LAS bf16x8*)(QE + (16 * it + fr) * 72 + 32 * t + 8 * fq);
                a = mfma16(vf[t], pf, a); a = mfma16(sf[t], qf, a); }
            *(LAS f32x4*)(OT + (16 * it + fr) * 132 + 16 * w + 4 * fq) = a; }
#pragma unroll
        for (int dt = 0; dt < 4; ++dt) { S[dt] *= DEC[16 * dt + fr];
#pragma unroll
            for (int t = 0; t < 2; ++t) { const bf16x8 kf = *(const LAS bf16x8*)(KDT + (16 * dt + fr) * 72 + 32 * t + 8 * fq); S[dt] = mfma16(vf[t], kf, S[dt]); }
#pragma unroll
            for (int e = 0; e < 4; ++e) STb[(w * 16 + 4 * fq + e) * 72 + 16 * dt + fr] = f2bf(S[dt][e]); }
        __syncthreads();
        {
            const int i = tid >> 3, vs = tid & 7; f32x4 o[4]; float ss = 0.f;
#pragma unroll
            for (int k = 0; k < 4; ++k) { o[k] = *(const LAS f32x4*)(OT + i * 132 + vs * 16 + 4 * k); ss += o[k][0] * o[k][0] + o[k][1] * o[k][1] + o[k][2] * o[k][2] + o[k][3] * o[k][3]; }
            ss += __shfl_xor(ss, 1); ss += __shfl_xor(ss, 2); ss += __shfl_xor(ss, 4);
            const float rs = __builtin_amdgcn_rsqf(ss * (1.f / 128.f) + EPS);
            const unsigned rw[8] = {rr0.x, rr0.y, rr0.z, rr0.w, rr1.x, rr1.y, rr1.z, rr1.w};
#pragma unroll
            for (int k = 0; k < 4; ++k) { const f32x4 gv = *(const f32x4*)(gng + vs * 16 + 4 * k);
                f32x4 r; r[0] = __uint_as_float(rw[2 * k] << 16); r[1] = __uint_as_float(rw[2 * k] & 0xffff0000u); r[2] = __uint_as_float(rw[2 * k + 1] << 16); r[3] = __uint_as_float(rw[2 * k + 1] & 0xffff0000u);
                *(u32x2*)(yp + 4 * k) = pk4(o[k] * rs * gv * r); }
        }
    }
    float* so = p.out + (grp ? O_GLAS + (size_t)l * 262144 + ((size_t)b * 4 + h) * 8192 : O_GLAP + (size_t)l * 524288 + ((size_t)b * 4 + h) * 8192);
#pragma unroll
    for (int dt = 0; dt < 4; ++dt) *(f32x4*)(so + (size_t)(16 * dt + fr) * 128 + 16 * w + 4 * fq) = S[dt];
    __syncthreads();
}

DEV void s5_item(CP& p, int l, LAS unsigned char* lds, int grp, int b, int gq) {
    unsigned char* ws = p.ws;
    const int tid = tid_o(), w = tid >> 6, lane = tid & 63, fr = lane & 15, fq = lane >> 4;
    const int g = gq * 8 + w; const int T = grp ? 64 : 2048; const int rowbase = grp ? MTP + b * 64 : b * 2048;
    u16* X = (u16*)(ws + W_S5);
    LAS u16* HT = (LAS u16*)lds + w * 32 * 136;
    const float dt = __expf(p.in[16][l * 32 + g]);
    bf16x8 breF[4], bimF[4]; float ar[4], ai[4], a8r[4], a8i[4];
#pragma unroll
    for (int pt = 0; pt < 4; ++pt) { const int pp = 16 * pt + fr; const size_t gp = (size_t)(l * 32 + g) * 64 + pp;
        const float lr = p.in[14][gp], li = p.in[15][gp];
        const float mag = __expf(lr * dt), ang = li * dt * 0.15915494309189535f;
        const float r_ = mag * __builtin_amdgcn_cosf(ang), i_ = mag * __builtin_amdgcn_sinf(ang);
        ar[pt] = r_; ai[pt] = i_;
        float xr = r_, xi = i_;
#pragma unroll
        for (int k = 0; k < 3; ++k) { const float nr2 = xr * xr - xi * xi, ni2 = 2.f * xr * xi; xr = nr2; xi = ni2; }
        a8r[pt] = xr; a8i[pt] = xi;
        const float den = lr * lr + li * li, nr = r_ - 1.f, ni = i_;
        const float kr = (nr * lr + ni * li) / den, ki = (ni * lr - nr * li) / den;
        float vr[8], vi[8];
#pragma unroll
        for (int j = 0; j < 8; ++j) { float br = 0.f, bi = 0.f; if (fq < 2) { br = p.in[17][gp * 16 + fq * 8 + j]; bi = p.in[18][gp * 16 + fq * 8 + j]; }
            vr[j] = kr * br - ki * bi; vi[j] = kr * bi + ki * br; }
        u32x4 wr_, wi_; wr_.x = pk2(vr[0], vr[1]); wr_.y = pk2(vr[2], vr[3]); wr_.z = pk2(vr[4], vr[5]); wr_.w = pk2(vr[6], vr[7]);
        wi_.x = pk2(vi[0], vi[1]); wi_.y = pk2(vi[2], vi[3]); wi_.z = pk2(vi[4], vi[5]); wi_.w = pk2(vi[6], vi[7]);
        breF[pt] = __builtin_bit_cast(bf16x8, wr_); bimF[pt] = __builtin_bit_cast(bf16x8, wi_); }
    bf16x8 cF[4];
#pragma unroll
    for (int ks = 0; ks < 4; ++ks) { float v[8]; const int k0 = 32 * ks + 8 * fq;
#pragma unroll
        for (int j = 0; j < 8; ++j) { const int k = k0 + j; v[j] = k < 64 ? p.in[19][((size_t)(l * 32 + g) * 16 + fr) * 64 + k] : -p.in[20][((size_t)(l * 32 + g) * 16 + fr) * 64 + k - 64]; }
        u32x4 wv; wv.x = pk2(v[0], v[1]); wv.y = pk2(v[2], v[3]); wv.z = pk2(v[4], v[5]); wv.w = pk2(v[6], v[7]); cF[ks] = __builtin_bit_cast(bf16x8, wv); }
    const f32x4 dsk = *(const f32x4*)(p.in[21] + l * 512 + g * 16 + 4 * fq);
    float Hr[4], Hi[4];
#pragma unroll
    for (int pt = 0; pt < 4; ++pt) { if (grp) { const size_t sp = ((size_t)(l * 8 + b) * 32 + g) * 64 + 16 * pt + fr; Hr[pt] = p.in[4][sp]; Hi[pt] = p.in[5][sp]; } else { Hr[pt] = 0.f; Hi[pt] = 0.f; } }
    const int trow = 8 * (fr >> 2) + (fr & 3);
    u32x4 xn[2];
#pragma unroll
    for (int tt = 0; tt < 2; ++tt) { xn[tt] = (u32x4){0u, 0u, 0u, 0u}; if (fq < 2) xn[tt] = *(const u32x4*)(X + (size_t)(rowbase + trow + 4 * tt) * 512 + g * 16 + fq * 8); }
    for (int ch = 0; ch < T / 32; ++ch) {
        const int r0 = rowbase + ch * 32;
        bf16x8 xF[2];
#pragma unroll
        for (int tt = 0; tt < 2; ++tt) xF[tt] = __builtin_bit_cast(bf16x8, xn[tt]);
        if (ch + 1 < T / 32) {
#pragma unroll
            for (int tt = 0; tt < 2; ++tt) if (fq < 2) xn[tt] = *(const u32x4*)(X + (size_t)(r0 + 32 + trow + 4 * tt) * 512 + g * 16 + fq * 8); }
        u32x2 xsk[2];
#pragma unroll
        for (int t2 = 0; t2 < 2; ++t2) xsk[t2] = *(const u32x2*)(X + (size_t)(r0 + 16 * t2 + fr) * 512 + g * 16 + 4 * fq);
        f32x4 bur[2][4], bui[2][4];
#pragma unroll
        for (int tt = 0; tt < 2; ++tt)
#pragma unroll
            for (int pt = 0; pt < 4; ++pt) { bur[tt][pt] = mfma16(xF[tt], breF[pt], (f32x4){0.f, 0.f, 0.f, 0.f}); bui[tt][pt] = mfma16(xF[tt], bimF[pt], (f32x4){0.f, 0.f, 0.f, 0.f}); }
#pragma unroll
        for (int pt = 0; pt < 4; ++pt) {
            float er = 0.f, ei = 0.f;
#pragma unroll
            for (int k = 0; k < 8; ++k) { const float ur = bur[k >> 2][pt][k & 3], ui = bui[k >> 2][pt][k & 3]; const float nr = ar[pt] * er - ai[pt] * ei + ur, ni = ar[pt] * ei + ai[pt] * er + ui; er = nr; ei = ni; }
            float cr = Hr[pt], ci = Hi[pt], mr = cr, mi = ci;
#pragma unroll
            for (int q = 0; q < 4; ++q) { const float Er = __shfl(er, fr + 16 * q), Ei = __shfl(ei, fr + 16 * q);
                const float nr = a8r[pt] * cr - a8i[pt] * ci + Er, ni = a8r[pt] * ci + a8i[pt] * cr + Ei; cr = nr; ci = ni;
                if (q + 1 == fq) { mr = cr; mi = ci; } }
            Hr[pt] = cr; Hi[pt] = ci;
            float hr = mr, hi = mi;
#pragma unroll
            for (int k = 0; k < 8; ++k) { const float ur = bur[k >> 2][pt][k & 3], ui = bui[k >> 2][pt][k & 3]; const float nr = ar[pt] * hr - ai[pt] * hi + ur, ni = ar[pt] * hi + ai[pt] * hr + ui; hr = nr; hi = ni;
                HT[(8 * fq + k) * 136 + 16 * pt + fr] = f2bf(hr); HT[(8 * fq + k) * 136 + 64 + 16 * pt + fr] = f2bf(hi); }
        }
        asm volatile("s_waitcnt lgkmcnt(0)" ::: "memory");
        f32x4 y[2];
#pragma unroll
        for (int t2 = 0; t2 < 2; ++t2) { y[t2] = (f32x4){0.f, 0.f, 0.f, 0.f};
#pragma unroll
            for (int ks = 0; ks < 4; ++ks) { const bf16x8 hf = *(const LAS bf16x8*)(HT + (16 * t2 + fr) * 136 + 32 * ks + 8 * fq); y[t2] = mfma16(cF[ks], hf, y[t2]); } }
#pragma unroll
        for (int t2 = 0; t2 < 2; ++t2) { u16* xp = X + (size_t)(r0 + 16 * t2 + fr) * 512 + g * 16 + 4 * fq; const u32x2 xx = xsk[t2];
            f32x4 xv; xv[0] = __uint_as_float(xx.x << 16); xv[1] = __uint_as_float(xx.x & 0xffff0000u); xv[2] = __uint_as_float(xx.y << 16); xv[3] = __uint_as_float(xx.y & 0xffff0000u);
            f32x4 z = y[t2] + dsk * xv;
#pragma unroll
            for (int e = 0; e < 4; ++e) z[e] = fgelu(z[e]);
            *(u32x2*)xp = pk4(z); }
        asm volatile("" ::: "memory");
    }
    if (fq == 0) { float* ore = p.out + (grp ? O_SRES + (size_t)l * 16384 + ((size_t)b * 32 + g) * 64 : O_SREP + (size_t)l * 32768 + ((size_t)b * 32 + g) * 64);
        float* oim = p.out + (grp ? O_SIMS + (size_t)l * 16384 + ((size_t)b * 32 + g) * 64 : O_SIMP + (size_t)l * 32768 + ((size_t)b * 32 + g) * 64);
#pragma unroll
        for (int pt = 0; pt < 4; ++pt) { ore[16 * pt + fr] = Hr[pt]; oim[16 * pt + fr] = Hi[pt]; } }
    __syncthreads();
}

DEV void gmlp_item(CP& p, int l, LAS unsigned char* lds, int grp, int b, int n, int g) {
    unsigned char* ws = p.ws;
    const int tid = tid_o(), w = tid >> 6, lane = tid & 63, fr = lane & 15, fq = lane >> 4;
    const int L = grp ? 64 : 128, T = grp ? 64 : 2048; const int rowbase = grp ? MTP + b * 64 : b * 2048 + n * 128;
    LAS u16* WT = (LAS u16*)lds; LAS u16* GT = WT + 128 * 136; LAS float* RS = (LAS float*)(GT + 128 * 136);
    const float* rowsq = (const float*)(ws + W_ROWSQ);
    if (tid < L) RS[tid] = __builtin_amdgcn_rsqf(rowsq[rowbase + tid] * (1.f / 512.f) + EPS);
    const u16* GV = (const u16*)(ws + W_GVT) + (grp ? (size_t)16 * 512 * 2048 : 0) + ((size_t)b * 512 + g * 128) * T + (grp ? 0 : n * 128);
    const u16* WM = (const u16*)(ws + W_WM) + (size_t)g * 128 * 128;
    const int cshift = grp ? 3 : 4, nchunk = 128 << cshift, nwch = L << cshift;
    u16* P1 = (u16*)(ws + W_P1);
    u32x4 gq[4], wq[4];
#pragma unroll
    for (int i = 0; i < 4; ++i) { const int chn = tid + 512 * i; const int cg_ = chn < nchunk ? chn : 0, cw_ = chn < nwch ? chn : 0;
        gq[i] = *(const u32x4*)(GV + (size_t)(cg_ >> cshift) * T + (cg_ & ((1 << cshift) - 1)) * 8);
        wq[i] = *(const u32x4*)(WM + (size_t)(cw_ >> cshift) * 128 + (cw_ & ((1 << cshift) - 1)) * 8); }
    u32x2 uq[8]; float bq[8];
    const int ntt = L >> 4;
#pragma unroll
    for (int tt = 0; tt < 8; ++tt) { const int t = tt < ntt ? 16 * tt + fr : fr; uq[tt] = *(const u32x2*)(P1 + (size_t)(rowbase + t) * 1024 + g * 128 + 16 * w + 4 * fq); bq[tt] = p.in[13][(size_t)(l * 4 + g) * 128 + t]; }
    const f32x4 gvg = *(const f32x4*)(p.in[11] + l * 512 + g * 128 + 16 * w + 4 * fq);
    __syncthreads();
#pragma unroll
    for (int i = 0; i < 4; ++i) { const int chn = tid + 512 * i;
        if (chn < nchunk) { const int c = chn >> cshift, kp = (chn & ((1 << cshift) - 1)) * 8; const unsigned gw[4] = {gq[i].x, gq[i].y, gq[i].z, gq[i].w}; u32x4 o;
            unsigned ow[4];
#pragma unroll
            for (int k = 0; k < 4; ++k) ow[k] = pk2(__uint_as_float(gw[k] << 16) * RS[kp + 2 * k], __uint_as_float(gw[k] & 0xffff0000u) * RS[kp + 2 * k + 1]);
            o.x = ow[0]; o.y = ow[1]; o.z = ow[2]; o.w = ow[3]; *(LAS u32x4*)(GT + c * 136 + kp) = o; }
        if (chn < nwch) { const int t = chn >> cshift, kp = (chn & ((1 << cshift) - 1)) * 8; *(LAS u32x4*)(WT + t * 136 + kp) = wq[i]; } }
    __syncthreads();
#pragma unroll
    for (int tt = 0; tt < 8; ++tt) { if (tt < ntt) { f32x4 a = (f32x4){0.f, 0.f, 0.f, 0.f};
        for (int ks = 0; ks < L / 32; ++ks) { if (32 * ks > 16 * tt + 15) break;
            const bf16x8 gf = *(const LAS bf16x8*)(GT + (16 * w + fr) * 136 + 32 * ks + 8 * fq), wf = *(const LAS bf16x8*)(WT + (16 * tt + fr) * 136 + 32 * ks + 8 * fq); a = mfma16(gf, wf, a); }
        const int t = 16 * tt + fr;
        f32x4 u; u[0] = __uint_as_float(uq[tt].x << 16); u[1] = __uint_as_float(uq[tt].x & 0xffff0000u); u[2] = __uint_as_float(uq[tt].y << 16); u[3] = __uint_as_float(uq[tt].y & 0xffff0000u);
        *(u32x2*)(P1 + (size_t)(rowbase + t) * 1024 + g * 128 + 16 * w + 4 * fq) = pk4(u * (a * gvg + bq[tt])); } }
    if (grp) {
        float* o = p.out + O_GMV + (size_t)l * 262144 + (size_t)b * 64 * 512; const float* gg = p.in[11] + l * 512 + g * 128;
        for (int idx = tid; idx < 64 * 128; idx += 512) { const int t = idx >> 7, c = idx & 127; o[(size_t)t * 512 + g * 128 + c] = bf2f(GT[c * 136 + t]) * gg[c]; }
    }
    __syncthreads();
}

DEV void phaseMix(CP& p, int l, LAS unsigned char* lds) {
    unsigned* ctr = (unsigned*)(p.ws + W_MISC) + l;
    LAS int* slot = (LAS int*)(lds + 160 * 1024 - 16);
    for (;;) {
        if (tid_o() == 0) *slot = (int)atomicAdd(ctr, 1u);
        __syncthreads();
        int it = __builtin_amdgcn_readfirstlane(*slot);
        __syncthreads();
        if (it >= 2304) break;
        int kind, grp = 0, a0, a1, a2 = 0;
        if (it < 64) { kind = 0; a0 = it >> 2; a1 = it & 3; }
        else if (it < 128) { it -= 64; kind = 1; a0 = it >> 2; a1 = it & 3; }
        else if (it < 160) { it -= 128; kind = 2; grp = 1; a0 = it >> 2; a1 = it & 3; }
        else if (it < 1184) { it -= 160; kind = 2; a2 = 15 - (it >> 6); a0 = (it & 63) >> 2; a1 = it & 3; }
        else if (it < 2208) { it -= 1184; kind = 3; a0 = it >> 6; a2 = (it >> 2) & 15; a1 = it & 3; }
        else if (it < 2240) { it -= 2208; kind = 0; grp = 1; a0 = it >> 2; a1 = it & 3; }
        else if (it < 2272) { it -= 2240; kind = 1; grp = 1; a0 = it >> 2; a1 = it & 3; }
        else { it -= 2272; kind = 3; grp = 1; a0 = it >> 2; a1 = it & 3; }
        asm volatile("" : "+s"(kind), "+s"(grp), "+s"(a0), "+s"(a1), "+s"(a2));
        if (kind == 0) {
#ifndef NO_S5
            s5_item(p, l, lds, grp, a0, a1);
#endif
        } else if (kind == 1) {
#ifndef NO_GLA
#ifdef GLA_SAMPLE_ONLY
            if (grp)
#endif
            gla_item(p, l, lds, grp, a0, a1);
#endif
        } else if (kind == 2) {
#ifndef NO_ATT
            attn_item(p, l, lds, grp, a0, a1, a2);
#endif
        } else {
#ifndef NO_GMLP
            gmlp_item(p, l, lds, grp, a0, a2, a1);
#endif
        }
    }
}

DEV void phaseFix(CP& p, int l) {
    unsigned char* ws = p.ws; const int gt = bid_o() * 512 + tid_o(), GT = gridDim.x * 512;
    const float* HEAD = (const float*)(ws + W_HEAD); const float* TAIL = (const float*)(ws + W_TAIL); u16* ACT = (u16*)(ws + W_ACT);
    const float* cw = p.in[35] + (size_t)l * 3 * 5632; const float* cb = p.in[36] + (size_t)l * 5632;
    for (int idx = gt; idx < 520 * 2816; idx += GT) { const int slab = idx / 2816, f = idx % 2816;
        float c0[2], c1[2];
#pragma unroll
        for (int bj = 0; bj < 2; ++bj) { const int ff = bj * 2816 + f; float pm2 = 0.f, pm1 = 0.f;
            if (slab >= 512) { const float* st = p.in[7] + ((size_t)(l * 8 + (slab - 512)) * 2) * 5632; pm2 = st[ff]; pm1 = st[5632 + ff]; }
            else if (slab & 31) { pm2 = TAIL[((size_t)(slab - 1) * 2) * 5632 + ff]; pm1 = TAIL[((size_t)(slab - 1) * 2 + 1) * 5632 + ff]; }
            const float h0 = HEAD[((size_t)slab * 2) * 5632 + ff], h1 = HEAD[((size_t)slab * 2 + 1) * 5632 + ff];
            const float w0 = cw[ff], w1 = cw[5632 + ff], w2 = cw[11264 + ff], bb = cb[ff];
            c0[bj] = bb + w0 * pm2 + w1 * pm1 + w2 * h0; c1[bj] = bb + w0 * pm1 + w1 * h0 + w2 * h1; }
        ACT[(size_t)(slab * 64) * 2816 + f] = f2bf(fsilu(c0[0]) * c0[1]); ACT[(size_t)(slab * 64 + 1) * 2816 + f] = f2bf(fsilu(c1[0]) * c1[1]); }
    for (int idx = gt; idx < 24 * 2 * 5632; idx += GT) { const int bb = idx / 11264, rem = idx % 11264;
        if (bb < 16) p.out[O_FCP + (size_t)l * 180224 + (size_t)bb * 11264 + rem] = TAIL[((size_t)(bb * 32 + 31) * 2) * 5632 + rem];
        else p.out[O_FCS + (size_t)l * 90112 + (size_t)(bb - 16) * 11264 + rem] = TAIL[((size_t)(512 + bb - 16) * 2) * 5632 + rem]; }
}

#define XB_TMO      128
#define XB_XCNT(j)  (256  + 64 * (j))
#define XB_XSUB(j)  (1280 + 64 * (j))
#define XB_XGEN(j)  (2304 + 64 * (j))
#define XB_TOP      3328
#define XB_TOPGEN   3392
#define XCD_BAR_WORDS 3456
#define XB_SPIN_CAP (1u << 18)

__device__ __forceinline__ unsigned xb_ld(unsigned* p)              { return __hip_atomic_load(p, __ATOMIC_RELAXED, __HIP_MEMORY_SCOPE_AGENT); }
__device__ __forceinline__ unsigned xb_add(unsigned* p, unsigned v) { return __hip_atomic_fetch_add(p, v, __ATOMIC_RELAXED, __HIP_MEMORY_SCOPE_AGENT); }
__device__ __forceinline__ unsigned xb_xcc_id() { return (unsigned)__builtin_amdgcn_s_getreg((3 << 11) | 20) & 0xFu; }
#define XB_SPIN(cond, bar) do { unsigned _sp = 0; while (cond) { __builtin_amdgcn_s_sleep(1); \
    if ((++_sp & 255u) == 0u) { if (xb_ld(&(bar)[XB_TMO])) break; if (_sp > XB_SPIN_CAP) { atomicAdd(&(bar)[XB_TMO], 1u); break; } } } } while (0)

struct XcdBarrier {
    unsigned* bar; unsigned x;
    volatile LAS unsigned* st;
};

__device__ __forceinline__ XcdBarrier xcd_barrier_post(unsigned* bar, volatile LAS unsigned* st) {
    XcdBarrier b; b.bar = bar; b.x = xb_xcc_id(); b.st = st;
    if (threadIdx.x == 0) (void)xb_add(&bar[XB_XCNT(b.x)], 1u);
    return b;
}
__device__ __forceinline__ void xcd_barrier_complete(unsigned* bar, unsigned x, unsigned& nloc, unsigned& nx) {
    const unsigned G = gridDim.x * gridDim.y * gridDim.z;
    unsigned sum, cnt, mine, sp = 0u;
    for (;;) {
        sum = 0u; cnt = 0u; mine = 0u;
#pragma unroll
        for (unsigned j = 0; j < 16; ++j) { const unsigned c = xb_ld(&bar[XB_XCNT(j)]); sum += c; cnt += (c > 0u) ? 1u : 0u; mine = (j == x) ? c : mine; }
        if (sum == G) break;
        __builtin_amdgcn_s_sleep(1);
        if ((++sp & 255u) == 0u) { if (xb_ld(&bar[XB_TMO])) break; if (sp > XB_SPIN_CAP) { atomicAdd(&bar[XB_TMO], 1u); break; } }
    }
    nloc = mine > 0u ? mine : 1u; nx = cnt > 0u ? cnt : 1u;
}

__device__ __forceinline__ void xcd_barrier(const XcdBarrier& b) {
    asm volatile("s_waitcnt vmcnt(0)" ::: "memory");
    __syncthreads();
    if (threadIdx.x == 0) {
        unsigned* bar = b.bar;
        __builtin_amdgcn_s_waitcnt(0);
        unsigned nloc = b.st[0], nx = b.st[1];
        if (nloc == 0u) { xcd_barrier_complete(bar, b.x, nloc, nx); b.st[0] = nloc; b.st[1] = nx; }
        const unsigned old = xb_add(&bar[XB_XSUB(b.x)], 1u);
        const unsigned gen = old / nloc;
        if (old + 1u == (gen + 1u) * nloc) {
            __builtin_amdgcn_fence(__ATOMIC_RELEASE, "agent");
            asm volatile("s_waitcnt vmcnt(0)" ::: "memory");
            const unsigned og = xb_add(&bar[XB_TOP], 1u);
            const unsigned tg = og / nx;
            if (og + 1u == (tg + 1u) * nx) xb_add(&bar[XB_TOPGEN], 1u);
            else XB_SPIN(xb_ld(&bar[XB_TOPGEN]) == tg, bar);
            __builtin_amdgcn_fence(__ATOMIC_ACQUIRE, "agent");
            xb_add(&bar[XB_XGEN(b.x)], 1u);
            asm volatile("s_waitcnt vmcnt(0)" ::: "memory");
        } else {
            XB_SPIN(xb_ld(&bar[XB_XGEN(b.x)]) == gen, bar);
            __builtin_amdgcn_fence(__ATOMIC_ACQUIRE, "agent");
            asm volatile("s_waitcnt vmcnt(0)" ::: "memory");
        }
    }
    __syncthreads();
}


__global__ void __launch_bounds__(512, 2) mega(Params p_unused) {
    extern __shared__ __attribute__((aligned(16))) unsigned char smem[];
    LAS unsigned char* lds = (LAS unsigned char*)smem;
    cg::grid_group grid = cg::this_grid();
    volatile LAS unsigned* xb_st = (volatile LAS unsigned*)(lds + 160 * 1024 - 32);
    if (threadIdx.x == 0) { xb_st[0] = 0u; xb_st[1] = 0u; }
    __syncthreads();
    const XcdBarrier xbar = xcd_barrier_post((unsigned*)(((CP*)__builtin_amdgcn_kernarg_segment_ptr())->ws + W_BAR), xb_st);
#define GSYNC() xcd_barrier(xbar)
#pragma unroll 1
    for (int l = 0; l < 2; ++l) {
        CP* pp = (CP*)__builtin_amdgcn_kernarg_segment_ptr(); asm volatile("" : "+s"(pp)); CP& p = *pp; unsigned char* ws = p.ws; const int G = gridDim.x, c = bid_o();
#ifndef SKIP_A
        phaseA(p, l);
#endif
        if (l == 0) grid.sync(); else GSYNC();
#ifndef SKIP_B
        {
            pg8::PlainSched S; S.T.init(130, NMIX, G, c); S.A = (const char*)ws + W_H; S.B = (const char*)ws + W_WIN; S.ld = 1024; S.nt = 16;
            EpiIn E; E.l = l; E.out = p.out; E.ws = ws; E.qg = p.in[27] + l * 64; E.kg = p.in[28] + l * 64; E.rs1 = (const float*)(ws + W_RS) + (size_t)(l * 2) * MT;
            pg8::gemm_phase(lds, 1024, S, E);
        }
#endif
        GSYNC();
#ifndef SKIP_C
        phaseMix(p, l, lds);
#endif
        GSYNC();
#ifndef SKIP_D
        {
            pg8::PlainSched S; S.T.init(130, 2, G, c); S.A = (const char*)ws + W_S5; S.B = (const char*)ws + W_WGLU; S.ld = 512; S.nt = 8;
            EpiGlu E; E.ws = ws; E.bias = p.in[23] + l * 512;
            pg8::gemm_phase(lds, 512, S, E);
        }
#endif
        GSYNC();
#ifndef SKIP_E
        {
            MergeSched S; S.T.init(128, 4, G, c); S.ws = ws;
            EpiMerge E; E.ws = ws; E.bgate = p.in[10] + l * 4096; E.rs1 = (const float*)(ws + W_RS) + (size_t)(l * 2) * MT;
            pg8::gemm_phase(lds, 1024, S, E);
        }
#endif
        GSYNC();
        {
            const f32x4* mf = (const f32x4*)(ws + W_MFS); u16* mg = (u16*)(ws + W_MERGED) + (size_t)MTP * 1024;
            for (int i = c * 512 + tid_o(); i < 512 * 256; i += G * 512) *(u32x2*)(mg + (size_t)i * 4) = pk4(mf[i]);
        }
        GSYNC();
#ifndef SKIP_F
        {
            pg8::TailSched S; S.T.init(128, 4, G, c); S.A = (const char*)ws + W_MERGED; S.B = (const char*)ws + W_WOUT; S.ld = 1024; S.nt = 16; S.npiece = 4; S.ntp = 4;
            EpiRes E; E.xin = l == 0 ? p.in[0] : nullptr; E.xb = (u16*)(ws + W_H); E.yout = nullptr; E.rsacc = (float*)(ws + W_RS) + (size_t)(l * 2 + 1) * MT; E.yfull = p.out;
            pg8::gemm_phase(lds, 1024, S, E);
        }
#endif
        GSYNC();
#ifndef SKIP_G
        raw_rows(nullptr, p.out + (size_t)MTP * 1024, MTP, MT, (u16*)(ws + W_H), (float*)(ws + W_RS) + (size_t)(l * 2 + 1) * MT);
#endif
        GSYNC();
#ifndef SKIP_H
        {
            pg8::PlainSched S; S.T.init(130, 22, G, c); S.A = (const char*)ws + W_H; S.B = (const char*)ws + W_WUP; S.ld = 1024; S.nt = 16;
            EpiUp E; E.ws = ws; E.cw = p.in[35] + (size_t)l * 3 * 5632; E.cbias = p.in[36] + (size_t)l * 5632; E.rs2 = (const float*)(ws + W_RS) + (size_t)(l * 2 + 1) * MT;
            pg8::gemm_phase(lds, 1024, S, E);
        }
#endif
        GSYNC();
#ifndef SKIP_I
        phaseFix(p, l);
#endif
        GSYNC();
#ifndef SKIP_J
        {
            pg8::TailSched S; S.T.init(128, 4, G, c); S.A = (const char*)ws + W_ACT; S.B = (const char*)ws + W_WDN; S.ld = 2816; S.nt = 44; S.npiece = 11; S.ntp = 4;
            EpiRes E; E.xin = nullptr; E.xb = (u16*)(ws + W_H); E.yout = l == 1 ? p.out : nullptr; E.rsacc = l == 0 ? (float*)(ws + W_RS) + (size_t)2 * MT : nullptr; E.yfull = p.out;
            pg8::gemm_phase(lds, 2816, S, E);
        }
#endif
        GSYNC();
    }
}

extern "C" void kernel_launch(void* const* d_in, const int* in_sizes, int n_in, void* d_out, int out_size, void* d_ws, size_t ws_size, hipStream_t stream) {
    constexpr int LDS_BYTES = 160 * 1024;
    static int grid_blocks = 0;
    if (!grid_blocks) {
        int dev = 0, cus = 0, per_cu = 0;
        hipGetDevice(&dev);
        hipDeviceGetAttribute(&cus, hipDeviceAttributeMultiprocessorCount, dev);
        hipFuncSetAttribute((const void*)mega, hipFuncAttributeMaxDynamicSharedMemorySize, LDS_BYTES);
        hipOccupancyMaxActiveBlocksPerMultiprocessor(&per_cu, (const void*)mega, 512, LDS_BYTES);
        if (per_cu < 1) per_cu = 1;
        grid_blocks = cus * per_cu;
        if (ws_size < W_END) fprintf(stderr, "kernel_launch: workspace too small: %zu < %zu\n", ws_size, (size_t)W_END);
    }
    Params p{};
    for (int i = 0; i < 38; ++i) p.in[i] = (const float*)d_in[i];
    p.out = (float*)d_out; p.ws = (unsigned char*)d_ws;
    (void)hipMemsetAsync((unsigned char*)d_ws + W_BAR, 0, 16384, stream);
    void* args[] = {&p};
    hipError_t e = hipLaunchCooperativeKernel((const void*)mega, dim3(grid_blocks), dim3(512), args, LDS_BYTES, stream);
    if (e != hipSuccess) fprintf(stderr, "cooperative launch failed: %s (grid %d)\n", hipGetErrorString(e), grid_blocks);
}
```

```cpp
#include <hip/hip_runtime.h>
#include <hip/hip_cooperative_groups.h>
#include <cstdio>
namespace cg = cooperative_groups;

#define LAS __attribute__((address_space(3)))
#define DEV __device__ __forceinline__
typedef unsigned short u16;
typedef short bf16x8 __attribute__((ext_vector_type(8)));
typedef float f32x4 __attribute__((ext_vector_type(4)));
typedef float f32x2 __attribute__((ext_vector_type(2)));
typedef unsigned u32x4 __attribute__((ext_vector_type(4)));
typedef unsigned u32x2 __attribute__((ext_vector_type(2)));

constexpr int MTP = 32768, MT = 33280;
constexpr int NINP = 8960;
constexpr int NMIX = 19;
constexpr int GATE0 = 4864;
constexpr float EPS = 1e-6f;
constexpr float LOG2E = 1.4426950408889634f;

constexpr size_t O_Y = 0, O_DKP = 34078720, O_DVP = 67633152, O_SREP = 101187584, O_SIMP = 101253120, O_GLAP = 101318656,
                 O_FCP = 102367232, O_DKS = 102727680, O_DVS = 103251968, O_SRES = 103776256, O_SIMS = 103809024, O_GLAS = 103841792,
                 O_FCS = 104366080, O_GMV = 104546304;

constexpr size_t SZ_H = (size_t)MT * 1024 * 2;
constexpr size_t SZ_HALF = (size_t)MT * 512 * 2;
constexpr size_t W_H = 0;
constexpr size_t W_P1 = W_H + SZ_H;
constexpr size_t W_P2 = W_P1 + SZ_H;
constexpr size_t W_S5 = W_P2 + SZ_H;
constexpr size_t W_GVT = W_S5 + SZ_HALF;
constexpr size_t W_CQ = W_GVT + SZ_HALF;
constexpr size_t W_CK = W_CQ + SZ_HALF / 2;
constexpr size_t W_CVT = W_CK + SZ_HALF / 2;
constexpr size_t W_CODE = W_CVT + SZ_HALF;
constexpr size_t W_DKP = W_CODE + (size_t)MT * 16 * 4;
constexpr size_t W_DKS = W_DKP + (size_t)MTP * 512 * 2;
constexpr size_t W_DVTP = W_DKS + (size_t)8 * 4160 * 512 * 2;
constexpr size_t W_DVTS = W_DVTP + (size_t)MTP * 512 * 2;
constexpr size_t W_ROWSQ = W_DVTS + (size_t)8 * 4160 * 512 * 2;
constexpr size_t W_MISC = W_ROWSQ + (size_t)MT * 4;
constexpr size_t W_WIN = W_MISC + 4096;
constexpr size_t W_WBR = W_WIN + (size_t)NINP * 1024 * 2;
constexpr size_t W_WOUT = W_WBR + (size_t)2 * 1024 * 1024 * 2;
constexpr size_t W_WGLU = W_WOUT + (size_t)1024 * 1024 * 2;
constexpr size_t W_WUP = W_WGLU + (size_t)512 * 512 * 2;
constexpr size_t W_WDN = W_WUP + (size_t)5632 * 1024 * 2;
constexpr size_t W_MFS = W_WDN + (size_t)1024 * 2816 * 2;
constexpr size_t W_BAR = W_MFS + (size_t)512 * 1024 * 4;
constexpr size_t W_WM = W_BAR + 16384;
constexpr size_t W_RS = W_WM + (size_t)4 * 128 * 128 * 2;
constexpr size_t W_END = W_RS + (size_t)4 * MT * 4;
constexpr size_t W_MERGED = W_CQ;
constexpr size_t W_SCR = W_DKP;
constexpr size_t W_ACT = W_P1;
constexpr size_t W_HEAD = W_DVTP;
constexpr size_t W_TAIL = W_HEAD + (size_t)520 * 2 * 5632 * 4;
static_assert(W_TAIL + (size_t)520 * 2 * 5632 * 4 <= W_ROWSQ, "head/tail alias");
static_assert((size_t)MT * 2816 * 2 <= W_CQ - W_P1, "act alias");

struct Params { const float* in[38]; float* out; unsigned char* ws; };
typedef const __attribute__((address_space(4))) Params CP;

DEV int tid_o() { int t = threadIdx.x; asm volatile("" : "+v"(t)); return t; }
DEV int bid_o() { int t = blockIdx.x; asm volatile("" : "+s"(t)); return t; }
DEV float bf2f(u16 v) { return __uint_as_float(((unsigned)v) << 16); }
typedef __bf16 b16x2 __attribute__((ext_vector_type(2)));
DEV unsigned pk2(float lo, float hi) { const f32x2 v = {lo, hi}; const b16x2 r = __builtin_convertvector(v, b16x2); return __builtin_bit_cast(unsigned, r); }
DEV u16 f2bf(float v) { return (u16)(pk2(v, 0.f) & 0xffffu); }
DEV float fsigmoid(float x) { return __builtin_amdgcn_rcpf(1.f + __expf(-x)); }
DEV float fsilu(float x) { return x * fsigmoid(x); }
DEV float fgelu(float x) { return x * fsigmoid(1.5957691216057308f * (x + 0.044715f * x * x * x)); }
DEV float flogsig(float x) { return fminf(x, 0.f) - __logf(1.f + __expf(-fabsf(x))); }
DEV f32x4 mfma16(bf16x8 a, bf16x8 b, f32x4 c) { return __builtin_amdgcn_mfma_f32_16x16x32_bf16(a, b, c, 0, 0, 0); }
DEV u32x2 pk4(f32x4 v) { u32x2 r; r.x = pk2(v[0], v[1]); r.y = pk2(v[2], v[3]); return r; }
DEV float red_fq(float v) { v += __shfl_xor(v, 16); v += __shfl_xor(v, 32); return v; }
DEV float wave_sum(float v) { for (int o = 32; o; o >>= 1) v += __shfl_xor(v, o); return v; }

namespace pg8 {
constexpr int BM = 256, BK = 64, HALF = 128, HTB = HALF * BK * 2, NXCD = 8, WGM = 8;
DEV int lds_byte(int r, int c) { const int st = (r >> 4) * 2 + (c >> 5), rr = r & 15, cc = c & 31, ob = rr * 64 + cc * 2; return st * 1024 + (ob ^ (((ob >> 9) & 1) << 5)); }
DEV void stage_rc(int b, int& R, int& C) { const int st = b / 1024, sb = b % 1024, swz = sb ^ (((sb >> 9) & 1) << 5); R = (st >> 1) * 16 + swz / 64; C = (st & 1) * 32 + (swz % 64) / 2; }
struct GUnit { const char* A; const char* B; int nt, pm, pn, kind; };
struct TileOrder {
    int nM, nN, nwg, G, c;
    DEV void init(int nM_, int nN_, int G_, int c_) { nM = nM_; nN = nN_; nwg = nM * nN; G = G_; c = c_; }
    DEV bool tile(int i, int& pm, int& pn) const {
        const long L = (long)i * G + c; if (L >= nwg) return false;
        int wgid = (int)L; { const int q = nwg / NXCD, r = nwg % NXCD, xcd = wgid % NXCD, off = wgid / NXCD; wgid = (xcd < r ? xcd * (q + 1) : r * (q + 1) + (xcd - r) * q) + off; }
        const int nig = WGM * nN, gid = wgid / nig, fm = gid * WGM, gsz = (nM - fm) < WGM ? (nM - fm) : WGM;
        pm = fm + ((wgid % nig) % gsz); pn = (wgid % nig) / gsz; return true;
    }
};
struct TailSched {
    TileOrder T; const char* A; const char* B; int ld, nt, npiece, ntp;
    DEV bool next(int i, GUnit& u) const { int pm, pn;
        if (T.tile(i, pm, pn)) { u.pm = pm; u.pn = pn; u.kind = 0; u.nt = nt; u.A = A + (size_t)pm * 256 * ld * 2; u.B = B + (size_t)pn * 256 * ld * 2; return true; }
        const int i0 = (T.nwg - T.c + T.G - 1) / T.G; const int j = (i - i0) * T.G + T.c; if (j >= 8 * npiece) return false;
        const int tile = j / npiece, kp = j % npiece; pm = 128 + (tile >> 2); pn = tile & 3; u.pm = pm; u.pn = pn; u.kind = 1; u.nt = ntp;
        u.A = A + (size_t)pm * 256 * ld * 2 + (size_t)kp * ntp * 128; u.B = B + (size_t)pn * 256 * ld * 2 + (size_t)kp * ntp * 128; return true; }
};
struct PlainSched {
    TileOrder T; const char* A; const char* B; int ld, nt;
    DEV bool next(int i, GUnit& u) const { int pm, pn; if (!T.tile(i, pm, pn)) return false; u.pm = pm; u.pn = pn; u.kind = 0; u.nt = nt;
        u.A = A + (size_t)pm * 256 * ld * 2; u.B = B + (size_t)pn * 256 * ld * 2; return true; }
};

template <class Epi, class Sched>
DEV void gemm_phase(LAS unsigned char* lds, const int ld, const Sched& S, const Epi& E) {
    const int tid = tid_o(), wid = __builtin_amdgcn_readfirstlane(tid >> 6), lane = tid & 63, wr = wid >> 2, wc = wid & 3, fr = lane & 15, fq = lane >> 4;
    unsigned voff[2];
#pragma unroll
    for (int i = 0; i < 2; ++i) { int R, C; stage_rc(tid * 16 + i * 8192, R, C); voff[i] = (unsigned)(R * ld + C) * 2u; }
    const size_t kstep = (size_t)(BK * 2);
    const size_t hstep = (size_t)HALF * ld * 2;
    const unsigned ldsw = (unsigned)wid * 1024u;
    const int aoff = lds_byte(wr * 64 + fr, fq * 8), boff = lds_byte(wc * 32 + fr, fq * 8);
#define PG8_SA(b, h) (((b) * 2 + (h)) * HTB)
#define PG8_SB(b, h) ((4 + (b) * 2 + (h)) * HTB)
#define PG8_STAGE(bufoff, gbase) do { _Pragma("unroll") for (int _i = 0; _i < 2; ++_i) \
        __builtin_amdgcn_global_load_lds((const unsigned*)((const char*)(gbase) + voff[_i]), (LAS unsigned*)(lds + (bufoff) + ldsw + _i * 8192), 16, 0, 0); } while (0)
#define PG8_LDA(dst, b, h) do { _Pragma("unroll") for (int m = 0; m < 4; ++m) _Pragma("unroll") for (int k = 0; k < 2; ++k) dst[m][k] = *(const LAS bf16x8*)(lds + PG8_SA(b, h) + aoff + m * 2048 + k * 1024); } while (0)
#define PG8_LDB(dst, b, h) do { _Pragma("unroll") for (int n = 0; n < 2; ++n) _Pragma("unroll") for (int k = 0; k < 2; ++k) dst[n][k] = *(const LAS bf16x8*)(lds + PG8_SB(b, h) + boff + n * 2048 + k * 1024); } while (0)
#define PG8_MMA(ai, bj, At, Bt) do { __builtin_amdgcn_s_setprio(1); _Pragma("unroll") for (int m = 0; m < 4; ++m) _Pragma("unroll") for (int n = 0; n < 2; ++n) _Pragma("unroll") for (int k = 0; k < 2; ++k) \
        acc[ai][bj][m][n] = __builtin_amdgcn_mfma_f32_16x16x32_bf16(Bt[n][k], At[m][k], acc[ai][bj][m][n], 0, 0, 0); __builtin_amdgcn_s_setprio(0); } while (0)
#define PG8_WAIT_V(n) asm volatile("s_waitcnt vmcnt(" #n ")" ::: "memory")
#define PG8_WAIT_L(n) asm volatile("s_waitcnt lgkmcnt(" #n ")" ::: "memory")
#define PG8_BAR __builtin_amdgcn_s_barrier()
#define PG8_SCHED __builtin_amdgcn_sched_barrier(0)
    GUnit cur, nxt; int ui = 0;
    if (!S.next(0, cur)) return;
    f32x4 acc[2][2][4][2];
#pragma unroll
    for (int a = 0; a < 2; ++a)
#pragma unroll
        for (int b = 0; b < 2; ++b)
#pragma unroll
            for (int m = 0; m < 4; ++m)
#pragma unroll
                for (int n = 0; n < 2; ++n) acc[a][b][m][n] = (f32x4){0.f, 0.f, 0.f, 0.f};
    bf16x8 At[4][2], B0[2][2], B1[2][2];
    const char* cA = cur.A; const char* cB = cur.B;
    PG8_STAGE(PG8_SB(0, 0), cB); PG8_STAGE(PG8_SA(0, 0), cA); PG8_STAGE(PG8_SB(0, 1), cB + hstep); PG8_STAGE(PG8_SA(0, 1), cA + hstep);
    if (wr == 1) PG8_BAR;
    PG8_WAIT_V(4); PG8_BAR;
    PG8_STAGE(PG8_SB(1, 0), cB + kstep); PG8_STAGE(PG8_SA(1, 0), cA + kstep); PG8_STAGE(PG8_SB(1, 1), cB + hstep + kstep);
    PG8_WAIT_V(6); PG8_BAR;
    for (;;) {
        const bool has_next = S.next(ui + 1, nxt);
        const char* nA = has_next ? nxt.A : cA; const char* nB = has_next ? nxt.B : cB;
        const int nt = cur.nt;
        for (int t = 0; t < nt; t += 2) {
            const bool last = (t == nt - 2);
            const char* a1 = cA + (size_t)(t + 1) * kstep;
            const char* a2 = last ? nA : cA + (size_t)(t + 2) * kstep; const char* b2 = last ? nB : cB + (size_t)(t + 2) * kstep;
            const char* a3 = a2 + kstep; const char* b3 = b2 + kstep;
            PG8_LDB(B0, 0, 0); PG8_SCHED; PG8_LDA(At, 0, 0); PG8_STAGE(PG8_SA(1, 1), a1 + hstep);
            PG8_WAIT_L(8); PG8_BAR; PG8_WAIT_L(0); PG8_MMA(0, 0, At, B0); PG8_BAR; PG8_SCHED;
            PG8_LDB(B1, 0, 1); PG8_STAGE(PG8_SB(0, 0), b2);
            PG8_BAR; PG8_WAIT_L(0); PG8_MMA(0, 1, At, B1); PG8_BAR;
            PG8_LDA(At, 0, 1); PG8_STAGE(PG8_SA(0, 0), a2);
            PG8_BAR; PG8_WAIT_L(0); PG8_MMA(1, 0, At, B0); PG8_BAR; PG8_SCHED;
            PG8_STAGE(PG8_SB(0, 1), b2 + hstep);
            PG8_WAIT_V(6); PG8_BAR; PG8_MMA(1, 1, At, B1); PG8_BAR;
            PG8_LDB(B0, 1, 0); PG8_SCHED; PG8_LDA(At, 1, 0); PG8_STAGE(PG8_SA(0, 1), a2 + hstep);
            PG8_WAIT_L(8); PG8_BAR; PG8_WAIT_L(0); PG8_MMA(0, 0, At, B0); PG8_BAR; PG8_SCHED;
            PG8_LDB(B1, 1, 1); PG8_STAGE(PG8_SB(1, 0), b3);
            PG8_BAR; PG8_WAIT_L(0); PG8_MMA(0, 1, At, B1); PG8_BAR;
            PG8_LDA(At, 1, 1); PG8_STAGE(PG8_SA(1, 0), a3);
            PG8_BAR; PG8_WAIT_L(0); PG8_MMA(1, 0, At, B0); PG8_BAR; PG8_SCHED;
            PG8_STAGE(PG8_SB(1, 1), b3 + hstep);
            PG8_WAIT_V(6); PG8_BAR; PG8_MMA(1, 1, At, B1); PG8_BAR;
        }
        { int fr_ = fr, fq_ = fq, wr_ = wr, wc_ = wc; asm volatile("" : "+v"(fr_), "+v"(fq_), "+s"(wr_), "+s"(wc_));
          E(acc, cur, wr_, wc_, fr_, fq_); }
        if (!has_next) break;
#pragma unroll
        for (int a = 0; a < 2; ++a)
#pragma unroll
            for (int b = 0; b < 2; ++b)
#pragma unroll
                for (int m = 0; m < 4; ++m)
#pragma unroll
                    for (int n = 0; n < 2; ++n) acc[a][b][m][n] = (f32x4){0.f, 0.f, 0.f, 0.f};
        cur = nxt; cA = nA; cB = nB; ++ui;
    }
    PG8_WAIT_V(0);
    if (wr == 0) PG8_BAR;
    PG8_BAR;
#undef PG8_SA
#undef PG8_SB
#undef PG8_STAGE
#undef PG8_LDA
#undef PG8_LDB
#undef PG8_MMA
#undef PG8_WAIT_V
#undef PG8_WAIT_L
#undef PG8_BAR
#undef PG8_SCHED
}
}
using pg8::GUnit;
typedef f32x4 AccT[2][2][4][2];

#define FOR_AM _Pragma("unroll") for (int ai = 0; ai < 2; ++ai) _Pragma("unroll") for (int m = 0; m < 4; ++m)
#define FOR_BN _Pragma("unroll") for (int bj = 0; bj < 2; ++bj) _Pragma("unroll") for (int n = 0; n < 2; ++n)

struct EpiIn {
    int l; float* out; unsigned char* ws; const float* qg; const float* kg; const float* rs1;
    DEV void operator()(const AccT& acc, const GUnit& u, int wr, int wc, int fr, int fq) const {
        const int pn = u.pn; const bool smp = u.pm >= 128;
        const int rowb = u.pm * 256 + wr * 64 + fr;
        const int ct0 = wc * 32 + 4 * fq;
        u16* P1 = (u16*)(ws + W_P1); u16* P2 = (u16*)(ws + W_P2);
        float rsx[2][4];
        FOR_AM rsx[ai][m] = __builtin_amdgcn_rsqf(rs1[rowb + ai * 128 + m * 16] * (1.f / 1024.f) + EPS);
        if (pn < 2) {
            FOR_AM { const int row = rowb + ai * 128 + m * 16; FOR_BN { f32x4 v = (acc[ai][bj][m][n] * rsx[ai][m]);
                for (int e = 0; e < 4; ++e) v[e] = fgelu(v[e]);
                *(u32x2*)(P1 + (size_t)row * 1024 + pn * 256 + ct0 + bj * 128 + n * 16) = pk4(v); } }
        } else if (pn < 4 || pn == 8 || pn == 9 || pn == 16 || pn == 17) {
            const int kind = pn < 4 ? 0 : (pn < 10 ? 1 : 2);
            const int cseg = (pn & 1) * 256;
            u16* dstT; int T, toff = 0;
            if (kind == 0) { dstT = (u16*)(ws + W_GVT) + (smp ? (size_t)16 * 512 * 2048 : 0); T = smp ? 64 : 2048; }
            else if (kind == 1) { dstT = (u16*)(ws + W_CVT) + (smp ? (size_t)16 * 512 * 2048 : 0); T = smp ? 64 : 2048; }
            else { dstT = (u16*)(ws + (smp ? W_DVTS : W_DVTP)); T = smp ? 4160 : 2048; toff = smp ? 4096 : 0; }
            float* rowsq = (float*)(ws + W_ROWSQ);
            FOR_AM { const int row = rowb + ai * 128 + m * 16;
                int b, t; if (smp) { const int rs = row - MTP; b = rs >> 6; t = rs & 63; } else { b = row >> 11; t = row & 2047; }
                float ss = 0.f;
                FOR_BN { f32x4 v = (acc[ai][bj][m][n] * rsx[ai][m]); const int cc = cseg + ct0 + bj * 128 + n * 16;
                    if (kind == 0) { for (int e = 0; e < 4; ++e) { v[e] = fgelu(v[e]); ss += v[e] * v[e]; } }
                    if (kind == 2) { float* o = smp ? out + O_DVS + (size_t)l * 262144 + (size_t)(row - MTP) * 512 + cc : out + O_DVP + (size_t)l * 16777216 + (size_t)row * 512 + cc;
                        *(f32x4*)o = v; }
                    for (int e = 0; e < 4; ++e) dstT[((size_t)b * 512 + cc + e) * T + toff + t] = f2bf(v[e]); }
                if (kind == 0) { ss = red_fq(ss); if (fq == 0) atomicAdd(rowsq + row, ss); } }
        } else if (pn < 6) {
            u16* S5 = (u16*)(ws + W_S5);
            FOR_AM { const int row = rowb + ai * 128 + m * 16; FOR_BN {
                *(u32x2*)(S5 + (size_t)row * 512 + (pn - 4) * 256 + ct0 + bj * 128 + n * 16) = pk4((acc[ai][bj][m][n] * rsx[ai][m])); } }
        } else if (pn < 8) {
            u16* D = (u16*)(ws + (pn == 6 ? W_CQ : W_CK)); const float sc = pn == 6 ? 0.125f : 1.f;
            FOR_AM { const int row = rowb + ai * 128 + m * 16; FOR_BN {
                *(u32x2*)(D + (size_t)row * 256 + ct0 + bj * 128 + n * 16) = pk4((acc[ai][bj][m][n] * rsx[ai][m]) * sc); } }
        } else if (pn < 12) {
            FOR_AM { const int row = rowb + ai * 128 + m * 16; FOR_BN { f32x4 v = (acc[ai][bj][m][n] * rsx[ai][m]);
                for (int e = 0; e < 4; ++e) v[e] = fsilu(v[e]);
                *(u32x2*)(P2 + (size_t)row * 1024 + (pn - 10) * 256 + ct0 + bj * 128 + n * 16) = pk4(v); } }
        } else if (pn < 16) {
            const bool isq = pn < 14; const int hh = 4 * (pn & 1) + wc; const float* g = isq ? qg : kg;
            f32x4 gv[2][2];
            FOR_BN gv[bj][n] = *(const f32x4*)(g + 32 * bj + 16 * n + 4 * fq);
            FOR_AM { const int row = rowb + ai * 128 + m * 16;
                float ss = 0.f;
                FOR_BN { const f32x4 v = (acc[ai][bj][m][n] * rsx[ai][m]); ss += v[0] * v[0] + v[1] * v[1] + v[2] * v[2] + v[3] * v[3]; }
                ss = red_fq(ss);
                float rs = __builtin_amdgcn_rsqf(ss * (1.f / 64.f) + EPS);
                if (isq) { rs *= 0.125f * LOG2E;
                    FOR_BN { *(u32x2*)(P2 + (size_t)row * 1024 + 512 + hh * 64 + 32 * bj + 16 * n + 4 * fq) = pk4((acc[ai][bj][m][n] * rsx[ai][m]) * rs * gv[bj][n]); }
                } else {
                    float* o; u16* kb;
                    if (smp) { const int rs_ = row - MTP; o = out + O_DKS + (size_t)l * 262144 + (size_t)rs_ * 512; kb = (u16*)(ws + W_DKS) + ((size_t)(rs_ >> 6) * 4160 + 4096 + (rs_ & 63)) * 512; }
                    else { o = out + O_DKP + (size_t)l * 16777216 + (size_t)row * 512; kb = (u16*)(ws + W_DKP) + (size_t)row * 512; }
                    FOR_BN { const f32x4 v = (acc[ai][bj][m][n] * rsx[ai][m]) * rs * gv[bj][n]; const int d = hh * 64 + 32 * bj + 16 * n + 4 * fq;
                        *(f32x4*)(o + d) = v; *(u32x2*)(kb + d) = pk4(v); } } }
        } else {
            if (wc == 0) { float* C = (float*)(ws + W_CODE);
                FOR_AM { const int row = rowb + ai * 128 + m * 16; *(f32x4*)(C + (size_t)row * 16 + 4 * fq) = acc[ai][0][m][0] * rsx[ai][m]; } }
        }
    }
};

struct EpiGlu {
    unsigned char* ws; const float* bias;
    DEV void operator()(const AccT& acc, const GUnit& u, int wr, int wc, int fr, int fq) const {
        const u16* Z = (const u16*)(ws + W_S5); u16* P1 = (u16*)(ws + W_P1);
        const int rowb = u.pm * 256 + wr * 64 + fr, cb = u.pn * 256 + wc * 32 + 4 * fq;
        FOR_AM { const int row = rowb + ai * 128 + m * 16; FOR_BN { const int col = cb + bj * 128 + n * 16;
            const f32x4 bv = *(const f32x4*)(bias + col); const u32x2 zz = *(const u32x2*)(Z + (size_t)row * 512 + col);
            f32x4 z; z[0] = __uint_as_float(zz.x << 16); z[1] = __uint_as_float(zz.x & 0xffff0000u); z[2] = __uint_as_float(zz.y << 16); z[3] = __uint_as_float(zz.y & 0xffff0000u);
            f32x4 v = acc[ai][bj][m][n] + bv;
            for (int e = 0; e < 4; ++e) v[e] = z[e] * fsigmoid(v[e]);
            *(u32x2*)(P1 + (size_t)row * 1024 + 512 + col) = pk4(v); } }
    }
};

struct MergeSched {
    pg8::TileOrder T; unsigned char* ws;
    DEV void fill(GUnit& u, int pm, int pn, int b, int sub) const {
        u.pm = pm; u.pn = pn;
        if (sub) { u.nt = 16; u.A = (const char*)ws + W_H + (size_t)pm * 256 * 2048; u.B = (const char*)ws + W_WIN + (size_t)(GATE0 + b * 1024 + pn * 256) * 2048; }
        else { u.nt = 8; u.A = (const char*)ws + (b < 2 ? W_P1 : W_P2) + (size_t)pm * 256 * 2048 + (b & 1) * 1024;
               u.B = (const char*)ws + W_WBR + (size_t)(b >> 1) * 1024 * 2048 + (size_t)pn * 256 * 2048 + (b & 1) * 1024; }
    }
    DEV bool next(int i, GUnit& u) const {
        int pm, pn;
        if (T.tile(i >> 3, pm, pn)) { const int s = i & 7; u.kind = s; fill(u, pm, pn, s >> 1, s & 1); return true; }
        const int i0 = (T.nwg - T.c + T.G - 1) / T.G; const int jj = i - 8 * i0; const int job = (jj >> 1) * T.G + T.c; if (job >= 32) return false;
        const int tile = job >> 2, b = job & 3; u.kind = 8 + 2 * b + (jj & 1); fill(u, 128 + (tile >> 2), tile & 3, b, jj & 1); return true;
    }
};
struct EpiMerge {
    unsigned char* ws; const float* bgate; const float* rs1;
    DEV void operator()(const AccT& acc, const GUnit& u, int wr, int wc, int fr, int fq) const {
        u32x4* sT = (u32x4*)(ws + W_SCR) + (size_t)bid_o() * 16 * 512 + tid_o();
        u32x4* sS = (u32x4*)(ws + W_SCR + (size_t)32 * 1024 * 1024) + (size_t)bid_o() * 16 * 512 + tid_o();
        const int s = u.kind & 7, b = s >> 1; const bool smp = u.kind >= 8;
        if (!(s & 1)) {
#pragma unroll
            for (int q = 0; q < 16; ++q) { const int ai = q >> 3, bj = (q >> 2) & 1, m = q & 3; const u32x2 lo = pk4(acc[ai][bj][m][0]), hi = pk4(acc[ai][bj][m][1]);
                u32x4 w; w.x = lo.x; w.y = lo.y; w.z = hi.x; w.w = hi.y; sT[q * 512] = w; }
        } else {
            u16* MG = (u16*)(ws + W_MERGED);
            const int rowb = u.pm * 256 + wr * 64 + fr, cb = u.pn * 256 + wc * 32 + 4 * fq;
            f32x4 bvv[2][2];
#pragma unroll
            for (int bj = 0; bj < 2; ++bj)
#pragma unroll
                for (int n = 0; n < 2; ++n) bvv[bj][n] = *(const f32x4*)(bgate + b * 1024 + cb + bj * 128 + n * 16);
            float rsx[2][4];
            FOR_AM rsx[ai][m] = __builtin_amdgcn_rsqf(rs1[rowb + ai * 128 + m * 16] * (1.f / 1024.f) + EPS);
#pragma unroll
            for (int q = 0; q < 16; ++q) { const int ai = q >> 3, bj = (q >> 2) & 1, m = q & 3; __builtin_amdgcn_sched_barrier(0);
                const u32x4 tw = sT[q * 512]; u32x4 sw = (u32x4){0u, 0u, 0u, 0u}; if (b > 0 && !smp) sw = sS[q * 512];
                const unsigned tws[4] = {tw.x, tw.y, tw.z, tw.w}; const unsigned sws[4] = {sw.x, sw.y, sw.z, sw.w};
                f32x4 r[2];
#pragma unroll
                for (int n = 0; n < 2; ++n) { const f32x4 bv = bvv[bj][n];
                    f32x4 v = acc[ai][bj][m][n] * rsx[ai][m] + bv;
#pragma unroll
                    for (int e = 0; e < 4; ++e) { const unsigned tt = tws[n * 2 + (e >> 1)], st = sws[n * 2 + (e >> 1)];
                        const float tv = (e & 1) ? __uint_as_float(tt & 0xffff0000u) : __uint_as_float(tt << 16);
                        const float sv = (e & 1) ? __uint_as_float(st & 0xffff0000u) : __uint_as_float(st << 16);
                        v[e] = fsigmoid(v[e]) * tv + sv; }
                    r[n] = v; }
                if (smp) { float* mf = (float*)(ws + W_MFS) + (size_t)(rowb + ai * 128 + m * 16 - MTP) * 1024 + cb + bj * 128;
#pragma unroll
                    for (int n = 0; n < 2; ++n)
#pragma unroll
                        for (int e = 0; e < 4; ++e) atomicAdd(mf + n * 16 + e, r[n][e]); }
                else if (b < 3) { const u32x2 lo = pk4(r[0]), hi = pk4(r[1]); u32x4 w; w.x = lo.x; w.y = lo.y; w.z = hi.x; w.w = hi.y; sS[q * 512] = w; }
                else { const int row = rowb + ai * 128 + m * 16;
#pragma unroll
                    for (int n = 0; n < 2; ++n) *(u32x2*)(MG + (size_t)row * 1024 + cb + bj * 128 + n * 16) = pk4(r[n]); } }
        }
    }
};

struct EpiRes {
    const float* xin;
    u16* xb;
    float* yout;
    float* rsacc;
    float* yfull;
    DEV void operator()(const AccT& acc, const GUnit& u, int wr, int wc, int fr, int fq) const {
        const int rowb = u.pm * 256 + wr * 64 + fr, cb = u.pn * 256 + wc * 32 + 4 * fq;
        if (u.kind == 1) {
            FOR_AM { const int row = rowb + ai * 128 + m * 16; FOR_BN { float* d = yfull + (size_t)row * 1024 + cb + bj * 128 + n * 16;
#pragma unroll
                for (int e = 0; e < 4; ++e) atomicAdd(d + e, acc[ai][bj][m][n][e]); } }
            return; }
        FOR_AM { const int row = rowb + ai * 128 + m * 16; float ss = 0.f;
            FOR_BN { const int col = cb + bj * 128 + n * 16; f32x4 x;
                if (xin) x = *(const f32x4*)(xin + (size_t)row * 1024 + col);
                else { const u32x2 xx = *(const u32x2*)(xb + (size_t)row * 1024 + col);
                    x[0] = __uint_as_float(xx.x << 16); x[1] = __uint_as_float(xx.x & 0xffff0000u); x[2] = __uint_as_float(xx.y << 16); x[3] = __uint_as_float(xx.y & 0xffff0000u); }
                const f32x4 v = x + acc[ai][bj][m][n];
                if (yout) *(f32x4*)(yout + (size_t)row * 1024 + col) = v; else *(u32x2*)(xb + (size_t)row * 1024 + col) = pk4(v);
                ss += v[0] * v[0] + v[1] * v[1] + v[2] * v[2] + v[3] * v[3]; }
            if (rsacc) { ss = red_fq(ss); if (fq == 0) atomicAdd(rsacc + row, ss); } }
    }
};

DEV float dpp_prev1(float cur, float prevm) {
    const int o = __builtin_amdgcn_update_dpp(0, __float_as_int(prevm), 0x121, 0xf, 0xf, false);
    return __int_as_float(__builtin_amdgcn_update_dpp(o, __float_as_int(cur), 0x111, 0xf, 0xf, false));
}
DEV float dpp_prev2(float cur, float prevm) {
    const int o = __builtin_amdgcn_update_dpp(0, __float_as_int(prevm), 0x122, 0xf, 0xf, false);
    return __int_as_float(__builtin_amdgcn_update_dpp(o, __float_as_int(cur), 0x112, 0xf, 0xf, false));
}
struct EpiUp {
    unsigned char* ws; const float* cw; const float* cbias; const float* rs2;
    DEV void operator()(const AccT& acc, const GUnit& u, int wr, int wc, int fr, int fq) const {
        u16* ACT = (u16*)(ws + W_ACT); float* HEAD = (float*)(ws + W_HEAD); float* TAIL = (float*)(ws + W_TAIL);
        float rsx[2][4];
        FOR_AM rsx[ai][m] = __builtin_amdgcn_rsqf(rs2[u.pm * 256 + wr * 64 + fr + ai * 128 + m * 16] * (1.f / 1024.f) + EPS);
        const int f0 = u.pn * 128 + wc * 32 + 4 * fq;
#pragma unroll
        for (int n = 0; n < 2; ++n) { const int f = f0 + n * 16;
            f32x4 w0[2], w1[2], w2[2], bb[2];
#pragma unroll
            for (int bj = 0; bj < 2; ++bj) { const int ff = bj * 2816 + f; w0[bj] = *(const f32x4*)(cw + ff); w1[bj] = *(const f32x4*)(cw + 5632 + ff); w2[bj] = *(const f32x4*)(cw + 11264 + ff); bb[bj] = *(const f32x4*)(cbias + ff); }
#pragma unroll
            for (int ai = 0; ai < 2; ++ai) {
                const int slab = u.pm * 4 + ai * 2 + wr;
#pragma unroll
                for (int m = 0; m < 4; ++m) {
                    f32x4 c[2];
#pragma unroll
                    for (int bj = 0; bj < 2; ++bj) { const f32x4 cur = acc[ai][bj][m][n] * rsx[ai][m]; const f32x4 pm_ = acc[ai][bj][m ? m - 1 : 0][n] * rsx[ai][m ? m - 1 : 0];
#pragma unroll
                        for (int e = 0; e < 4; ++e) { const float p1 = dpp_prev1(cur[e], pm_[e]), p2 = dpp_prev2(cur[e], pm_[e]);
                            c[bj][e] = bb[bj][e] + w2[bj][e] * cur[e] + w1[bj][e] * p1 + w0[bj][e] * p2; } }
                    if (m > 0 || fr >= 2) { f32x4 a; for (int e = 0; e < 4; ++e) a[e] = fsilu(c[0][e]) * c[1][e];
                        *(u32x2*)(ACT + (size_t)(slab * 64 + m * 16 + fr) * 2816 + f) = pk4(a); }
                    if (m == 0 && fr < 2) { for (int bj = 0; bj < 2; ++bj) *(f32x4*)(HEAD + ((size_t)slab * 2 + fr) * 5632 + bj * 2816 + f) = acc[ai][bj][0][n] * rsx[ai][0]; }
                    if (m == 3 && fr >= 14) { for (int bj = 0; bj < 2; ++bj) *(f32x4*)(TAIL + ((size_t)slab * 2 + fr - 14) * 5632 + bj * 2816 + f) = acc[ai][bj][3][n] * rsx[ai][3]; }
                } } }
    }
};

template <int MAP> DEV int src_col(int j) {
    if (MAP == 0) return j;
    if (MAP == 1) {
        const int tile = j >> 8, tc = j & 255;
        if (tile < 10) return j;
        if (tile < 12) return j + 16;
        if (tile < 16) { const int perm = ((tc >> 5) & 3) * 64 + (tc >> 7) * 32 + (tc & 31); return (tile < 14 ? 3088 : 3600) + (tile & 1) * 256 + perm; }
        if (tile < 18) return j + 16;
        if (tile == 18) return tc < 16 ? 2560 + tc : -1;
        return 4624 + (j - GATE0);
    }
    { const int q = j >> 8, tc = j & 255; return tc < 128 ? 128 * q + tc : 2816 + 128 * q + (tc - 128); }
}
template <int MAP> DEV void conv_T(u16* dst, int dst_ld, int K, int Nd, const float* src, int src_ld, int gt, int GT, const float* gain = nullptr) {
    const int total = Nd * (K >> 3);
    for (int idx = gt; idx < total; idx += GT) { const int j = idx % Nd, kb = idx / Nd; const int sc = src_col<MAP>(j);
        float v[8];
#pragma unroll
        for (int i = 0; i < 8; ++i) v[i] = sc >= 0 ? src[(size_t)(kb * 8 + i) * src_ld + sc] : 0.f;
        if (gain) {
#pragma unroll
            for (int i = 0; i < 8; ++i) v[i] *= gain[kb * 8 + i]; }
        u32x4 w; w.x = pk2(v[0], v[1]); w.y = pk2(v[2], v[3]); w.z = pk2(v[4], v[5]); w.w = pk2(v[6], v[7]);
        *(u32x4*)(dst + (size_t)j * dst_ld + kb * 8) = w; }
}
DEV void raw_rows(const float* xp, const float* xs, int r0, int r1, u16* XB, float* RS) {
    const int tid = tid_o(); const int lane = tid & 63; const int gw = bid_o() * 8 + (tid >> 6), GW = gridDim.x * 8;
    for (int row = r0 + gw; row < r1; row += GW) {
        const float* src = row < MTP ? xp + (size_t)row * 1024 : xs + (size_t)(row - MTP) * 1024;
        f32x4 v[4]; float ss = 0.f;
#pragma unroll
        for (int i = 0; i < 4; ++i) { v[i] = *(const f32x4*)(src + (lane + 64 * i) * 4); ss += v[i][0] * v[i][0] + v[i][1] * v[i][1] + v[i][2] * v[i][2] + v[i][3] * v[i][3]; }
        ss = wave_sum(ss); if (lane == 0) RS[row] = ss;
#pragma unroll
        for (int i = 0; i < 4; ++i) *(u32x2*)(XB + (size_t)row * 1024 + (lane + 64 * i) * 4) = pk4(v[i]);
    }
}

DEV void phaseA(CP& p, int l) {
    unsigned char* ws = p.ws;
    const int gt = bid_o() * 512 + tid_o(), GT = gridDim.x * 512;
    conv_T<1>((u16*)(ws + W_WIN), 1024, 1024, NINP, p.in[9] + (size_t)l * 1024 * 8720, 8720, gt, GT, p.in[8] + l * 1024);
    for (int b = 0; b < 4; ++b) conv_T<0>((u16*)(ws + W_WBR) + (size_t)(b >> 1) * 1024 * 1024 + (b & 1) * 512, 1024, 512, 1024, p.in[31] + (size_t)(l * 4 + b) * 512 * 1024, 1024, gt, GT);
    conv_T<0>((u16*)(ws + W_WOUT), 1024, 1024, 1024, p.in[32] + (size_t)l * 1024 * 1024, 1024, gt, GT);
    conv_T<0>((u16*)(ws + W_WGLU), 512, 512, 512, p.in[22] + (size_t)l * 512 * 512, 512, gt, GT);
    conv_T<2>((u16*)(ws + W_WUP), 1024, 1024, 5632, p.in[34] + (size_t)l * 1024 * 5632, 5632, gt, GT, p.in[33] + l * 1024);
    conv_T<0>((u16*)(ws + W_WDN), 2816, 2816, 1024, p.in[37] + (size_t)l * 2816 * 1024, 1024, gt, GT);
    for (int b = 0; b < 8; ++b) conv_T<0>((u16*)(ws + W_DVTS) + (size_t)b * 512 * 4160, 4160, 4096, 512, p.in[3] + ((size_t)(l * 8 + b) * 4096) * 512, 512, gt, GT);
    {
        const float* ck = p.in[2] + (size_t)l * 8 * 4096 * 512; u16* dk = (u16*)(ws + W_DKS);
        for (int idx = gt; idx < 8 * 4096 * 64; idx += GT) { const int b = idx >> 18, rem = idx & 262143, key = rem >> 6, c8 = (rem & 63) * 8;
            const f32x4 a = *(const f32x4*)(ck + ((size_t)(b * 4096 + key)) * 512 + c8), c = *(const f32x4*)(ck + ((size_t)(b * 4096 + key)) * 512 + c8 + 4);
            u32x4 w; w.x = pk2(a[0], a[1]); w.y = pk2(a[2], a[3]); w.z = pk2(c[0], c[1]); w.w = pk2(c[2], c[3]);
            *(u32x4*)(dk + ((size_t)b * 4160 + key) * 512 + c8) = w; }
    }
    { float* rq = (float*)(ws + W_ROWSQ); for (int i = gt; i < MT; i += GT) rq[i] = 0.f; }
    { const float* wsp = p.in[12] + (size_t)l * 4 * 128 * 128; u16* wm = (u16*)(ws + W_WM); for (int i = gt; i < 4 * 128 * 128; i += GT) { const int t = (i >> 7) & 127, s2 = i & 127; wm[i] = f2bf(s2 <= t ? wsp[i] : 0.f); } }
    { f32x4* mf = (f32x4*)(ws + W_MFS); for (int i = gt; i < 512 * 256; i += GT) mf[i] = (f32x4){0.f, 0.f, 0.f, 0.f}; }
    if (l == 0) { const f32x4* xs = (const f32x4*)p.in[1]; f32x4* xo = (f32x4*)(p.out + (size_t)MTP * 1024); for (int i = gt; i < 512 * 256; i += GT) xo[i] = xs[i]; }
    if (gt == 0) {
        unsigned* misc = (unsigned*)(ws + W_MISC); misc[l] = 0u;
        const float* dl = p.in[29] + l * 256; float s1 = 0.f, s2 = 0.f;
        for (int i = 0; i < 64; ++i) { s1 += dl[i] * dl[64 + i]; s2 += dl[128 + i] * dl[192 + i]; }
        const float lam_init = 0.8f - 0.6f * expf(-0.3f * (float)l);
        ((float*)misc)[8 + 2 * l] = expf(s1) - expf(s2) + lam_init; ((float*)misc)[9 + 2 * l] = lam_init;
        float mq = 0.f, mk = 0.f; for (int i = 0; i < 64; ++i) { mq = fmaxf(mq, fabsf(p.in[27][l * 64 + i])); mk = fmaxf(mk, fabsf(p.in[28][l * 64 + i])); }
        ((float*)misc)[16 + l] = 64.f * mq * mk * 0.125f * LOG2E;
    }
    { float* RS = (float*)(ws + W_RS);
      for (int i = gt; i < MT; i += GT) { RS[(size_t)(l * 2 + 1) * MT + i] = 0.f; if (l == 0) RS[(size_t)2 * MT + i] = 0.f; }
      if (l == 0) raw_rows(p.in[0], p.in[1], 0, MT, (u16*)(ws + W_H), RS);
      else raw_rows(nullptr, p.out + (size_t)MTP * 1024, MTP, MT, (u16*)(ws + W_H), RS + (size_t)2 * MT); }
}

DEV void attn_item(CP& p, int l, LAS unsigned char* lds, int grp, int b, int h, int qp) {
    unsigned char* ws = p.ws;
    const int tid = tid_o(), w = tid >> 6, lane = tid & 63, fr = lane & 15, fq = lane >> 4, c = w >> 2, qs = w & 3;
    const int Tk = grp ? 4160 : 2048, nkv = grp ? 65 : 2 * qp + 2;
    const int nact = grp ? (qs < 2 ? 65 : 0) : (qs < 2 ? nkv - 1 : nkv);
    const int rowbase = grp ? MTP + b * 64 : b * 2048 + qp * 128;
    const u16* Kb = grp ? (const u16*)(ws + W_DKS) + (size_t)b * 4160 * 512 : (const u16*)(ws + W_DKP) + (size_t)b * 2048 * 512;
    const u16* Vb = grp ? (const u16*)(ws + W_DVTS) + ((size_t)b * 512 + h * 128) * 4160 : (const u16*)(ws + W_DVTP) + ((size_t)b * 512 + h * 128) * 2048;
    u16* P2 = (u16*)(ws + W_P2);
    bf16x8 qf[2][2];
    if (nact > 0) {
#pragma unroll
        for (int r = 0; r < 2; ++r)
#pragma unroll
            for (int kk = 0; kk < 2; ++kk) qf[r][kk] = *(const bf16x8*)(P2 + (size_t)(rowbase + 32 * qs + 16 * r + fr) * 1024 + 512 + h * 128 + c * 64 + kk * 32 + fq * 8);
    } else {
#pragma unroll
        for (int r = 0; r < 2; ++r)
#pragma unroll
            for (int kk = 0; kk < 2; ++kk) qf[r][kk] = (bf16x8){0, 0, 0, 0, 0, 0, 0, 0};
    }
    constexpr int STG = 36864;
    int gK[2], lK[2], gV[2], lV[2];
#pragma unroll
    for (int i = 0; i < 2; ++i) { const int ch = tid + 512 * i; const int key = ch >> 4, part = ch & 15; gK[i] = key * 512 + h * 128 + part * 8; lK[i] = (((part >> 3) * 64 + key) * 72 + (part & 7) * 8) * 2;
        const int v = ch >> 3, kp = (ch & 7) * 8; gV[i] = v * Tk + kp; lV[i] = (128 * 72 + v * 72 + kp) * 2; }
    u32x4 rk[2], rv[2];
#pragma unroll
    for (int i = 0; i < 2; ++i) { rk[i] = *(const u32x4*)(Kb + gK[i]); rv[i] = *(const u32x4*)(Vb + gV[i]); }
#pragma unroll
    for (int i = 0; i < 2; ++i) { *(LAS u32x4*)(lds + lK[i]) = rk[i]; *(LAS u32x4*)(lds + lV[i]) = rv[i]; }
    __syncthreads();
    f32x4 O[2][8];
#pragma unroll
    for (int r = 0; r < 2; ++r)
#pragma unroll
        for (int i = 0; i < 8; ++i) O[r][i] = (f32x4){0.f, 0.f, 0.f, 0.f};
    const bool fixedref = ((const float*)(ws + W_MISC))[16 + l] < 40.f;
    float mrun[2] = {-1e30f, -1e30f}, lrun[2] = {0.f, 0.f};
    for (int kt = 0; kt < nkv; ++kt) {
        const bool more = kt + 1 < nkv;
        if (more) { const size_t k0 = (size_t)(kt + 1) * 64;
#pragma unroll
            for (int i = 0; i < 2; ++i) { rk[i] = *(const u32x4*)(Kb + k0 * 512 + gK[i]); rv[i] = *(const u32x4*)(Vb + k0 + gV[i]); } }
        if (kt < nact) {
            LAS unsigned char* st = lds + (kt & 1) * STG;
            f32x4 s[2][4];
#pragma unroll
            for (int jt = 0; jt < 4; ++jt) { s[0][jt] = (f32x4){0.f, 0.f, 0.f, 0.f}; s[1][jt] = (f32x4){0.f, 0.f, 0.f, 0.f};
#pragma unroll
                for (int kk = 0; kk < 2; ++kk) { const bf16x8 kf = *(const LAS bf16x8*)(st + ((c * 64 + 16 * jt + fr) * 72 + kk * 32 + fq * 8) * 2);
                    s[0][jt] = mfma16(kf, qf[0][kk], s[0][jt]); s[1][jt] = mfma16(kf, qf[1][kk], s[1][jt]); } }
            bf16x8 pf[2][2];
#pragma unroll
            for (int r = 0; r < 2; ++r) {
                float ps = 0.f;
                if (fixedref) {
#pragma unroll
                    for (int jt = 0; jt < 4; ++jt)
#pragma unroll
                        for (int e = 0; e < 4; ++e) { s[r][jt][e] = __builtin_amdgcn_exp2f(s[r][jt][e]); ps += s[r][jt][e]; }
                    lrun[r] += ps;
                } else {
                    float mt = s[r][0][0];
#pragma unroll
                    for (int jt = 0; jt < 4; ++jt)
#pragma unroll
                        for (int e = 0; e < 4; ++e) mt = fmaxf(mt, s[r][jt][e]);
                    mt = fmaxf(mt, __shfl_xor(mt, 16)); mt = fmaxf(mt, __shfl_xor(mt, 32));
                    const float mnew = fmaxf(mrun[r], mt), alpha = __builtin_amdgcn_exp2f(mrun[r] - mnew); mrun[r] = mnew;
#pragma unroll
                    for (int jt = 0; jt < 4; ++jt)
#pragma unroll
                        for (int e = 0; e < 4; ++e) { s[r][jt][e] = __builtin_amdgcn_exp2f(s[r][jt][e] - mnew); ps += s[r][jt][e]; }
                    lrun[r] = lrun[r] * alpha + ps;
#pragma unroll
                    for (int i = 0; i < 8; ++i) O[r][i] *= alpha;
                }
#pragma unroll
                for (int t = 0; t < 2; ++t) { const u32x2 lo = pk4(s[r][2 * t]), hi = pk4(s[r][2 * t + 1]); u32x4 wv; wv.x = lo.x; wv.y = lo.y; wv.z = hi.x; wv.w = hi.y; pf[r][t] = __builtin_bit_cast(bf16x8, wv); }
            }
#pragma unroll
            for (int vt = 0; vt < 8; ++vt)
#pragma unroll
                for (int t = 0; t < 2; ++t) { const LAS unsigned char* vp = st + (128 * 72 + (16 * vt + fr) * 72 + 32 * t + 4 * fq) * 2;
                    const u32x2 a = *(const LAS u32x2*)vp, bq = *(const LAS u32x2*)(vp + 32); u32x4 wv; wv.x = a.x; wv.y = a.y; wv.z = bq.x; wv.w = bq.y;
                    const bf16x8 vf = __builtin_bit_cast(bf16x8, wv);
                    O[0][vt] = mfma16(vf, pf[0][t], O[0][vt]); O[1][vt] = mfma16(vf, pf[1][t], O[1][vt]); }
        }
        if (more) { LAS unsigned char* nx = lds + ((kt + 1) & 1) * STG;
#pragma unroll
            for (int i = 0; i < 2; ++i) { *(LAS u32x4*)(nx + lK[i]) = rk[i]; *(LAS u32x4*)(nx + lV[i]) = rv[i]; } }
        __syncthreads();
    }
    const float lam = ((const float*)(ws + W_MISC))[8 + 2 * l], lam_init = ((const float*)(ws + W_MISC))[9 + 2 * l];
    LAS float* X = (LAS float*)lds;
    float inv[2];
#pragma unroll
    for (int r = 0; r < 2; ++r) inv[r] = __builtin_amdgcn_rcpf(fmaxf(red_fq(lrun[r]), 1e-30f));
    if (c == 1) {
#pragma unroll
        for (int r = 0; r < 2; ++r)
#pragma unroll
            for (int vt = 0; vt < 8; ++vt)
#pragma unroll
                for (int e = 0; e < 4; ++e) X[(qs * 64 + r * 32 + vt * 4 + e) * 64 + lane] = O[r][vt][e] * inv[r] * lam;
    }
    __syncthreads();
    if (c == 0 && nact > 0) {
        const float* g = p.in[30] + l * 128;
#pragma unroll
        for (int r = 0; r < 2; ++r) { float ss = 0.f;
#pragma unroll
            for (int vt = 0; vt < 8; ++vt)
#pragma unroll
                for (int e = 0; e < 4; ++e) { const float d = O[r][vt][e] * inv[r] - X[(qs * 64 + r * 32 + vt * 4 + e) * 64 + lane]; O[r][vt][e] = d; ss += d * d; }
            ss = red_fq(ss); const float rs = __builtin_amdgcn_rsqf(ss * (1.f / 128.f) + EPS) * (1.f - lam_init);
#pragma unroll
            for (int vt = 0; vt < 8; ++vt) { const f32x4 gv = *(const f32x4*)(g + 16 * vt + 4 * fq);
                *(u32x2*)(P2 + (size_t)(rowbase + 32 * qs + 16 * r + fr) * 1024 + 512 + h * 128 + 16 * vt + 4 * fq) = pk4(O[r][vt] * rs * gv); } }
    }
    __syncthreads();
}

DEV void gla_item(CP& p, int l, LAS unsigned char* lds, int grp, int b, int h) {
    unsigned char* ws = p.ws;
    const int tid = tid_o(), w = tid >> 6, lane = tid & 63, fr = lane & 15, fq = lane >> 4;
    const int T = grp ? 64 : 2048, nch = grp ? 1 : 32; const int rowbase = grp ? MTP + b * 64 : b * 2048;
    const u16* CQ = (const u16*)(ws + W_CQ); const u16* CK = (const u16*)(ws + W_CK); const float* CODE = (const float*)(ws + W_CODE);
    const u16* VT = (const u16*)(ws + W_CVT) + (grp ? (size_t)16 * 512 * 2048 : 0) + ((size_t)b * 512 + h * 128) * T;
    u16* P2 = (u16*)(ws + W_P2);
    LAS u16* QE = (LAS u16*)lds; LAS u16* KE = QE + 64 * 72; LAS u16* KDT = KE + 64 * 72; LAS u16* VTl = KDT + 64 * 72;
    LAS u16* PP = VTl + 128 * 72; LAS u16* STb = PP + 64 * 72;
    LAS float* OT = (LAS float*)(STb + 8 * 16 * 72); LAS float* SEG = OT + 64 * 132; LAS float* DEC = SEG + 8 * 64;
    LAS u16* QR = (LAS u16*)(DEC + 64); LAS u16* KR = QR + 64 * 72; LAS float* CD = (LAS float*)(KR + 64 * 72);
    const int d_ = tid & 63, seg = tid >> 6;
    float wa[16];
#pragma unroll
    for (int r = 0; r < 16; ++r) wa[r] = p.in[24][(size_t)l * 16 * 256 + r * 256 + h * 64 + d_];
    const float ba = p.in[25][l * 256 + h * 64 + d_];
    f32x4 S[4];
    if (grp) { const float* s0 = p.in[6] + ((size_t)(l * 8 + b) * 4 + h) * 64 * 128;
#pragma unroll
        for (int dt = 0; dt < 4; ++dt) S[dt] = *(const f32x4*)(s0 + (size_t)(16 * dt + fr) * 128 + 16 * w + 4 * fq); }
    else {
#pragma unroll
        for (int dt = 0; dt < 4; ++dt) S[dt] = (f32x4){0.f, 0.f, 0.f, 0.f}; }
#pragma unroll
    for (int dt = 0; dt < 4; ++dt)
#pragma unroll
        for (int e = 0; e < 4; ++e) STb[(w * 16 + 4 * fq + e) * 72 + 16 * dt + fr] = f2bf(S[dt][e]);
    const float* gng = p.in[26] + l * 128;
    const int tl = tid >> 3, d8 = (tid & 7) * 8;
    u32x4 rq, rkk, rvv[2]; f32x2 rcd;
    {
        rq = *(const u32x4*)(CQ + (size_t)(rowbase + tl) * 256 + h * 64 + d8); rkk = *(const u32x4*)(CK + (size_t)(rowbase + tl) * 256 + h * 64 + d8);
        rcd = *(const f32x2*)(CODE + (size_t)(rowbase + tl) * 16 + (tid & 7) * 2);
#pragma unroll
        for (int i = 0; i < 2; ++i) { const int chn = tid + 512 * i, v = chn >> 3, kp = (chn & 7) * 8; rvv[i] = *(const u32x4*)(VT + (size_t)v * T + kp); }
    }
    for (int ch = 0; ch < nch; ++ch) {
        const int r0 = rowbase + ch * 64;
        *(LAS u32x4*)(QR + tl * 72 + d8) = rq; *(LAS u32x4*)(KR + tl * 72 + d8) = rkk; *(LAS f32x2*)(CD + tl * 16 + (tid & 7) * 2) = rcd;
#pragma unroll
        for (int i = 0; i < 2; ++i) { const int chn = tid + 512 * i, v = chn >> 3, kp = (chn & 7) * 8; *(LAS u32x4*)(VTl + v * 72 + kp) = rvv[i]; }
        if (ch + 1 < nch) { const int r1 = r0 + 64;
            rq = *(const u32x4*)(CQ + (size_t)(r1 + tl) * 256 + h * 64 + d8); rkk = *(const u32x4*)(CK + (size_t)(r1 + tl) * 256 + h * 64 + d8);
            rcd = *(const f32x2*)(CODE + (size_t)(r1 + tl) * 16 + (tid & 7) * 2);
#pragma unroll
            for (int i = 0; i < 2; ++i) { const int chn = tid + 512 * i, v = chn >> 3, kp = (chn & 7) * 8; rvv[i] = *(const u32x4*)(VT + (size_t)v * T + (ch + 1) * 64 + kp); } }
        u16* yp = P2 + (size_t)(r0 + tl) * 1024 + h * 128 + (tid & 7) * 16;
        const u32x4 rr0 = *(const u32x4*)yp, rr1 = *(const u32x4*)(yp + 8);
        __syncthreads();
        float bl[8]; float run = 0.f;
#pragma unroll
        for (int i = 0; i < 8; ++i) { const LAS float* cp = CD + (seg * 8 + i) * 16; float a = ba;
#pragma unroll
            for (int r = 0; r < 16; ++r) a += cp[r] * wa[r];
            run += flogsig(a) * (1.f / 16.f); bl[i] = run; }
        SEG[seg * 64 + d_] = run;
        __syncthreads();
        float off = 0.f, tot = 0.f;
#pragma unroll
        for (int s2 = 0; s2 < 8; ++s2) { const float x = SEG[s2 * 64 + d_]; tot += x; if (s2 < seg) off += x; }
        if (seg == 0) DEC[d_] = __expf(tot);
        { float kd[8];
#pragma unroll
          for (int i = 0; i < 8; ++i) { const int t = seg * 8 + i; const float bb = bl[i] + off;
              const float q = bf2f(QR[t * 72 + d_]), k = bf2f(KR[t * 72 + d_]);
              QE[t * 72 + d_] = f2bf(q * __expf(bb)); KE[t * 72 + d_] = f2bf(k * __expf(-bb)); kd[i] = k * __expf(tot - bb); }
          u32x4 wv; wv.x = pk2(kd[0], kd[1]); wv.y = pk2(kd[2], kd[3]); wv.z = pk2(kd[4], kd[5]); wv.w = pk2(kd[6], kd[7]);
          *(LAS u32x4*)(KDT + d_ * 72 + seg * 8) = wv; }
        __syncthreads();
#pragma unroll
        for (int r = 0; r < 2; ++r) { const int ti = w + 8 * r, jt = ti >> 2, it = ti & 3; f32x4 a = (f32x4){0.f, 0.f, 0.f, 0.f};
            if (jt <= it) {
#pragma unroll
                for (int kk = 0; kk < 2; ++kk) { const bf16x8 kf = *(const LAS bf16x8*)(KE + (16 * jt + fr) * 72 + kk * 32 + fq * 8), qf = *(const LAS bf16x8*)(QE + (16 * it + fr) * 72 + kk * 32 + fq * 8); a = mfma16(kf, qf, a); }
#pragma unroll
                for (int e = 0; e < 4; ++e) if (16 * jt + 4 * fq + e > 16 * it + fr) a[e] = 0.f;
            }
            *(LAS u32x2*)(PP + (16 * it + fr) * 72 + 16 * jt + 4 * fq) = pk4(a); }
        __syncthreads();
        bf16x8 vf[2], sf[2];
#pragma unroll
        for (int t = 0; t < 2; ++t) { vf[t] = *(const LAS bf16x8*)(VTl + (16 * w + fr) * 72 + 32 * t + 8 * fq); sf[t] = *(const LAS bf16x8*)(STb + (w * 16 + fr) * 72 + 32 * t + 8 * fq); }
#pragma unroll
        for (int it = 0; it < 4; ++it) { f32x4 a = (f32x4){0.f, 0.f, 0.f, 0.f};
#pragma unroll
            for (int t = 0; t < 2; ++t) { const bf16x8 pf = *(const LAS bf16x8*)(PP + (16 * it + fr) * 72 + 32 * t + 8 * fq), qf = *(const LAS bf16x8*)(QE + (16 * it + fr) * 72 + 32 * t + 8 * fq);
                a = mfma16(vf[t], pf, a); a = mfma16(sf[t], qf, a); }
            *(LAS f32x4*)(OT + (16 * it + fr) * 132 + 16 * w + 4 * fq) = a; }
#pragma unroll
        for (int dt = 0; dt < 4; ++dt) { S[dt] *= DEC[16 * dt + fr];
#pragma unroll
            for (int t = 0; t < 2; ++t) { const bf16x8 kf = *(const LAS bf16x8*)(KDT + (16 * dt + fr) * 72 + 32 * t + 8 * fq); S[dt] = mfma16(vf[t], kf, S[dt]); }
#pragma unroll
            for (int e = 0; e < 4; ++e) STb[(w * 16 + 4 * fq + e) * 72 + 16 * dt + fr] = f2bf(S[dt][e]); }
        __syncthreads();
        {
            const int i = tid >> 3, vs = tid & 7; f32x4 o[4]; float ss = 0.f;
#pragma unroll
            for (int k = 0; k < 4; ++k) { o[k] = *(const LAS f32x4*)(OT + i * 132 + vs * 16 + 4 * k); ss += o[k][0] * o[k][0] + o[k][1] * o[k][1] + o[k][2] * o[k][2] + o[k][3] * o[k][3]; }
            ss += __shfl_xor(ss, 1); ss += __shfl_xor(ss, 2); ss += __shfl_xor(ss, 4);
            const float rs = __builtin_amdgcn_rsqf(ss * (1.f / 128.f) + EPS);
            const unsigned rw[8] = {rr0.x, rr0.y, rr0.z, rr0.w, rr1.x, rr1.y, rr1.z, rr1.w};
#pragma unroll
            for (int k = 0; k < 4; ++k) { const f32x4 gv = *(const f32x4*)(gng + vs * 16 + 4 * k);
                f32x4 r; r[0] = __uint_as_float(rw[2 * k] << 16); r[1] = __uint_as_float(rw[2 * k] & 0xffff0000u); r[2] = __uint_as_float(rw[2 * k + 1] << 16); r[3] = __uint_as_float(rw[2 * k + 1] & 0xffff0000u);
                *(u32x2*)(yp + 4 * k) = pk4(o[k] * rs * gv * r); }
        }
    }
    float* so = p.out + (grp ? O_GLAS + (size_t)l * 262144 + ((size_t)b * 4 + h) * 8192 : O_GLAP + (size_t)l * 524288 + ((size_t)b * 4 + h) * 8192);
#pragma unroll
    for (int dt = 0; dt < 4; ++dt) *(f32x4*)(so + (size_t)(16 * dt + fr) * 128 + 16 * w + 4 * fq) = S[dt];
    __syncthreads();
}

DEV void s5_item(CP& p, int l, LAS unsigned char* lds, int grp, int b, int gq) {
    unsigned char* ws = p.ws;
    const int tid = tid_o(), w = tid >> 6, lane = tid & 63, fr = lane & 15, fq = lane >> 4;
    const int g = gq * 8 + w; const int T = grp ? 64 : 2048; const int rowbase = grp ? MTP + b * 64 : b * 2048;
    u16* X = (u16*)(ws + W_S5);
    LAS u16* HT = (LAS u16*)lds + w * 32 * 136;
    const float dt = __expf(p.in[16][l * 32 + g]);
    bf16x8 breF[4], bimF[4]; float ar[4], ai[4], a8r[4], a8i[4];
#pragma unroll
    for (int pt = 0; pt < 4; ++pt) { const int pp = 16 * pt + fr; const size_t gp = (size_t)(l * 32 + g) * 64 + pp;
        const float lr = p.in[14][gp], li = p.in[15][gp];
        const float mag = __expf(lr * dt), ang = li * dt * 0.15915494309189535f;
        const float r_ = mag * __builtin_amdgcn_cosf(ang), i_ = mag * __builtin_amdgcn_sinf(ang);
        ar[pt] = r_; ai[pt] = i_;
        float xr = r_, xi = i_;
#pragma unroll
        for (int k = 0; k < 3; ++k) { const float nr2 = xr * xr - xi * xi, ni2 = 2.f * xr * xi; xr = nr2; xi = ni2; }
        a8r[pt] = xr; a8i[pt] = xi;
        const float den = lr * lr + li * li, nr = r_ - 1.f, ni = i_;
        const float kr = (nr * lr + ni * li) / den, ki = (ni * lr - nr * li) / den;
        float vr[8], vi[8];
#pragma unroll
        for (int j = 0; j < 8; ++j) { float br = 0.f, bi = 0.f; if (fq < 2) { br = p.in[17][gp * 16 + fq * 8 + j]; bi = p.in[18][gp * 16 + fq * 8 + j]; }
            vr[j] = kr * br - ki * bi; vi[j] = kr * bi + ki * br; }
        u32x4 wr_, wi_; wr_.x = pk2(vr[0], vr[1]); wr_.y = pk2(vr[2], vr[3]); wr_.z = pk2(vr[4], vr[5]); wr_.w = pk2(vr[6], vr[7]);
        wi_.x = pk2(vi[0], vi[1]); wi_.y = pk2(vi[2], vi[3]); wi_.z = pk2(vi[4], vi[5]); wi_.w = pk2(vi[6], vi[7]);
        breF[pt] = __builtin_bit_cast(bf16x8, wr_); bimF[pt] = __builtin_bit_cast(bf16x8, wi_); }
    bf16x8 cF[4];
#pragma unroll
    for (int ks = 0; ks < 4; ++ks) { float v[8]; const int k0 = 32 * ks + 8 * fq;
#pragma unroll
        for (int j = 0; j < 8; ++j) { const int k = k0 + j; v[j] = k < 64 ? p.in[19][((size_t)(l * 32 + g) * 16 + fr) * 64 + k] : -p.in[20][((size_t)(l * 32 + g) * 16 + fr) * 64 + k - 64]; }
        u32x4 wv; wv.x = pk2(v[0], v[1]); wv.y = pk2(v[2], v[3]); wv.z = pk2(v[4], v[5]); wv.w = pk2(v[6], v[7]); cF[ks] = __builtin_bit_cast(bf16x8, wv); }
    const f32x4 dsk = *(const f32x4*)(p.in[21] + l * 512 + g * 16 + 4 * fq);
    float Hr[4], Hi[4];
#pragma unroll
    for (int pt = 0; pt < 4; ++pt) { if (grp) { const size_t sp = ((size_t)(l * 8 + b) * 32 + g) * 64 + 16 * pt + fr; Hr[pt] = p.in[4][sp]; Hi[pt] = p.in[5][sp]; } else { Hr[pt] = 0.f; Hi[pt] = 0.f; } }
    const int trow = 8 * (fr >> 2) + (fr & 3);
    u32x4 xn[2];
#pragma unroll
    for (int tt = 0; tt < 2; ++tt) { xn[tt] = (u32x4){0u, 0u, 0u, 0u}; if (fq < 2) xn[tt] = *(const u32x4*)(X + (size_t)(rowbase + trow + 4 * tt) * 512 + g * 16 + fq * 8); }
    for (int ch = 0; ch < T / 32; ++ch) {
        const int r0 = rowbase + ch * 32;
        bf16x8 xF[2];
#pragma unroll
        for (int tt = 0; tt < 2; ++tt) xF[tt] = __builtin_bit_cast(bf16x8, xn[tt]);
        if (ch + 1 < T / 32) {
#pragma unroll
            for (int tt = 0; tt < 2; ++tt) if (fq < 2) xn[tt] = *(const u32x4*)(X + (size_t)(r0 + 32 + trow + 4 * tt) * 512 + g * 16 + fq * 8); }
        u32x2 xsk[2];
#pragma unroll
        for (int t2 = 0; t2 < 2; ++t2) xsk[t2] = *(const u32x2*)(X + (size_t)(r0 + 16 * t2 + fr) * 512 + g * 16 + 4 * fq);
        f32x4 bur[2][4], bui[2][4];
#pragma unroll
        for (int tt = 0; tt < 2; ++tt)
#pragma unroll
            for (int pt = 0; pt < 4; ++pt) { bur[tt][pt] = mfma16(xF[tt], breF[pt], (f32x4){0.f, 0.f, 0.f, 0.f}); bui[tt][pt] = mfma16(xF[tt], bimF[pt], (f32x4){0.f, 0.f, 0.f, 0.f}); }
#pragma unroll
        for (int pt = 0; pt < 4; ++pt) {
            float er = 0.f, ei = 0.f;
#pragma unroll
            for (int k = 0; k < 8; ++k) { const float ur = bur[k >> 2][pt][k & 3], ui = bui[k >> 2][pt][k & 3]; const float nr = ar[pt] * er - ai[pt] * ei + ur, ni = ar[pt] * ei + ai[pt] * er + ui; er = nr; ei = ni; }
            float cr = Hr[pt], ci = Hi[pt], mr = cr, mi = ci;
#pragma unroll
            for (int q = 0; q < 4; ++q) { const float Er = __shfl(er, fr + 16 * q), Ei = __shfl(ei, fr + 16 * q);
                const float nr = a8r[pt] * cr - a8i[pt] * ci + Er, ni = a8r[pt] * ci + a8i[pt] * cr + Ei; cr = nr; ci = ni;
                if (q + 1 == fq) { mr = cr; mi = ci; } }
            Hr[pt] = cr; Hi[pt] = ci;
            float hr = mr, hi = mi;
#pragma unroll
            for (int k = 0; k < 8; ++k) { const float ur = bur[k >> 2][pt][k & 3], ui = bui[k >> 2][pt][k & 3]; const float nr = ar[pt] * hr - ai[pt] * hi + ur, ni = ar[pt] * hi + ai[pt] * hr + ui; hr = nr; hi = ni;
                HT[(8 * fq + k) * 136 + 16 * pt + fr] = f2bf(hr); HT[(8 * fq + k) * 136 + 64 + 16 * pt + fr] = f2bf(hi); }
        }
        asm volatile("s_waitcnt lgkmcnt(0)" ::: "memory");
        f32x4 y[2];
#pragma unroll
        for (int t2 = 0; t2 < 2; ++t2) { y[t2] = (f32x4){0.f, 0.f, 0.f, 0.f};
#pragma unroll
            for (int ks = 0; ks < 4; ++ks) { const bf16x8 hf = *(const LAS bf16x8*)(HT + (16 * t2 + fr) * 136 + 32 * ks + 8 * fq); y[t2] = mfma16(cF[ks], hf, y[t2]); } }
#pragma unroll
        for (int t2 = 0; t2 < 2; ++t2) { u16* xp = X + (size_t)(r0 + 16 * t2 + fr) * 512 + g * 16 + 4 * fq; const u32x2 xx = xsk[t2];
            f32x4 xv; xv[0] = __uint_as_float(xx.x << 16); xv[1] = __uint_as_float(xx.x & 0xffff0000u); xv[2] = __uint_as_float(xx.y << 16); xv[3] = __uint_as_float(xx.y & 0xffff0000u);
            f32x4 z = y[t2] + dsk * xv;
#pragma unroll
            for (int e = 0; e < 4; ++e) z[e] = fgelu(z[e]);
            *(u32x2*)xp = pk4(z); }
        asm volatile("" ::: "memory");
    }
    if (fq == 0) { float* ore = p.out + (grp ? O_SRES + (size_t)l * 16384 + ((size_t)b * 32 + g) * 64 : O_SREP + (size_t)l * 32768 + ((size_t)b * 32 + g) * 64);
        float* oim = p.out + (grp ? O_SIMS + (size_t)l * 16384 + ((size_t)b * 32 + g) * 64 : O_SIMP + (size_t)l * 32768 + ((size_t)b * 32 + g) * 64);
#pragma unroll
        for (int pt = 0; pt < 4; ++pt) { ore[16 * pt + fr] = Hr[pt]; oim[16 * pt + fr] = Hi[pt]; } }
    __syncthreads();
}

DEV void gmlp_item(CP& p, int l, LAS unsigned char* lds, int grp, int b, int n, int g) {
    unsigned char* ws = p.ws;
    const int tid = tid_o(), w = tid >> 6, lane = tid & 63, fr = lane & 15, fq = lane >> 4;
    const int L = grp ? 64 : 128, T = grp ? 64 : 2048; const int rowbase = grp ? MTP + b * 64 : b * 2048 + n * 128;
    LAS u16* WT = (LAS u16*)lds; LAS u16* GT = WT + 128 * 136; LAS float* RS = (LAS float*)(GT + 128 * 136);
    const float* rowsq = (const float*)(ws + W_ROWSQ);
    if (tid < L) RS[tid] = __builtin_amdgcn_rsqf(rowsq[rowbase + tid] * (1.f / 512.f) + EPS);
    const u16* GV = (const u16*)(ws + W_GVT) + (grp ? (size_t)16 * 512 * 2048 : 0) + ((size_t)b * 512 + g * 128) * T + (grp ? 0 : n * 128);
    const u16* WM = (const u16*)(ws + W_WM) + (size_t)g * 128 * 128;
    const int cshift = grp ? 3 : 4, nchunk = 128 << cshift, nwch = L << cshift;
    u16* P1 = (u16*)(ws + W_P1);
    u32x4 gq[4], wq[4];
#pragma unroll
    for (int i = 0; i < 4; ++i) { const int chn = tid + 512 * i; const int cg_ = chn < nchunk ? chn : 0, cw_ = chn < nwch ? chn : 0;
        gq[i] = *(const u32x4*)(GV + (size_t)(cg_ >> cshift) * T + (cg_ & ((1 << cshift) - 1)) * 8);
        wq[i] = *(const u32x4*)(WM + (size_t)(cw_ >> cshift) * 128 + (cw_ & ((1 << cshift) - 1)) * 8); }
    u32x2 uq[8]; float bq[8];
    const int ntt = L >> 4;
#pragma unroll
    for (int tt = 0; tt < 8; ++tt) { const int t = tt < ntt ? 16 * tt + fr : fr; uq[tt] = *(const u32x2*)(P1 + (size_t)(rowbase + t) * 1024 + g * 128 + 16 * w + 4 * fq); bq[tt] = p.in[13][(size_t)(l * 4 + g) * 128 + t]; }
    const f32x4 gvg = *(const f32x4*)(p.in[11] + l * 512 + g * 128 + 16 * w + 4 * fq);
    __syncthreads();
#pragma unroll
    for (int i = 0; i < 4; ++i) { const int chn = tid + 512 * i;
        if (chn < nchunk) { const int c = chn >> cshift, kp = (chn & ((1 << cshift) - 1)) * 8; const unsigned gw[4] = {gq[i].x, gq[i].y, gq[i].z, gq[i].w}; u32x4 o;
            unsigned ow[4];
#pragma unroll
            for (int k = 0; k < 4; ++k) ow[k] = pk2(__uint_as_float(gw[k] << 16) * RS[kp + 2 * k], __uint_as_float(gw[k] & 0xffff0000u) * RS[kp + 2 * k + 1]);
            o.x = ow[0]; o.y = ow[1]; o.z = ow[2]; o.w = ow[3]; *(LAS u32x4*)(GT + c * 136 + kp) = o; }
        if (chn < nwch) { const int t = chn >> cshift, kp = (chn & ((1 << cshift) - 1)) * 8; *(LAS u32x4*)(WT + t * 136 + kp) = wq[i]; } }
    __syncthreads();
#pragma unroll
    for (int tt = 0; tt < 8; ++tt) { if (tt < ntt) { f32x4 a = (f32x4){0.f, 0.f, 0.f, 0.f};
        for (int ks = 0; ks < L / 32; ++ks) { if (32 * ks > 16 * tt + 15) break;
            const bf16x8 gf = *(const LAS bf16x8*)(GT + (16 * w + fr) * 136 + 32 * ks + 8 * fq), wf = *(const LAS bf16x8*)(WT + (16 * tt + fr) * 136 + 32 * ks + 8 * fq); a = mfma16(gf, wf, a); }
        const int t = 16 * tt + fr;
        f32x4 u; u[0] = __uint_as_float(uq[tt].x << 16); u[1] = __uint_as_float(uq[tt].x & 0xffff0000u); u[2] = __uint_as_float(uq[tt].y << 16); u[3] = __uint_as_float(uq[tt].y & 0xffff0000u);
        *(u32x2*)(P1 + (size_t)(rowbase + t) * 1024 + g * 128 + 16 * w + 4 * fq) = pk4(u * (a * gvg + bq[tt])); } }
    if (grp) {
        float* o = p.out + O_GMV + (size_t)l * 262144 + (size_t)b * 64 * 512; const float* gg = p.in[11] + l * 512 + g * 128;
        for (int idx = tid; idx < 64 * 128; idx += 512) { const int t = idx >> 7, c = idx & 127; o[(size_t)t * 512 + g * 128 + c] = bf2f(GT[c * 136 + t]) * gg[c]; }
    }
    __syncthreads();
}

DEV void phaseMix(CP& p, int l, LAS unsigned char* lds) {
    unsigned* ctr = (unsigned*)(p.ws + W_MISC) + l;
    LAS int* slot = (LAS int*)(lds + 160 * 1024 - 16);
    for (;;) {
        if (tid_o() == 0) *slot = (int)atomicAdd(ctr, 1u);
        __syncthreads();
        int it = __builtin_amdgcn_readfirstlane(*slot);
        __syncthreads();
        if (it >= 2304) break;
        int kind, grp = 0, a0, a1, a2 = 0;
        if (it < 64) { kind = 0; a0 = it >> 2; a1 = it & 3; }
        else if (it < 128) { it -= 64; kind = 1; a0 = it >> 2; a1 = it & 3; }
        else if (it < 160) { it -= 128; kind = 2; grp = 1; a0 = it >> 2; a1 = it & 3; }
        else if (it < 1184) { it -= 160; kind = 2; a2 = 15 - (it >> 6); a0 = (it & 63) >> 2; a1 = it & 3; }
        else if (it < 2208) { it -= 1184; kind = 3; a0 = it >> 6; a2 = (it >> 2) & 15; a1 = it & 3; }
        else if (it < 2240) { it -= 2208; kind = 0; grp = 1; a0 = it >> 2; a1 = it & 3; }
        else if (it < 2272) { it -= 2240; kind = 1; grp = 1; a0 = it >> 2; a1 = it & 3; }
        else { it -= 2272; kind = 3; grp = 1; a0 = it >> 2; a1 = it & 3; }
        asm volatile("" : "+s"(kind), "+s"(grp), "+s"(a0), "+s"(a1), "+s"(a2));
        if (kind == 0) {
#ifndef NO_S5
            s5_item(p, l, lds, grp, a0, a1);
#endif
        } else if (kind == 1) {
#ifndef NO_GLA
#ifdef GLA_SAMPLE_ONLY
            if (grp)
#endif
            gla_item(p, l, lds, grp, a0, a1);
#endif
        } else if (kind == 2) {
#ifndef NO_ATT
            attn_item(p, l, lds, grp, a0, a1, a2);
#endif
        } else {
#ifndef NO_GMLP
            gmlp_item(p, l, lds, grp, a0, a2, a1);
#endif
        }
    }
}

DEV void phaseFix(CP& p, int l) {
    unsigned char* ws = p.ws; const int gt = bid_o() * 512 + tid_o(), GT = gridDim.x * 512;
    const float* HEAD = (const float*)(ws + W_HEAD); const float* TAIL = (const float*)(ws + W_TAIL); u16* ACT = (u16*)(ws + W_ACT);
    const float* cw = p.in[35] + (size_t)l * 3 * 5632; const float* cb = p.in[36] + (size_t)l * 5632;
    for (int idx = gt; idx < 520 * 2816; idx += GT) { const int slab = idx / 2816, f = idx % 2816;
        float c0[2], c1[2];
#pragma unroll
        for (int bj = 0; bj < 2; ++bj) { const int ff = bj * 2816 + f; float pm2 = 0.f, pm1 = 0.f;
            if (slab >= 512) { const float* st = p.in[7] + ((size_t)(l * 8 + (slab - 512)) * 2) * 5632; pm2 = st[ff]; pm1 = st[5632 + ff]; }
            else if (slab & 31) { pm2 = TAIL[((size_t)(slab - 1) * 2) * 5632 + ff]; pm1 = TAIL[((size_t)(slab - 1) * 2 + 1) * 5632 + ff]; }
            const float h0 = HEAD[((size_t)slab * 2) * 5632 + ff], h1 = HEAD[((size_t)slab * 2 + 1) * 5632 + ff];
            const float w0 = cw[ff], w1 = cw[5632 + ff], w2 = cw[11264 + ff], bb = cb[ff];
            c0[bj] = bb + w0 * pm2 + w1 * pm1 + w2 * h0; c1[bj] = bb + w0 * pm1 + w1 * h0 + w2 * h1; }
        ACT[(size_t)(slab * 64) * 2816 + f] = f2bf(fsilu(c0[0]) * c0[1]); ACT[(size_t)(slab * 64 + 1) * 2816 + f] = f2bf(fsilu(c1[0]) * c1[1]); }
    for (int idx = gt; idx < 24 * 2 * 5632; idx += GT) { const int bb = idx / 11264, rem = idx % 11264;
        if (bb < 16) p.out[O_FCP + (size_t)l * 180224 + (size_t)bb * 11264 + rem] = TAIL[((size_t)(bb * 32 + 31) * 2) * 5632 + rem];
        else p.out[O_FCS + (size_t)l * 90112 + (size_t)(bb - 16) * 11264 + rem] = TAIL[((size_t)(512 + bb - 16) * 2) * 5632 + rem]; }
}

#define XB_TMO      128
#define XB_XCNT(j)  (256  + 64 * (j))
#define XB_XSUB(j)  (1280 + 64 * (j))
#define XB_XGEN(j)  (2304 + 64 * (j))
#define XB_TOP      3328
#define XB_TOPGEN   3392
#define XCD_BAR_WORDS 3456
#define XB_SPIN_CAP (1u << 18)

__device__ __forceinline__ unsigned xb_ld(unsigned* p)              { return __hip_atomic_load(p, __ATOMIC_RELAXED, __HIP_MEMORY_SCOPE_AGENT); }
__device__ __forceinline__ unsigned xb_add(unsigned* p, unsigned v) { return __hip_atomic_fetch_add(p, v, __ATOMIC_RELAXED, __HIP_MEMORY_SCOPE_AGENT); }
__device__ __forceinline__ unsigned xb_xcc_id() { return (unsigned)__builtin_amdgcn_s_getreg((3 << 11) | 20) & 0xFu; }
#define XB_SPIN(cond, bar) do { unsigned _sp = 0; while (cond) { __builtin_amdgcn_s_sleep(1); \
    if ((++_sp & 255u) == 0u) { if (xb_ld(&(bar)[XB_TMO])) break; if (_sp > XB_SPIN_CAP) { atomicAdd(&(bar)[XB_TMO], 1u); break; } } } } while (0)

struct XcdBarrier {
    unsigned* bar; unsigned x;
    volatile LAS unsigned* st;
};

__device__ __forceinline__ XcdBarrier xcd_barrier_post(unsigned* bar, volatile LAS unsigned* st) {
    XcdBarrier b; b.bar = bar; b.x = xb_xcc_id(); b.st = st;
    if (threadIdx.x == 0) (void)xb_add(&bar[XB_XCNT(b.x)], 1u);
    return b;
}
__device__ __forceinline__ void xcd_barrier_complete(unsigned* bar, unsigned x, unsigned& nloc, unsigned& nx) {
    const unsigned G = gridDim.x * gridDim.y * gridDim.z;
    unsigned sum, cnt, mine, sp = 0u;
    for (;;) {
        sum = 0u; cnt = 0u; mine = 0u;
#pragma unroll
        for (unsigned j = 0; j < 16; ++j) { const unsigned c = xb_ld(&bar[XB_XCNT(j)]); sum += c; cnt += (c > 0u) ? 1u : 0u; mine = (j == x) ? c : mine; }
        if (sum == G) break;
        __builtin_amdgcn_s_sleep(1);
        if ((++sp & 255u) == 0u) { if (xb_ld(&bar[XB_TMO])) break; if (sp > XB_SPIN_CAP) { atomicAdd(&bar[XB_TMO], 1u); break; } }
    }
    nloc = mine > 0u ? mine : 1u; nx = cnt > 0u ? cnt : 1u;
}

__device__ __forceinline__ void xcd_barrier(const XcdBarrier& b) {
    asm volatile("s_waitcnt vmcnt(0)" ::: "memory");
    __syncthreads();
    if (threadIdx.x == 0) {
        unsigned* bar = b.bar;
        __builtin_amdgcn_s_waitcnt(0);
        unsigned nloc = b.st[0], nx = b.st[1];
        if (nloc == 0u) { xcd_barrier_complete(bar, b.x, nloc, nx); b.st[0] = nloc; b.st[1] = nx; }
        const unsigned old = xb_add(&bar[XB_XSUB(b.x)], 1u);
        const unsigned gen = old / nloc;
        if (old + 1u == (gen + 1u) * nloc) {
            __builtin_amdgcn_fence(__ATOMIC_RELEASE, "agent");
            asm volatile("s_waitcnt vmcnt(0)" ::: "memory");
            const unsigned og = xb_add(&bar[XB_TOP], 1u);
            const unsigned tg = og / nx;
            if (og + 1u == (tg + 1u) * nx) xb_add(&bar[XB_TOPGEN], 1u);
            else XB_SPIN(xb_ld(&bar[XB_TOPGEN]) == tg, bar);
            __builtin_amdgcn_fence(__ATOMIC_ACQUIRE, "agent");
            xb_add(&bar[XB_XGEN(b.x)], 1u);
            asm volatile("s_waitcnt vmcnt(0)" ::: "memory");
        } else {
            XB_SPIN(xb_ld(&bar[XB_XGEN(b.x)]) == gen, bar);
            __builtin_amdgcn_fence(__ATOMIC_ACQUIRE, "agent");
            asm volatile("s_waitcnt vmcnt(0)" ::: "memory");
        }
    }
    __syncthreads();
}


__global__ void __launch_bounds__(512, 2) mega(Params p_unused) {
    extern __shared__ __attribute__((aligned(16))) unsigned char smem[];
    LAS unsigned char* lds = (LAS unsigned char*)smem;
    cg::grid_group grid = cg::this_grid();
    volatile LAS unsigned* xb_st = (volatile LAS unsigned*)(lds + 160 * 1024 - 32);
    if (threadIdx.x == 0) { xb_st[0] = 0u; xb_st[1] = 0u; }
    __syncthreads();
    const XcdBarrier xbar = xcd_barrier_post((unsigned*)(((CP*)__builtin_amdgcn_kernarg_segment_ptr())->ws + W_BAR), xb_st);
#define GSYNC() xcd_barrier(xbar)
#pragma unroll 1
    for (int l = 0; l < 2; ++l) {
        CP* pp = (CP*)__builtin_amdgcn_kernarg_segment_ptr(); asm volatile("" : "+s"(pp)); CP& p = *pp; unsigned char* ws = p.ws; const int G = gridDim.x, c = bid_o();
#ifndef SKIP_A
        phaseA(p, l);
#endif
        if (l == 0) grid.sync(); else GSYNC();
#ifndef SKIP_B
        {
            pg8::PlainSched S; S.T.init(130, NMIX, G, c); S.A = (const char*)ws + W_H; S.B = (const char*)ws + W_WIN; S.ld = 1024; S.nt = 16;
            EpiIn E; E.l = l; E.out = p.out; E.ws = ws; E.qg = p.in[27] + l * 64; E.kg = p.in[28] + l * 64; E.rs1 = (const float*)(ws + W_RS) + (size_t)(l * 2) * MT;
            pg8::gemm_phase(lds, 1024, S, E);
        }
#endif
        GSYNC();
#ifndef SKIP_C
        phaseMix(p, l, lds);
#endif
        GSYNC();
#ifndef SKIP_D
        {
            pg8::PlainSched S; S.T.init(130, 2, G, c); S.A = (const char*)ws + W_S5; S.B = (const char*)ws + W_WGLU; S.ld = 512; S.nt = 8;
            EpiGlu E; E.ws = ws; E.bias = p.in[23] + l * 512;
            pg8::gemm_phase(lds, 512, S, E);
        }
#endif
        GSYNC();
#ifndef SKIP_E
        {
            MergeSched S; S.T.init(128, 4, G, c); S.ws = ws;
            EpiMerge E; E.ws = ws; E.bgate = p.in[10] + l * 4096; E.rs1 = (const float*)(ws + W_RS) + (size_t)(l * 2) * MT;
            pg8::gemm_phase(lds, 1024, S, E);
        }
#endif
        GSYNC();
        {
            const f32x4* mf = (const f32x4*)(ws + W_MFS); u16* mg = (u16*)(ws + W_MERGED) + (size_t)MTP * 1024;
            for (int i = c * 512 + tid_o(); i < 512 * 256; i += G * 512) *(u32x2*)(mg + (size_t)i * 4) = pk4(mf[i]);
        }
        GSYNC();
#ifndef SKIP_F
        {
            pg8::TailSched S; S.T.init(128, 4, G, c); S.A = (const char*)ws + W_MERGED; S.B = (const char*)ws + W_WOUT; S.ld = 1024; S.nt = 16; S.npiece = 4; S.ntp = 4;
            EpiRes E; E.xin = l == 0 ? p.in[0] : nullptr; E.xb = (u16*)(ws + W_H); E.yout = nullptr; E.rsacc = (float*)(ws + W_RS) + (size_t)(l * 2 + 1) * MT; E.yfull = p.out;
            pg8::gemm_phase(lds, 1024, S, E);
        }
#endif
        GSYNC();
#ifndef SKIP_G
        raw_rows(nullptr, p.out + (size_t)MTP * 1024, MTP, MT, (u16*)(ws + W_H), (float*)(ws + W_RS) + (size_t)(l * 2 + 1) * MT);
#endif
        GSYNC();
#ifndef SKIP_H
        {
            pg8::PlainSched S; S.T.init(130, 22, G, c); S.A = (const char*)ws + W_H; S.B = (const char*)ws + W_WUP; S.ld = 1024; S.nt = 16;
            EpiUp E; E.ws = ws; E.cw = p.in[35] + (size_t)l * 3 * 5632; E.cbias = p.in[36] + (size_t)l * 5632; E.rs2 = (const float*)(ws + W_RS) + (size_t)(l * 2 + 1) * MT;
            pg8::gemm_phase(lds, 1024, S, E);
        }
#endif
        GSYNC();
#ifndef SKIP_I
        phaseFix(p, l);
#endif
        GSYNC();
#ifndef SKIP_J
        {
            pg8::TailSched S; S.T.init(128, 4, G, c); S.A = (const char*)ws + W_ACT; S.B = (const char*)ws + W_WDN; S.ld = 2816; S.nt = 44; S.npiece = 11; S.ntp = 4;
            EpiRes E; E.xin = nullptr; E.xb = (u16*)(ws + W_H); E.yout = l == 1 ? p.out : nullptr; E.rsacc = l == 0 ? (float*)(ws + W_RS) + (size_t)2 * MT : nullptr; E.yfull = p.out;
            pg8::gemm_phase(lds, 2816, S, E);
        }
#endif
        GSYNC();
    }
}

extern "C" void kernel_launch(void* const* d_in, const int* in_sizes, int n_in, void* d_out, int out_size, void* d_ws, size_t ws_size, hipStream_t stream) {
    constexpr int LDS_BYTES = 160 * 1024;
    static int grid_blocks = 0;
    if (!grid_blocks) {
        int dev = 0, cus = 0, per_cu = 0;
        hipGetDevice(&dev);
        hipDeviceGetAttribute(&cus, hipDeviceAttributeMultiprocessorCount, dev);
        hipFuncSetAttribute((const void*)mega, hipFuncAttributeMaxDynamicSharedMemorySize, LDS_BYTES);
        hipOccupancyMaxActiveBlocksPerMultiprocessor(&per_cu, (const void*)mega, 512, LDS_BYTES);
        if (per_cu < 1) per_cu = 1;
        grid_blocks = cus * per_cu;
        if (ws_size < W_END) fprintf(stderr, "kernel_launch: workspace too small: %zu < %zu\n", ws_size, (size_t)W_END);
    }
    Params p{};
    for (int i = 0; i < 38; ++i) p.in[i] = (const float*)d_in[i];
    p.out = (float*)d_out; p.ws = (unsigned char*)d_ws;
    (void)hipMemsetAsync((unsigned char*)d_ws + W_BAR, 0, 16384, stream);
    void* args[] = {&p};
    hipError_t e = hipLaunchCooperativeKernel((const void*)mega, dim3(grid_blocks), dim3(512), args, LDS_BYTES, stream);
    if (e != hipSuccess) fprintf(stderr, "cooperative launch failed: %s (grid %d)\n", hipGetErrorString(e), grid_blocks);
}
```

```cpp
#include <hip/hip_runtime.h>
#include <hip/hip_cooperative_groups.h>
#include <cstdio>
namespace cg = cooperative_groups;

#define LAS __attribute__((address_space(3)))
#define DEV __device__ __forceinline__
typedef unsigned short u16;
typedef short bf16x8 __attribute__((ext_vector_type(8)));
typedef float f32x4 __attribute__((ext_vector_type(4)));
typedef float f32x2 __attribute__((ext_vector_type(2)));
typedef unsigned u32x4 __attribute__((ext_vector_type(4)));
typedef unsigned u32x2 __attribute__((ext_vector_type(2)));

constexpr int MTP = 32768, MT = 33280;
constexpr int NINP = 8960;
constexpr int NMIX = 19;
constexpr int GATE0 = 4864;
constexpr float EPS = 1e-6f;
constexpr float LOG2E = 1.4426950408889634f;

constexpr size_t O_Y = 0, O_DKP = 34078720, O_DVP = 67633152, O_SREP = 101187584, O_SIMP = 101253120, O_GLAP = 101318656,
                 O_FCP = 102367232, O_DKS = 102727680, O_DVS = 103251968, O_SRES = 103776256, O_SIMS = 103809024, O_GLAS = 103841792,
                 O_FCS = 104366080, O_GMV = 104546304;

constexpr size_t SZ_H = (size_t)MT * 1024 * 2;
constexpr size_t SZ_HALF = (size_t)MT * 512 * 2;
constexpr size_t W_H = 0;
constexpr size_t W_P1 = W_H + SZ_H;
constexpr size_t W_P2 = W_P1 + SZ_H;
constexpr size_t W_S5 = W_P2 + SZ_H;
constexpr size_t W_GVT = W_S5 + SZ_HALF;
constexpr size_t W_CQ = W_GVT + SZ_HALF;
constexpr size_t W_CK = W_CQ + SZ_HALF / 2;
constexpr size_t W_CVT = W_CK + SZ_HALF / 2;
constexpr size_t W_CODE = W_CVT + SZ_HALF;
constexpr size_t W_DKP = W_CODE + (size_t)MT * 16 * 4;
constexpr size_t W_DKS = W_DKP + (size_t)MTP * 512 * 2;
constexpr size_t W_DVTP = W_DKS + (size_t)8 * 4160 * 512 * 2;
constexpr size_t W_DVTS = W_DVTP + (size_t)MTP * 512 * 2;
constexpr size_t W_ROWSQ = W_DVTS + (size_t)8 * 4160 * 512 * 2;
constexpr size_t W_MISC = W_ROWSQ + (size_t)MT * 4;
constexpr size_t W_WIN = W_MISC + 4096;
constexpr size_t W_WBR = W_WIN + (size_t)NINP * 1024 * 2;
constexpr size_t W_WOUT = W_WBR + (size_t)2 * 1024 * 1024 * 2;
constexpr size_t W_WGLU = W_WOUT + (size_t)1024 * 1024 * 2;
constexpr size_t W_WUP = W_WGLU + (size_t)512 * 512 * 2;
constexpr size_t W_WDN = W_WUP + (size_t)5632 * 1024 * 2;
constexpr size_t W_MFS = W_WDN + (size_t)1024 * 2816 * 2;
constexpr size_t W_BAR = W_MFS + (size_t)512 * 1024 * 4;
constexpr size_t W_WM = W_BAR + 16384;
constexpr size_t W_RS = W_WM + (size_t)4 * 128 * 128 * 2;
constexpr size_t W_PART = W_RS + (size_t)4 * MT * 4;
constexpr size_t W_END = W_PART + (size_t)11 * 512 * 1024 * 4;
constexpr size_t W_MERGED = W_CQ;
constexpr size_t W_SCR = W_DKP;
constexpr size_t W_ACT = W_P1;
constexpr size_t W_HEAD = W_DVTP;
constexpr size_t W_TAIL = W_HEAD + (size_t)520 * 2 * 5632 * 4;
static_assert(W_TAIL + (size_t)520 * 2 * 5632 * 4 <= W_ROWSQ, "head/tail alias");
static_assert((size_t)MT * 2816 * 2 <= W_CQ - W_P1, "act alias");

struct Params { const float* in[38]; float* out; unsigned char* ws; };
typedef const __attribute__((address_space(4))) Params CP;

DEV int tid_o() { int t = threadIdx.x; asm volatile("" : "+v"(t)); return t; }
DEV int bid_o() { int t = blockIdx.x; asm volatile("" : "+s"(t)); return t; }
DEV float bf2f(u16 v) { return __uint_as_float(((unsigned)v) << 16); }
typedef __bf16 b16x2 __attribute__((ext_vector_type(2)));
DEV unsigned pk2(float lo, float hi) { const f32x2 v = {lo, hi}; const b16x2 r = __builtin_convertvector(v, b16x2); return __builtin_bit_cast(unsigned, r); }
DEV u16 f2bf(float v) { return (u16)(pk2(v, 0.f) & 0xffffu); }
DEV float fsigmoid(float x) { return __builtin_amdgcn_rcpf(1.f + __expf(-x)); }
DEV float fsilu(float x) { return x * fsigmoid(x); }
DEV float fgelu(float x) { return x * fsigmoid(1.5957691216057308f * (x + 0.044715f * x * x * x)); }
DEV float flogsig(float x) { return fminf(x, 0.f) - __logf(1.f + __expf(-fabsf(x))); }
DEV f32x4 mfma16(bf16x8 a, bf16x8 b, f32x4 c) { return __builtin_amdgcn_mfma_f32_16x16x32_bf16(a, b, c, 0, 0, 0); }
DEV u32x2 pk4(f32x4 v) { u32x2 r; r.x = pk2(v[0], v[1]); r.y = pk2(v[2], v[3]); return r; }
DEV float red_fq(float v) { v += __shfl_xor(v, 16); v += __shfl_xor(v, 32); return v; }
DEV float wave_sum(float v) { for (int o = 32; o; o >>= 1) v += __shfl_xor(v, o); return v; }

namespace pg8 {
constexpr int BM = 256, BK = 64, HALF = 128, HTB = HALF * BK * 2, NXCD = 8, WGM = 8;
DEV int lds_byte(int r, int c) { const int st = (r >> 4) * 2 + (c >> 5), rr = r & 15, cc = c & 31, ob = rr * 64 + cc * 2; return st * 1024 + (ob ^ (((ob >> 9) & 1) << 5)); }
DEV void stage_rc(int b, int& R, int& C) { const int st = b / 1024, sb = b % 1024, swz = sb ^ (((sb >> 9) & 1) << 5); R = (st >> 1) * 16 + swz / 64; C = (st & 1) * 32 + (swz % 64) / 2; }
struct GUnit { const char* A; const char* B; int nt, pm, pn, kind; };
struct TileOrder {
    int nM, nN, nwg, G, c;
    DEV void init(int nM_, int nN_, int G_, int c_) { nM = nM_; nN = nN_; nwg = nM * nN; G = G_; c = c_; }
    DEV bool tile(int i, int& pm, int& pn) const {
        const long L = (long)i * G + c; if (L >= nwg) return false;
        int wgid = (int)L; { const int q = nwg / NXCD, r = nwg % NXCD, xcd = wgid % NXCD, off = wgid / NXCD; wgid = (xcd < r ? xcd * (q + 1) : r * (q + 1) + (xcd - r) * q) + off; }
        const int nig = WGM * nN, gid = wgid / nig, fm = gid * WGM, gsz = (nM - fm) < WGM ? (nM - fm) : WGM;
        pm = fm + ((wgid % nig) % gsz); pn = (wgid % nig) / gsz; return true;
    }
};
struct TailSched {
    TileOrder T; const char* A; const char* B; int ld, nt, npiece, ntp;
    DEV bool next(int i, GUnit& u) const { int pm, pn;
        if (T.tile(i, pm, pn)) { u.pm = pm; u.pn = pn; u.kind = 0; u.nt = nt; u.A = A + (size_t)pm * 256 * ld * 2; u.B = B + (size_t)pn * 256 * ld * 2; return true; }
        const int i0 = (T.nwg - T.c + T.G - 1) / T.G; const int j = (i - i0) * T.G + T.c; if (j >= 8 * npiece) return false;
        const int tile = j / npiece, kp = j % npiece; pm = 128 + (tile >> 2); pn = tile & 3; u.pm = pm; u.pn = pn; u.kind = 1 + kp; u.nt = ntp;
        u.A = A + (size_t)pm * 256 * ld * 2 + (size_t)kp * ntp * 128; u.B = B + (size_t)pn * 256 * ld * 2 + (size_t)kp * ntp * 128; return true; }
};
struct PlainSched {
    TileOrder T; const char* A; const char* B; int ld, nt;
    DEV bool next(int i, GUnit& u) const { int pm, pn; if (!T.tile(i, pm, pn)) return false; u.pm = pm; u.pn = pn; u.kind = 0; u.nt = nt;
        u.A = A + (size_t)pm * 256 * ld * 2; u.B = B + (size_t)pn * 256 * ld * 2; return true; }
};

template <class Epi, class Sched>
DEV void gemm_phase(LAS unsigned char* lds, const int ld, const Sched& S, const Epi& E) {
    const int tid = tid_o(), wid = __builtin_amdgcn_readfirstlane(tid >> 6), lane = tid & 63, wr = wid >> 2, wc = wid & 3, fr = lane & 15, fq = lane >> 4;
    unsigned voff[2];
#pragma unroll
    for (int i = 0; i < 2; ++i) { int R, C; stage_rc(tid * 16 + i * 8192, R, C); voff[i] = (unsigned)(R * ld + C) * 2u; }
    const size_t kstep = (size_t)(BK * 2);
    const size_t hstep = (size_t)HALF * ld * 2;
    const unsigned ldsw = (unsigned)wid * 1024u;
    const int aoff = lds_byte(wr * 64 + fr, fq * 8), boff = lds_byte(wc * 32 + fr, fq * 8);
#define PG8_SA(b, h) (((b) * 2 + (h)) * HTB)
#define PG8_SB(b, h) ((4 + (b) * 2 + (h)) * HTB)
#define PG8_STAGE(bufoff, gbase) do { _Pragma("unroll") for (int _i = 0; _i < 2; ++_i) \
        __builtin_amdgcn_global_load_lds((const unsigned*)((const char*)(gbase) + voff[_i]), (LAS unsigned*)(lds + (bufoff) + ldsw + _i * 8192), 16, 0, 0); } while (0)
#define PG8_LDA(dst, b, h) do { _Pragma("unroll") for (int m = 0; m < 4; ++m) _Pragma("unroll") for (int k = 0; k < 2; ++k) dst[m][k] = *(const LAS bf16x8*)(lds + PG8_SA(b, h) + aoff + m * 2048 + k * 1024); } while (0)
#define PG8_LDB(dst, b, h) do { _Pragma("unroll") for (int n = 0; n < 2; ++n) _Pragma("unroll") for (int k = 0; k < 2; ++k) dst[n][k] = *(const LAS bf16x8*)(lds + PG8_SB(b, h) + boff + n * 2048 + k * 1024); } while (0)
#define PG8_MMA(ai, bj, At, Bt) do { __builtin_amdgcn_s_setprio(1); _Pragma("unroll") for (int m = 0; m < 4; ++m) _Pragma("unroll") for (int n = 0; n < 2; ++n) _Pragma("unroll") for (int k = 0; k < 2; ++k) \
        acc[ai][bj][m][n] = __builtin_amdgcn_mfma_f32_16x16x32_bf16(Bt[n][k], At[m][k], acc[ai][bj][m][n], 0, 0, 0); __builtin_amdgcn_s_setprio(0); } while (0)
#define PG8_WAIT_V(n) asm volatile("s_waitcnt vmcnt(" #n ")" ::: "memory")
#define PG8_WAIT_L(n) asm volatile("s_waitcnt lgkmcnt(" #n ")" ::: "memory")
#define PG8_BAR __builtin_amdgcn_s_barrier()
#define PG8_SCHED __builtin_amdgcn_sched_barrier(0)
    GUnit cur, nxt; int ui = 0;
    if (!S.next(0, cur)) return;
    f32x4 acc[2][2][4][2];
#pragma unroll
    for (int a = 0; a < 2; ++a)
#pragma unroll
        for (int b = 0; b < 2; ++b)
#pragma unroll
            for (int m = 0; m < 4; ++m)
#pragma unroll
                for (int n = 0; n < 2; ++n) acc[a][b][m][n] = (f32x4){0.f, 0.f, 0.f, 0.f};
    bf16x8 At[4][2], B0[2][2], B1[2][2];
    const char* cA = cur.A; const char* cB = cur.B;
    PG8_STAGE(PG8_SB(0, 0), cB); PG8_STAGE(PG8_SA(0, 0), cA); PG8_STAGE(PG8_SB(0, 1), cB + hstep); PG8_STAGE(PG8_SA(0, 1), cA + hstep);
    if (wr == 1) PG8_BAR;
    PG8_WAIT_V(4); PG8_BAR;
    PG8_STAGE(PG8_SB(1, 0), cB + kstep); PG8_STAGE(PG8_SA(1, 0), cA + kstep); PG8_STAGE(PG8_SB(1, 1), cB + hstep + kstep);
    PG8_WAIT_V(6); PG8_BAR;
    for (;;) {
        const bool has_next = S.next(ui + 1, nxt);
        const char* nA = has_next ? nxt.A : cA; const char* nB = has_next ? nxt.B : cB;
        const int nt = cur.nt;
        for (int t = 0; t < nt; t += 2) {
            const bool last = (t == nt - 2);
            const char* a1 = cA + (size_t)(t + 1) * kstep;
            const char* a2 = last ? nA : cA + (size_t)(t + 2) * kstep; const char* b2 = last ? nB : cB + (size_t)(t + 2) * kstep;
            const char* a3 = a2 + kstep; const char* b3 = b2 + kstep;
            PG8_LDB(B0, 0, 0); PG8_SCHED; PG8_LDA(At, 0, 0); PG8_STAGE(PG8_SA(1, 1), a1 + hstep);
            PG8_WAIT_L(8); PG8_BAR; PG8_WAIT_L(0); PG8_MMA(0, 0, At, B0); PG8_BAR; PG8_SCHED;
            PG8_LDB(B1, 0, 1); PG8_STAGE(PG8_SB(0, 0), b2);
            PG8_BAR; PG8_WAIT_L(0); PG8_MMA(0, 1, At, B1); PG8_BAR;
            PG8_LDA(At, 0, 1); PG8_STAGE(PG8_SA(0, 0), a2);
            PG8_BAR; PG8_WAIT_L(0); PG8_MMA(1, 0, At, B0); PG8_BAR; PG8_SCHED;
            PG8_STAGE(PG8_SB(0, 1), b2 + hstep);
            PG8_WAIT_V(6); PG8_BAR; PG8_MMA(1, 1, At, B1); PG8_BAR;
            PG8_LDB(B0, 1, 0); PG8_SCHED; PG8_LDA(At, 1, 0); PG8_STAGE(PG8_SA(0, 1), a2 + hstep);
            PG8_WAIT_L(8); PG8_BAR; PG8_WAIT_L(0); PG8_MMA(0, 0, At, B0); PG8_BAR; PG8_SCHED;
            PG8_LDB(B1, 1, 1); PG8_STAGE(PG8_SB(1, 0), b3);
            PG8_BAR; PG8_WAIT_L(0); PG8_MMA(0, 1, At, B1); PG8_BAR;
            PG8_LDA(At, 1, 1); PG8_STAGE(PG8_SA(1, 0), a3);
            PG8_BAR; PG8_WAIT_L(0); PG8_MMA(1, 0, At, B0); PG8_BAR; PG8_SCHED;
            PG8_STAGE(PG8_SB(1, 1), b3 + hstep);
            PG8_WAIT_V(6); PG8_BAR; PG8_MMA(1, 1, At, B1); PG8_BAR;
        }
        { int fr_ = fr, fq_ = fq, wr_ = wr, wc_ = wc; asm volatile("" : "+v"(fr_), "+v"(fq_), "+s"(wr_), "+s"(wc_));
          E(acc, cur, wr_, wc_, fr_, fq_); }
        if (!has_next) break;
#pragma unroll
        for (int a = 0; a < 2; ++a)
#pragma unroll
            for (int b = 0; b < 2; ++b)
#pragma unroll
                for (int m = 0; m < 4; ++m)
#pragma unroll
                    for (int n = 0; n < 2; ++n) acc[a][b][m][n] = (f32x4){0.f, 0.f, 0.f, 0.f};
        cur = nxt; cA = nA; cB = nB; ++ui;
    }
    PG8_WAIT_V(0);
    if (wr == 0) PG8_BAR;
    PG8_BAR;
#undef PG8_SA
#undef PG8_SB
#undef PG8_STAGE
#undef PG8_LDA
#undef PG8_LDB
#undef PG8_MMA
#undef PG8_WAIT_V
#undef PG8_WAIT_L
#undef PG8_BAR
#undef PG8_SCHED
}
}
using pg8::GUnit;
typedef f32x4 AccT[2][2][4][2];

#define FOR_AM _Pragma("unroll") for (int ai = 0; ai < 2; ++ai) _Pragma("unroll") for (int m = 0; m < 4; ++m)
#define FOR_BN _Pragma("unroll") for (int bj = 0; bj < 2; ++bj) _Pragma("unroll") for (int n = 0; n < 2; ++n)

struct EpiIn {
    int l; float* out; unsigned char* ws; const float* qg; const float* kg; const float* rs1;
    DEV void operator()(const AccT& acc, const GUnit& u, int wr, int wc, int fr, int fq) const {
        const int pn = u.pn; const bool smp = u.pm >= 128;
        const int rowb = u.pm * 256 + wr * 64 + fr;
        const int ct0 = wc * 32 + 4 * fq;
        u16* P1 = (u16*)(ws + W_P1); u16* P2 = (u16*)(ws + W_P2);
        float rsx[2][4];
        FOR_AM rsx[ai][m] = __builtin_amdgcn_rsqf(rs1[rowb + ai * 128 + m * 16] * (1.f / 1024.f) + EPS);
        if (pn < 2) {
            FOR_AM { const int row = rowb + ai * 128 + m * 16; FOR_BN { f32x4 v = (acc[ai][bj][m][n] * rsx[ai][m]);
                for (int e = 0; e < 4; ++e) v[e] = fgelu(v[e]);
                *(u32x2*)(P1 + (size_t)row * 1024 + pn * 256 + ct0 + bj * 128 + n * 16) = pk4(v); } }
        } else if (pn < 4 || pn == 8 || pn == 9 || pn == 16 || pn == 17) {
            const int kind = pn < 4 ? 0 : (pn < 10 ? 1 : 2);
            const int cseg = (pn & 1) * 256;
            u16* dstT; int T, toff = 0;
            if (kind == 0) { dstT = (u16*)(ws + W_GVT) + (smp ? (size_t)16 * 512 * 2048 : 0); T = smp ? 64 : 2048; }
            else if (kind == 1) { dstT = (u16*)(ws + W_CVT) + (smp ? (size_t)16 * 512 * 2048 : 0); T = smp ? 64 : 2048; }
            else { dstT = (u16*)(ws + (smp ? W_DVTS : W_DVTP)); T = smp ? 4160 : 2048; toff = smp ? 4096 : 0; }
            float* rowsq = (float*)(ws + W_ROWSQ);
            FOR_AM { const int row = rowb + ai * 128 + m * 16;
                int b, t; if (smp) { const int rs = row - MTP; b = rs >> 6; t = rs & 63; } else { b = row >> 11; t = row & 2047; }
                float ss = 0.f;
                FOR_BN { f32x4 v = (acc[ai][bj][m][n] * rsx[ai][m]); const int cc = cseg + ct0 + bj * 128 + n * 16;
                    if (kind == 0) { for (int e = 0; e < 4; ++e) { v[e] = fgelu(v[e]); ss += v[e] * v[e]; } }
                    if (kind == 2) { float* o = smp ? out + O_DVS + (size_t)l * 262144 + (size_t)(row - MTP) * 512 + cc : out + O_DVP + (size_t)l * 16777216 + (size_t)row * 512 + cc;
                        *(f32x4*)o = v; }
                    for (int e = 0; e < 4; ++e) dstT[((size_t)b * 512 + cc + e) * T + toff + t] = f2bf(v[e]); }
                if (kind == 0) { ss = red_fq(ss); if (fq == 0) atomicAdd(rowsq + row, ss); } }
        } else if (pn < 6) {
            u16* S5 = (u16*)(ws + W_S5);
            FOR_AM { const int row = rowb + ai * 128 + m * 16; FOR_BN {
                *(u32x2*)(S5 + (size_t)row * 512 + (pn - 4) * 256 + ct0 + bj * 128 + n * 16) = pk4((acc[ai][bj][m][n] * rsx[ai][m])); } }
        } else if (pn < 8) {
            u16* D = (u16*)(ws + (pn == 6 ? W_CQ : W_CK)); const float sc = pn == 6 ? 0.125f : 1.f;
            FOR_AM { const int row = rowb + ai * 128 + m * 16; FOR_BN {
                *(u32x2*)(D + (size_t)row * 256 + ct0 + bj * 128 + n * 16) = pk4((acc[ai][bj][m][n] * rsx[ai][m]) * sc); } }
        } else if (pn < 12) {
            FOR_AM { const int row = rowb + ai * 128 + m * 16; FOR_BN { f32x4 v = (acc[ai][bj][m][n] * rsx[ai][m]);
                for (int e = 0; e < 4; ++e) v[e] = fsilu(v[e]);
                *(u32x2*)(P2 + (size_t)row * 1024 + (pn - 10) * 256 + ct0 + bj * 128 + n * 16) = pk4(v); } }
        } else if (pn < 16) {
            const bool isq = pn < 14; const int hh = 4 * (pn & 1) + wc; const float* g = isq ? qg : kg;
            f32x4 gv[2][2];
            FOR_BN gv[bj][n] = *(const f32x4*)(g + 32 * bj + 16 * n + 4 * fq);
            FOR_AM { const int row = rowb + ai * 128 + m * 16;
                float ss = 0.f;
                FOR_BN { const f32x4 v = (acc[ai][bj][m][n] * rsx[ai][m]); ss += v[0] * v[0] + v[1] * v[1] + v[2] * v[2] + v[3] * v[3]; }
                ss = red_fq(ss);
                float rs = __builtin_amdgcn_rsqf(ss * (1.f / 64.f) + EPS);
                if (isq) { rs *= 0.125f * LOG2E;
                    FOR_BN { *(u32x2*)(P2 + (size_t)row * 1024 + 512 + hh * 64 + 32 * bj + 16 * n + 4 * fq) = pk4((acc[ai][bj][m][n] * rsx[ai][m]) * rs * gv[bj][n]); }
                } else {
                    float* o; u16* kb;
                    if (smp) { const int rs_ = row - MTP; o = out + O_DKS + (size_t)l * 262144 + (size_t)rs_ * 512; kb = (u16*)(ws + W_DKS) + ((size_t)(rs_ >> 6) * 4160 + 4096 + (rs_ & 63)) * 512; }
                    else { o = out + O_DKP + (size_t)l * 16777216 + (size_t)row * 512; kb = (u16*)(ws + W_DKP) + (size_t)row * 512; }
                    FOR_BN { const f32x4 v = (acc[ai][bj][m][n] * rsx[ai][m]) * rs * gv[bj][n]; const int d = hh * 64 + 32 * bj + 16 * n + 4 * fq;
                        *(f32x4*)(o + d) = v; *(u32x2*)(kb + d) = pk4(v); } } }
        } else {
            if (wc == 0) { float* C = (float*)(ws + W_CODE);
                FOR_AM { const int row = rowb + ai * 128 + m * 16; *(f32x4*)(C + (size_t)row * 16 + 4 * fq) = acc[ai][0][m][0] * rsx[ai][m]; } }
        }
    }
};

struct EpiGlu {
    unsigned char* ws; const float* bias;
    DEV void operator()(const AccT& acc, const GUnit& u, int wr, int wc, int fr, int fq) const {
        const u16* Z = (const u16*)(ws + W_S5); u16* P1 = (u16*)(ws + W_P1);
        const int rowb = u.pm * 256 + wr * 64 + fr, cb = u.pn * 256 + wc * 32 + 4 * fq;
        FOR_AM { const int row = rowb + ai * 128 + m * 16; FOR_BN { const int col = cb + bj * 128 + n * 16;
            const f32x4 bv = *(const f32x4*)(bias + col); const u32x2 zz = *(const u32x2*)(Z + (size_t)row * 512 + col);
            f32x4 z; z[0] = __uint_as_float(zz.x << 16); z[1] = __uint_as_float(zz.x & 0xffff0000u); z[2] = __uint_as_float(zz.y << 16); z[3] = __uint_as_float(zz.y & 0xffff0000u);
            f32x4 v = acc[ai][bj][m][n] + bv;
            for (int e = 0; e < 4; ++e) v[e] = z[e] * fsigmoid(v[e]);
            *(u32x2*)(P1 + (size_t)row * 1024 + 512 + col) = pk4(v); } }
    }
};

struct MergeSched {
    pg8::TileOrder T; unsigned char* ws;
    DEV void fill(GUnit& u, int pm, int pn, int b, int sub) const {
        u.pm = pm; u.pn = pn;
        if (sub) { u.nt = 16; u.A = (const char*)ws + W_H + (size_t)pm * 256 * 2048; u.B = (const char*)ws + W_WIN + (size_t)(GATE0 + b * 1024 + pn * 256) * 2048; }
        else { u.nt = 8; u.A = (const char*)ws + (b < 2 ? W_P1 : W_P2) + (size_t)pm * 256 * 2048 + (b & 1) * 1024;
               u.B = (const char*)ws + W_WBR + (size_t)(b >> 1) * 1024 * 2048 + (size_t)pn * 256 * 2048 + (b & 1) * 1024; }
    }
    DEV bool next(int i, GUnit& u) const {
        int pm, pn;
        if (T.tile(i >> 3, pm, pn)) { const int s = i & 7; u.kind = s; fill(u, pm, pn, s >> 1, s & 1); return true; }
        const int i0 = (T.nwg - T.c + T.G - 1) / T.G; const int jj = i - 8 * i0; const int job = (jj >> 1) * T.G + T.c; if (job >= 32) return false;
        const int tile = job >> 2, b = job & 3; u.kind = 8 + 2 * b + (jj & 1); fill(u, 128 + (tile >> 2), tile & 3, b, jj & 1); return true;
    }
};
struct EpiMerge {
    unsigned char* ws; const float* bgate; const float* rs1;
    DEV void operator()(const AccT& acc, const GUnit& u, int wr, int wc, int fr, int fq) const {
        u32x4* sT = (u32x4*)(ws + W_SCR) + (size_t)bid_o() * 16 * 512 + tid_o();
        u32x4* sS = (u32x4*)(ws + W_SCR + (size_t)32 * 1024 * 1024) + (size_t)bid_o() * 16 * 512 + tid_o();
        const int s = u.kind & 7, b = s >> 1; const bool smp = u.kind >= 8;
        if (!(s & 1)) {
#pragma unroll
            for (int q = 0; q < 16; ++q) { const int ai = q >> 3, bj = (q >> 2) & 1, m = q & 3; const u32x2 lo = pk4(acc[ai][bj][m][0]), hi = pk4(acc[ai][bj][m][1]);
                u32x4 w; w.x = lo.x; w.y = lo.y; w.z = hi.x; w.w = hi.y; sT[q * 512] = w; }
        } else {
            u16* MG = (u16*)(ws + W_MERGED);
            const int rowb = u.pm * 256 + wr * 64 + fr, cb = u.pn * 256 + wc * 32 + 4 * fq;
            f32x4 bvv[2][2];
#pragma unroll
            for (int bj = 0; bj < 2; ++bj)
#pragma unroll
                for (int n = 0; n < 2; ++n) bvv[bj][n] = *(const f32x4*)(bgate + b * 1024 + cb + bj * 128 + n * 16);
            float rsx[2][4];
            FOR_AM rsx[ai][m] = __builtin_amdgcn_rsqf(rs1[rowb + ai * 128 + m * 16] * (1.f / 1024.f) + EPS);
#pragma unroll
            for (int q = 0; q < 16; ++q) { const int ai = q >> 3, bj = (q >> 2) & 1, m = q & 3; __builtin_amdgcn_sched_barrier(0);
                const u32x4 tw = sT[q * 512]; u32x4 sw = (u32x4){0u, 0u, 0u, 0u}; if (b > 0 && !smp) sw = sS[q * 512];
                const unsigned tws[4] = {tw.x, tw.y, tw.z, tw.w}; const unsigned sws[4] = {sw.x, sw.y, sw.z, sw.w};
                f32x4 r[2];
#pragma unroll
                for (int n = 0; n < 2; ++n) { const f32x4 bv = bvv[bj][n];
                    f32x4 v = acc[ai][bj][m][n] * rsx[ai][m] + bv;
#pragma unroll
                    for (int e = 0; e < 4; ++e) { const unsigned tt = tws[n * 2 + (e >> 1)], st = sws[n * 2 + (e >> 1)];
                        const float tv = (e & 1) ? __uint_as_float(tt & 0xffff0000u) : __uint_as_float(tt << 16);
                        const float sv = (e & 1) ? __uint_as_float(st & 0xffff0000u) : __uint_as_float(st << 16);
                        v[e] = fsigmoid(v[e]) * tv + sv; }
                    r[n] = v; }
                if (smp) { float* mf = (float*)(ws + W_MFS) + (size_t)(rowb + ai * 128 + m * 16 - MTP) * 1024 + cb + bj * 128;
#pragma unroll
                    for (int n = 0; n < 2; ++n)
#pragma unroll
                        for (int e = 0; e < 4; ++e) atomicAdd(mf + n * 16 + e, r[n][e]); }
                else if (b < 3) { const u32x2 lo = pk4(r[0]), hi = pk4(r[1]); u32x4 w; w.x = lo.x; w.y = lo.y; w.z = hi.x; w.w = hi.y; sS[q * 512] = w; }
                else { const int row = rowb + ai * 128 + m * 16;
#pragma unroll
                    for (int n = 0; n < 2; ++n) *(u32x2*)(MG + (size_t)row * 1024 + cb + bj * 128 + n * 16) = pk4(r[n]); } }
        }
    }
};

struct EpiRes {
    const float* xin;
    u16* xb;
    float* yout;
    float* rsacc;
    float* yfull;
    DEV void operator()(const AccT& acc, const GUnit& u, int wr, int wc, int fr, int fq) const {
        const int rowb = u.pm * 256 + wr * 64 + fr, cb = u.pn * 256 + wc * 32 + 4 * fq;
        if (u.kind >= 1) {
            float* pp = yfull + ((size_t)(u.kind - 1) * 512) * 1024;
            FOR_AM { const int row = rowb + ai * 128 + m * 16 - MTP; FOR_BN { *(f32x4*)(pp + (size_t)row * 1024 + cb + bj * 128 + n * 16) = acc[ai][bj][m][n]; } }
            return; }
        FOR_AM { const int row = rowb + ai * 128 + m * 16; float ss = 0.f;
            FOR_BN { const int col = cb + bj * 128 + n * 16; f32x4 x;
                if (xin) x = *(const f32x4*)(xin + (size_t)row * 1024 + col);
                else { const u32x2 xx = *(const u32x2*)(xb + (size_t)row * 1024 + col);
                    x[0] = __uint_as_float(xx.x << 16); x[1] = __uint_as_float(xx.x & 0xffff0000u); x[2] = __uint_as_float(xx.y << 16); x[3] = __uint_as_float(xx.y & 0xffff0000u); }
                const f32x4 v = x + acc[ai][bj][m][n];
                if (yout) *(f32x4*)(yout + (size_t)row * 1024 + col) = v; else *(u32x2*)(xb + (size_t)row * 1024 + col) = pk4(v);
                ss += v[0] * v[0] + v[1] * v[1] + v[2] * v[2] + v[3] * v[3]; }
            if (rsacc) { ss = red_fq(ss); if (fq == 0) atomicAdd(rsacc + row, ss); } }
    }
};

DEV float dpp_prev1(float cur, float prevm) {
    const int o = __builtin_amdgcn_update_dpp(0, __float_as_int(prevm), 0x121, 0xf, 0xf, false);
    return __int_as_float(__builtin_amdgcn_update_dpp(o, __float_as_int(cur), 0x111, 0xf, 0xf, false));
}
DEV float dpp_prev2(float cur, float prevm) {
    const int o = __builtin_amdgcn_update_dpp(0, __float_as_int(prevm), 0x122, 0xf, 0xf, false);
    return __int_as_float(__builtin_amdgcn_update_dpp(o, __float_as_int(cur), 0x112, 0xf, 0xf, false));
}
struct EpiUp {
    unsigned char* ws; const float* cw; const float* cbias; const float* rs2;
    DEV void operator()(const AccT& acc, const GUnit& u, int wr, int wc, int fr, int fq) const {
        u16* ACT = (u16*)(ws + W_ACT); float* HEAD = (float*)(ws + W_HEAD); float* TAIL = (float*)(ws + W_TAIL);
        float rsx[2][4];
        FOR_AM rsx[ai][m] = __builtin_amdgcn_rsqf(rs2[u.pm * 256 + wr * 64 + fr + ai * 128 + m * 16] * (1.f / 1024.f) + EPS);
        const int f0 = u.pn * 128 + wc * 32 + 4 * fq;
#pragma unroll
        for (int n = 0; n < 2; ++n) { const int f = f0 + n * 16;
            f32x4 w0[2], w1[2], w2[2], bb[2];
#pragma unroll
            for (int bj = 0; bj < 2; ++bj) { const int ff = bj * 2816 + f; w0[bj] = *(const f32x4*)(cw + ff); w1[bj] = *(const f32x4*)(cw + 5632 + ff); w2[bj] = *(const f32x4*)(cw + 11264 + ff); bb[bj] = *(const f32x4*)(cbias + ff); }
#pragma unroll
            for (int ai = 0; ai < 2; ++ai) {
                const int slab = u.pm * 4 + ai * 2 + wr;
#pragma unroll
                for (int m = 0; m < 4; ++m) {
                    f32x4 c[2];
#pragma unroll
                    for (int bj = 0; bj < 2; ++bj) { const f32x4 cur = acc[ai][bj][m][n] * rsx[ai][m]; const f32x4 pm_ = acc[ai][bj][m ? m - 1 : 0][n] * rsx[ai][m ? m - 1 : 0];
#pragma unroll
                        for (int e = 0; e < 4; ++e) { const float p1 = dpp_prev1(cur[e], pm_[e]), p2 = dpp_prev2(cur[e], pm_[e]);
                            c[bj][e] = bb[bj][e] + w2[bj][e] * cur[e] + w1[bj][e] * p1 + w0[bj][e] * p2; } }
                    if (m > 0 || fr >= 2) { f32x4 a; for (int e = 0; e < 4; ++e) a[e] = fsilu(c[0][e]) * c[1][e];
                        *(u32x2*)(ACT + (size_t)(slab * 64 + m * 16 + fr) * 2816 + f) = pk4(a); }
                    if (m == 0 && fr < 2) { for (int bj = 0; bj < 2; ++bj) *(f32x4*)(HEAD + ((size_t)slab * 2 + fr) * 5632 + bj * 2816 + f) = acc[ai][bj][0][n] * rsx[ai][0]; }
                    if (m == 3 && fr >= 14) { for (int bj = 0; bj < 2; ++bj) *(f32x4*)(TAIL + ((size_t)slab * 2 + fr - 14) * 5632 + bj * 2816 + f) = acc[ai][bj][3][n] * rsx[ai][3]; }
                } } }
    }
};

template <int MAP> DEV int src_col(int j) {
    if (MAP == 0) return j;
    if (MAP == 1) {
        const int tile = j >> 8, tc = j & 255;
        if (tile < 10) return j;
        if (tile < 12) return j + 16;
        if (tile < 16) { const int perm = ((tc >> 5) & 3) * 64 + (tc >> 7) * 32 + (tc & 31); return (tile < 14 ? 3088 : 3600) + (tile & 1) * 256 + perm; }
        if (tile < 18) return j + 16;
        if (tile == 18) return tc < 16 ? 2560 + tc : -1;
        return 4624 + (j - GATE0);
    }
    { const int q = j >> 8, tc = j & 255; return tc < 128 ? 128 * q + tc : 2816 + 128 * q + (tc - 128); }
}
template <int MAP> DEV void conv_T(u16* dst, int dst_ld, int K, int Nd, const float* src, int src_ld, int gt, int GT, const float* gain = nullptr) {
    const int total = Nd * (K >> 3);
    for (int idx = gt; idx < total; idx += GT) { const int j = idx % Nd, kb = idx / Nd; const int sc = src_col<MAP>(j);
        float v[8];
#pragma unroll
        for (int i = 0; i < 8; ++i) v[i] = sc >= 0 ? src[(size_t)(kb * 8 + i) * src_ld + sc] : 0.f;
        if (gain) {
#pragma unroll
            for (int i = 0; i < 8; ++i) v[i] *= gain[kb * 8 + i]; }
        u32x4 w; w.x = pk2(v[0], v[1]); w.y = pk2(v[2], v[3]); w.z = pk2(v[4], v[5]); w.w = pk2(v[6], v[7]);
        *(u32x4*)(dst + (size_t)j * dst_ld + kb * 8) = w; }
}
DEV void raw_rows(const float* xp, const float* xs, int r0, int r1, u16* XB, float* RS) {
    const int tid = tid_o(); const int lane = tid & 63; const int gw = bid_o() * 8 + (tid >> 6), GW = gridDim.x * 8;
    for (int row = r0 + gw; row < r1; row += GW) {
        const float* src = row < MTP ? xp + (size_t)row * 1024 : xs + (size_t)(row - MTP) * 1024;
        f32x4 v[4]; float ss = 0.f;
#pragma unroll
        for (int i = 0; i < 4; ++i) { v[i] = *(const f32x4*)(src + (lane + 64 * i) * 4); ss += v[i][0] * v[i][0] + v[i][1] * v[i][1] + v[i][2] * v[i][2] + v[i][3] * v[i][3]; }
        ss = wave_sum(ss); if (lane == 0) RS[row] = ss;
#pragma unroll
        for (int i = 0; i < 4; ++i) *(u32x2*)(XB + (size_t)row * 1024 + (lane + 64 * i) * 4) = pk4(v[i]);
    }
}

DEV void sample_rows_reduce(float* xs, const float* part, int npart, u16* XBs, float* RSs) {
    const int tid = tid_o(); const int lane = tid & 63; const int gw = bid_o() * 8 + (tid >> 6), GW = gridDim.x * 8;
    for (int r = gw; r < 512; r += GW) {
        float* src = xs + (size_t)r * 1024; f32x4 v[4];
#pragma unroll
        for (int i = 0; i < 4; ++i) v[i] = *(const f32x4*)(src + (lane + 64 * i) * 4);
        for (int k = 0; k < npart; ++k) { const float* pp = part + ((size_t)k * 512 + r) * 1024;
#pragma unroll
            for (int i = 0; i < 4; ++i) v[i] += *(const f32x4*)(pp + (lane + 64 * i) * 4); }
        float ss = 0.f;
#pragma unroll
        for (int i = 0; i < 4; ++i) { *(f32x4*)(src + (lane + 64 * i) * 4) = v[i]; ss += v[i][0] * v[i][0] + v[i][1] * v[i][1] + v[i][2] * v[i][2] + v[i][3] * v[i][3]; }
        ss = wave_sum(ss); if (lane == 0) RSs[r] = ss;
#pragma unroll
        for (int i = 0; i < 4; ++i) *(u32x2*)(XBs + (size_t)r * 1024 + (lane + 64 * i) * 4) = pk4(v[i]);
    }
}
DEV void phaseA(CP& p, int l) {
    unsigned char* ws = p.ws;
    const int gt = bid_o() * 512 + tid_o(), GT = gridDim.x * 512;
    conv_T<1>((u16*)(ws + W_WIN), 1024, 1024, NINP, p.in[9] + (size_t)l * 1024 * 8720, 8720, gt, GT, p.in[8] + l * 1024);
    for (int b = 0; b < 4; ++b) conv_T<0>((u16*)(ws + W_WBR) + (size_t)(b >> 1) * 1024 * 1024 + (b & 1) * 512, 1024, 512, 1024, p.in[31] + (size_t)(l * 4 + b) * 512 * 1024, 1024, gt, GT);
    conv_T<0>((u16*)(ws + W_WOUT), 1024, 1024, 1024, p.in[32] + (size_t)l * 1024 * 1024, 1024, gt, GT);
    conv_T<0>((u16*)(ws + W_WGLU), 512, 512, 512, p.in[22] + (size_t)l * 512 * 512, 512, gt, GT);
    conv_T<2>((u16*)(ws + W_WUP), 1024, 1024, 5632, p.in[34] + (size_t)l * 1024 * 5632, 5632, gt, GT, p.in[33] + l * 1024);
    conv_T<0>((u16*)(ws + W_WDN), 2816, 2816, 1024, p.in[37] + (size_t)l * 2816 * 1024, 1024, gt, GT);
    for (int b = 0; b < 8; ++b) conv_T<0>((u16*)(ws + W_DVTS) + (size_t)b * 512 * 4160, 4160, 4096, 512, p.in[3] + ((size_t)(l * 8 + b) * 4096) * 512, 512, gt, GT);
    {
        const float* ck = p.in[2] + (size_t)l * 8 * 4096 * 512; u16* dk = (u16*)(ws + W_DKS);
        for (int idx = gt; idx < 8 * 4096 * 64; idx += GT) { const int b = idx >> 18, rem = idx & 262143, key = rem >> 6, c8 = (rem & 63) * 8;
            const f32x4 a = *(const f32x4*)(ck + ((size_t)(b * 4096 + key)) * 512 + c8), c = *(const f32x4*)(ck + ((size_t)(b * 4096 + key)) * 512 + c8 + 4);
            u32x4 w; w.x = pk2(a[0], a[1]); w.y = pk2(a[2], a[3]); w.z = pk2(c[0], c[1]); w.w = pk2(c[2], c[3]);
            *(u32x4*)(dk + ((size_t)b * 4160 + key) * 512 + c8) = w; }
    }
    { float* rq = (float*)(ws + W_ROWSQ); for (int i = gt; i < MT; i += GT) rq[i] = 0.f; }
    { const float* wsp = p.in[12] + (size_t)l * 4 * 128 * 128; u16* wm = (u16*)(ws + W_WM); for (int i = gt; i < 4 * 128 * 128; i += GT) { const int t = (i >> 7) & 127, s2 = i & 127; wm[i] = f2bf(s2 <= t ? wsp[i] : 0.f); } }
    { f32x4* mf = (f32x4*)(ws + W_MFS); for (int i = gt; i < 512 * 256; i += GT) mf[i] = (f32x4){0.f, 0.f, 0.f, 0.f}; }
    if (l == 0) { const f32x4* xs = (const f32x4*)p.in[1]; f32x4* xo = (f32x4*)(p.out + (size_t)MTP * 1024); for (int i = gt; i < 512 * 256; i += GT) xo[i] = xs[i]; }
    if (gt == 0) {
        unsigned* misc = (unsigned*)(ws + W_MISC); misc[l] = 0u;
        const float* dl = p.in[29] + l * 256; float s1 = 0.f, s2 = 0.f;
        for (int i = 0; i < 64; ++i) { s1 += dl[i] * dl[64 + i]; s2 += dl[128 + i] * dl[192 + i]; }
        const float lam_init = 0.8f - 0.6f * expf(-0.3f * (float)l);
        ((float*)misc)[8 + 2 * l] = expf(s1) - expf(s2) + lam_init; ((float*)misc)[9 + 2 * l] = lam_init;
        float mq = 0.f, mk = 0.f; for (int i = 0; i < 64; ++i) { mq = fmaxf(mq, fabsf(p.in[27][l * 64 + i])); mk = fmaxf(mk, fabsf(p.in[28][l * 64 + i])); }
        ((float*)misc)[16 + l] = 64.f * mq * mk * 0.125f * LOG2E;
    }
    { float* RS = (float*)(ws + W_RS);
      for (int i = gt; i < MT; i += GT) { RS[(size_t)(l * 2 + 1) * MT + i] = 0.f; if (l == 0) RS[(size_t)2 * MT + i] = 0.f; }
      if (l == 0) raw_rows(p.in[0], p.in[1], 0, MT, (u16*)(ws + W_H), RS);
      else sample_rows_reduce(p.out + (size_t)MTP * 1024, (const float*)(ws + W_PART), 11, (u16*)(ws + W_H) + (size_t)MTP * 1024, RS + (size_t)2 * MT + MTP); }
}

DEV void attn_item(CP& p, int l, LAS unsigned char* lds, int grp, int b, int h, int qp) {
    unsigned char* ws = p.ws;
    const int tid = tid_o(), w = tid >> 6, lane = tid & 63, fr = lane & 15, fq = lane >> 4, c = w >> 2, qs = w & 3;
    const int Tk = grp ? 4160 : 2048, nkv = grp ? 65 : 2 * qp + 2;
    const int nact = grp ? (qs < 2 ? 65 : 0) : (qs < 2 ? nkv - 1 : nkv);
    const int rowbase = grp ? MTP + b * 64 : b * 2048 + qp * 128;
    const u16* Kb = grp ? (const u16*)(ws + W_DKS) + (size_t)b * 4160 * 512 : (const u16*)(ws + W_DKP) + (size_t)b * 2048 * 512;
    const u16* Vb = grp ? (const u16*)(ws + W_DVTS) + ((size_t)b * 512 + h * 128) * 4160 : (const u16*)(ws + W_DVTP) + ((size_t)b * 512 + h * 128) * 2048;
    u16* P2 = (u16*)(ws + W_P2);
    bf16x8 qf[2][2];
    if (nact > 0) {
#pragma unroll
        for (int r = 0; r < 2; ++r)
#pragma unroll
            for (int kk = 0; kk < 2; ++kk) qf[r][kk] = *(const bf16x8*)(P2 + (size_t)(rowbase + 32 * qs + 16 * r + fr) * 1024 + 512 + h * 128 + c * 64 + kk * 32 + fq * 8);
    } else {
#pragma unroll
        for (int r = 0; r < 2; ++r)
#pragma unroll
            for (int kk = 0; kk < 2; ++kk) qf[r][kk] = (bf16x8){0, 0, 0, 0, 0, 0, 0, 0};
    }
    constexpr int STG = 36864;
    int gK[2], lK[2], gV[2], lV[2];
#pragma unroll
    for (int i = 0; i < 2; ++i) { const int ch = tid + 512 * i; const int key = ch >> 4, part = ch & 15; gK[i] = key * 512 + h * 128 + part * 8; lK[i] = (((part >> 3) * 64 + key) * 72 + (part & 7) * 8) * 2;
        const int v = ch >> 3, kp = (ch & 7) * 8; gV[i] = v * Tk + kp; lV[i] = (128 * 72 + v * 72 + kp) * 2; }
    u32x4 rk[2], rv[2];
#pragma unroll
    for (int i = 0; i < 2; ++i) { rk[i] = *(const u32x4*)(Kb + gK[i]); rv[i] = *(const u32x4*)(Vb + gV[i]); }
#pragma unroll
    for (int i = 0; i < 2; ++i) { *(LAS u32x4*)(lds + lK[i]) = rk[i]; *(LAS u32x4*)(lds + lV[i]) = rv[i]; }
    __syncthreads();
    f32x4 O[2][8];
#pragma unroll
    for (int r = 0; r < 2; ++r)
#pragma unroll
        for (int i = 0; i < 8; ++i) O[r][i] = (f32x4){0.f, 0.f, 0.f, 0.f};
    const bool fixedref = ((const float*)(ws + W_MISC))[16 + l] < 40.f;
    float mrun[2] = {-1e30f, -1e30f}, lrun[2] = {0.f, 0.f};
    for (int kt = 0; kt < nkv; ++kt) {
        const bool more = kt + 1 < nkv;
        if (more) { const size_t k0 = (size_t)(kt + 1) * 64;
#pragma unroll
            for (int i = 0; i < 2; ++i) { rk[i] = *(const u32x4*)(Kb + k0 * 512 + gK[i]); rv[i] = *(const u32x4*)(Vb + k0 + gV[i]); } }
        if (kt < nact) {
            LAS unsigned char* st = lds + (kt & 1) * STG;
            f32x4 s[2][4];
#pragma unroll
            for (int jt = 0; jt < 4; ++jt) { s[0][jt] = (f32x4){0.f, 0.f, 0.f, 0.f}; s[1][jt] = (f32x4){0.f, 0.f, 0.f, 0.f};
#pragma unroll
                for (int kk = 0; kk < 2; ++kk) { const bf16x8 kf = *(const LAS bf16x8*)(st + ((c * 64 + 16 * jt + fr) * 72 + kk * 32 + fq * 8) * 2);
                    s[0][jt] = mfma16(kf, qf[0][kk], s[0][jt]); s[1][jt] = mfma16(kf, qf[1][kk], s[1][jt]); } }
            bf16x8 pf[2][2];
#pragma unroll
            for (int r = 0; r < 2; ++r) {
                float ps = 0.f;
                if (fixedref) {
#pragma unroll
                    for (int jt = 0; jt < 4; ++jt)
#pragma unroll
                        for (int e = 0; e < 4; ++e) { s[r][jt][e] = __builtin_amdgcn_exp2f(s[r][jt][e]); ps += s[r][jt][e]; }
                    lrun[r] += ps;
                } else {
                    float mt = s[r][0][0];
#pragma unroll
                    for (int jt = 0; jt < 4; ++jt)
#pragma unroll
                        for (int e = 0; e < 4; ++e) mt = fmaxf(mt, s[r][jt][e]);
                    mt = fmaxf(mt, __shfl_xor(mt, 16)); mt = fmaxf(mt, __shfl_xor(mt, 32));
                    const float mnew = fmaxf(mrun[r], mt), alpha = __builtin_amdgcn_exp2f(mrun[r] - mnew); mrun[r] = mnew;
#pragma unroll
                    for (int jt = 0; jt < 4; ++jt)
#pragma unroll
                        for (int e = 0; e < 4; ++e) { s[r][jt][e] = __builtin_amdgcn_exp2f(s[r][jt][e] - mnew); ps += s[r][jt][e]; }
                    lrun[r] = lrun[r] * alpha + ps;
#pragma unroll
                    for (int i = 0; i < 8; ++i) O[r][i] *= alpha;
                }
#pragma unroll
                for (int t = 0; t < 2; ++t) { const u32x2 lo = pk4(s[r][2 * t]), hi = pk4(s[r][2 * t + 1]); u32x4 wv; wv.x = lo.x; wv.y = lo.y; wv.z = hi.x; wv.w = hi.y; pf[r][t] = __builtin_bit_cast(bf16x8, wv); }
            }
#pragma unroll
            for (int vt = 0; vt < 8; ++vt)
#pragma unroll
                for (int t = 0; t < 2; ++t) { const LAS unsigned char* vp = st + (128 * 72 + (16 * vt + fr) * 72 + 32 * t + 4 * fq) * 2;
                    const u32x2 a = *(const LAS u32x2*)vp, bq = *(const LAS u32x2*)(vp + 32); u32x4 wv; wv.x = a.x; wv.y = a.y; wv.z = bq.x; wv.w = bq.y;
                    const bf16x8 vf = __builtin_bit_cast(bf16x8, wv);
                    O[0][vt] = mfma16(vf, pf[0][t], O[0][vt]); O[1][vt] = mfma16(vf, pf[1][t], O[1][vt]); }
        }
        if (more) { LAS unsigned char* nx = lds + ((kt + 1) & 1) * STG;
#pragma unroll
            for (int i = 0; i < 2; ++i) { *(LAS u32x4*)(nx + lK[i]) = rk[i]; *(LAS u32x4*)(nx + lV[i]) = rv[i]; } }
        __syncthreads();
    }
    const float lam = ((const float*)(ws + W_MISC))[8 + 2 * l], lam_init = ((const float*)(ws + W_MISC))[9 + 2 * l];
    LAS float* X = (LAS float*)lds;
    float inv[2];
#pragma unroll
    for (int r = 0; r < 2; ++r) inv[r] = __builtin_amdgcn_rcpf(fmaxf(red_fq(lrun[r]), 1e-30f));
    if (c == 1) {
#pragma unroll
        for (int r = 0; r < 2; ++r)
#pragma unroll
            for (int vt = 0; vt < 8; ++vt)
#pragma unroll
                for (int e = 0; e < 4; ++e) X[(qs * 64 + r * 32 + vt * 4 + e) * 64 + lane] = O[r][vt][e] * inv[r] * lam;
    }
    __syncthreads();
    if (c == 0 && nact > 0) {
        const float* g = p.in[30] + l * 128;
#pragma unroll
        for (int r = 0; r < 2; ++r) { float ss = 0.f;
#pragma unroll
            for (int vt = 0; vt < 8; ++vt)
#pragma unroll
                for (int e = 0; e < 4; ++e) { const float d = O[r][vt][e] * inv[r] - X[(qs * 64 + r * 32 + vt * 4 + e) * 64 + lane]; O[r][vt][e] = d; ss += d * d; }
            ss = red_fq(ss); const float rs = __builtin_amdgcn_rsqf(ss * (1.f / 128.f) + EPS) * (1.f - lam_init);
#pragma unroll
            for (int vt = 0; vt < 8; ++vt) { const f32x4 gv = *(const f32x4*)(g + 16 * vt + 4 * fq);
                *(u32x2*)(P2 + (size_t)(rowbase + 32 * qs + 16 * r + fr) * 1024 + 512 + h * 128 + 16 * vt + 4 * fq) = pk4(O[r][vt] * rs * gv); } }
    }
    __syncthreads();
}

DEV void gla_item(CP& p, int l, LAS unsigned char* lds, int grp, int b, int h) {
    unsigned char* ws = p.ws;
    const int tid = tid_o(), w = tid >> 6, lane = tid & 63, fr = lane & 15, fq = lane >> 4;
    const int T = grp ? 64 : 2048, nch = grp ? 1 : 32; const int rowbase = grp ? MTP + b * 64 : b * 2048;
    const u16* CQ = (const u16*)(ws + W_CQ); const u16* CK = (const u16*)(ws + W_CK); const float* CODE = (const float*)(ws + W_CODE);
    const u16* VT = (const u16*)(ws + W_CVT) + (grp ? (size_t)16 * 512 * 2048 : 0) + ((size_t)b * 512 + h * 128) * T;
    u16* P2 = (u16*)(ws + W_P2);
    LAS u16* QE = (LAS u16*)lds; LAS u16* KE = QE + 64 * 72; LAS u16* KDT = KE + 64 * 72; LAS u16* VTl = KDT + 64 * 72;
    LAS u16* PP = VTl + 128 * 72; LAS u16* STb = PP + 64 * 72;
    LAS float* OT = (LAS float*)(STb + 8 * 16 * 72); LAS float* SEG = OT + 64 * 132; LAS float* DEC = SEG + 8 * 64;
    LAS u16* QR = (LAS u16*)(DEC + 64); LAS u16* KR = QR + 64 * 72; LAS float* CD = (LAS float*)(KR + 64 * 72);
    const int d_ = tid & 63, seg = tid >> 6;
    float wa[16];
#pragma unroll
    for (int r = 0; r < 16; ++r) wa[r] = p.in[24][(size_t)l * 16 * 256 + r * 256 + h * 64 + d_];
    const float ba = p.in[25][l * 256 + h * 64 + d_];
    f32x4 S[4];
    if (grp) { const float* s0 = p.in[6] + ((size_t)(l * 8 + b) * 4 + h) * 64 * 128;
#pragma unroll
        for (int dt = 0; dt < 4; ++dt) S[dt] = *(const f32x4*)(s0 + (size_t)(16 * dt + fr) * 128 + 16 * w + 4 * fq); }
    else {
#pragma unroll
        for (int dt = 0; dt < 4; ++dt) S[dt] = (f32x4){0.f, 0.f, 0.f, 0.f}; }
#pragma unroll
    for (int dt = 0; dt < 4; ++dt)
#pragma unroll
        for (int e = 0; e < 4; ++e) STb[(w * 16 + 4 * fq + e) * 72 + 16 * dt + fr] = f2bf(S[dt][e]);
    const float* gng = p.in[26] + l * 128;
    const int tl = tid >> 3, d8 = (tid & 7) * 8;
    u32x4 rq, rkk, rvv[2]; f32x2 rcd;
    {
        rq = *(const u32x4*)(CQ + (size_t)(rowbase + tl) * 256 + h * 64 + d8); rkk = *(const u32x4*)(CK + (size_t)(rowbase + tl) * 256 + h * 64 + d8);
        rcd = *(const f32x2*)(CODE + (size_t)(rowbase + tl) * 16 + (tid & 7) * 2);
#pragma unroll
        for (int i = 0; i < 2; ++i) { const int chn = tid + 512 * i, v = chn >> 3, kp = (chn & 7) * 8; rvv[i] = *(const u32x4*)(VT + (size_t)v * T + kp); }
    }
    for (int ch = 0; ch < nch; ++ch) {
        const int r0 = rowbase + ch * 64;
        *(LAS u32x4*)(QR + tl * 72 + d8) = rq; *(LAS u32x4*)(KR + tl * 72 + d8) = rkk; *(LAS f32x2*)(CD + tl * 16 + (tid & 7) * 2) = rcd;
#pragma unroll
        for (int i = 0; i < 2; ++i) { const int chn = tid + 512 * i, v = chn >> 3, kp = (chn & 7) * 8; *(LAS u32x4*)(VTl + v * 72 + kp) = rvv[i]; }
        if (ch + 1 < nch) { const int r1 = r0 + 64;
            rq = *(const u32x4*)(CQ + (size_t)(r1 + tl) * 256 + h * 64 + d8); rkk = *(const u32x4*)(CK + (size_t)(r1 + tl) * 256 + h * 64 + d8);
            rcd = *(const f32x2*)(CODE + (size_t)(r1 + tl) * 16 + (tid & 7) * 2);
#pragma unroll
            for (int i = 0; i < 2; ++i) { const int chn = tid + 512 * i, v = chn >> 3, kp = (chn & 7) * 8; rvv[i] = *(const u32x4*)(VT + (size_t)v * T + (ch + 1) * 64 + kp); } }
        u16* yp = P2 + (size_t)(r0 + tl) * 1024 + h * 128 + (tid & 7) * 16;
        const u32x4 rr0 = *(const u32x4*)yp, rr1 = *(const u32x4*)(yp + 8);
        __syncthreads();
        float bl[8]; float run = 0.f;
#pragma unroll
        for (int i = 0; i < 8; ++i) { const LAS float* cp = CD + (seg * 8 + i) * 16; float a = ba;
#pragma unroll
            for (int r = 0; r < 16; ++r) a += cp[r] * wa[r];
            run += flogsig(a) * (1.f / 16.f); bl[i] = run; }
        SEG[seg * 64 + d_] = run;
        __syncthreads();
        float off = 0.f, tot = 0.f;
#pragma unroll
        for (int s2 = 0; s2 < 8; ++s2) { const float x = SEG[s2 * 64 + d_]; tot += x; if (s2 < seg) off += x; }
        if (seg == 0) DEC[d_] = __expf(tot);
        { float kd[8];
#pragma unroll
          for (int i = 0; i < 8; ++i) { const int t = seg * 8 + i; const float bb = bl[i] + off;
              const float q = bf2f(QR[t * 72 + d_]), k = bf2f(KR[t * 72 + d_]);
              QE[t * 72 + d_] = f2bf(q * __expf(bb)); KE[t * 72 + d_] = f2bf(k * __expf(-bb)); kd[i] = k * __expf(tot - bb); }
          u32x4 wv; wv.x = pk2(kd[0], kd[1]); wv.y = pk2(kd[2], kd[3]); wv.z = pk2(kd[4], kd[5]); wv.w = pk2(kd[6], kd[7]);
          *(LAS u32x4*)(KDT + d_ * 72 + seg * 8) = wv; }
        __syncthreads();
#pragma unroll
        for (int r = 0; r < 2; ++r) { const int ti = w + 8 * r, jt = ti >> 2, it = ti & 3; f32x4 a = (f32x4){0.f, 0.f, 0.f, 0.f};
            if (jt <= it) {
#pragma unroll
                for (int kk = 0; kk < 2; ++kk) { const bf16x8 kf = *(const LAS bf16x8*)(KE + (16 * jt + fr) * 72 + kk * 32 + fq * 8), qf = *(const LAS bf16x8*)(QE + (16 * it + fr) * 72 + kk * 32 + fq * 8); a = mfma16(kf, qf, a); }
#pragma unroll
                for (int e = 0; e < 4; ++e) if (16 * jt + 4 * fq + e > 16 * it + fr) a[e] = 0.f;
            }
            *(LAS u32x2*)(PP + (16 * it + fr) * 72 + 16 * jt + 4 * fq) = pk4(a); }
        __syncthreads();
        bf16x8 vf[2], sf[2];
#pragma unroll
        for (int t = 0; t < 2; ++t) { vf[t] = *(const LAS bf16x8*)(VTl + (16 * w + fr) * 72 + 32 * t + 8 * fq); sf[t] = *(const LAS bf16x8*)(STb + (w * 16 + fr) * 72 + 32 * t + 8 * fq); }
#pragma unroll
        for (int it = 0; it < 4; ++it) { f32x4 a = (f32x4){0.f, 0.f, 0.f, 0.f};
#pragma unroll
            for (int t = 0; t < 2; ++t) { const bf16x8 pf = *(const LAS bf16x8*)(PP + (16 * it + fr) * 72 + 32 * t + 8 * fq), qf = *(const LAS bf16x8*)(QE + (16 * it + fr) * 72 + 32 * t + 8 * fq);
                a = mfma16(vf[t], pf, a); a = mfma16(sf[t], qf, a); }
            *(LAS f32x4*)(OT + (16 * it + fr) * 132 + 16 * w + 4 * fq) = a; }
#pragma unroll
        for (int dt = 0; dt < 4; ++dt) { S[dt] *= DEC[16 * dt + fr];
#pragma unroll
            for (int t = 0; t < 2; ++t) { const bf16x8 kf = *(const LAS bf16x8*)(KDT + (16 * dt + fr) * 72 + 32 * t + 8 * fq); S[dt] = mfma16(vf[t], kf, S[dt]); }
#pragma unroll
            for (int e = 0; e < 4; ++e) STb[(w * 16 + 4 * fq + e) * 72 + 16 * dt + fr] = f2bf(S[dt][e]); }
        __syncthreads();
        {
            const int i = tid >> 3, vs = tid & 7; f32x4 o[4]; float ss = 0.f;
#pragma unroll
            for (int k = 0; k < 4; ++k) { o[k] = *(const LAS f32x4*)(OT + i * 132 + vs * 16 + 4 * k); ss += o[k][0] * o[k][0] + o[k][1] * o[k][1] + o[k][2] * o[k][2] + o[k][3] * o[k][3]; }
            ss += __shfl_xor(ss, 1); ss += __shfl_xor(ss, 2); ss += __shfl_xor(ss, 4);
            const float rs = __builtin_amdgcn_rsqf(ss * (1.f / 128.f) + EPS);
            const unsigned rw[8] = {rr0.x, rr0.y, rr0.z, rr0.w, rr1.x, rr1.y, rr1.z, rr1.w};
#pragma unroll
            for (int k = 0; k < 4; ++k) { const f32x4 gv = *(const f32x4*)(gng + vs * 16 + 4 * k);
                f32x4 r; r[0] = __uint_as_float(rw[2 * k] << 16); r[1] = __uint_as_float(rw[2 * k] & 0xffff0000u); r[2] = __uint_as_float(rw[2 * k + 1] << 16); r[3] = __uint_as_float(rw[2 * k + 1] & 0xffff0000u);
                *(u32x2*)(yp + 4 * k) = pk4(o[k] * rs * gv * r); }
        }
    }
    float* so = p.out + (grp ? O_GLAS + (size_t)l * 262144 + ((size_t)b * 4 + h) * 8192 : O_GLAP + (size_t)l * 524288 + ((size_t)b * 4 + h) * 8192);
#pragma unroll
    for (int dt = 0; dt < 4; ++dt) *(f32x4*)(so + (size_t)(16 * dt + fr) * 128 + 16 * w + 4 * fq) = S[dt];
    __syncthreads();
}

DEV void s5_item(CP& p, int l, LAS unsigned char* lds, int grp, int b, int gq) {
    unsigned char* ws = p.ws;
    const int tid = tid_o(), w = tid >> 6, lane = tid & 63, fr = lane & 15, fq = lane >> 4;
    const int g = gq * 8 + w; const int T = grp ? 64 : 2048; const int rowbase = grp ? MTP + b * 64 : b * 2048;
    u16* X = (u16*)(ws + W_S5);
    LAS u16* HT = (LAS u16*)lds + w * 32 * 136;
    const float dt = __expf(p.in[16][l * 32 + g]);
    bf16x8 breF[4], bimF[4]; float ar[4], ai[4], a8r[4], a8i[4];
#pragma unroll
    for (int pt = 0; pt < 4; ++pt) { const int pp = 16 * pt + fr; const size_t gp = (size_t)(l * 32 + g) * 64 + pp;
        const float lr = p.in[14][gp], li = p.in[15][gp];
        const float mag = __expf(lr * dt), ang = li * dt * 0.15915494309189535f;
        const float r_ = mag * __builtin_amdgcn_cosf(ang), i_ = mag * __builtin_amdgcn_sinf(ang);
        ar[pt] = r_; ai[pt] = i_;
        float xr = r_, xi = i_;
#pragma unroll
        for (int k = 0; k < 3; ++k) { const float nr2 = xr * xr - xi * xi, ni2 = 2.f * xr * xi; xr = nr2; xi = ni2; }
        a8r[pt] = xr; a8i[pt] = xi;
        const float den = lr * lr + li * li, nr = r_ - 1.f, ni = i_;
        const float kr = (nr * lr + ni * li) / den, ki = (ni * lr - nr * li) / den;
        float vr[8], vi[8];
#pragma unroll
        for (int j = 0; j < 8; ++j) { float br = 0.f, bi = 0.f; if (fq < 2) { br = p.in[17][gp * 16 + fq * 8 + j]; bi = p.in[18][gp * 16 + fq * 8 + j]; }
            vr[j] = kr * br - ki * bi; vi[j] = kr * bi + ki * br; }
        u32x4 wr_, wi_; wr_.x = pk2(vr[0], vr[1]); wr_.y = pk2(vr[2], vr[3]); wr_.z = pk2(vr[4], vr[5]); wr_.w = pk2(vr[6], vr[7]);
        wi_.x = pk2(vi[0], vi[1]); wi_.y = pk2(vi[2], vi[3]); wi_.z = pk2(vi[4], vi[5]); wi_.w = pk2(vi[6], vi[7]);
        breF[pt] = __builtin_bit_cast(bf16x8, wr_); bimF[pt] = __builtin_bit_cast(bf16x8, wi_); }
    bf16x8 cF[4];
#pragma unroll
    for (int ks = 0; ks < 4; ++ks) { float v[8]; const int k0 = 32 * ks + 8 * fq;
#pragma unroll
        for (int j = 0; j < 8; ++j) { const int k = k0 + j; v[j] = k < 64 ? p.in[19][((size_t)(l * 32 + g) * 16 + fr) * 64 + k] : -p.in[20][((size_t)(l * 32 + g) * 16 + fr) * 64 + k - 64]; }
        u32x4 wv; wv.x = pk2(v[0], v[1]); wv.y = pk2(v[2], v[3]); wv.z = pk2(v[4], v[5]); wv.w = pk2(v[6], v[7]); cF[ks] = __builtin_bit_cast(bf16x8, wv); }
    const f32x4 dsk = *(const f32x4*)(p.in[21] + l * 512 + g * 16 + 4 * fq);
    float Hr[4], Hi[4];
#pragma unroll
    for (int pt = 0; pt < 4; ++pt) { if (grp) { const size_t sp = ((size_t)(l * 8 + b) * 32 + g) * 64 + 16 * pt + fr; Hr[pt] = p.in[4][sp]; Hi[pt] = p.in[5][sp]; } else { Hr[pt] = 0.f; Hi[pt] = 0.f; } }
    const int trow = 8 * (fr >> 2) + (fr & 3);
    u32x4 xn[2];
#pragma unroll
    for (int tt = 0; tt < 2; ++tt) { xn[tt] = (u32x4){0u, 0u, 0u, 0u}; if (fq < 2) xn[tt] = *(const u32x4*)(X + (size_t)(rowbase + trow + 4 * tt) * 512 + g * 16 + fq * 8); }
    for (int ch = 0; ch < T / 32; ++ch) {
        const int r0 = rowbase + ch * 32;
        bf16x8 xF[2];
#pragma unroll
        for (int tt = 0; tt < 2; ++tt) xF[tt] = __builtin_bit_cast(bf16x8, xn[tt]);
        if (ch + 1 < T / 32) {
#pragma unroll
            for (int tt = 0; tt < 2; ++tt) if (fq < 2) xn[tt] = *(const u32x4*)(X + (size_t)(r0 + 32 + trow + 4 * tt) * 512 + g * 16 + fq * 8); }
        u32x2 xsk[2];
#pragma unroll
        for (int t2 = 0; t2 < 2; ++t2) xsk[t2] = *(const u32x2*)(X + (size_t)(r0 + 16 * t2 + fr) * 512 + g * 16 + 4 * fq);
        f32x4 bur[2][4], bui[2][4];
#pragma unroll
        for (int tt = 0; tt < 2; ++tt)
#pragma unroll
            for (int pt = 0; pt < 4; ++pt) { bur[tt][pt] = mfma16(xF[tt], breF[pt], (f32x4){0.f, 0.f, 0.f, 0.f}); bui[tt][pt] = mfma16(xF[tt], bimF[pt], (f32x4){0.f, 0.f, 0.f, 0.f}); }
#pragma unroll
        for (int pt = 0; pt < 4; ++pt) {
            float er = 0.f, ei = 0.f;
#pragma unroll
            for (int k = 0; k < 8; ++k) { const float ur = bur[k >> 2][pt][k & 3], ui = bui[k >> 2][pt][k & 3]; const float nr = ar[pt] * er - ai[pt] * ei + ur, ni = ar[pt] * ei + ai[pt] * er + ui; er = nr; ei = ni; }
            float cr = Hr[pt], ci = Hi[pt], mr = cr, mi = ci;
#pragma unroll
            for (int q = 0; q < 4; ++q) { const float Er = __shfl(er, fr + 16 * q), Ei = __shfl(ei, fr + 16 * q);
                const float nr = a8r[pt] * cr - a8i[pt] * ci + Er, ni = a8r[pt] * ci + a8i[pt] * cr + Ei; cr = nr; ci = ni;
                if (q + 1 == fq) { mr = cr; mi = ci; } }
            Hr[pt] = cr; Hi[pt] = ci;
            float hr = mr, hi = mi;
#pragma unroll
            for (int k = 0; k < 8; ++k) { const float ur = bur[k >> 2][pt][k & 3], ui = bui[k >> 2][pt][k & 3]; const float nr = ar[pt] * hr - ai[pt] * hi + ur, ni = ar[pt] * hi + ai[pt] * hr + ui; hr = nr; hi = ni;
                HT[(8 * fq + k) * 136 + 16 * pt + fr] = f2bf(hr); HT[(8 * fq + k) * 136 + 64 + 16 * pt + fr] = f2bf(hi); }
        }
        asm volatile("s_waitcnt lgkmcnt(0)" ::: "memory");
        f32x4 y[2];
#pragma unroll
        for (int t2 = 0; t2 < 2; ++t2) { y[t2] = (f32x4){0.f, 0.f, 0.f, 0.f};
#pragma unroll
            for (int ks = 0; ks < 4; ++ks) { const bf16x8 hf = *(const LAS bf16x8*)(HT + (16 * t2 + fr) * 136 + 32 * ks + 8 * fq); y[t2] = mfma16(cF[ks], hf, y[t2]); } }
#pragma unroll
        for (int t2 = 0; t2 < 2; ++t2) { u16* xp = X + (size_t)(r0 + 16 * t2 + fr) * 512 + g * 16 + 4 * fq; const u32x2 xx = xsk[t2];
            f32x4 xv; xv[0] = __uint_as_float(xx.x << 16); xv[1] = __uint_as_float(xx.x & 0xffff0000u); xv[2] = __uint_as_float(xx.y << 16); xv[3] = __uint_as_float(xx.y & 0xffff0000u);
            f32x4 z = y[t2] + dsk * xv;
#pragma unroll
            for (int e = 0; e < 4; ++e) z[e] = fgelu(z[e]);
            *(u32x2*)xp = pk4(z); }
        asm volatile("" ::: "memory");
    }
    if (fq == 0) { float* ore = p.out + (grp ? O_SRES + (size_t)l * 16384 + ((size_t)b * 32 + g) * 64 : O_SREP + (size_t)l * 32768 + ((size_t)b * 32 + g) * 64);
        float* oim = p.out + (grp ? O_SIMS + (size_t)l * 16384 + ((size_t)b * 32 + g) * 64 : O_SIMP + (size_t)l * 32768 + ((size_t)b * 32 + g) * 64);
#pragma unroll
        for (int pt = 0; pt < 4; ++pt) { ore[16 * pt + fr] = Hr[pt]; oim[16 * pt + fr] = Hi[pt]; } }
    __syncthreads();
}

DEV void gmlp_item(CP& p, int l, LAS unsigned char* lds, int grp, int b, int n, int g) {
    unsigned char* ws = p.ws;
    const int tid = tid_o(), w = tid >> 6, lane = tid & 63, fr = lane & 15, fq = lane >> 4;
    const int L = grp ? 64 : 128, T = grp ? 64 : 2048; const int rowbase = grp ? MTP + b * 64 : b * 2048 + n * 128;
    LAS u16* WT = (LAS u16*)lds; LAS u16* GT = WT + 128 * 136; LAS float* RS = (LAS float*)(GT + 128 * 136);
    const float* rowsq = (const float*)(ws + W_ROWSQ);
    if (tid < L) RS[tid] = __builtin_amdgcn_rsqf(rowsq[rowbase + tid] * (1.f / 512.f) + EPS);
    const u16* GV = (const u16*)(ws + W_GVT) + (grp ? (size_t)16 * 512 * 2048 : 0) + ((size_t)b * 512 + g * 128) * T + (grp ? 0 : n * 128);
    const u16* WM = (const u16*)(ws + W_WM) + (size_t)g * 128 * 128;
    const int cshift = grp ? 3 : 4, nchunk = 128 << cshift, nwch = L << cshift;
    u16* P1 = (u16*)(ws + W_P1);
    u32x4 gq[4], wq[4];
#pragma unroll
    for (int i = 0; i < 4; ++i) { const int chn = tid + 512 * i; const int cg_ = chn < nchunk ? chn : 0, cw_ = chn < nwch ? chn : 0;
        gq[i] = *(const u32x4*)(GV + (size_t)(cg_ >> cshift) * T + (cg_ & ((1 << cshift) - 1)) * 8);
        wq[i] = *(const u32x4*)(WM + (size_t)(cw_ >> cshift) * 128 + (cw_ & ((1 << cshift) - 1)) * 8); }
    u32x2 uq[8]; float bq[8];
    const int ntt = L >> 4;
#pragma unroll
    for (int tt = 0; tt < 8; ++tt) { const int t = tt < ntt ? 16 * tt + fr : fr; uq[tt] = *(const u32x2*)(P1 + (size_t)(rowbase + t) * 1024 + g * 128 + 16 * w + 4 * fq); bq[tt] = p.in[13][(size_t)(l * 4 + g) * 128 + t]; }
    const f32x4 gvg = *(const f32x4*)(p.in[11] + l * 512 + g * 128 + 16 * w + 4 * fq);
    __syncthreads();
#pragma unroll
    for (int i = 0; i < 4; ++i) { const int chn = tid + 512 * i;
        if (chn < nchunk) { const int c = chn >> cshift, kp = (chn & ((1 << cshift) - 1)) * 8; const unsigned gw[4] = {gq[i].x, gq[i].y, gq[i].z, gq[i].w}; u32x4 o;
            unsigned ow[4];
#pragma unroll
            for (int k = 0; k < 4; ++k) ow[k] = pk2(__uint_as_float(gw[k] << 16) * RS[kp + 2 * k], __uint_as_float(gw[k] & 0xffff0000u) * RS[kp + 2 * k + 1]);
            o.x = ow[0]; o.y = ow[1]; o.z = ow[2]; o.w = ow[3]; *(LAS u32x4*)(GT + c * 136 + kp) = o; }
        if (chn < nwch) { const int t = chn >> cshift, kp = (chn & ((1 << cshift) - 1)) * 8; *(LAS u32x4*)(WT + t * 136 + kp) = wq[i]; } }
    __syncthreads();
#pragma unroll
    for (int tt = 0; tt < 8; ++tt) { if (tt < ntt) { f32x4 a = (f32x4){0.f, 0.f, 0.f, 0.f};
        for (int ks = 0; ks < L / 32; ++ks) { if (32 * ks > 16 * tt + 15) break;
            const bf16x8 gf = *(const LAS bf16x8*)(GT + (16 * w + fr) * 136 + 32 * ks + 8 * fq), wf = *(const LAS bf16x8*)(WT + (16 * tt + fr) * 136 + 32 * ks + 8 * fq); a = mfma16(gf, wf, a); }
        const int t = 16 * tt + fr;
        f32x4 u; u[0] = __uint_as_float(uq[tt].x << 16); u[1] = __uint_as_float(uq[tt].x & 0xffff0000u); u[2] = __uint_as_float(uq[tt].y << 16); u[3] = __uint_as_float(uq[tt].y & 0xffff0000u);
        *(u32x2*)(P1 + (size_t)(rowbase + t) * 1024 + g * 128 + 16 * w + 4 * fq) = pk4(u * (a * gvg + bq[tt])); } }
    if (grp) {
        float* o = p.out + O_GMV + (size_t)l * 262144 + (size_t)b * 64 * 512; const float* gg = p.in[11] + l * 512 + g * 128;
        for (int idx = tid; idx < 64 * 128; idx += 512) { const int t = idx >> 7, c = idx & 127; o[(size_t)t * 512 + g * 128 + c] = bf2f(GT[c * 136 + t]) * gg[c]; }
    }
    __syncthreads();
}

DEV void phaseMix(CP& p, int l, LAS unsigned char* lds) {
    unsigned* ctr = (unsigned*)(p.ws + W_MISC) + l;
    LAS int* slot = (LAS int*)(lds + 160 * 1024 - 16);
    for (;;) {
        if (tid_o() == 0) *slot = (int)atomicAdd(ctr, 1u);
        __syncthreads();
        int it = __builtin_amdgcn_readfirstlane(*slot);
        __syncthreads();
        if (it >= 2304) break;
        int kind, grp = 0, a0, a1, a2 = 0;
        if (it < 64) { kind = 0; a0 = it >> 2; a1 = it & 3; }
        else if (it < 128) { it -= 64; kind = 1; a0 = it >> 2; a1 = it & 3; }
        else if (it < 160) { it -= 128; kind = 2; grp = 1; a0 = it >> 2; a1 = it & 3; }
        else if (it < 1184) { it -= 160; kind = 2; a2 = 15 - (it >> 6); a0 = (it & 63) >> 2; a1 = it & 3; }
        else if (it < 2208) { it -= 1184; kind = 3; a0 = it >> 6; a2 = (it >> 2) & 15; a1 = it & 3; }
        else if (it < 2240) { it -= 2208; kind = 0; grp = 1; a0 = it >> 2; a1 = it & 3; }
        else if (it < 2272) { it -= 2240; kind = 1; grp = 1; a0 = it >> 2; a1 = it & 3; }
        else { it -= 2272; kind = 3; grp = 1; a0 = it >> 2; a1 = it & 3; }
        asm volatile("" : "+s"(kind), "+s"(grp), "+s"(a0), "+s"(a1), "+s"(a2));
        if (kind == 0) {
#ifndef NO_S5
            s5_item(p, l, lds, grp, a0, a1);
#endif
        } else if (kind == 1) {
#ifndef NO_GLA
#ifdef GLA_SAMPLE_ONLY
            if (grp)
#endif
            gla_item(p, l, lds, grp, a0, a1);
#endif
        } else if (kind == 2) {
#ifndef NO_ATT
            attn_item(p, l, lds, grp, a0, a1, a2);
#endif
        } else {
#ifndef NO_GMLP
            gmlp_item(p, l, lds, grp, a0, a2, a1);
#endif
        }
    }
}

DEV void phaseFix(CP& p, int l) {
    unsigned char* ws = p.ws; const int gt = bid_o() * 512 + tid_o(), GT = gridDim.x * 512;
    const float* HEAD = (const float*)(ws + W_HEAD); const float* TAIL = (const float*)(ws + W_TAIL); u16* ACT = (u16*)(ws + W_ACT);
    const float* cw = p.in[35] + (size_t)l * 3 * 5632; const float* cb = p.in[36] + (size_t)l * 5632;
    for (int idx = gt; idx < 520 * 2816; idx += GT) { const int slab = idx / 2816, f = idx % 2816;
        float c0[2], c1[2];
#pragma unroll
        for (int bj = 0; bj < 2; ++bj) { const int ff = bj * 2816 + f; float pm2 = 0.f, pm1 = 0.f;
            if (slab >= 512) { const float* st = p.in[7] + ((size_t)(l * 8 + (slab - 512)) * 2) * 5632; pm2 = st[ff]; pm1 = st[5632 + ff]; }
            else if (slab & 31) { pm2 = TAIL[((size_t)(slab - 1) * 2) * 5632 + ff]; pm1 = TAIL[((size_t)(slab - 1) * 2 + 1) * 5632 + ff]; }
            const float h0 = HEAD[((size_t)slab * 2) * 5632 + ff], h1 = HEAD[((size_t)slab * 2 + 1) * 5632 + ff];
            const float w0 = cw[ff], w1 = cw[5632 + ff], w2 = cw[11264 + ff], bb = cb[ff];
            c0[bj] = bb + w0 * pm2 + w1 * pm1 + w2 * h0; c1[bj] = bb + w0 * pm1 + w1 * h0 + w2 * h1; }
        ACT[(size_t)(slab * 64) * 2816 + f] = f2bf(fsilu(c0[0]) * c0[1]); ACT[(size_t)(slab * 64 + 1) * 2816 + f] = f2bf(fsilu(c1[0]) * c1[1]); }
    for (int idx = gt; idx < 24 * 2 * 5632; idx += GT) { const int bb = idx / 11264, rem = idx % 11264;
        if (bb < 16) p.out[O_FCP + (size_t)l * 180224 + (size_t)bb * 11264 + rem] = TAIL[((size_t)(bb * 32 + 31) * 2) * 5632 + rem];
        else p.out[O_FCS + (size_t)l * 90112 + (size_t)(bb - 16) * 11264 + rem] = TAIL[((size_t)(512 + bb - 16) * 2) * 5632 + rem]; }
}

#define XB_TMO      128
#define XB_XCNT(j)  (256  + 64 * (j))
#define XB_XSUB(j)  (1280 + 64 * (j))
#define XB_XGEN(j)  (2304 + 64 * (j))
#define XB_TOP      3328
#define XB_TOPGEN   3392
#define XCD_BAR_WORDS 3456
#define XB_SPIN_CAP (1u << 18)

__device__ __forceinline__ unsigned xb_ld(unsigned* p)              { return __hip_atomic_load(p, __ATOMIC_RELAXED, __HIP_MEMORY_SCOPE_AGENT); }
__device__ __forceinline__ unsigned xb_add(unsigned* p, unsigned v) { return __hip_atomic_fetch_add(p, v, __ATOMIC_RELAXED, __HIP_MEMORY_SCOPE_AGENT); }
__device__ __forceinline__ unsigned xb_xcc_id() { return (unsigned)__builtin_amdgcn_s_getreg((3 << 11) | 20) & 0xFu; }
#define XB_SPIN(cond, bar) do { unsigned _sp = 0; while (cond) { __builtin_amdgcn_s_sleep(1); \
    if ((++_sp & 255u) == 0u) { if (xb_ld(&(bar)[XB_TMO])) break; if (_sp > XB_SPIN_CAP) { atomicAdd(&(bar)[XB_TMO], 1u); break; } } } } while (0)

struct XcdBarrier {
    unsigned* bar; unsigned x;
    volatile LAS unsigned* st;
};

__device__ __forceinline__ XcdBarrier xcd_barrier_post(unsigned* bar, volatile LAS unsigned* st) {
    XcdBarrier b; b.bar = bar; b.x = xb_xcc_id(); b.st = st;
    if (threadIdx.x == 0) (void)xb_add(&bar[XB_XCNT(b.x)], 1u);
    return b;
}
__device__ __forceinline__ void xcd_barrier_complete(unsigned* bar, unsigned x, unsigned& nloc, unsigned& nx) {
    const unsigned G = gridDim.x * gridDim.y * gridDim.z;
    unsigned sum, cnt, mine, sp = 0u;
    for (;;) {
        sum = 0u; cnt = 0u; mine = 0u;
#pragma unroll
        for (unsigned j = 0; j < 16; ++j) { const unsigned c = xb_ld(&bar[XB_XCNT(j)]); sum += c; cnt += (c > 0u) ? 1u : 0u; mine = (j == x) ? c : mine; }
        if (sum == G) break;
        __builtin_amdgcn_s_sleep(1);
        if ((++sp & 255u) == 0u) { if (xb_ld(&bar[XB_TMO])) break; if (sp > XB_SPIN_CAP) { atomicAdd(&bar[XB_TMO], 1u); break; } }
    }
    nloc = mine > 0u ? mine : 1u; nx = cnt > 0u ? cnt : 1u;
}

__device__ __forceinline__ void xcd_barrier(const XcdBarrier& b) {
    asm volatile("s_waitcnt vmcnt(0)" ::: "memory");
    __syncthreads();
    if (threadIdx.x == 0) {
        unsigned* bar = b.bar;
        __builtin_amdgcn_s_waitcnt(0);
        unsigned nloc = b.st[0], nx = b.st[1];
        if (nloc == 0u) { xcd_barrier_complete(bar, b.x, nloc, nx); b.st[0] = nloc; b.st[1] = nx; }
        const unsigned old = xb_add(&bar[XB_XSUB(b.x)], 1u);
        const unsigned gen = old / nloc;
        if (old + 1u == (gen + 1u) * nloc) {
            __builtin_amdgcn_fence(__ATOMIC_RELEASE, "agent");
            asm volatile("s_waitcnt vmcnt(0)" ::: "memory");
            const unsigned og = xb_add(&bar[XB_TOP], 1u);
            const unsigned tg = og / nx;
            if (og + 1u == (tg + 1u) * nx) xb_add(&bar[XB_TOPGEN], 1u);
            else XB_SPIN(xb_ld(&bar[XB_TOPGEN]) == tg, bar);
            __builtin_amdgcn_fence(__ATOMIC_ACQUIRE, "agent");
            xb_add(&bar[XB_XGEN(b.x)], 1u);
            asm volatile("s_waitcnt vmcnt(0)" ::: "memory");
        } else {
            XB_SPIN(xb_ld(&bar[XB_XGEN(b.x)]) == gen, bar);
            __builtin_amdgcn_fence(__ATOMIC_ACQUIRE, "agent");
            asm volatile("s_waitcnt vmcnt(0)" ::: "memory");
        }
    }
    __syncthreads();
}


__global__ void __launch_bounds__(512, 2) mega(Params p_unused) {
    extern __shared__ __attribute__((aligned(16))) unsigned char smem[];
    LAS unsigned char* lds = (LAS unsigned char*)smem;
    cg::grid_group grid = cg::this_grid();
    volatile LAS unsigned* xb_st = (volatile LAS unsigned*)(lds + 160 * 1024 - 32);
    if (threadIdx.x == 0) { xb_st[0] = 0u; xb_st[1] = 0u; }
    __syncthreads();
    const XcdBarrier xbar = xcd_barrier_post((unsigned*)(((CP*)__builtin_amdgcn_kernarg_segment_ptr())->ws + W_BAR), xb_st);
#define GSYNC() xcd_barrier(xbar)
#pragma unroll 1
    for (int l = 0; l < 2; ++l) {
        CP* pp = (CP*)__builtin_amdgcn_kernarg_segment_ptr(); asm volatile("" : "+s"(pp)); CP& p = *pp; unsigned char* ws = p.ws; const int G = gridDim.x, c = bid_o();
#ifndef SKIP_A
        phaseA(p, l);
#endif
        if (l == 0) grid.sync(); else GSYNC();
#ifndef SKIP_B
        {
            pg8::PlainSched S; S.T.init(130, NMIX, G, c); S.A = (const char*)ws + W_H; S.B = (const char*)ws + W_WIN; S.ld = 1024; S.nt = 16;
            EpiIn E; E.l = l; E.out = p.out; E.ws = ws; E.qg = p.in[27] + l * 64; E.kg = p.in[28] + l * 64; E.rs1 = (const float*)(ws + W_RS) + (size_t)(l * 2) * MT;
            pg8::gemm_phase(lds, 1024, S, E);
        }
#endif
        GSYNC();
#ifndef SKIP_C
        phaseMix(p, l, lds);
#endif
        GSYNC();
#ifndef SKIP_D
        {
            pg8::PlainSched S; S.T.init(130, 2, G, c); S.A = (const char*)ws + W_S5; S.B = (const char*)ws + W_WGLU; S.ld = 512; S.nt = 8;
            EpiGlu E; E.ws = ws; E.bias = p.in[23] + l * 512;
            pg8::gemm_phase(lds, 512, S, E);
        }
#endif
        GSYNC();
#ifndef SKIP_E
        {
            MergeSched S; S.T.init(128, 4, G, c); S.ws = ws;
            EpiMerge E; E.ws = ws; E.bgate = p.in[10] + l * 4096; E.rs1 = (const float*)(ws + W_RS) + (size_t)(l * 2) * MT;
            pg8::gemm_phase(lds, 1024, S, E);
        }
#endif
        GSYNC();
        {
            const f32x4* mf = (const f32x4*)(ws + W_MFS); u16* mg = (u16*)(ws + W_MERGED) + (size_t)MTP * 1024;
            for (int i = c * 512 + tid_o(); i < 512 * 256; i += G * 512) *(u32x2*)(mg + (size_t)i * 4) = pk4(mf[i]);
        }
        GSYNC();
#ifndef SKIP_F
        {
            pg8::TailSched S; S.T.init(128, 4, G, c); S.A = (const char*)ws + W_MERGED; S.B = (const char*)ws + W_WOUT; S.ld = 1024; S.nt = 16; S.npiece = 4; S.ntp = 4;
            EpiRes E; E.xin = l == 0 ? p.in[0] : nullptr; E.xb = (u16*)(ws + W_H); E.yout = nullptr; E.rsacc = (float*)(ws + W_RS) + (size_t)(l * 2 + 1) * MT; E.yfull = (float*)(ws + W_PART);
            pg8::gemm_phase(lds, 1024, S, E);
        }
#endif
        GSYNC();
#ifndef SKIP_G
        sample_rows_reduce(p.out + (size_t)MTP * 1024, (const float*)(ws + W_PART), 4, (u16*)(ws + W_H) + (size_t)MTP * 1024, (float*)(ws + W_RS) + (size_t)(l * 2 + 1) * MT + MTP);
#endif
        GSYNC();
#ifndef SKIP_H
        {
            pg8::PlainSched S; S.T.init(130, 22, G, c); S.A = (const char*)ws + W_H; S.B = (const char*)ws + W_WUP; S.ld = 1024; S.nt = 16;
            EpiUp E; E.ws = ws; E.cw = p.in[35] + (size_t)l * 3 * 5632; E.cbias = p.in[36] + (size_t)l * 5632; E.rs2 = (const float*)(ws + W_RS) + (size_t)(l * 2 + 1) * MT;
            pg8::gemm_phase(lds, 1024, S, E);
        }
#endif
        GSYNC();
#ifndef SKIP_I
        phaseFix(p, l);
#endif
        GSYNC();
#ifndef SKIP_J
        {
            pg8::TailSched S; S.T.init(128, 4, G, c); S.A = (const char*)ws + W_ACT; S.B = (const char*)ws + W_WDN; S.ld = 2816; S.nt = 44; S.npiece = 11; S.ntp = 4;
            EpiRes E; E.xin = nullptr; E.xb = (u16*)(ws + W_H); E.yout = l == 1 ? p.out : nullptr; E.rsacc = l == 0 ? (float*)(ws + W_RS) + (size_t)2 * MT : nullptr; E.yfull = (float*)(ws + W_PART);
            pg8::gemm_phase(lds, 2816, S, E);
        }
#endif
        GSYNC();
        if (l == 1) sample_rows_reduce(p.out + (size_t)MTP * 1024, (const float*)(ws + W_PART), 11, (u16*)(ws + W_H) + (size_t)MTP * 1024, (float*)(ws + W_RS) + (size_t)3 * MT + MTP);
    }
}

extern "C" void kernel_launch(void* const* d_in, const int* in_sizes, int n_in, void* d_out, int out_size, void* d_ws, size_t ws_size, hipStream_t stream) {
    constexpr int LDS_BYTES = 160 * 1024;
    static int grid_blocks = 0;
    if (!grid_blocks) {
        int dev = 0, cus = 0, per_cu = 0;
        hipGetDevice(&dev);
        hipDeviceGetAttribute(&cus, hipDeviceAttributeMultiprocessorCount, dev);
        hipFuncSetAttribute((const void*)mega, hipFuncAttributeMaxDynamicSharedMemorySize, LDS_BYTES);
        hipOccupancyMaxActiveBlocksPerMultiprocessor(&per_cu, (const void*)mega, 512, LDS_BYTES);
        if (per_cu < 1) per_cu = 1;
        grid_blocks = cus * per_cu;
        if (ws_size < W_END) fprintf(stderr, "kernel_launch: workspace too small: %zu < %zu\n", ws_size, (size_t)W_END);
    }
    Params p{};
    for (int i = 0; i < 38; ++i) p.in[i] = (const float*)d_in[i];
    p.out = (float*)d_out; p.ws = (unsigned char*)d_ws;
    (void)hipMemsetAsync((unsigned char*)d_ws + W_BAR, 0, 16384, stream);
    void* args[] = {&p};
    hipError_t e = hipLaunchCooperativeKernel((const void*)mega, dim3(grid_blocks), dim3(512), args, LDS_BYTES, stream);
    if (e != hipSuccess) fprintf(stderr, "cooperative launch failed: %s (grid %d)\n", hipGetErrorString(e), grid_blocks);
}
```

```cpp
#include <hip/hip_runtime.h>
#include <hip/hip_cooperative_groups.h>
#include <cstdio>
namespace cg = cooperative_groups;

#define LAS __attribute__((address_space(3)))
#define DEV __device__ __forceinline__
typedef unsigned short u16;
typedef short bf16x8 __attribute__((ext_vector_type(8)));
typedef float f32x4 __attribute__((ext_vector_type(4)));
typedef float f32x2 __attribute__((ext_vector_type(2)));
typedef unsigned u32x4 __attribute__((ext_vector_type(4)));
typedef unsigned u32x2 __attribute__((ext_vector_type(2)));

constexpr int MTP = 32768, MT = 33280;
constexpr int NINP = 8960;
constexpr int NMIX = 19;
constexpr int GATE0 = 4864;
constexpr float EPS = 1e-6f;
constexpr float LOG2E = 1.4426950408889634f;

constexpr size_t O_Y = 0, O_DKP = 34078720, O_DVP = 67633152, O_SREP = 101187584, O_SIMP = 101253120, O_GLAP = 101318656,
                 O_FCP = 102367232, O_DKS = 102727680, O_DVS = 103251968, O_SRES = 103776256, O_SIMS = 103809024, O_GLAS = 103841792,
                 O_FCS = 104366080, O_GMV = 104546304;

constexpr size_t SZ_H = (size_t)MT * 1024 * 2;
constexpr size_t SZ_HALF = (size_t)MT * 512 * 2;
constexpr size_t W_H = 0;
constexpr size_t W_P1 = W_H + SZ_H;
constexpr size_t W_P2 = W_P1 + SZ_H;
constexpr size_t W_S5 = W_P2 + SZ_H;
constexpr size_t W_GVT = W_S5 + SZ_HALF;
constexpr size_t W_CQ = W_GVT + SZ_HALF;
constexpr size_t W_CK = W_CQ + SZ_HALF / 2;
constexpr size_t W_CVT = W_CK + SZ_HALF / 2;
constexpr size_t W_CODE = W_CVT + SZ_HALF;
constexpr size_t W_DKP = W_CODE + (size_t)MT * 16 * 4;
constexpr size_t W_DKS = W_DKP + (size_t)MTP * 512 * 2;
constexpr size_t W_DVTP = W_DKS + (size_t)8 * 4160 * 512 * 2;
constexpr size_t W_DVTS = W_DVTP + (size_t)MTP * 512 * 2;
constexpr size_t W_ROWSQ = W_DVTS + (size_t)8 * 4160 * 512 * 2;
constexpr size_t W_MISC = W_ROWSQ + (size_t)MT * 4;
constexpr size_t W_WIN = W_MISC + 4096;
constexpr size_t W_WBR = W_WIN + (size_t)NINP * 1024 * 2;
constexpr size_t W_WOUT = W_WBR + (size_t)2 * 1024 * 1024 * 2;
constexpr size_t W_WGLU = W_WOUT + (size_t)1024 * 1024 * 2;
constexpr size_t W_WUP = W_WGLU + (size_t)512 * 512 * 2;
constexpr size_t W_WDN = W_WUP + (size_t)5632 * 1024 * 2;
constexpr size_t W_MFS = W_WDN + (size_t)1024 * 2816 * 2;
constexpr size_t W_BAR = W_MFS + (size_t)512 * 1024 * 4;
constexpr size_t W_WM = W_BAR + 16384;
constexpr size_t W_RS = W_WM + (size_t)4 * 128 * 128 * 2;
constexpr size_t W_PART = W_RS + (size_t)4 * MT * 4;
constexpr size_t W_END = W_PART + (size_t)11 * 512 * 1024 * 4;
constexpr size_t W_MERGED = W_CQ;
constexpr size_t W_SCR = W_DKP;
constexpr size_t W_ACT = W_P1;
constexpr size_t W_HEAD = W_DVTP;
constexpr size_t W_TAIL = W_HEAD + (size_t)520 * 2 * 5632 * 4;
static_assert(W_TAIL + (size_t)520 * 2 * 5632 * 4 <= W_ROWSQ, "head/tail alias");
static_assert((size_t)MT * 2816 * 2 <= W_CQ - W_P1, "act alias");

struct Params { const float* in[38]; float* out; unsigned char* ws; };
typedef const __attribute__((address_space(4))) Params CP;

DEV int tid_o() { int t = threadIdx.x; asm volatile("" : "+v"(t)); return t; }
DEV int bid_o() { int t = blockIdx.x; asm volatile("" : "+s"(t)); return t; }
DEV float bf2f(u16 v) { return __uint_as_float(((unsigned)v) << 16); }
typedef __bf16 b16x2 __attribute__((ext_vector_type(2)));
DEV unsigned pk2(float lo, float hi) { const f32x2 v = {lo, hi}; const b16x2 r = __builtin_convertvector(v, b16x2); return __builtin_bit_cast(unsigned, r); }
DEV u16 f2bf(float v) { return (u16)(pk2(v, 0.f) & 0xffffu); }
DEV float fsigmoid(float x) { return __builtin_amdgcn_rcpf(1.f + __expf(-x)); }
DEV float fsilu(float x) { return x * fsigmoid(x); }
DEV float fgelu(float x) { return x * fsigmoid(1.5957691216057308f * (x + 0.044715f * x * x * x)); }
DEV float flogsig(float x) { return fminf(x, 0.f) - __logf(1.f + __expf(-fabsf(x))); }
DEV f32x4 mfma16(bf16x8 a, bf16x8 b, f32x4 c) { return __builtin_amdgcn_mfma_f32_16x16x32_bf16(a, b, c, 0, 0, 0); }
DEV u32x2 pk4(f32x4 v) { u32x2 r; r.x = pk2(v[0], v[1]); r.y = pk2(v[2], v[3]); return r; }
DEV float red_fq(float v) { v += __shfl_xor(v, 16); v += __shfl_xor(v, 32); return v; }
DEV float wave_sum(float v) { for (int o = 32; o; o >>= 1) v += __shfl_xor(v, o); return v; }

namespace pg8 {
constexpr int BM = 256, BK = 64, HALF = 128, HTB = HALF * BK * 2, NXCD = 8, WGM = 8;
DEV int lds_byte(int r, int c) { const int st = (r >> 4) * 2 + (c >> 5), rr = r & 15, cc = c & 31, ob = rr * 64 + cc * 2; return st * 1024 + (ob ^ (((ob >> 9) & 1) << 5)); }
DEV void stage_rc(int b, int& R, int& C) { const int st = b / 1024, sb = b % 1024, swz = sb ^ (((sb >> 9) & 1) << 5); R = (st >> 1) * 16 + swz / 64; C = (st & 1) * 32 + (swz % 64) / 2; }
struct GUnit { const char* A; const char* B; int nt, pm, pn, kind; };
struct TileOrder {
    int nM, nN, nwg, G, c;
    DEV void init(int nM_, int nN_, int G_, int c_) { nM = nM_; nN = nN_; nwg = nM * nN; G = G_; c = c_; }
    DEV bool tile(int i, int& pm, int& pn) const {
        const long L = (long)i * G + c; if (L >= nwg) return false;
        int wgid = (int)L; { const int q = nwg / NXCD, r = nwg % NXCD, xcd = wgid % NXCD, off = wgid / NXCD; wgid = (xcd < r ? xcd * (q + 1) : r * (q + 1) + (xcd - r) * q) + off; }
        const int nig = WGM * nN, gid = wgid / nig, fm = gid * WGM, gsz = (nM - fm) < WGM ? (nM - fm) : WGM;
        pm = fm + ((wgid % nig) % gsz); pn = (wgid % nig) / gsz; return true;
    }
};
struct TailSched {
    TileOrder T; const char* A; const char* B; int ld, nt, npiece, ntp;
    DEV bool next(int i, GUnit& u) const { int pm, pn;
        if (T.tile(i, pm, pn)) { u.pm = pm; u.pn = pn; u.kind = 0; u.nt = nt; u.A = A + (size_t)pm * 256 * ld * 2; u.B = B + (size_t)pn * 256 * ld * 2; return true; }
        const int i0 = (T.nwg - T.c + T.G - 1) / T.G; const int j = (i - i0) * T.G + T.c; if (j >= 8 * npiece) return false;
        const int tile = j / npiece, kp = j % npiece; pm = 128 + (tile >> 2); pn = tile & 3; u.pm = pm; u.pn = pn; u.kind = 1 + kp; u.nt = ntp;
        u.A = A + (size_t)pm * 256 * ld * 2 + (size_t)kp * ntp * 128; u.B = B + (size_t)pn * 256 * ld * 2 + (size_t)kp * ntp * 128; return true; }
};
struct PlainSched {
    TileOrder T; const char* A; const char* B; int ld, nt;
    DEV bool next(int i, GUnit& u) const { int pm, pn; if (!T.tile(i, pm, pn)) return false; u.pm = pm; u.pn = pn; u.kind = 0; u.nt = nt;
        u.A = A + (size_t)pm * 256 * ld * 2; u.B = B + (size_t)pn * 256 * ld * 2; return true; }
};

template <class Epi, class Sched>
DEV void gemm_phase(LAS unsigned char* lds, const int ld, const Sched& S, const Epi& E) {
    const int tid = tid_o(), wid = __builtin_amdgcn_readfirstlane(tid >> 6), lane = tid & 63, wr = wid >> 2, wc = wid & 3, fr = lane & 15, fq = lane >> 4;
    unsigned voff[2];
#pragma unroll
    for (int i = 0; i < 2; ++i) { int R, C; stage_rc(tid * 16 + i * 8192, R, C); voff[i] = (unsigned)(R * ld + C) * 2u; }
    const size_t kstep = (size_t)(BK * 2);
    const size_t hstep = (size_t)HALF * ld * 2;
    const unsigned ldsw = (unsigned)wid * 1024u;
    const int aoff = lds_byte(wr * 64 + fr, fq * 8), boff = lds_byte(wc * 32 + fr, fq * 8);
#define PG8_SA(b, h) (((b) * 2 + (h)) * HTB)
#define PG8_SB(b, h) ((4 + (b) * 2 + (h)) * HTB)
#define PG8_STAGE(bufoff, gbase) do { _Pragma("unroll") for (int _i = 0; _i < 2; ++_i) \
        __builtin_amdgcn_global_load_lds((const unsigned*)((const char*)(gbase) + voff[_i]), (LAS unsigned*)(lds + (bufoff) + ldsw + _i * 8192), 16, 0, 0); } while (0)
#define PG8_LDA(dst, b, h) do { _Pragma("unroll") for (int m = 0; m < 4; ++m) _Pragma("unroll") for (int k = 0; k < 2; ++k) dst[m][k] = *(const LAS bf16x8*)(lds + PG8_SA(b, h) + aoff + m * 2048 + k * 1024); } while (0)
#define PG8_LDB(dst, b, h) do { _Pragma("unroll") for (int n = 0; n < 2; ++n) _Pragma("unroll") for (int k = 0; k < 2; ++k) dst[n][k] = *(const LAS bf16x8*)(lds + PG8_SB(b, h) + boff + n * 2048 + k * 1024); } while (0)
#define PG8_MMA(ai, bj, At, Bt) do { __builtin_amdgcn_s_setprio(1); _Pragma("unroll") for (int m = 0; m < 4; ++m) _Pragma("unroll") for (int n = 0; n < 2; ++n) _Pragma("unroll") for (int k = 0; k < 2; ++k) \
        acc[ai][bj][m][n] = __builtin_amdgcn_mfma_f32_16x16x32_bf16(Bt[n][k], At[m][k], acc[ai][bj][m][n], 0, 0, 0); __builtin_amdgcn_s_setprio(0); } while (0)
#define PG8_WAIT_V(n) asm volatile("s_waitcnt vmcnt(" #n ")" ::: "memory")
#define PG8_WAIT_L(n) asm volatile("s_waitcnt lgkmcnt(" #n ")" ::: "memory")
#define PG8_BAR __builtin_amdgcn_s_barrier()
#define PG8_SCHED __builtin_amdgcn_sched_barrier(0)
    GUnit cur, nxt; int ui = 0;
    if (!S.next(0, cur)) return;
    f32x4 acc[2][2][4][2];
#pragma unroll
    for (int a = 0; a < 2; ++a)
#pragma unroll
        for (int b = 0; b < 2; ++b)
#pragma unroll
            for (int m = 0; m < 4; ++m)
#pragma unroll
                for (int n = 0; n < 2; ++n) acc[a][b][m][n] = (f32x4){0.f, 0.f, 0.f, 0.f};
    bf16x8 At[4][2], B0[2][2], B1[2][2];
    const char* cA = cur.A; const char* cB = cur.B;
    PG8_STAGE(PG8_SB(0, 0), cB); PG8_STAGE(PG8_SA(0, 0), cA); PG8_STAGE(PG8_SB(0, 1), cB + hstep); PG8_STAGE(PG8_SA(0, 1), cA + hstep);
    if (wr == 1) PG8_BAR;
    PG8_WAIT_V(4); PG8_BAR;
    PG8_STAGE(PG8_SB(1, 0), cB + kstep); PG8_STAGE(PG8_SA(1, 0), cA + kstep); PG8_STAGE(PG8_SB(1, 1), cB + hstep + kstep);
    PG8_WAIT_V(6); PG8_BAR;
    for (;;) {
        const bool has_next = S.next(ui + 1, nxt);
        const char* nA = has_next ? nxt.A : cA; const char* nB = has_next ? nxt.B : cB;
        const int nt = cur.nt;
        for (int t = 0; t < nt; t += 2) {
            const bool last = (t == nt - 2);
            const char* a1 = cA + (size_t)(t + 1) * kstep;
            const char* a2 = last ? nA : cA + (size_t)(t + 2) * kstep; const char* b2 = last ? nB : cB + (size_t)(t + 2) * kstep;
            const char* a3 = a2 + kstep; const char* b3 = b2 + kstep;
            PG8_LDB(B0, 0, 0); PG8_SCHED; PG8_LDA(At, 0, 0); PG8_STAGE(PG8_SA(1, 1), a1 + hstep);
            PG8_WAIT_L(8); PG8_BAR; PG8_WAIT_L(0); PG8_MMA(0, 0, At, B0); PG8_BAR; PG8_SCHED;
            PG8_LDB(B1, 0, 1); PG8_STAGE(PG8_SB(0, 0), b2);
            PG8_BAR; PG8_WAIT_L(0); PG8_MMA(0, 1, At, B1); PG8_BAR;
            PG8_LDA(At, 0, 1); PG8_STAGE(PG8_SA(0, 0), a2);
            PG8_BAR; PG8_WAIT_L(0); PG8_MMA(1, 0, At, B0); PG8_BAR; PG8_SCHED;
            PG8_STAGE(PG8_SB(0, 1), b2 + hstep);
            PG8_WAIT_V(6); PG8_BAR; PG8_MMA(1, 1, At, B1); PG8_BAR;
            PG8_LDB(B0, 1, 0); PG8_SCHED; PG8_LDA(At, 1, 0); PG8_STAGE(PG8_SA(0, 1), a2 + hstep);
            PG8_WAIT_L(8); PG8_BAR; PG8_WAIT_L(0); PG8_MMA(0, 0, At, B0); PG8_BAR; PG8_SCHED;
            PG8_LDB(B1, 1, 1); PG8_STAGE(PG8_SB(1, 0), b3);
            PG8_BAR; PG8_WAIT_L(0); PG8_MMA(0, 1, At, B1); PG8_BAR;
            PG8_LDA(At, 1, 1); PG8_STAGE(PG8_SA(1, 0), a3);
            PG8_BAR; PG8_WAIT_L(0); PG8_MMA(1, 0, At, B0); PG8_BAR; PG8_SCHED;
            PG8_STAGE(PG8_SB(1, 1), b3 + hstep);
            PG8_WAIT_V(6); PG8_BAR; PG8_MMA(1, 1, At, B1); PG8_BAR;
        }
        { int fr_ = fr, fq_ = fq, wr_ = wr, wc_ = wc; asm volatile("" : "+v"(fr_), "+v"(fq_), "+s"(wr_), "+s"(wc_));
          E(acc, cur, wr_, wc_, fr_, fq_); }
        if (!has_next) break;
#pragma unroll
        for (int a = 0; a < 2; ++a)
#pragma unroll
            for (int b = 0; b < 2; ++b)
#pragma unroll
                for (int m = 0; m < 4; ++m)
#pragma unroll
                    for (int n = 0; n < 2; ++n) acc[a][b][m][n] = (f32x4){0.f, 0.f, 0.f, 0.f};
        cur = nxt; cA = nA; cB = nB; ++ui;
    }
    PG8_WAIT_V(0);
    if (wr == 0) PG8_BAR;
    PG8_BAR;
#undef PG8_SA
#undef PG8_SB
#undef PG8_STAGE
#undef PG8_LDA
#undef PG8_LDB
#undef PG8_MMA
#undef PG8_WAIT_V
#undef PG8_WAIT_L
#undef PG8_BAR
#undef PG8_SCHED
}
}
using pg8::GUnit;
typedef f32x4 AccT[2][2][4][2];

#define FOR_AM _Pragma("unroll") for (int ai = 0; ai < 2; ++ai) _Pragma("unroll") for (int m = 0; m < 4; ++m)
#define FOR_BN _Pragma("unroll") for (int bj = 0; bj < 2; ++bj) _Pragma("unroll") for (int n = 0; n < 2; ++n)

struct EpiIn {
    int l; float* out; unsigned char* ws; const float* qg; const float* kg; const float* rs1;
    DEV void operator()(const AccT& acc, const GUnit& u, int wr, int wc, int fr, int fq) const {
        const int pn = u.pn; const bool smp = u.pm >= 128;
        const int rowb = u.pm * 256 + wr * 64 + fr;
        const int ct0 = wc * 32 + 4 * fq;
        u16* P1 = (u16*)(ws + W_P1); u16* P2 = (u16*)(ws + W_P2);
        float rsx[2][4];
        FOR_AM rsx[ai][m] = __builtin_amdgcn_rsqf(rs1[rowb + ai * 128 + m * 16] * (1.f / 1024.f) + EPS);
        if (pn < 2) {
            FOR_AM { const int row = rowb + ai * 128 + m * 16; FOR_BN { f32x4 v = (acc[ai][bj][m][n] * rsx[ai][m]);
                for (int e = 0; e < 4; ++e) v[e] = fgelu(v[e]);
                *(u32x2*)(P1 + (size_t)row * 1024 + pn * 256 + ct0 + bj * 128 + n * 16) = pk4(v); } }
        } else if (pn < 4 || pn == 8 || pn == 9 || pn == 16 || pn == 17) {
            const int kind = pn < 4 ? 0 : (pn < 10 ? 1 : 2);
            const int cseg = (pn & 1) * 256;
            u16* dstT; int T, toff = 0;
            if (kind == 0) { dstT = (u16*)(ws + W_GVT) + (smp ? (size_t)16 * 512 * 2048 : 0); T = smp ? 64 : 2048; }
            else if (kind == 1) { dstT = (u16*)(ws + W_CVT) + (smp ? (size_t)16 * 512 * 2048 : 0); T = smp ? 64 : 2048; }
            else { dstT = (u16*)(ws + (smp ? W_DVTS : W_DVTP)); T = smp ? 4160 : 2048; toff = smp ? 4096 : 0; }
            float* rowsq = (float*)(ws + W_ROWSQ);
            FOR_AM { const int row = rowb + ai * 128 + m * 16;
                int b, t; if (smp) { const int rs = row - MTP; b = rs >> 6; t = rs & 63; } else { b = row >> 11; t = row & 2047; }
                float ss = 0.f;
                FOR_BN { f32x4 v = (acc[ai][bj][m][n] * rsx[ai][m]); const int cc = cseg + ct0 + bj * 128 + n * 16;
                    if (kind == 0) { for (int e = 0; e < 4; ++e) { v[e] = fgelu(v[e]); ss += v[e] * v[e]; } }
                    if (kind == 2) { float* o = smp ? out + O_DVS + (size_t)l * 262144 + (size_t)(row - MTP) * 512 + cc : out + O_DVP + (size_t)l * 16777216 + (size_t)row * 512 + cc;
                        *(f32x4*)o = v; }
                    for (int e = 0; e < 4; ++e) dstT[((size_t)b * 512 + cc + e) * T + toff + t] = f2bf(v[e]); }
                if (kind == 0) { ss = red_fq(ss); if (fq == 0) atomicAdd(rowsq + row, ss); } }
        } else if (pn < 6) {
            u16* S5 = (u16*)(ws + W_S5);
            FOR_AM { const int row = rowb + ai * 128 + m * 16; FOR_BN {
                *(u32x2*)(S5 + (size_t)row * 512 + (pn - 4) * 256 + ct0 + bj * 128 + n * 16) = pk4((acc[ai][bj][m][n] * rsx[ai][m])); } }
        } else if (pn < 8) {
            u16* D = (u16*)(ws + (pn == 6 ? W_CQ : W_CK)); const float sc = pn == 6 ? 0.125f : 1.f;
            FOR_AM { const int row = rowb + ai * 128 + m * 16; FOR_BN {
                *(u32x2*)(D + (size_t)row * 256 + ct0 + bj * 128 + n * 16) = pk4((acc[ai][bj][m][n] * rsx[ai][m]) * sc); } }
        } else if (pn < 12) {
            FOR_AM { const int row = rowb + ai * 128 + m * 16; FOR_BN { f32x4 v = (acc[ai][bj][m][n] * rsx[ai][m]);
                for (int e = 0; e < 4; ++e) v[e] = fsilu(v[e]);
                *(u32x2*)(P2 + (size_t)row * 1024 + (pn - 10) * 256 + ct0 + bj * 128 + n * 16) = pk4(v); } }
        } else if (pn < 16) {
            const bool isq = pn < 14; const int hh = 4 * (pn & 1) + wc; const float* g = isq ? qg : kg;
            f32x4 gv[2][2];
            FOR_BN gv[bj][n] = *(const f32x4*)(g + 32 * bj + 16 * n + 4 * fq);
            FOR_AM { const int row = rowb + ai * 128 + m * 16;
                float ss = 0.f;
                FOR_BN { const f32x4 v = (acc[ai][bj][m][n] * rsx[ai][m]); ss += v[0] * v[0] + v[1] * v[1] + v[2] * v[2] + v[3] * v[3]; }
                ss = red_fq(ss);
                float rs = __builtin_amdgcn_rsqf(ss * (1.f / 64.f) + EPS);
                if (isq) { rs *= 0.125f * LOG2E;
                    FOR_BN { *(u32x2*)(P2 + (size_t)row * 1024 + 512 + hh * 64 + 32 * bj + 16 * n + 4 * fq) = pk4((acc[ai][bj][m][n] * rsx[ai][m]) * rs * gv[bj][n]); }
                } else {
                    float* o; u16* kb;
                    if (smp) { const int rs_ = row - MTP; o = out + O_DKS + (size_t)l * 262144 + (size_t)rs_ * 512; kb = (u16*)(ws + W_DKS) + ((size_t)(rs_ >> 6) * 4160 + 4096 + (rs_ & 63)) * 512; }
                    else { o = out + O_DKP + (size_t)l * 16777216 + (size_t)row * 512; kb = (u16*)(ws + W_DKP) + (size_t)row * 512; }
                    FOR_BN { const f32x4 v = (acc[ai][bj][m][n] * rsx[ai][m]) * rs * gv[bj][n]; const int d = hh * 64 + 32 * bj + 16 * n + 4 * fq;
                        *(f32x4*)(o + d) = v; *(u32x2*)(kb + d) = pk4(v); } } }
        } else {
            if (wc == 0) { float* C = (float*)(ws + W_CODE);
                FOR_AM { const int row = rowb + ai * 128 + m * 16; *(f32x4*)(C + (size_t)row * 16 + 4 * fq) = acc[ai][0][m][0] * rsx[ai][m]; } }
        }
    }
};

struct EpiGlu {
    unsigned char* ws; const float* bias;
    DEV void operator()(const AccT& acc, const GUnit& u, int wr, int wc, int fr, int fq) const {
        const u16* Z = (const u16*)(ws + W_S5); u16* P1 = (u16*)(ws + W_P1);
        const int rowb = u.pm * 256 + wr * 64 + fr, cb = u.pn * 256 + wc * 32 + 4 * fq;
        FOR_AM { const int row = rowb + ai * 128 + m * 16; FOR_BN { const int col = cb + bj * 128 + n * 16;
            const f32x4 bv = *(const f32x4*)(bias + col); const u32x2 zz = *(const u32x2*)(Z + (size_t)row * 512 + col);
            f32x4 z; z[0] = __uint_as_float(zz.x << 16); z[1] = __uint_as_float(zz.x & 0xffff0000u); z[2] = __uint_as_float(zz.y << 16); z[3] = __uint_as_float(zz.y & 0xffff0000u);
            f32x4 v = acc[ai][bj][m][n] + bv;
            for (int e = 0; e < 4; ++e) v[e] = z[e] * fsigmoid(v[e]);
            *(u32x2*)(P1 + (size_t)row * 1024 + 512 + col) = pk4(v); } }
    }
};

struct MergeSched {
    pg8::TileOrder T; unsigned char* ws;
    DEV void fill(GUnit& u, int pm, int pn, int b, int sub) const {
        u.pm = pm; u.pn = pn;
        if (sub) { u.nt = 16; u.A = (const char*)ws + W_H + (size_t)pm * 256 * 2048; u.B = (const char*)ws + W_WIN + (size_t)(GATE0 + b * 1024 + pn * 256) * 2048; }
        else { u.nt = 8; u.A = (const char*)ws + (b < 2 ? W_P1 : W_P2) + (size_t)pm * 256 * 2048 + (b & 1) * 1024;
               u.B = (const char*)ws + W_WBR + (size_t)(b >> 1) * 1024 * 2048 + (size_t)pn * 256 * 2048 + (b & 1) * 1024; }
    }
    DEV bool next(int i, GUnit& u) const {
        int pm, pn;
        if (T.tile(i >> 3, pm, pn)) { const int s = i & 7; u.kind = s; fill(u, pm, pn, s >> 1, s & 1); return true; }
        const int i0 = (T.nwg - T.c + T.G - 1) / T.G; const int jj = i - 8 * i0; const int job = (jj >> 1) * T.G + T.c; if (job >= 32) return false;
        const int tile = job >> 2, b = job & 3; u.kind = 8 + 2 * b + (jj & 1); fill(u, 128 + (tile >> 2), tile & 3, b, jj & 1); return true;
    }
};
struct EpiMerge {
    unsigned char* ws; const float* bgate; const float* rs1;
    DEV void operator()(const AccT& acc, const GUnit& u, int wr, int wc, int fr, int fq) const {
        u32x4* sT = (u32x4*)(ws + W_SCR) + (size_t)bid_o() * 16 * 512 + tid_o();
        u32x4* sS = (u32x4*)(ws + W_SCR + (size_t)32 * 1024 * 1024) + (size_t)bid_o() * 16 * 512 + tid_o();
        const int s = u.kind & 7, b = s >> 1; const bool smp = u.kind >= 8;
        if (!(s & 1)) {
#pragma unroll
            for (int q = 0; q < 16; ++q) { const int ai = q >> 3, bj = (q >> 2) & 1, m = q & 3; const u32x2 lo = pk4(acc[ai][bj][m][0]), hi = pk4(acc[ai][bj][m][1]);
                u32x4 w; w.x = lo.x; w.y = lo.y; w.z = hi.x; w.w = hi.y; sT[q * 512] = w; }
        } else {
            u16* MG = (u16*)(ws + W_MERGED);
            const int rowb = u.pm * 256 + wr * 64 + fr, cb = u.pn * 256 + wc * 32 + 4 * fq;
            f32x4 bvv[2][2];
#pragma unroll
            for (int bj = 0; bj < 2; ++bj)
#pragma unroll
                for (int n = 0; n < 2; ++n) bvv[bj][n] = *(const f32x4*)(bgate + b * 1024 + cb + bj * 128 + n * 16);
            float rsx[2][4];
            FOR_AM rsx[ai][m] = __builtin_amdgcn_rsqf(rs1[rowb + ai * 128 + m * 16] * (1.f / 1024.f) + EPS);
#pragma unroll
            for (int q = 0; q < 16; ++q) { const int ai = q >> 3, bj = (q >> 2) & 1, m = q & 3; __builtin_amdgcn_sched_barrier(0);
                const u32x4 tw = sT[q * 512]; u32x4 sw = (u32x4){0u, 0u, 0u, 0u}; if (b > 0 && !smp) sw = sS[q * 512];
                const unsigned tws[4] = {tw.x, tw.y, tw.z, tw.w}; const unsigned sws[4] = {sw.x, sw.y, sw.z, sw.w};
                f32x4 r[2];
#pragma unroll
                for (int n = 0; n < 2; ++n) { const f32x4 bv = bvv[bj][n];
                    f32x4 v = acc[ai][bj][m][n] * rsx[ai][m] + bv;
#pragma unroll
                    for (int e = 0; e < 4; ++e) { const unsigned tt = tws[n * 2 + (e >> 1)], st = sws[n * 2 + (e >> 1)];
                        const float tv = (e & 1) ? __uint_as_float(tt & 0xffff0000u) : __uint_as_float(tt << 16);
                        const float sv = (e & 1) ? __uint_as_float(st & 0xffff0000u) : __uint_as_float(st << 16);
                        v[e] = fsigmoid(v[e]) * tv + sv; }
                    r[n] = v; }
                if (smp) { float* mf = (float*)(ws + W_PART) + ((size_t)b * 512 + rowb + ai * 128 + m * 16 - MTP) * 1024 + cb + bj * 128;
#pragma unroll
                    for (int n = 0; n < 2; ++n) *(f32x4*)(mf + n * 16) = r[n]; }
                else if (b < 3) { const u32x2 lo = pk4(r[0]), hi = pk4(r[1]); u32x4 w; w.x = lo.x; w.y = lo.y; w.z = hi.x; w.w = hi.y; sS[q * 512] = w; }
                else { const int row = rowb + ai * 128 + m * 16;
#pragma unroll
                    for (int n = 0; n < 2; ++n) *(u32x2*)(MG + (size_t)row * 1024 + cb + bj * 128 + n * 16) = pk4(r[n]); } }
        }
    }
};

struct EpiRes {
    const float* xin;
    u16* xb;
    float* yout;
    float* rsacc;
    float* yfull;
    DEV void operator()(const AccT& acc, const GUnit& u, int wr, int wc, int fr, int fq) const {
        const int rowb = u.pm * 256 + wr * 64 + fr, cb = u.pn * 256 + wc * 32 + 4 * fq;
        if (u.kind >= 1) {
            float* pp = yfull + ((size_t)(u.kind - 1) * 512) * 1024;
            FOR_AM { const int row = rowb + ai * 128 + m * 16 - MTP; FOR_BN { *(f32x4*)(pp + (size_t)row * 1024 + cb + bj * 128 + n * 16) = acc[ai][bj][m][n]; } }
            return; }
        FOR_AM { const int row = rowb + ai * 128 + m * 16; float ss = 0.f;
            FOR_BN { const int col = cb + bj * 128 + n * 16; f32x4 x;
                if (xin) x = *(const f32x4*)(xin + (size_t)row * 1024 + col);
                else { const u32x2 xx = *(const u32x2*)(xb + (size_t)row * 1024 + col);
                    x[0] = __uint_as_float(xx.x << 16); x[1] = __uint_as_float(xx.x & 0xffff0000u); x[2] = __uint_as_float(xx.y << 16); x[3] = __uint_as_float(xx.y & 0xffff0000u); }
                const f32x4 v = x + acc[ai][bj][m][n];
                if (yout) *(f32x4*)(yout + (size_t)row * 1024 + col) = v; else *(u32x2*)(xb + (size_t)row * 1024 + col) = pk4(v);
                ss += v[0] * v[0] + v[1] * v[1] + v[2] * v[2] + v[3] * v[3]; }
            if (rsacc) { ss = red_fq(ss); if (fq == 0) atomicAdd(rsacc + row, ss); } }
    }
};

DEV float dpp_prev1(float cur, float prevm) {
    const int o = __builtin_amdgcn_update_dpp(0, __float_as_int(prevm), 0x121, 0xf, 0xf, false);
    return __int_as_float(__builtin_amdgcn_update_dpp(o, __float_as_int(cur), 0x111, 0xf, 0xf, false));
}
DEV float dpp_prev2(float cur, float prevm) {
    const int o = __builtin_amdgcn_update_dpp(0, __float_as_int(prevm), 0x122, 0xf, 0xf, false);
    return __int_as_float(__builtin_amdgcn_update_dpp(o, __float_as_int(cur), 0x112, 0xf, 0xf, false));
}
struct EpiUp {
    unsigned char* ws; const float* cw; const float* cbias; const float* rs2;
    DEV void operator()(const AccT& acc, const GUnit& u, int wr, int wc, int fr, int fq) const {
        u16* ACT = (u16*)(ws + W_ACT); float* HEAD = (float*)(ws + W_HEAD); float* TAIL = (float*)(ws + W_TAIL);
        float rsx[2][4];
        FOR_AM rsx[ai][m] = __builtin_amdgcn_rsqf(rs2[u.pm * 256 + wr * 64 + fr + ai * 128 + m * 16] * (1.f / 1024.f) + EPS);
        const int f0 = u.pn * 128 + wc * 32 + 4 * fq;
#pragma unroll
        for (int n = 0; n < 2; ++n) { const int f = f0 + n * 16;
            f32x4 w0[2], w1[2], w2[2], bb[2];
#pragma unroll
            for (int bj = 0; bj < 2; ++bj) { const int ff = bj * 2816 + f; w0[bj] = *(const f32x4*)(cw + ff); w1[bj] = *(const f32x4*)(cw + 5632 + ff); w2[bj] = *(const f32x4*)(cw + 11264 + ff); bb[bj] = *(const f32x4*)(cbias + ff); }
#pragma unroll
            for (int ai = 0; ai < 2; ++ai) {
                const int slab = u.pm * 4 + ai * 2 + wr;
#pragma unroll
                for (int m = 0; m < 4; ++m) {
                    f32x4 c[2];
#pragma unroll
                    for (int bj = 0; bj < 2; ++bj) { const f32x4 cur = acc[ai][bj][m][n] * rsx[ai][m]; const f32x4 pm_ = acc[ai][bj][m ? m - 1 : 0][n] * rsx[ai][m ? m - 1 : 0];
#pragma unroll
                        for (int e = 0; e < 4; ++e) { const float p1 = dpp_prev1(cur[e], pm_[e]), p2 = dpp_prev2(cur[e], pm_[e]);
                            c[bj][e] = bb[bj][e] + w2[bj][e] * cur[e] + w1[bj][e] * p1 + w0[bj][e] * p2; } }
                    if (m > 0 || fr >= 2) { f32x4 a; for (int e = 0; e < 4; ++e) a[e] = fsilu(c[0][e]) * c[1][e];
                        *(u32x2*)(ACT + (size_t)(slab * 64 + m * 16 + fr) * 2816 + f) = pk4(a); }
                    if (m == 0 && fr < 2) { for (int bj = 0; bj < 2; ++bj) *(f32x4*)(HEAD + ((size_t)slab * 2 + fr) * 5632 + bj * 2816 + f) = acc[ai][bj][0][n] * rsx[ai][0]; }
                    if (m == 3 && fr >= 14) { for (int bj = 0; bj < 2; ++bj) *(f32x4*)(TAIL + ((size_t)slab * 2 + fr - 14) * 5632 + bj * 2816 + f) = acc[ai][bj][3][n] * rsx[ai][3]; }
                } } }
    }
};

template <int MAP> DEV int src_col(int j) {
    if (MAP == 0) return j;
    if (MAP == 1) {
        const int tile = j >> 8, tc = j & 255;
        if (tile < 10) return j;
        if (tile < 12) return j + 16;
        if (tile < 16) { const int perm = ((tc >> 5) & 3) * 64 + (tc >> 7) * 32 + (tc & 31); return (tile < 14 ? 3088 : 3600) + (tile & 1) * 256 + perm; }
        if (tile < 18) return j + 16;
        if (tile == 18) return tc < 16 ? 2560 + tc : -1;
        return 4624 + (j - GATE0);
    }
    { const int q = j >> 8, tc = j & 255; return tc < 128 ? 128 * q + tc : 2816 + 128 * q + (tc - 128); }
}
template <int MAP> DEV void conv_T(u16* dst, int dst_ld, int K, int Nd, const float* src, int src_ld, int gt, int GT, const float* gain = nullptr) {
    const int total = Nd * (K >> 3);
    for (int idx = gt; idx < total; idx += GT) { const int j = idx % Nd, kb = idx / Nd; const int sc = src_col<MAP>(j);
        float v[8];
#pragma unroll
        for (int i = 0; i < 8; ++i) v[i] = sc >= 0 ? src[(size_t)(kb * 8 + i) * src_ld + sc] : 0.f;
        if (gain) {
#pragma unroll
            for (int i = 0; i < 8; ++i) v[i] *= gain[kb * 8 + i]; }
        u32x4 w; w.x = pk2(v[0], v[1]); w.y = pk2(v[2], v[3]); w.z = pk2(v[4], v[5]); w.w = pk2(v[6], v[7]);
        *(u32x4*)(dst + (size_t)j * dst_ld + kb * 8) = w; }
}
DEV void raw_rows(const float* xp, const float* xs, int r0, int r1, u16* XB, float* RS) {
    const int tid = tid_o(); const int lane = tid & 63; const int gw = bid_o() * 8 + (tid >> 6), GW = gridDim.x * 8;
    for (int row = r0 + gw; row < r1; row += GW) {
        const float* src = row < MTP ? xp + (size_t)row * 1024 : xs + (size_t)(row - MTP) * 1024;
        f32x4 v[4]; float ss = 0.f;
#pragma unroll
        for (int i = 0; i < 4; ++i) { v[i] = *(const f32x4*)(src + (lane + 64 * i) * 4); ss += v[i][0] * v[i][0] + v[i][1] * v[i][1] + v[i][2] * v[i][2] + v[i][3] * v[i][3]; }
        ss = wave_sum(ss); if (lane == 0) RS[row] = ss;
#pragma unroll
        for (int i = 0; i < 4; ++i) *(u32x2*)(XB + (size_t)row * 1024 + (lane + 64 * i) * 4) = pk4(v[i]);
    }
}

DEV void sample_rows_reduce(float* xs, const float* part, int npart, u16* XBs, float* RSs) {
    const int tid = tid_o(); const int lane = tid & 63; const int gw = bid_o() * 8 + (tid >> 6), GW = gridDim.x * 8;
    for (int r = gw; r < 512; r += GW) {
        float* src = xs + (size_t)r * 1024; f32x4 v[4];
#pragma unroll
        for (int i = 0; i < 4; ++i) v[i] = *(const f32x4*)(src + (lane + 64 * i) * 4);
        for (int k = 0; k < npart; ++k) { const float* pp = part + ((size_t)k * 512 + r) * 1024;
#pragma unroll
            for (int i = 0; i < 4; ++i) v[i] += *(const f32x4*)(pp + (lane + 64 * i) * 4); }
        float ss = 0.f;
#pragma unroll
        for (int i = 0; i < 4; ++i) { *(f32x4*)(src + (lane + 64 * i) * 4) = v[i]; ss += v[i][0] * v[i][0] + v[i][1] * v[i][1] + v[i][2] * v[i][2] + v[i][3] * v[i][3]; }
        ss = wave_sum(ss); if (lane == 0) RSs[r] = ss;
#pragma unroll
        for (int i = 0; i < 4; ++i) *(u32x2*)(XBs + (size_t)r * 1024 + (lane + 64 * i) * 4) = pk4(v[i]);
    }
}
DEV void phaseA(CP& p, int l) {
    unsigned char* ws = p.ws;
    const int gt = bid_o() * 512 + tid_o(), GT = gridDim.x * 512;
    conv_T<1>((u16*)(ws + W_WIN), 1024, 1024, NINP, p.in[9] + (size_t)l * 1024 * 8720, 8720, gt, GT, p.in[8] + l * 1024);
    for (int b = 0; b < 4; ++b) conv_T<0>((u16*)(ws + W_WBR) + (size_t)(b >> 1) * 1024 * 1024 + (b & 1) * 512, 1024, 512, 1024, p.in[31] + (size_t)(l * 4 + b) * 512 * 1024, 1024, gt, GT);
    conv_T<0>((u16*)(ws + W_WOUT), 1024, 1024, 1024, p.in[32] + (size_t)l * 1024 * 1024, 1024, gt, GT);
    conv_T<0>((u16*)(ws + W_WGLU), 512, 512, 512, p.in[22] + (size_t)l * 512 * 512, 512, gt, GT);
    conv_T<2>((u16*)(ws + W_WUP), 1024, 1024, 5632, p.in[34] + (size_t)l * 1024 * 5632, 5632, gt, GT, p.in[33] + l * 1024);
    conv_T<0>((u16*)(ws + W_WDN), 2816, 2816, 1024, p.in[37] + (size_t)l * 2816 * 1024, 1024, gt, GT);
    for (int b = 0; b < 8; ++b) conv_T<0>((u16*)(ws + W_DVTS) + (size_t)b * 512 * 4160, 4160, 4096, 512, p.in[3] + ((size_t)(l * 8 + b) * 4096) * 512, 512, gt, GT);
    {
        const float* ck = p.in[2] + (size_t)l * 8 * 4096 * 512; u16* dk = (u16*)(ws + W_DKS);
        for (int idx = gt; idx < 8 * 4096 * 64; idx += GT) { const int b = idx >> 18, rem = idx & 262143, key = rem >> 6, c8 = (rem & 63) * 8;
            const f32x4 a = *(const f32x4*)(ck + ((size_t)(b * 4096 + key)) * 512 + c8), c = *(const f32x4*)(ck + ((size_t)(b * 4096 + key)) * 512 + c8 + 4);
            u32x4 w; w.x = pk2(a[0], a[1]); w.y = pk2(a[2], a[3]); w.z = pk2(c[0], c[1]); w.w = pk2(c[2], c[3]);
            *(u32x4*)(dk + ((size_t)b * 4160 + key) * 512 + c8) = w; }
    }
    { float* rq = (float*)(ws + W_ROWSQ); for (int i = gt; i < MT; i += GT) rq[i] = 0.f; }
    { const float* wsp = p.in[12] + (size_t)l * 4 * 128 * 128; u16* wm = (u16*)(ws + W_WM); for (int i = gt; i < 4 * 128 * 128; i += GT) { const int t = (i >> 7) & 127, s2 = i & 127; wm[i] = f2bf(s2 <= t ? wsp[i] : 0.f); } }
    if (l == 0) { const f32x4* xs = (const f32x4*)p.in[1]; f32x4* xo = (f32x4*)(p.out + (size_t)MTP * 1024); for (int i = gt; i < 512 * 256; i += GT) xo[i] = xs[i]; }
    if (gt == 0) {
        unsigned* misc = (unsigned*)(ws + W_MISC); misc[l] = 0u;
        const float* dl = p.in[29] + l * 256; float s1 = 0.f, s2 = 0.f;
        for (int i = 0; i < 64; ++i) { s1 += dl[i] * dl[64 + i]; s2 += dl[128 + i] * dl[192 + i]; }
        const float lam_init = 0.8f - 0.6f * expf(-0.3f * (float)l);
        ((float*)misc)[8 + 2 * l] = expf(s1) - expf(s2) + lam_init; ((float*)misc)[9 + 2 * l] = lam_init;
        float mq = 0.f, mk = 0.f; for (int i = 0; i < 64; ++i) { mq = fmaxf(mq, fabsf(p.in[27][l * 64 + i])); mk = fmaxf(mk, fabsf(p.in[28][l * 64 + i])); }
        ((float*)misc)[16 + l] = 64.f * mq * mk * 0.125f * LOG2E;
    }
    { float* RS = (float*)(ws + W_RS);
      for (int i = gt; i < MT; i += GT) { RS[(size_t)(l * 2 + 1) * MT + i] = 0.f; if (l == 0) RS[(size_t)2 * MT + i] = 0.f; }
      if (l == 0) raw_rows(p.in[0], p.in[1], 0, MT, (u16*)(ws + W_H), RS);
      else sample_rows_reduce(p.out + (size_t)MTP * 1024, (const float*)(ws + W_PART), 11, (u16*)(ws + W_H) + (size_t)MTP * 1024, RS + (size_t)2 * MT + MTP); }
}

DEV void attn_item(CP& p, int l, LAS unsigned char* lds, int grp, int b, int h, int qp) {
    unsigned char* ws = p.ws;
    const int tid = tid_o(), w = tid >> 6, lane = tid & 63, fr = lane & 15, fq = lane >> 4, c = w >> 2, qs = w & 3;
    const int Tk = grp ? 4160 : 2048, nkv = grp ? 65 : 2 * qp + 2;
    const int nact = grp ? (qs < 2 ? 65 : 0) : (qs < 2 ? nkv - 1 : nkv);
    const int rowbase = grp ? MTP + b * 64 : b * 2048 + qp * 128;
    const u16* Kb = grp ? (const u16*)(ws + W_DKS) + (size_t)b * 4160 * 512 : (const u16*)(ws + W_DKP) + (size_t)b * 2048 * 512;
    const u16* Vb = grp ? (const u16*)(ws + W_DVTS) + ((size_t)b * 512 + h * 128) * 4160 : (const u16*)(ws + W_DVTP) + ((size_t)b * 512 + h * 128) * 2048;
    u16* P2 = (u16*)(ws + W_P2);
    bf16x8 qf[2][2];
    if (nact > 0) {
#pragma unroll
        for (int r = 0; r < 2; ++r)
#pragma unroll
            for (int kk = 0; kk < 2; ++kk) qf[r][kk] = *(const bf16x8*)(P2 + (size_t)(rowbase + 32 * qs + 16 * r + fr) * 1024 + 512 + h * 128 + c * 64 + kk * 32 + fq * 8);
    } else {
#pragma unroll
        for (int r = 0; r < 2; ++r)
#pragma unroll
            for (int kk = 0; kk < 2; ++kk) qf[r][kk] = (bf16x8){0, 0, 0, 0, 0, 0, 0, 0};
    }
    constexpr int STG = 36864;
    int gK[2], lK[2], gV[2], lV[2];
#pragma unroll
    for (int i = 0; i < 2; ++i) { const int ch = tid + 512 * i; const int key = ch >> 4, part = ch & 15; gK[i] = key * 512 + h * 128 + part * 8; lK[i] = (((part >> 3) * 64 + key) * 72 + (part & 7) * 8) * 2;
        const int v = ch >> 3, kp = (ch & 7) * 8; gV[i] = v * Tk + kp; lV[i] = (128 * 72 + v * 72 + kp) * 2; }
    u32x4 rk[2], rv[2];
#pragma unroll
    for (int i = 0; i < 2; ++i) { rk[i] = *(const u32x4*)(Kb + gK[i]); rv[i] = *(const u32x4*)(Vb + gV[i]); }
#pragma unroll
    for (int i = 0; i < 2; ++i) { *(LAS u32x4*)(lds + lK[i]) = rk[i]; *(LAS u32x4*)(lds + lV[i]) = rv[i]; }
    __syncthreads();
    f32x4 O[2][8];
#pragma unroll
    for (int r = 0; r < 2; ++r)
#pragma unroll
        for (int i = 0; i < 8; ++i) O[r][i] = (f32x4){0.f, 0.f, 0.f, 0.f};
    const bool fixedref = ((const float*)(ws + W_MISC))[16 + l] < 40.f;
    float mrun[2] = {-1e30f, -1e30f}, lrun[2] = {0.f, 0.f};
    for (int kt = 0; kt < nkv; ++kt) {
        const bool more = kt + 1 < nkv;
        if (more) { const size_t k0 = (size_t)(kt + 1) * 64;
#pragma unroll
            for (int i = 0; i < 2; ++i) { rk[i] = *(const u32x4*)(Kb + k0 * 512 + gK[i]); rv[i] = *(const u32x4*)(Vb + k0 + gV[i]); } }
        if (kt < nact) {
            LAS unsigned char* st = lds + (kt & 1) * STG;
            f32x4 s[2][4];
#pragma unroll
            for (int jt = 0; jt < 4; ++jt) { s[0][jt] = (f32x4){0.f, 0.f, 0.f, 0.f}; s[1][jt] = (f32x4){0.f, 0.f, 0.f, 0.f};
#pragma unroll
                for (int kk = 0; kk < 2; ++kk) { const bf16x8 kf = *(const LAS bf16x8*)(st + ((c * 64 + 16 * jt + fr) * 72 + kk * 32 + fq * 8) * 2);
                    s[0][jt] = mfma16(kf, qf[0][kk], s[0][jt]); s[1][jt] = mfma16(kf, qf[1][kk], s[1][jt]); } }
            bf16x8 pf[2][2];
#pragma unroll
            for (int r = 0; r < 2; ++r) {
                float ps = 0.f;
                if (fixedref) {
#pragma unroll
                    for (int jt = 0; jt < 4; ++jt)
#pragma unroll
                        for (int e = 0; e < 4; ++e) { s[r][jt][e] = __builtin_amdgcn_exp2f(s[r][jt][e]); ps += s[r][jt][e]; }
                    lrun[r] += ps;
                } else {
                    float mt = s[r][0][0];
#pragma unroll
                    for (int jt = 0; jt < 4; ++jt)
#pragma unroll
                        for (int e = 0; e < 4; ++e) mt = fmaxf(mt, s[r][jt][e]);
                    mt = fmaxf(mt, __shfl_xor(mt, 16)); mt = fmaxf(mt, __shfl_xor(mt, 32));
                    const float mnew = fmaxf(mrun[r], mt), alpha = __builtin_amdgcn_exp2f(mrun[r] - mnew); mrun[r] = mnew;
#pragma unroll
                    for (int jt = 0; jt < 4; ++jt)
#pragma unroll
                        for (int e = 0; e < 4; ++e) { s[r][jt][e] = __builtin_amdgcn_exp2f(s[r][jt][e] - mnew); ps += s[r][jt][e]; }
                    lrun[r] = lrun[r] * alpha + ps;
#pragma unroll
                    for (int i = 0; i < 8; ++i) O[r][i] *= alpha;
                }
#pragma unroll
                for (int t = 0; t < 2; ++t) { const u32x2 lo = pk4(s[r][2 * t]), hi = pk4(s[r][2 * t + 1]); u32x4 wv; wv.x = lo.x; wv.y = lo.y; wv.z = hi.x; wv.w = hi.y; pf[r][t] = __builtin_bit_cast(bf16x8, wv); }
            }
#pragma unroll
            for (int vt = 0; vt < 8; ++vt)
#pragma unroll
                for (int t = 0; t < 2; ++t) { const LAS unsigned char* vp = st + (128 * 72 + (16 * vt + fr) * 72 + 32 * t + 4 * fq) * 2;
                    const u32x2 a = *(const LAS u32x2*)vp, bq = *(const LAS u32x2*)(vp + 32); u32x4 wv; wv.x = a.x; wv.y = a.y; wv.z = bq.x; wv.w = bq.y;
                    const bf16x8 vf = __builtin_bit_cast(bf16x8, wv);
                    O[0][vt] = mfma16(vf, pf[0][t], O[0][vt]); O[1][vt] = mfma16(vf, pf[1][t], O[1][vt]); }
        }
        if (more) { LAS unsigned char* nx = lds + ((kt + 1) & 1) * STG;
#pragma unroll
            for (int i = 0; i < 2; ++i) { *(LAS u32x4*)(nx + lK[i]) = rk[i]; *(LAS u32x4*)(nx + lV[i]) = rv[i]; } }
        __syncthreads();
    }
    const float lam = ((const float*)(ws + W_MISC))[8 + 2 * l], lam_init = ((const float*)(ws + W_MISC))[9 + 2 * l];
    LAS float* X = (LAS float*)lds;
    float inv[2];
#pragma unroll
    for (int r = 0; r < 2; ++r) inv[r] = __builtin_amdgcn_rcpf(fmaxf(red_fq(lrun[r]), 1e-30f));
    if (c == 1) {
#pragma unroll
        for (int r = 0; r < 2; ++r)
#pragma unroll
            for (int vt = 0; vt < 8; ++vt)
#pragma unroll
                for (int e = 0; e < 4; ++e) X[(qs * 64 + r * 32 + vt * 4 + e) * 64 + lane] = O[r][vt][e] * inv[r] * lam;
    }
    __syncthreads();
    if (c == 0 && nact > 0) {
        const float* g = p.in[30] + l * 128;
#pragma unroll
        for (int r = 0; r < 2; ++r) { float ss = 0.f;
#pragma unroll
            for (int vt = 0; vt < 8; ++vt)
#pragma unroll
                for (int e = 0; e < 4; ++e) { const float d = O[r][vt][e] * inv[r] - X[(qs * 64 + r * 32 + vt * 4 + e) * 64 + lane]; O[r][vt][e] = d; ss += d * d; }
            ss = red_fq(ss); const float rs = __builtin_amdgcn_rsqf(ss * (1.f / 128.f) + EPS) * (1.f - lam_init);
#pragma unroll
            for (int vt = 0; vt < 8; ++vt) { const f32x4 gv = *(const f32x4*)(g + 16 * vt + 4 * fq);
                *(u32x2*)(P2 + (size_t)(rowbase + 32 * qs + 16 * r + fr) * 1024 + 512 + h * 128 + 16 * vt + 4 * fq) = pk4(O[r][vt] * rs * gv); } }
    }
    __syncthreads();
}

DEV void gla_item(CP& p, int l, LAS unsigned char* lds, int grp, int b, int h) {
    unsigned char* ws = p.ws;
    const int tid = tid_o(), w = tid >> 6, lane = tid & 63, fr = lane & 15, fq = lane >> 4;
    const int T = grp ? 64 : 2048, nch = grp ? 1 : 32; const int rowbase = grp ? MTP + b * 64 : b * 2048;
    const u16* CQ = (const u16*)(ws + W_CQ); const u16* CK = (const u16*)(ws + W_CK); const float* CODE = (const float*)(ws + W_CODE);
    const u16* VT = (const u16*)(ws + W_CVT) + (grp ? (size_t)16 * 512 * 2048 : 0) + ((size_t)b * 512 + h * 128) * T;
    u16* P2 = (u16*)(ws + W_P2);
    LAS u16* QE = (LAS u16*)lds; LAS u16* KE = QE + 64 * 72; LAS u16* KDT = KE + 64 * 72; LAS u16* VTl = KDT + 64 * 72;
    LAS u16* PP = VTl + 128 * 72; LAS u16* STb = PP + 64 * 72;
    LAS float* OT = (LAS float*)(STb + 8 * 16 * 72); LAS float* SEG = OT + 64 * 132; LAS float* DEC = SEG + 8 * 64;
    LAS u16* QR = (LAS u16*)(DEC + 64); LAS u16* KR = QR + 64 * 72; LAS float* CD = (LAS float*)(KR + 64 * 72);
    const int d_ = tid & 63, seg = tid >> 6;
    float wa[16];
#pragma unroll
    for (int r = 0; r < 16; ++r) wa[r] = p.in[24][(size_t)l * 16 * 256 + r * 256 + h * 64 + d_];
    const float ba = p.in[25][l * 256 + h * 64 + d_];
    f32x4 S[4];
    if (grp) { const float* s0 = p.in[6] + ((size_t)(l * 8 + b) * 4 + h) * 64 * 128;
#pragma unroll
        for (int dt = 0; dt < 4; ++dt) S[dt] = *(const f32x4*)(s0 + (size_t)(16 * dt + fr) * 128 + 16 * w + 4 * fq); }
    else {
#pragma unroll
        for (int dt = 0; dt < 4; ++dt) S[dt] = (f32x4){0.f, 0.f, 0.f, 0.f}; }
#pragma unroll
    for (int dt = 0; dt < 4; ++dt)
#pragma unroll
        for (int e = 0; e < 4; ++e) STb[(w * 16 + 4 * fq + e) * 72 + 16 * dt + fr] = f2bf(S[dt][e]);
    const float* gng = p.in[26] + l * 128;
    const int tl = tid >> 3, d8 = (tid & 7) * 8;
    u32x4 rq, rkk, rvv[2]; f32x2 rcd;
    {
        rq = *(const u32x4*)(CQ + (size_t)(rowbase + tl) * 256 + h * 64 + d8); rkk = *(const u32x4*)(CK + (size_t)(rowbase + tl) * 256 + h * 64 + d8);
        rcd = *(const f32x2*)(CODE + (size_t)(rowbase + tl) * 16 + (tid & 7) * 2);
#pragma unroll
        for (int i = 0; i < 2; ++i) { const int chn = tid + 512 * i, v = chn >> 3, kp = (chn & 7) * 8; rvv[i] = *(const u32x4*)(VT + (size_t)v * T + kp); }
    }
    for (int ch = 0; ch < nch; ++ch) {
        const int r0 = rowbase + ch * 64;
        *(LAS u32x4*)(QR + tl * 72 + d8) = rq; *(LAS u32x4*)(KR + tl * 72 + d8) = rkk; *(LAS f32x2*)(CD + tl * 16 + (tid & 7) * 2) = rcd;
#pragma unroll
        for (int i = 0; i < 2; ++i) { const int chn = tid + 512 * i, v = chn >> 3, kp = (chn & 7) * 8; *(LAS u32x4*)(VTl + v * 72 + kp) = rvv[i]; }
        if (ch + 1 < nch) { const int r1 = r0 + 64;
            rq = *(const u32x4*)(CQ + (size_t)(r1 + tl) * 256 + h * 64 + d8); rkk = *(const u32x4*)(CK + (size_t)(r1 + tl) * 256 + h * 64 + d8);
            rcd = *(const f32x2*)(CODE + (size_t)(r1 + tl) * 16 + (tid & 7) * 2);
#pragma unroll
            for (int i = 0; i < 2; ++i) { const int chn = tid + 512 * i, v = chn >> 3, kp = (chn & 7) * 8; rvv[i] = *(const u32x4*)(VT + (size_t)v * T + (ch + 1) * 64 + kp); } }
        u16* yp = P2 + (size_t)(r0 + tl) * 1024 + h * 128 + (tid & 7) * 16;
        const u32x4 rr0 = *(const u32x4*)yp, rr1 = *(const u32x4*)(yp + 8);
        __syncthreads();
        float bl[8]; float run = 0.f;
#pragma unroll
        for (int i = 0; i < 8; ++i) { const LAS float* cp = CD + (seg * 8 + i) * 16; float a = ba;
#pragma unroll
            for (int r = 0; r < 16; ++r) a += cp[r] * wa[r];
            run += flogsig(a) * (1.f / 16.f); bl[i] = run; }
        SEG[seg * 64 + d_] = run;
        __syncthreads();
        float off = 0.f, tot = 0.f;
#pragma unroll
        for (int s2 = 0; s2 < 8; ++s2) { const float x = SEG[s2 * 64 + d_]; tot += x; if (s2 < seg) off += x; }
        if (seg == 0) DEC[d_] = __expf(tot);
        { float kd[8];
#pragma unroll
          for (int i = 0; i < 8; ++i) { const int t = seg * 8 + i; const float bb = bl[i] + off;
              const float q = bf2f(QR[t * 72 + d_]), k = bf2f(KR[t * 72 + d_]);
              QE[t * 72 + d_] = f2bf(q * __expf(bb)); KE[t * 72 + d_] = f2bf(k * __expf(-bb)); kd[i] = k * __expf(tot - bb); }
          u32x4 wv; wv.x = pk2(kd[0], kd[1]); wv.y = pk2(kd[2], kd[3]); wv.z = pk2(kd[4], kd[5]); wv.w = pk2(kd[6], kd[7]);
          *(LAS u32x4*)(KDT + d_ * 72 + seg * 8) = wv; }
        __syncthreads();
#pragma unroll
        for (int r = 0; r < 2; ++r) { const int ti = w + 8 * r, jt = ti >> 2, it = ti & 3; f32x4 a = (f32x4){0.f, 0.f, 0.f, 0.f};
            if (jt <= it) {
#pragma unroll
                for (int kk = 0; kk < 2; ++kk) { const bf16x8 kf = *(const LAS bf16x8*)(KE + (16 * jt + fr) * 72 + kk * 32 + fq * 8), qf = *(const LAS bf16x8*)(QE + (16 * it + fr) * 72 + kk * 32 + fq * 8); a = mfma16(kf, qf, a); }
#pragma unroll
                for (int e = 0; e < 4; ++e) if (16 * jt + 4 * fq + e > 16 * it + fr) a[e] = 0.f;
            }
            *(LAS u32x2*)(PP + (16 * it + fr) * 72 + 16 * jt + 4 * fq) = pk4(a); }
        __syncthreads();
        bf16x8 vf[2], sf[2];
#pragma unroll
        for (int t = 0; t < 2; ++t) { vf[t] = *(const LAS bf16x8*)(VTl + (16 * w + fr) * 72 + 32 * t + 8 * fq); sf[t] = *(const LAS bf16x8*)(STb + (w * 16 + fr) * 72 + 32 * t + 8 * fq); }
#pragma unroll
        for (int it = 0; it < 4; ++it) { f32x4 a = (f32x4){0.f, 0.f, 0.f, 0.f};
#pragma unroll
            for (int t = 0; t < 2; ++t) { const bf16x8 pf = *(const LAS bf16x8*)(PP + (16 * it + fr) * 72 + 32 * t + 8 * fq), qf = *(const LAS bf16x8*)(QE + (16 * it + fr) * 72 + 32 * t + 8 * fq);
                a = mfma16(vf[t], pf, a); a = mfma16(sf[t], qf, a); }
            *(LAS f32x4*)(OT + (16 * it + fr) * 132 + 16 * w + 4 * fq) = a; }
#pragma unroll
        for (int dt = 0; dt < 4; ++dt) { S[dt] *= DEC[16 * dt + fr];
#pragma unroll
            for (int t = 0; t < 2; ++t) { const bf16x8 kf = *(const LAS bf16x8*)(KDT + (16 * dt + fr) * 72 + 32 * t + 8 * fq); S[dt] = mfma16(vf[t], kf, S[dt]); }
#pragma unroll
            for (int e = 0; e < 4; ++e) STb[(w * 16 + 4 * fq + e) * 72 + 16 * dt + fr] = f2bf(S[dt][e]); }
        __syncthreads();
        {
            const int i = tid >> 3, vs = tid & 7; f32x4 o[4]; float ss = 0.f;
#pragma unroll
            for (int k = 0; k < 4; ++k) { o[k] = *(const LAS f32x4*)(OT + i * 132 + vs * 16 + 4 * k); ss += o[k][0] * o[k][0] + o[k][1] * o[k][1] + o[k][2] * o[k][2] + o[k][3] * o[k][3]; }
            ss += __shfl_xor(ss, 1); ss += __shfl_xor(ss, 2); ss += __shfl_xor(ss, 4);
            const float rs = __builtin_amdgcn_rsqf(ss * (1.f / 128.f) + EPS);
            const unsigned rw[8] = {rr0.x, rr0.y, rr0.z, rr0.w, rr1.x, rr1.y, rr1.z, rr1.w};
#pragma unroll
            for (int k = 0; k < 4; ++k) { const f32x4 gv = *(const f32x4*)(gng + vs * 16 + 4 * k);
                f32x4 r; r[0] = __uint_as_float(rw[2 * k] << 16); r[1] = __uint_as_float(rw[2 * k] & 0xffff0000u); r[2] = __uint_as_float(rw[2 * k + 1] << 16); r[3] = __uint_as_float(rw[2 * k + 1] & 0xffff0000u);
                *(u32x2*)(yp + 4 * k) = pk4(o[k] * rs * gv * r); }
        }
    }
    float* so = p.out + (grp ? O_GLAS + (size_t)l * 262144 + ((size_t)b * 4 + h) * 8192 : O_GLAP + (size_t)l * 524288 + ((size_t)b * 4 + h) * 8192);
#pragma unroll
    for (int dt = 0; dt < 4; ++dt) *(f32x4*)(so + (size_t)(16 * dt + fr) * 128 + 16 * w + 4 * fq) = S[dt];
    __syncthreads();
}

DEV void s5_item(CP& p, int l, LAS unsigned char* lds, int grp, int b, int gq) {
    unsigned char* ws = p.ws;
    const int tid = tid_o(), w = tid >> 6, lane = tid & 63, fr = lane & 15, fq = lane >> 4;
    const int g = gq * 8 + w; const int T = grp ? 64 : 2048; const int rowbase = grp ? MTP + b * 64 : b * 2048;
    u16* X = (u16*)(ws + W_S5);
    LAS u16* HT = (LAS u16*)lds + w * 32 * 136;
    const float dt = __expf(p.in[16][l * 32 + g]);
    bf16x8 breF[4], bimF[4]; float ar[4], ai[4], a8r[4], a8i[4];
#pragma unroll
    for (int pt = 0; pt < 4; ++pt) { const int pp = 16 * pt + fr; const size_t gp = (size_t)(l * 32 + g) * 64 + pp;
        const float lr = p.in[14][gp], li = p.in[15][gp];
        const float mag = __expf(lr * dt), ang = li * dt * 0.15915494309189535f;
        const float r_ = mag * __builtin_amdgcn_cosf(ang), i_ = mag * __builtin_amdgcn_sinf(ang);
        ar[pt] = r_; ai[pt] = i_;
        float xr = r_, xi = i_;
#pragma unroll
        for (int k = 0; k < 3; ++k) { const float nr2 = xr * xr - xi * xi, ni2 = 2.f * xr * xi; xr = nr2; xi = ni2; }
        a8r[pt] = xr; a8i[pt] = xi;
        const float den = lr * lr + li * li, nr = r_ - 1.f, ni = i_;
        const float kr = (nr * lr + ni * li) / den, ki = (ni * lr - nr * li) / den;
        float vr[8], vi[8];
#pragma unroll
        for (int j = 0; j < 8; ++j) { float br = 0.f, bi = 0.f; if (fq < 2) { br = p.in[17][gp * 16 + fq * 8 + j]; bi = p.in[18][gp * 16 + fq * 8 + j]; }
            vr[j] = kr * br - ki * bi; vi[j] = kr * bi + ki * br; }
        u32x4 wr_, wi_; wr_.x = pk2(vr[0], vr[1]); wr_.y = pk2(vr[2], vr[3]); wr_.z = pk2(vr[4], vr[5]); wr_.w = pk2(vr[6], vr[7]);
        wi_.x = pk2(vi[0], vi[1]); wi_.y = pk2(vi[2], vi[3]); wi_.z = pk2(vi[4], vi[5]); wi_.w = pk2(vi[6], vi[7]);
        breF[pt] = __builtin_bit_cast(bf16x8, wr_); bimF[pt] = __builtin_bit_cast(bf16x8, wi_); }
    bf16x8 cF[4];
#pragma unroll
    for (int ks = 0; ks < 4; ++ks) { float v[8]; const int k0 = 32 * ks + 8 * fq;
#pragma unroll
        for (int j = 0; j < 8; ++j) { const int k = k0 + j; v[j] = k < 64 ? p.in[19][((size_t)(l * 32 + g) * 16 + fr) * 64 + k] : -p.in[20][((size_t)(l * 32 + g) * 16 + fr) * 64 + k - 64]; }
        u32x4 wv; wv.x = pk2(v[0], v[1]); wv.y = pk2(v[2], v[3]); wv.z = pk2(v[4], v[5]); wv.w = pk2(v[6], v[7]); cF[ks] = __builtin_bit_cast(bf16x8, wv); }
    const f32x4 dsk = *(const f32x4*)(p.in[21] + l * 512 + g * 16 + 4 * fq);
    float Hr[4], Hi[4];
#pragma unroll
    for (int pt = 0; pt < 4; ++pt) { if (grp) { const size_t sp = ((size_t)(l * 8 + b) * 32 + g) * 64 + 16 * pt + fr; Hr[pt] = p.in[4][sp]; Hi[pt] = p.in[5][sp]; } else { Hr[pt] = 0.f; Hi[pt] = 0.f; } }
    const int trow = 8 * (fr >> 2) + (fr & 3);
    u32x4 xn[2];
#pragma unroll
    for (int tt = 0; tt < 2; ++tt) { xn[tt] = (u32x4){0u, 0u, 0u, 0u}; if (fq < 2) xn[tt] = *(const u32x4*)(X + (size_t)(rowbase + trow + 4 * tt) * 512 + g * 16 + fq * 8); }
    for (int ch = 0; ch < T / 32; ++ch) {
        const int r0 = rowbase + ch * 32;
        bf16x8 xF[2];
#pragma unroll
        for (int tt = 0; tt < 2; ++tt) xF[tt] = __builtin_bit_cast(bf16x8, xn[tt]);
        if (ch + 1 < T / 32) {
#pragma unroll
            for (int tt = 0; tt < 2; ++tt) if (fq < 2) xn[tt] = *(const u32x4*)(X + (size_t)(r0 + 32 + trow + 4 * tt) * 512 + g * 16 + fq * 8); }
        u32x2 xsk[2];
#pragma unroll
        for (int t2 = 0; t2 < 2; ++t2) xsk[t2] = *(const u32x2*)(X + (size_t)(r0 + 16 * t2 + fr) * 512 + g * 16 + 4 * fq);
        f32x4 bur[2][4], bui[2][4];
#pragma unroll
        for (int tt = 0; tt < 2; ++tt)
#pragma unroll
            for (int pt = 0; pt < 4; ++pt) { bur[tt][pt] = mfma16(xF[tt], breF[pt], (f32x4){0.f, 0.f, 0.f, 0.f}); bui[tt][pt] = mfma16(xF[tt], bimF[pt], (f32x4){0.f, 0.f, 0.f, 0.f}); }
#pragma unroll
        for (int pt = 0; pt < 4; ++pt) {
            float er = 0.f, ei = 0.f;
#pragma unroll
            for (int k = 0; k < 8; ++k) { const float ur = bur[k >> 2][pt][k & 3], ui = bui[k >> 2][pt][k & 3]; const float nr = ar[pt] * er - ai[pt] * ei + ur, ni = ar[pt] * ei + ai[pt] * er + ui; er = nr; ei = ni; }
            float cr = Hr[pt], ci = Hi[pt], mr = cr, mi = ci;
#pragma unroll
            for (int q = 0; q < 4; ++q) { const float Er = __shfl(er, fr + 16 * q), Ei = __shfl(ei, fr + 16 * q);
                const float nr = a8r[pt] * cr - a8i[pt] * ci + Er, ni = a8r[pt] * ci + a8i[pt] * cr + Ei; cr = nr; ci = ni;
                if (q + 1 == fq) { mr = cr; mi = ci; } }
            Hr[pt] = cr; Hi[pt] = ci;
            float hr = mr, hi = mi;
#pragma unroll
            for (int k = 0; k < 8; ++k) { const float ur = bur[k >> 2][pt][k & 3], ui = bui[k >> 2][pt][k & 3]; const float nr = ar[pt] * hr - ai[pt] * hi + ur, ni = ar[pt] * hi + ai[pt] * hr + ui; hr = nr; hi = ni;
                HT[(8 * fq + k) * 136 + 16 * pt + fr] = f2bf(hr); HT[(8 * fq + k) * 136 + 64 + 16 * pt + fr] = f2bf(hi); }
        }
        asm volatile("s_waitcnt lgkmcnt(0)" ::: "memory");
        f32x4 y[2];
#pragma unroll
        for (int t2 = 0; t2 < 2; ++t2) { y[t2] = (f32x4){0.f, 0.f, 0.f, 0.f};
#pragma unroll
            for (int ks = 0; ks < 4; ++ks) { const bf16x8 hf = *(const LAS bf16x8*)(HT + (16 * t2 + fr) * 136 + 32 * ks + 8 * fq); y[t2] = mfma16(cF[ks], hf, y[t2]); } }
#pragma unroll
        for (int t2 = 0; t2 < 2; ++t2) { u16* xp = X + (size_t)(r0 + 16 * t2 + fr) * 512 + g * 16 + 4 * fq; const u32x2 xx = xsk[t2];
            f32x4 xv; xv[0] = __uint_as_float(xx.x << 16); xv[1] = __uint_as_float(xx.x & 0xffff0000u); xv[2] = __uint_as_float(xx.y << 16); xv[3] = __uint_as_float(xx.y & 0xffff0000u);
            f32x4 z = y[t2] + dsk * xv;
#pragma unroll
            for (int e = 0; e < 4; ++e) z[e] = fgelu(z[e]);
            *(u32x2*)xp = pk4(z); }
        asm volatile("" ::: "memory");
    }
    if (fq == 0) { float* ore = p.out + (grp ? O_SRES + (size_t)l * 16384 + ((size_t)b * 32 + g) * 64 : O_SREP + (size_t)l * 32768 + ((size_t)b * 32 + g) * 64);
        float* oim = p.out + (grp ? O_SIMS + (size_t)l * 16384 + ((size_t)b * 32 + g) * 64 : O_SIMP + (size_t)l * 32768 + ((size_t)b * 32 + g) * 64);
#pragma unroll
        for (int pt = 0; pt < 4; ++pt) { ore[16 * pt + fr] = Hr[pt]; oim[16 * pt + fr] = Hi[pt]; } }
    __syncthreads();
}

DEV void gmlp_item(CP& p, int l, LAS unsigned char* lds, int grp, int b, int n, int g) {
    unsigned char* ws = p.ws;
    const int tid = tid_o(), w = tid >> 6, lane = tid & 63, fr = lane & 15, fq = lane >> 4;
    const int L = grp ? 64 : 128, T = grp ? 64 : 2048; const int rowbase = grp ? MTP + b * 64 : b * 2048 + n * 128;
    LAS u16* WT = (LAS u16*)lds; LAS u16* GT = WT + 128 * 136; LAS float* RS = (LAS float*)(GT + 128 * 136);
    const float* rowsq = (const float*)(ws + W_ROWSQ);
    if (tid < L) RS[tid] = __builtin_amdgcn_rsqf(rowsq[rowbase + tid] * (1.f / 512.f) + EPS);
    const u16* GV = (const u16*)(ws + W_GVT) + (grp ? (size_t)16 * 512 * 2048 : 0) + ((size_t)b * 512 + g * 128) * T + (grp ? 0 : n * 128);
    const u16* WM = (const u16*)(ws + W_WM) + (size_t)g * 128 * 128;
    const int cshift = grp ? 3 : 4, nchunk = 128 << cshift, nwch = L << cshift;
    u16* P1 = (u16*)(ws + W_P1);
    u32x4 gq[4], wq[4];
#pragma unroll
    for (int i = 0; i < 4; ++i) { const int chn = tid + 512 * i; const int cg_ = chn < nchunk ? chn : 0, cw_ = chn < nwch ? chn : 0;
        gq[i] = *(const u32x4*)(GV + (size_t)(cg_ >> cshift) * T + (cg_ & ((1 << cshift) - 1)) * 8);
        wq[i] = *(const u32x4*)(WM + (size_t)(cw_ >> cshift) * 128 + (cw_ & ((1 << cshift) - 1)) * 8); }
    u32x2 uq[8]; float bq[8];
    const int ntt = L >> 4;
#pragma unroll
    for (int tt = 0; tt < 8; ++tt) { const int t = tt < ntt ? 16 * tt + fr : fr; uq[tt] = *(const u32x2*)(P1 + (size_t)(rowbase + t) * 1024 + g * 128 + 16 * w + 4 * fq); bq[tt] = p.in[13][(size_t)(l * 4 + g) * 128 + t]; }
    const f32x4 gvg = *(const f32x4*)(p.in[11] + l * 512 + g * 128 + 16 * w + 4 * fq);
    __syncthreads();
#pragma unroll
    for (int i = 0; i < 4; ++i) { const int chn = tid + 512 * i;
        if (chn < nchunk) { const int c = chn >> cshift, kp = (chn & ((1 << cshift) - 1)) * 8; const unsigned gw[4] = {gq[i].x, gq[i].y, gq[i].z, gq[i].w}; u32x4 o;
            unsigned ow[4];
#pragma unroll
            for (int k = 0; k < 4; ++k) ow[k] = pk2(__uint_as_float(gw[k] << 16) * RS[kp + 2 * k], __uint_as_float(gw[k] & 0xffff0000u) * RS[kp + 2 * k + 1]);
            o.x = ow[0]; o.y = ow[1]; o.z = ow[2]; o.w = ow[3]; *(LAS u32x4*)(GT + c * 136 + kp) = o; }
        if (chn < nwch) { const int t = chn >> cshift, kp = (chn & ((1 << cshift) - 1)) * 8; *(LAS u32x4*)(WT + t * 136 + kp) = wq[i]; } }
    __syncthreads();
#pragma unroll
    for (int tt = 0; tt < 8; ++tt) { if (tt < ntt) { f32x4 a = (f32x4){0.f, 0.f, 0.f, 0.f};
        for (int ks = 0; ks < L / 32; ++ks) { if (32 * ks > 16 * tt + 15) break;
            const bf16x8 gf = *(const LAS bf16x8*)(GT + (16 * w + fr) * 136 + 32 * ks + 8 * fq), wf = *(const LAS bf16x8*)(WT + (16 * tt + fr) * 136 + 32 * ks + 8 * fq); a = mfma16(gf, wf, a); }
        const int t = 16 * tt + fr;
        f32x4 u; u[0] = __uint_as_float(uq[tt].x << 16); u[1] = __uint_as_float(uq[tt].x & 0xffff0000u); u[2] = __uint_as_float(uq[tt].y << 16); u[3] = __uint_as_float(uq[tt].y & 0xffff0000u);
        *(u32x2*)(P1 + (size_t)(rowbase + t) * 1024 + g * 128 + 16 * w + 4 * fq) = pk4(u * (a * gvg + bq[tt])); } }
    if (grp) {
        float* o = p.out + O_GMV + (size_t)l * 262144 + (size_t)b * 64 * 512; const float* gg = p.in[11] + l * 512 + g * 128;
        for (int idx = tid; idx < 64 * 128; idx += 512) { const int t = idx >> 7, c = idx & 127; o[(size_t)t * 512 + g * 128 + c] = bf2f(GT[c * 136 + t]) * gg[c]; }
    }
    __syncthreads();
}

DEV void phaseMix(CP& p, int l, LAS unsigned char* lds) {
    unsigned* ctr = (unsigned*)(p.ws + W_MISC) + l;
    LAS int* slot = (LAS int*)(lds + 160 * 1024 - 16);
    for (;;) {
        if (tid_o() == 0) *slot = (int)atomicAdd(ctr, 1u);
        __syncthreads();
        int it = __builtin_amdgcn_readfirstlane(*slot);
        __syncthreads();
        if (it >= 2304) break;
        int kind, grp = 0, a0, a1, a2 = 0;
        if (it < 64) { kind = 0; a0 = it >> 2; a1 = it & 3; }
        else if (it < 128) { it -= 64; kind = 1; a0 = it >> 2; a1 = it & 3; }
        else if (it < 160) { it -= 128; kind = 2; grp = 1; a0 = it >> 2; a1 = it & 3; }
        else if (it < 1184) { it -= 160; kind = 2; a2 = 15 - (it >> 6); a0 = (it & 63) >> 2; a1 = it & 3; }
        else if (it < 2208) { it -= 1184; kind = 3; a0 = it >> 6; a2 = (it >> 2) & 15; a1 = it & 3; }
        else if (it < 2240) { it -= 2208; kind = 0; grp = 1; a0 = it >> 2; a1 = it & 3; }
        else if (it < 2272) { it -= 2240; kind = 1; grp = 1; a0 = it >> 2; a1 = it & 3; }
        else { it -= 2272; kind = 3; grp = 1; a0 = it >> 2; a1 = it & 3; }
        asm volatile("" : "+s"(kind), "+s"(grp), "+s"(a0), "+s"(a1), "+s"(a2));
        if (kind == 0) {
#ifndef NO_S5
            s5_item(p, l, lds, grp, a0, a1);
#endif
        } else if (kind == 1) {
#ifndef NO_GLA
#ifdef GLA_SAMPLE_ONLY
            if (grp)
#endif
            gla_item(p, l, lds, grp, a0, a1);
#endif
        } else if (kind == 2) {
#ifndef NO_ATT
            attn_item(p, l, lds, grp, a0, a1, a2);
#endif
        } else {
#ifndef NO_GMLP
            gmlp_item(p, l, lds, grp, a0, a2, a1);
#endif
        }
    }
}

DEV void phaseFix(CP& p, int l) {
    unsigned char* ws = p.ws; const int gt = bid_o() * 512 + tid_o(), GT = gridDim.x * 512;
    const float* HEAD = (const float*)(ws + W_HEAD); const float* TAIL = (const float*)(ws + W_TAIL); u16* ACT = (u16*)(ws + W_ACT);
    const float* cw = p.in[35] + (size_t)l * 3 * 5632; const float* cb = p.in[36] + (size_t)l * 5632;
    for (int idx = gt; idx < 520 * 2816; idx += GT) { const int slab = idx / 2816, f = idx % 2816;
        float c0[2], c1[2];
#pragma unroll
        for (int bj = 0; bj < 2; ++bj) { const int ff = bj * 2816 + f; float pm2 = 0.f, pm1 = 0.f;
            if (slab >= 512) { const float* st = p.in[7] + ((size_t)(l * 8 + (slab - 512)) * 2) * 5632; pm2 = st[ff]; pm1 = st[5632 + ff]; }
            else if (slab & 31) { pm2 = TAIL[((size_t)(slab - 1) * 2) * 5632 + ff]; pm1 = TAIL[((size_t)(slab - 1) * 2 + 1) * 5632 + ff]; }
            const float h0 = HEAD[((size_t)slab * 2) * 5632 + ff], h1 = HEAD[((size_t)slab * 2 + 1) * 5632 + ff];
            const float w0 = cw[ff], w1 = cw[5632 + ff], w2 = cw[11264 + ff], bb = cb[ff];
            c0[bj] = bb + w0 * pm2 + w1 * pm1 + w2 * h0; c1[bj] = bb + w0 * pm1 + w1 * h0 + w2 * h1; }
        ACT[(size_t)(slab * 64) * 2816 + f] = f2bf(fsilu(c0[0]) * c0[1]); ACT[(size_t)(slab * 64 + 1) * 2816 + f] = f2bf(fsilu(c1[0]) * c1[1]); }
    for (int idx = gt; idx < 24 * 2 * 5632; idx += GT) { const int bb = idx / 11264, rem = idx % 11264;
        if (bb < 16) p.out[O_FCP + (size_t)l * 180224 + (size_t)bb * 11264 + rem] = TAIL[((size_t)(bb * 32 + 31) * 2) * 5632 + rem];
        else p.out[O_FCS + (size_t)l * 90112 + (size_t)(bb - 16) * 11264 + rem] = TAIL[((size_t)(512 + bb - 16) * 2) * 5632 + rem]; }
}

#define XB_TMO      128
#define XB_XCNT(j)  (256  + 64 * (j))
#define XB_XSUB(j)  (1280 + 64 * (j))
#define XB_XGEN(j)  (2304 + 64 * (j))
#define XB_TOP      3328
#define XB_TOPGEN   3392
#define XCD_BAR_WORDS 3456
#define XB_SPIN_CAP (1u << 18)

__device__ __forceinline__ unsigned xb_ld(unsigned* p)              { return __hip_atomic_load(p, __ATOMIC_RELAXED, __HIP_MEMORY_SCOPE_AGENT); }
__device__ __forceinline__ unsigned xb_add(unsigned* p, unsigned v) { return __hip_atomic_fetch_add(p, v, __ATOMIC_RELAXED, __HIP_MEMORY_SCOPE_AGENT); }
__device__ __forceinline__ unsigned xb_xcc_id() { return (unsigned)__builtin_amdgcn_s_getreg((3 << 11) | 20) & 0xFu; }
#define XB_SPIN(cond, bar) do { unsigned _sp = 0; while (cond) { __builtin_amdgcn_s_sleep(1); \
    if ((++_sp & 255u) == 0u) { if (xb_ld(&(bar)[XB_TMO])) break; if (_sp > XB_SPIN_CAP) { atomicAdd(&(bar)[XB_TMO], 1u); break; } } } } while (0)

struct XcdBarrier {
    unsigned* bar; unsigned x;
    volatile LAS unsigned* st;
};

__device__ __forceinline__ XcdBarrier xcd_barrier_post(unsigned* bar, volatile LAS unsigned* st) {
    XcdBarrier b; b.bar = bar; b.x = xb_xcc_id(); b.st = st;
    if (threadIdx.x == 0) (void)xb_add(&bar[XB_XCNT(b.x)], 1u);
    return b;
}
__device__ __forceinline__ void xcd_barrier_complete(unsigned* bar, unsigned x, unsigned& nloc, unsigned& nx) {
    const unsigned G = gridDim.x * gridDim.y * gridDim.z;
    unsigned sum, cnt, mine, sp = 0u;
    for (;;) {
        sum = 0u; cnt = 0u; mine = 0u;
#pragma unroll
        for (unsigned j = 0; j < 16; ++j) { const unsigned c = xb_ld(&bar[XB_XCNT(j)]); sum += c; cnt += (c > 0u) ? 1u : 0u; mine = (j == x) ? c : mine; }
        if (sum == G) break;
        __builtin_amdgcn_s_sleep(1);
        if ((++sp & 255u) == 0u) { if (xb_ld(&bar[XB_TMO])) break; if (sp > XB_SPIN_CAP) { atomicAdd(&bar[XB_TMO], 1u); break; } }
    }
    nloc = mine > 0u ? mine : 1u; nx = cnt > 0u ? cnt : 1u;
}

__device__ __forceinline__ void xcd_barrier(const XcdBarrier& b) {
    asm volatile("s_waitcnt vmcnt(0)" ::: "memory");
    __syncthreads();
    if (threadIdx.x == 0) {
        unsigned* bar = b.bar;
        __builtin_amdgcn_s_waitcnt(0);
        unsigned nloc = b.st[0], nx = b.st[1];
        if (nloc == 0u) { xcd_barrier_complete(bar, b.x, nloc, nx); b.st[0] = nloc; b.st[1] = nx; }
        const unsigned old = xb_add(&bar[XB_XSUB(b.x)], 1u);
        const unsigned gen = old / nloc;
        if (old + 1u == (gen + 1u) * nloc) {
            __builtin_amdgcn_fence(__ATOMIC_RELEASE, "agent");
            asm volatile("s_waitcnt vmcnt(0)" ::: "memory");
            const unsigned og = xb_add(&bar[XB_TOP], 1u);
            const unsigned tg = og / nx;
            if (og + 1u == (tg + 1u) * nx) xb_add(&bar[XB_TOPGEN], 1u);
            else XB_SPIN(xb_ld(&bar[XB_TOPGEN]) == tg, bar);
            __builtin_amdgcn_fence(__ATOMIC_ACQUIRE, "agent");
            xb_add(&bar[XB_XGEN(b.x)], 1u);
            asm volatile("s_waitcnt vmcnt(0)" ::: "memory");
        } else {
            XB_SPIN(xb_ld(&bar[XB_XGEN(b.x)]) == gen, bar);
            __builtin_amdgcn_fence(__ATOMIC_ACQUIRE, "agent");
            asm volatile("s_waitcnt vmcnt(0)" ::: "memory");
        }
    }
    __syncthreads();
}


__global__ void __launch_bounds__(512, 2) mega(Params p_unused) {
    extern __shared__ __attribute__((aligned(16))) unsigned char smem[];
    LAS unsigned char* lds = (LAS unsigned char*)smem;
    cg::grid_group grid = cg::this_grid();
    volatile LAS unsigned* xb_st = (volatile LAS unsigned*)(lds + 160 * 1024 - 32);
    if (threadIdx.x == 0) { xb_st[0] = 0u; xb_st[1] = 0u; }
    __syncthreads();
    const XcdBarrier xbar = xcd_barrier_post((unsigned*)(((CP*)__builtin_amdgcn_kernarg_segment_ptr())->ws + W_BAR), xb_st);
#define GSYNC() xcd_barrier(xbar)
#pragma unroll 1
    for (int l = 0; l < 2; ++l) {
        CP* pp = (CP*)__builtin_amdgcn_kernarg_segment_ptr(); asm volatile("" : "+s"(pp)); CP& p = *pp; unsigned char* ws = p.ws; const int G = gridDim.x, c = bid_o();
#ifndef SKIP_A
        phaseA(p, l);
#endif
        if (l == 0) grid.sync(); else GSYNC();
#ifndef SKIP_B
        {
            pg8::PlainSched S; S.T.init(130, NMIX, G, c); S.A = (const char*)ws + W_H; S.B = (const char*)ws + W_WIN; S.ld = 1024; S.nt = 16;
            EpiIn E; E.l = l; E.out = p.out; E.ws = ws; E.qg = p.in[27] + l * 64; E.kg = p.in[28] + l * 64; E.rs1 = (const float*)(ws + W_RS) + (size_t)(l * 2) * MT;
            pg8::gemm_phase(lds, 1024, S, E);
        }
#endif
        GSYNC();
#ifndef SKIP_C
        phaseMix(p, l, lds);
#endif
        GSYNC();
#ifndef SKIP_D
        {
            pg8::PlainSched S; S.T.init(130, 2, G, c); S.A = (const char*)ws + W_S5; S.B = (const char*)ws + W_WGLU; S.ld = 512; S.nt = 8;
            EpiGlu E; E.ws = ws; E.bias = p.in[23] + l * 512;
            pg8::gemm_phase(lds, 512, S, E);
        }
#endif
        GSYNC();
#ifndef SKIP_E
        {
            MergeSched S; S.T.init(128, 4, G, c); S.ws = ws;
            EpiMerge E; E.ws = ws; E.bgate = p.in[10] + l * 4096; E.rs1 = (const float*)(ws + W_RS) + (size_t)(l * 2) * MT;
            pg8::gemm_phase(lds, 1024, S, E);
        }
#endif
        GSYNC();
        {
            const f32x4* mf = (const f32x4*)(ws + W_PART); u16* mg = (u16*)(ws + W_MERGED) + (size_t)MTP * 1024;
            for (int i = c * 512 + tid_o(); i < 512 * 256; i += G * 512) *(u32x2*)(mg + (size_t)i * 4) = pk4(mf[i] + mf[i + 131072] + mf[i + 262144] + mf[i + 393216]);
        }
        GSYNC();
#ifndef SKIP_F
        {
            pg8::TailSched S; S.T.init(128, 4, G, c); S.A = (const char*)ws + W_MERGED; S.B = (const char*)ws + W_WOUT; S.ld = 1024; S.nt = 16; S.npiece = 4; S.ntp = 4;
            EpiRes E; E.xin = l == 0 ? p.in[0] : nullptr; E.xb = (u16*)(ws + W_H); E.yout = nullptr; E.rsacc = (float*)(ws + W_RS) + (size_t)(l * 2 + 1) * MT; E.yfull = (float*)(ws + W_PART);
            pg8::gemm_phase(lds, 1024, S, E);
        }
#endif
        GSYNC();
#ifndef SKIP_G
        sample_rows_reduce(p.out + (size_t)MTP * 1024, (const float*)(ws + W_PART), 4, (u16*)(ws + W_H) + (size_t)MTP * 1024, (float*)(ws + W_RS) + (size_t)(l * 2 + 1) * MT + MTP);
#endif
        GSYNC();
#ifndef SKIP_H
        {
            pg8::PlainSched S; S.T.init(130, 22, G, c); S.A = (const char*)ws + W_H; S.B = (const char*)ws + W_WUP; S.ld = 1024; S.nt = 16;
            EpiUp E; E.ws = ws; E.cw = p.in[35] + (size_t)l * 3 * 5632; E.cbias = p.in[36] + (size_t)l * 5632; E.rs2 = (const float*)(ws + W_RS) + (size_t)(l * 2 + 1) * MT;
            pg8::gemm_phase(lds, 1024, S, E);
        }
#endif
        GSYNC();
#ifndef SKIP_I
        phaseFix(p, l);
#endif
        GSYNC();
#ifndef SKIP_J
        {
            pg8::TailSched S; S.T.init(128, 4, G, c); S.A = (const char*)ws + W_ACT; S.B = (const char*)ws + W_WDN; S.ld = 2816; S.nt = 44; S.npiece = 11; S.ntp = 4;
            EpiRes E; E.xin = nullptr; E.xb = (u16*)(ws + W_H); E.yout = l == 1 ? p.out : nullptr; E.rsacc = l == 0 ? (float*)(ws + W_RS) + (size_t)2 * MT : nullptr; E.yfull = (float*)(ws + W_PART);
            pg8::gemm_phase(lds, 2816, S, E);
        }
#endif
        GSYNC();
        if (l == 1) sample_rows_reduce(p.out + (size_t)MTP * 1024, (const float*)(ws + W_PART), 11, (u16*)(ws + W_H) + (size_t)MTP * 1024, (float*)(ws + W_RS) + (size_t)3 * MT + MTP);
    }
}

extern "C" void kernel_launch(void* const* d_in, const int* in_sizes, int n_in, void* d_out, int out_size, void* d_ws, size_t ws_size, hipStream_t stream) {
    constexpr int LDS_BYTES = 160 * 1024;
    static int grid_blocks = 0;
    if (!grid_blocks) {
        int dev = 0, cus = 0, per_cu = 0;
        hipGetDevice(&dev);
        hipDeviceGetAttribute(&cus, hipDeviceAttributeMultiprocessorCount, dev);
        hipFuncSetAttribute((const void*)mega, hipFuncAttributeMaxDynamicSharedMemorySize, LDS_BYTES);
        hipOccupancyMaxActiveBlocksPerMultiprocessor(&per_cu, (const void*)mega, 512, LDS_BYTES);
        if (per_cu < 1) per_cu = 1;
        grid_blocks = cus * per_cu;
        if (ws_size < W_END) fprintf(stderr, "kernel_launch: workspace too small: %zu < %zu\n", ws_size, (size_t)W_END);
    }
    Params p{};
    for (int i = 0; i < 38; ++i) p.in[i] = (const float*)d_in[i];
    p.out = (float*)d_out; p.ws = (unsigned char*)d_ws;
    (void)hipMemsetAsync((unsigned char*)d_ws + W_BAR, 0, 16384, stream);
    void* args[] = {&p};
    hipError_t e = hipLaunchCooperativeKernel((const void*)mega, dim3(grid_blocks), dim3(512), args, LDS_BYTES, stream);
    if (e != hipSuccess) fprintf(stderr, "cooperative launch failed: %s (grid %d)\n", hipGetErrorString(e), grid_blocks);
}
```

```cpp
#include <hip/hip_runtime.h>
#include <hip/hip_cooperative_groups.h>
#include <cstdio>
namespace cg = cooperative_groups;

#define LAS __attribute__((address_space(3)))
#define DEV __device__ __forceinline__
typedef unsigned short u16;
typedef short bf16x8 __attribute__((ext_vector_type(8)));
typedef float f32x4 __attribute__((ext_vector_type(4)));
typedef float f32x2 __attribute__((ext_vector_type(2)));
typedef unsigned u32x4 __attribute__((ext_vector_type(4)));
typedef unsigned u32x2 __attribute__((ext_vector_type(2)));

constexpr int MTP = 32768, MT = 33280;
constexpr int NINP = 8960;
constexpr int NMIX = 19;
constexpr int GATE0 = 4864;
constexpr float EPS = 1e-6f;
constexpr float LOG2E = 1.4426950408889634f;

constexpr size_t O_Y = 0, O_DKP = 34078720, O_DVP = 67633152, O_SREP = 101187584, O_SIMP = 101253120, O_GLAP = 101318656,
                 O_FCP = 102367232, O_DKS = 102727680, O_DVS = 103251968, O_SRES = 103776256, O_SIMS = 103809024, O_GLAS = 103841792,
                 O_FCS = 104366080, O_GMV = 104546304;

constexpr size_t SZ_H = (size_t)MT * 1024 * 2;
constexpr size_t SZ_HALF = (size_t)MT * 512 * 2;
constexpr size_t W_H = 0;
constexpr size_t W_P1 = W_H + SZ_H;
constexpr size_t W_P2 = W_P1 + SZ_H;
constexpr size_t W_S5 = W_P2 + SZ_H;
constexpr size_t W_GVT = W_S5 + SZ_HALF;
constexpr size_t W_CQ = W_GVT + SZ_HALF;
constexpr size_t W_CK = W_CQ + SZ_HALF / 2;
constexpr size_t W_CVT = W_CK + SZ_HALF / 2;
constexpr size_t W_CODE = W_CVT + SZ_HALF;
constexpr size_t W_DKP = W_CODE + (size_t)MT * 16 * 4;
constexpr size_t W_DKS = W_DKP + (size_t)MTP * 512 * 2;
constexpr size_t W_DVTP = W_DKS + (size_t)8 * 4160 * 512 * 2;
constexpr size_t W_DVTS = W_DVTP + (size_t)MTP * 512 * 2;
constexpr size_t W_ROWSQ = W_DVTS + (size_t)8 * 4160 * 512 * 2;
constexpr size_t W_MISC = W_ROWSQ + (size_t)MT * 4;
constexpr size_t W_WIN = W_MISC + 4096;
constexpr size_t W_WBR = W_WIN + (size_t)NINP * 1024 * 2;
constexpr size_t W_WOUT = W_WBR + (size_t)2 * 1024 * 1024 * 2;
constexpr size_t W_WGLU = W_WOUT + (size_t)1024 * 1024 * 2;
constexpr size_t W_WUP = W_WGLU + (size_t)512 * 512 * 2;
constexpr size_t W_WDN = W_WUP + (size_t)5632 * 1024 * 2;
constexpr size_t W_MFS = W_WDN + (size_t)1024 * 2816 * 2;
constexpr size_t W_BAR = W_MFS + (size_t)512 * 1024 * 4;
constexpr size_t W_WM = W_BAR + 16384;
constexpr size_t W_RS = W_WM + (size_t)4 * 128 * 128 * 2;
constexpr size_t W_PART = W_RS + (size_t)4 * MT * 4;
constexpr size_t W_END = W_PART + (size_t)11 * 512 * 1024 * 4;
constexpr size_t W_MERGED = W_CQ;
constexpr size_t W_SCR = W_DKP;
constexpr size_t W_ACT = W_P1;
constexpr size_t W_HEAD = W_DVTP;
constexpr size_t W_TAIL = W_HEAD + (size_t)520 * 2 * 5632 * 4;
static_assert(W_TAIL + (size_t)520 * 2 * 5632 * 4 <= W_ROWSQ, "head/tail alias");
static_assert((size_t)MT * 2816 * 2 <= W_CQ - W_P1, "act alias");

struct Params { const float* in[38]; float* out; unsigned char* ws; };
typedef const __attribute__((address_space(4))) Params CP;

DEV int tid_o() { int t = threadIdx.x; asm volatile("" : "+v"(t)); return t; }
DEV int bid_o() { int t = blockIdx.x; asm volatile("" : "+s"(t)); return t; }
DEV float bf2f(u16 v) { return __uint_as_float(((unsigned)v) << 16); }
typedef __bf16 b16x2 __attribute__((ext_vector_type(2)));
DEV unsigned pk2(float lo, float hi) { const f32x2 v = {lo, hi}; const b16x2 r = __builtin_convertvector(v, b16x2); return __builtin_bit_cast(unsigned, r); }
DEV u16 f2bf(float v) { return (u16)(pk2(v, 0.f) & 0xffffu); }
DEV float fsigmoid(float x) { return __builtin_amdgcn_rcpf(1.f + __expf(-x)); }
DEV float fsilu(float x) { return x * fsigmoid(x); }
DEV float fgelu(float x) { return x * fsigmoid(1.5957691216057308f * (x + 0.044715f * x * x * x)); }
DEV float flogsig(float x) { return fminf(x, 0.f) - __logf(1.f + __expf(-fabsf(x))); }
DEV f32x4 mfma16(bf16x8 a, bf16x8 b, f32x4 c) { return __builtin_amdgcn_mfma_f32_16x16x32_bf16(a, b, c, 0, 0, 0); }
DEV u32x2 pk4(f32x4 v) { u32x2 r; r.x = pk2(v[0], v[1]); r.y = pk2(v[2], v[3]); return r; }
DEV float red_fq(float v) { v += __shfl_xor(v, 16); v += __shfl_xor(v, 32); return v; }
DEV float wave_sum(float v) { for (int o = 32; o; o >>= 1) v += __shfl_xor(v, o); return v; }

namespace pg8 {
constexpr int BM = 256, BK = 64, HALF = 128, HTB = HALF * BK * 2, NXCD = 8, WGM = 8;
DEV int lds_byte(int r, int c) { const int st = (r >> 4) * 2 + (c >> 5), rr = r & 15, cc = c & 31, ob = rr * 64 + cc * 2; return st * 1024 + (ob ^ (((ob >> 9) & 1) << 5)); }
DEV void stage_rc(int b, int& R, int& C) { const int st = b / 1024, sb = b % 1024, swz = sb ^ (((sb >> 9) & 1) << 5); R = (st >> 1) * 16 + swz / 64; C = (st & 1) * 32 + (swz % 64) / 2; }
struct GUnit { const char* A; const char* B; int nt, pm, pn, kind; };
struct TileOrder {
    int nM, nN, nwg, G, c;
    DEV void init(int nM_, int nN_, int G_, int c_) { nM = nM_; nN = nN_; nwg = nM * nN; G = G_; c = c_; }
    DEV bool tile(int i, int& pm, int& pn) const {
        const long L = (long)i * G + c; if (L >= nwg) return false;
        int wgid = (int)L; { const int q = nwg / NXCD, r = nwg % NXCD, xcd = wgid % NXCD, off = wgid / NXCD; wgid = (xcd < r ? xcd * (q + 1) : r * (q + 1) + (xcd - r) * q) + off; }
        const int nig = WGM * nN, gid = wgid / nig, fm = gid * WGM, gsz = (nM - fm) < WGM ? (nM - fm) : WGM;
        pm = fm + ((wgid % nig) % gsz); pn = (wgid % nig) / gsz; return true;
    }
};
struct TailSched {
    TileOrder T; const char* A; const char* B; int ld, nt, npiece, ntp;
    DEV bool next(int i, GUnit& u) const { int pm, pn;
        if (T.tile(i, pm, pn)) { u.pm = pm; u.pn = pn; u.kind = 0; u.nt = nt; u.A = A + (size_t)pm * 256 * ld * 2; u.B = B + (size_t)pn * 256 * ld * 2; return true; }
        const int i0 = (T.nwg - T.c + T.G - 1) / T.G; const int j = (i - i0) * T.G + T.c; if (j >= 8 * npiece) return false;
        const int tile = j / npiece, kp = j % npiece; pm = 128 + (tile >> 2); pn = tile & 3; u.pm = pm; u.pn = pn; u.kind = 1 + kp; u.nt = ntp;
        u.A = A + (size_t)pm * 256 * ld * 2 + (size_t)kp * ntp * 128; u.B = B + (size_t)pn * 256 * ld * 2 + (size_t)kp * ntp * 128; return true; }
};
struct PlainSched {
    TileOrder T; const char* A; const char* B; int ld, nt;
    DEV bool next(int i, GUnit& u) const { int pm, pn; if (!T.tile(i, pm, pn)) return false; u.pm = pm; u.pn = pn; u.kind = 0; u.nt = nt;
        u.A = A + (size_t)pm * 256 * ld * 2; u.B = B + (size_t)pn * 256 * ld * 2; return true; }
};

template <class Epi, class Sched>
DEV void gemm_phase(LAS unsigned char* lds, const int ld, const Sched& S, const Epi& E) {
    const int tid = tid_o(), wid = __builtin_amdgcn_readfirstlane(tid >> 6), lane = tid & 63, wr = wid >> 2, wc = wid & 3, fr = lane & 15, fq = lane >> 4;
    unsigned voff[2];
#pragma unroll
    for (int i = 0; i < 2; ++i) { int R, C; stage_rc(tid * 16 + i * 8192, R, C); voff[i] = (unsigned)(R * ld + C) * 2u; }
    const size_t kstep = (size_t)(BK * 2);
    const size_t hstep = (size_t)HALF * ld * 2;
    const unsigned ldsw = (unsigned)wid * 1024u;
    const int aoff = lds_byte(wr * 64 + fr, fq * 8), boff = lds_byte(wc * 32 + fr, fq * 8);
#define PG8_SA(b, h) (((b) * 2 + (h)) * HTB)
#define PG8_SB(b, h) ((4 + (b) * 2 + (h)) * HTB)
#define PG8_STAGE(bufoff, gbase) do { _Pragma("unroll") for (int _i = 0; _i < 2; ++_i) \
        __builtin_amdgcn_global_load_lds((const unsigned*)((const char*)(gbase) + voff[_i]), (LAS unsigned*)(lds + (bufoff) + ldsw + _i * 8192), 16, 0, 0); } while (0)
#define PG8_LDA(dst, b, h) do { _Pragma("unroll") for (int m = 0; m < 4; ++m) _Pragma("unroll") for (int k = 0; k < 2; ++k) dst[m][k] = *(const LAS bf16x8*)(lds + PG8_SA(b, h) + aoff + m * 2048 + k * 1024); } while (0)
#define PG8_LDB(dst, b, h) do { _Pragma("unroll") for (int n = 0; n < 2; ++n) _Pragma("unroll") for (int k = 0; k < 2; ++k) dst[n][k] = *(const LAS bf16x8*)(lds + PG8_SB(b, h) + boff + n * 2048 + k * 1024); } while (0)
#define PG8_MMA(ai, bj, At, Bt) do { __builtin_amdgcn_s_setprio(1); _Pragma("unroll") for (int m = 0; m < 4; ++m) _Pragma("unroll") for (int n = 0; n < 2; ++n) _Pragma("unroll") for (int k = 0; k < 2; ++k) \
        acc[ai][bj][m][n] = __builtin_amdgcn_mfma_f32_16x16x32_bf16(Bt[n][k], At[m][k], acc[ai][bj][m][n], 0, 0, 0); __builtin_amdgcn_s_setprio(0); } while (0)
#define PG8_WAIT_V(n) asm volatile("s_waitcnt vmcnt(" #n ")" ::: "memory")
#define PG8_WAIT_L(n) asm volatile("s_waitcnt lgkmcnt(" #n ")" ::: "memory")
#define PG8_BAR __builtin_amdgcn_s_barrier()
#define PG8_SCHED __builtin_amdgcn_sched_barrier(0)
    GUnit cur, nxt; int ui = 0;
    if (!S.next(0, cur)) return;
    f32x4 acc[2][2][4][2];
#pragma unroll
    for (int a = 0; a < 2; ++a)
#pragma unroll
        for (int b = 0; b < 2; ++b)
#pragma unroll
            for (int m = 0; m < 4; ++m)
#pragma unroll
                for (int n = 0; n < 2; ++n) acc[a][b][m][n] = (f32x4){0.f, 0.f, 0.f, 0.f};
    bf16x8 At[4][2], B0[2][2], B1[2][2];
    const char* cA = cur.A; const char* cB = cur.B;
    PG8_STAGE(PG8_SB(0, 0), cB); PG8_STAGE(PG8_SA(0, 0), cA); PG8_STAGE(PG8_SB(0, 1), cB + hstep); PG8_STAGE(PG8_SA(0, 1), cA + hstep);
    if (wr == 1) PG8_BAR;
    PG8_WAIT_V(4); PG8_BAR;
    PG8_STAGE(PG8_SB(1, 0), cB + kstep); PG8_STAGE(PG8_SA(1, 0), cA + kstep); PG8_STAGE(PG8_SB(1, 1), cB + hstep + kstep);
    PG8_WAIT_V(6); PG8_BAR;
    for (;;) {
        const bool has_next = S.next(ui + 1, nxt);
        const char* nA = has_next ? nxt.A : cA; const char* nB = has_next ? nxt.B : cB;
        const int nt = cur.nt;
        for (int t = 0; t < nt; t += 2) {
            const bool last = (t == nt - 2);
            const char* a1 = cA + (size_t)(t + 1) * kstep;
            const char* a2 = last ? nA : cA + (size_t)(t + 2) * kstep; const char* b2 = last ? nB : cB + (size_t)(t + 2) * kstep;
            const char* a3 = a2 + kstep; const char* b3 = b2 + kstep;
            PG8_LDB(B0, 0, 0); PG8_SCHED; PG8_LDA(At, 0, 0); PG8_STAGE(PG8_SA(1, 1), a1 + hstep);
            PG8_WAIT_L(8); PG8_BAR; PG8_WAIT_L(0); PG8_MMA(0, 0, At, B0); PG8_BAR; PG8_SCHED;
            PG8_LDB(B1, 0, 1); PG8_STAGE(PG8_SB(0, 0), b2);
            PG8_BAR; PG8_WAIT_L(0); PG8_MMA(0, 1, At, B1); PG8_BAR;
            PG8_LDA(At, 0, 1); PG8_STAGE(PG8_SA(0, 0), a2);
            PG8_BAR; PG8_WAIT_L(0); PG8_MMA(1, 0, At, B0); PG8_BAR; PG8_SCHED;
            PG8_STAGE(PG8_SB(0, 1), b2 + hstep);
            PG8_WAIT_V(6); PG8_BAR; PG8_MMA(1, 1, At, B1); PG8_BAR;
            PG8_LDB(B0, 1, 0); PG8_SCHED; PG8_LDA(At, 1, 0); PG8_STAGE(PG8_SA(0, 1), a2 + hstep);
            PG8_WAIT_L(8); PG8_BAR; PG8_WAIT_L(0); PG8_MMA(0, 0, At, B0); PG8_BAR; PG8_SCHED;
            PG8_LDB(B1, 1, 1); PG8_STAGE(PG8_SB(1, 0), b3);
            PG8_BAR; PG8_WAIT_L(0); PG8_MMA(0, 1, At, B1); PG8_BAR;
            PG8_LDA(At, 1, 1); PG8_STAGE(PG8_SA(1, 0), a3);
            PG8_BAR; PG8_WAIT_L(0); PG8_MMA(1, 0, At, B0); PG8_BAR; PG8_SCHED;
            PG8_STAGE(PG8_SB(1, 1), b3 + hstep);
            PG8_WAIT_V(6); PG8_BAR; PG8_MMA(1, 1, At, B1); PG8_BAR;
        }
        { int fr_ = fr, fq_ = fq, wr_ = wr, wc_ = wc; asm volatile("" : "+v"(fr_), "+v"(fq_), "+s"(wr_), "+s"(wc_));
          E(acc, cur, wr_, wc_, fr_, fq_); }
        if (!has_next) break;
#pragma unroll
        for (int a = 0; a < 2; ++a)
#pragma unroll
            for (int b = 0; b < 2; ++b)
#pragma unroll
                for (int m = 0; m < 4; ++m)
#pragma unroll
                    for (int n = 0; n < 2; ++n) acc[a][b][m][n] = (f32x4){0.f, 0.f, 0.f, 0.f};
        cur = nxt; cA = nA; cB = nB; ++ui;
    }
    PG8_WAIT_V(0);
    if (wr == 0) PG8_BAR;
    PG8_BAR;
#undef PG8_SA
#undef PG8_SB
#undef PG8_STAGE
#undef PG8_LDA
#undef PG8_LDB
#undef PG8_MMA
#undef PG8_WAIT_V
#undef PG8_WAIT_L
#undef PG8_BAR
#undef PG8_SCHED
}
}
using pg8::GUnit;
typedef f32x4 AccT[2][2][4][2];

#define FOR_AM _Pragma("unroll") for (int ai = 0; ai < 2; ++ai) _Pragma("unroll") for (int m = 0; m < 4; ++m)
#define FOR_BN _Pragma("unroll") for (int bj = 0; bj < 2; ++bj) _Pragma("unroll") for (int n = 0; n < 2; ++n)

struct EpiIn {
    int l; float* out; unsigned char* ws; const float* qg; const float* kg; const float* rs1;
    DEV void operator()(const AccT& acc, const GUnit& u, int wr, int wc, int fr, int fq) const {
        const int pn = u.pn; const bool smp = u.pm >= 128;
        const int rowb = u.pm * 256 + wr * 64 + fr;
        const int ct0 = wc * 32 + 4 * fq;
        u16* P1 = (u16*)(ws + W_P1); u16* P2 = (u16*)(ws + W_P2);
        float rsx[2][4];
        FOR_AM rsx[ai][m] = __builtin_amdgcn_rsqf(rs1[rowb + ai * 128 + m * 16] * (1.f / 1024.f) + EPS);
        if (pn < 2) {
            FOR_AM { const int row = rowb + ai * 128 + m * 16; FOR_BN { f32x4 v = (acc[ai][bj][m][n] * rsx[ai][m]);
                for (int e = 0; e < 4; ++e) v[e] = fgelu(v[e]);
                *(u32x2*)(P1 + (size_t)row * 1024 + pn * 256 + ct0 + bj * 128 + n * 16) = pk4(v); } }
        } else if (pn < 4 || pn == 8 || pn == 9 || pn == 16 || pn == 17) {
            const int kind = pn < 4 ? 0 : (pn < 10 ? 1 : 2);
            const int cseg = (pn & 1) * 256;
            u16* dstT; int T, toff = 0;
            if (kind == 0) { dstT = (u16*)(ws + W_GVT) + (smp ? (size_t)16 * 512 * 2048 : 0); T = smp ? 64 : 2048; }
            else if (kind == 1) { dstT = (u16*)(ws + W_CVT) + (smp ? (size_t)16 * 512 * 2048 : 0); T = smp ? 64 : 2048; }
            else { dstT = (u16*)(ws + (smp ? W_DVTS : W_DVTP)); T = smp ? 4160 : 2048; toff = smp ? 4096 : 0; }
            float* rowsq = (float*)(ws + W_ROWSQ);
            FOR_AM { const int row = rowb + ai * 128 + m * 16;
                int b, t; if (smp) { const int rs = row - MTP; b = rs >> 6; t = rs & 63; } else { b = row >> 11; t = row & 2047; }
                float ss = 0.f;
                FOR_BN { f32x4 v = (acc[ai][bj][m][n] * rsx[ai][m]); const int cc = cseg + ct0 + bj * 128 + n * 16;
                    if (kind == 0) { for (int e = 0; e < 4; ++e) { v[e] = fgelu(v[e]); ss += v[e] * v[e]; } }
                    if (kind == 2) { float* o = smp ? out + O_DVS + (size_t)l * 262144 + (size_t)(row - MTP) * 512 + cc : out + O_DVP + (size_t)l * 16777216 + (size_t)row * 512 + cc;
                        *(f32x4*)o = v; }
                    for (int e = 0; e < 4; ++e) dstT[((size_t)b * 512 + cc + e) * T + toff + t] = f2bf(v[e]); }
                if (kind == 0) { ss = red_fq(ss); if (fq == 0) atomicAdd(rowsq + row, ss); } }
        } else if (pn < 6) {
            u16* S5 = (u16*)(ws + W_S5);
            FOR_AM { const int row = rowb + ai * 128 + m * 16; FOR_BN {
                *(u32x2*)(S5 + (size_t)row * 512 + (pn - 4) * 256 + ct0 + bj * 128 + n * 16) = pk4((acc[ai][bj][m][n] * rsx[ai][m])); } }
        } else if (pn < 8) {
            u16* D = (u16*)(ws + (pn == 6 ? W_CQ : W_CK)); const float sc = pn == 6 ? 0.125f : 1.f;
            FOR_AM { const int row = rowb + ai * 128 + m * 16; FOR_BN {
                *(u32x2*)(D + (size_t)row * 256 + ct0 + bj * 128 + n * 16) = pk4((acc[ai][bj][m][n] * rsx[ai][m]) * sc); } }
        } else if (pn < 12) {
            FOR_AM { const int row = rowb + ai * 128 + m * 16; FOR_BN { f32x4 v = (acc[ai][bj][m][n] * rsx[ai][m]);
                for (int e = 0; e < 4; ++e) v[e] = fsilu(v[e]);
                *(u32x2*)(P2 + (size_t)row * 1024 + (pn - 10) * 256 + ct0 + bj * 128 + n * 16) = pk4(v); } }
        } else if (pn < 16) {
            const bool isq = pn < 14; const int hh = 4 * (pn & 1) + wc; const float* g = isq ? qg : kg;
            f32x4 gv[2][2];
            FOR_BN gv[bj][n] = *(const f32x4*)(g + 32 * bj + 16 * n + 4 * fq);
            FOR_AM { const int row = rowb + ai * 128 + m * 16;
                float ss = 0.f;
                FOR_BN { const f32x4 v = (acc[ai][bj][m][n] * rsx[ai][m]); ss += v[0] * v[0] + v[1] * v[1] + v[2] * v[2] + v[3] * v[3]; }
                ss = red_fq(ss);
                float rs = __builtin_amdgcn_rsqf(ss * (1.f / 64.f) + EPS);
                if (isq) { rs *= 0.125f * LOG2E;
                    FOR_BN { *(u32x2*)(P2 + (size_t)row * 1024 + 512 + hh * 64 + 32 * bj + 16 * n + 4 * fq) = pk4((acc[ai][bj][m][n] * rsx[ai][m]) * rs * gv[bj][n]); }
                } else {
                    float* o; u16* kb;
                    if (smp) { const int rs_ = row - MTP; o = out + O_DKS + (size_t)l * 262144 + (size_t)rs_ * 512; kb = (u16*)(ws + W_DKS) + ((size_t)(rs_ >> 6) * 4160 + 4096 + (rs_ & 63)) * 512; }
                    else { o = out + O_DKP + (size_t)l * 16777216 + (size_t)row * 512; kb = (u16*)(ws + W_DKP) + (size_t)row * 512; }
                    FOR_BN { const f32x4 v = (acc[ai][bj][m][n] * rsx[ai][m]) * rs * gv[bj][n]; const int d = hh * 64 + 32 * bj + 16 * n + 4 * fq;
                        *(f32x4*)(o + d) = v; *(u32x2*)(kb + d) = pk4(v); } } }
        } else {
            if (wc == 0) { float* C = (float*)(ws + W_CODE);
                FOR_AM { const int row = rowb + ai * 128 + m * 16; *(f32x4*)(C + (size_t)row * 16 + 4 * fq) = acc[ai][0][m][0] * rsx[ai][m]; } }
        }
    }
};

struct EpiGlu {
    unsigned char* ws; const float* bias;
    DEV void operator()(const AccT& acc, const GUnit& u, int wr, int wc, int fr, int fq) const {
        const u16* Z = (const u16*)(ws + W_S5); u16* P1 = (u16*)(ws + W_P1);
        const int rowb = u.pm * 256 + wr * 64 + fr, cb = u.pn * 256 + wc * 32 + 4 * fq;
        FOR_AM { const int row = rowb + ai * 128 + m * 16; FOR_BN { const int col = cb + bj * 128 + n * 16;
            const f32x4 bv = *(const f32x4*)(bias + col); const u32x2 zz = *(const u32x2*)(Z + (size_t)row * 512 + col);
            f32x4 z; z[0] = __uint_as_float(zz.x << 16); z[1] = __uint_as_float(zz.x & 0xffff0000u); z[2] = __uint_as_float(zz.y << 16); z[3] = __uint_as_float(zz.y & 0xffff0000u);
            f32x4 v = acc[ai][bj][m][n] + bv;
            for (int e = 0; e < 4; ++e) v[e] = z[e] * fsigmoid(v[e]);
            *(u32x2*)(P1 + (size_t)row * 1024 + 512 + col) = pk4(v); } }
    }
};

struct MergeSched {
    pg8::TileOrder T; unsigned char* ws;
    DEV void fill(GUnit& u, int pm, int pn, int b, int sub) const {
        u.pm = pm; u.pn = pn;
        if (sub) { u.nt = 16; u.A = (const char*)ws + W_H + (size_t)pm * 256 * 2048; u.B = (const char*)ws + W_WIN + (size_t)(GATE0 + b * 1024 + pn * 256) * 2048; }
        else { u.nt = 8; u.A = (const char*)ws + (b < 2 ? W_P1 : W_P2) + (size_t)pm * 256 * 2048 + (b & 1) * 1024;
               u.B = (const char*)ws + W_WBR + (size_t)(b >> 1) * 1024 * 2048 + (size_t)pn * 256 * 2048 + (b & 1) * 1024; }
    }
    DEV bool next(int i, GUnit& u) const {
        int pm, pn;
        if (T.tile(i >> 3, pm, pn)) { const int s = i & 7; u.kind = s; fill(u, pm, pn, s >> 1, s & 1); return true; }
        const int i0 = (T.nwg - T.c + T.G - 1) / T.G; const int jj = i - 8 * i0; const int job = (jj >> 1) * T.G + T.c; if (job >= 32) return false;
        const int tile = job >> 2, b = job & 3; u.kind = 8 + 2 * b + (jj & 1); fill(u, 128 + (tile >> 2), tile & 3, b, jj & 1); return true;
    }
};
struct EpiMerge {
    unsigned char* ws; const float* bgate; const float* rs1;
    DEV void operator()(const AccT& acc, const GUnit& u, int wr, int wc, int fr, int fq) const {
        u32x4* sT = (u32x4*)(ws + W_SCR) + (size_t)bid_o() * 16 * 512 + tid_o();
        u32x4* sS = (u32x4*)(ws + W_SCR + (size_t)32 * 1024 * 1024) + (size_t)bid_o() * 16 * 512 + tid_o();
        const int s = u.kind & 7, b = s >> 1; const bool smp = u.kind >= 8;
        if (!(s & 1)) {
#pragma unroll
            for (int q = 0; q < 16; ++q) { const int ai = q >> 3, bj = (q >> 2) & 1, m = q & 3; const u32x2 lo = pk4(acc[ai][bj][m][0]), hi = pk4(acc[ai][bj][m][1]);
                u32x4 w; w.x = lo.x; w.y = lo.y; w.z = hi.x; w.w = hi.y; sT[q * 512] = w; }
        } else {
            u16* MG = (u16*)(ws + W_MERGED);
            const int rowb = u.pm * 256 + wr * 64 + fr, cb = u.pn * 256 + wc * 32 + 4 * fq;
            f32x4 bvv[2][2];
#pragma unroll
            for (int bj = 0; bj < 2; ++bj)
#pragma unroll
                for (int n = 0; n < 2; ++n) bvv[bj][n] = *(const f32x4*)(bgate + b * 1024 + cb + bj * 128 + n * 16);
            float rsx[2][4];
            FOR_AM rsx[ai][m] = __builtin_amdgcn_rsqf(rs1[rowb + ai * 128 + m * 16] * (1.f / 1024.f) + EPS);
#pragma unroll
            for (int q = 0; q < 16; ++q) { const int ai = q >> 3, bj = (q >> 2) & 1, m = q & 3; __builtin_amdgcn_sched_barrier(0);
                const u32x4 tw = sT[q * 512]; u32x4 sw = (u32x4){0u, 0u, 0u, 0u}; if (b > 0 && !smp) sw = sS[q * 512];
                const unsigned tws[4] = {tw.x, tw.y, tw.z, tw.w}; const unsigned sws[4] = {sw.x, sw.y, sw.z, sw.w};
                f32x4 r[2];
#pragma unroll
                for (int n = 0; n < 2; ++n) { const f32x4 bv = bvv[bj][n];
                    f32x4 v = acc[ai][bj][m][n] * rsx[ai][m] + bv;
#pragma unroll
                    for (int e = 0; e < 4; ++e) { const unsigned tt = tws[n * 2 + (e >> 1)], st = sws[n * 2 + (e >> 1)];
                        const float tv = (e & 1) ? __uint_as_float(tt & 0xffff0000u) : __uint_as_float(tt << 16);
                        const float sv = (e & 1) ? __uint_as_float(st & 0xffff0000u) : __uint_as_float(st << 16);
                        v[e] = fsigmoid(v[e]) * tv + sv; }
                    r[n] = v; }
                if (smp) { float* mf = (float*)(ws + W_PART) + ((size_t)b * 512 + rowb + ai * 128 + m * 16 - MTP) * 1024 + cb + bj * 128;
#pragma unroll
                    for (int n = 0; n < 2; ++n) *(f32x4*)(mf + n * 16) = r[n]; }
                else if (b < 3) { const u32x2 lo = pk4(r[0]), hi = pk4(r[1]); u32x4 w; w.x = lo.x; w.y = lo.y; w.z = hi.x; w.w = hi.y; sS[q * 512] = w; }
                else { const int row = rowb + ai * 128 + m * 16;
#pragma unroll
                    for (int n = 0; n < 2; ++n) *(u32x2*)(MG + (size_t)row * 1024 + cb + bj * 128 + n * 16) = pk4(r[n]); } }
        }
    }
};

struct EpiRes {
    const float* xin;
    u16* xb;
    float* yout;
    float* rsacc;
    float* yfull;
    DEV void operator()(const AccT& acc, const GUnit& u, int wr, int wc, int fr, int fq) const {
        const int rowb = u.pm * 256 + wr * 64 + fr, cb = u.pn * 256 + wc * 32 + 4 * fq;
        if (u.kind >= 1) {
            float* pp = yfull + ((size_t)(u.kind - 1) * 512) * 1024;
            FOR_AM { const int row = rowb + ai * 128 + m * 16 - MTP; FOR_BN { *(f32x4*)(pp + (size_t)row * 1024 + cb + bj * 128 + n * 16) = acc[ai][bj][m][n]; } }
            return; }
        FOR_AM { const int row = rowb + ai * 128 + m * 16; float ss = 0.f;
            FOR_BN { const int col = cb + bj * 128 + n * 16; f32x4 x;
                if (xin) x = *(const f32x4*)(xin + (size_t)row * 1024 + col);
                else { const u32x2 xx = *(const u32x2*)(xb + (size_t)row * 1024 + col);
                    x[0] = __uint_as_float(xx.x << 16); x[1] = __uint_as_float(xx.x & 0xffff0000u); x[2] = __uint_as_float(xx.y << 16); x[3] = __uint_as_float(xx.y & 0xffff0000u); }
                const f32x4 v = x + acc[ai][bj][m][n];
                if (yout) *(f32x4*)(yout + (size_t)row * 1024 + col) = v; else *(u32x2*)(xb + (size_t)row * 1024 + col) = pk4(v);
                ss += v[0] * v[0] + v[1] * v[1] + v[2] * v[2] + v[3] * v[3]; }
            if (rsacc) { ss = red_fq(ss); if (fq == 0) atomicAdd(rsacc + row, ss); } }
    }
};

DEV float dpp_prev1(float cur, float prevm) {
    const int o = __builtin_amdgcn_update_dpp(0, __float_as_int(prevm), 0x121, 0xf, 0xf, false);
    return __int_as_float(__builtin_amdgcn_update_dpp(o, __float_as_int(cur), 0x111, 0xf, 0xf, false));
}
DEV float dpp_prev2(float cur, float prevm) {
    const int o = __builtin_amdgcn_update_dpp(0, __float_as_int(prevm), 0x122, 0xf, 0xf, false);
    return __int_as_float(__builtin_amdgcn_update_dpp(o, __float_as_int(cur), 0x112, 0xf, 0xf, false));
}
struct EpiUp {
    unsigned char* ws; const float* cw; const float* cbias; const float* rs2;
    DEV void operator()(const AccT& acc, const GUnit& u, int wr, int wc, int fr, int fq) const {
        u16* ACT = (u16*)(ws + W_ACT); float* HEAD = (float*)(ws + W_HEAD); float* TAIL = (float*)(ws + W_TAIL);
        float rsx[2][4];
        FOR_AM rsx[ai][m] = __builtin_amdgcn_rsqf(rs2[u.pm * 256 + wr * 64 + fr + ai * 128 + m * 16] * (1.f / 1024.f) + EPS);
        const int f0 = u.pn * 128 + wc * 32 + 4 * fq;
#pragma unroll
        for (int n = 0; n < 2; ++n) { const int f = f0 + n * 16;
            f32x4 w0[2], w1[2], w2[2], bb[2];
#pragma unroll
            for (int bj = 0; bj < 2; ++bj) { const int ff = bj * 2816 + f; w0[bj] = *(const f32x4*)(cw + ff); w1[bj] = *(const f32x4*)(cw + 5632 + ff); w2[bj] = *(const f32x4*)(cw + 11264 + ff); bb[bj] = *(const f32x4*)(cbias + ff); }
#pragma unroll
            for (int ai = 0; ai < 2; ++ai) {
                const int slab = u.pm * 4 + ai * 2 + wr;
#pragma unroll
                for (int m = 0; m < 4; ++m) {
                    f32x4 c[2];
#pragma unroll
                    for (int bj = 0; bj < 2; ++bj) { const f32x4 cur = acc[ai][bj][m][n] * rsx[ai][m]; const f32x4 pm_ = acc[ai][bj][m ? m - 1 : 0][n] * rsx[ai][m ? m - 1 : 0];
#pragma unroll
                        for (int e = 0; e < 4; ++e) { const float p1 = dpp_prev1(cur[e], pm_[e]), p2 = dpp_prev2(cur[e], pm_[e]);
                            c[bj][e] = bb[bj][e] + w2[bj][e] * cur[e] + w1[bj][e] * p1 + w0[bj][e] * p2; } }
                    if (m > 0 || fr >= 2) { f32x4 a; for (int e = 0; e < 4; ++e) a[e] = fsilu(c[0][e]) * c[1][e];
                        *(u32x2*)(ACT + (size_t)(slab * 64 + m * 16 + fr) * 2816 + f) = pk4(a); }
                    if (m == 0 && fr < 2) { for (int bj = 0; bj < 2; ++bj) *(f32x4*)(HEAD + ((size_t)slab * 2 + fr) * 5632 + bj * 2816 + f) = acc[ai][bj][0][n] * rsx[ai][0]; }
                    if (m == 3 && fr >= 14) { for (int bj = 0; bj < 2; ++bj) *(f32x4*)(TAIL + ((size_t)slab * 2 + fr - 14) * 5632 + bj * 2816 + f) = acc[ai][bj][3][n] * rsx[ai][3]; }
                } } }
    }
};

template <int MAP> DEV int src_col(int j) {
    if (MAP == 0) return j;
    if (MAP == 1) {
        const int tile = j >> 8, tc = j & 255;
        if (tile < 10) return j;
        if (tile < 12) return j + 16;
        if (tile < 16) { const int perm = ((tc >> 5) & 3) * 64 + (tc >> 7) * 32 + (tc & 31); return (tile < 14 ? 3088 : 3600) + (tile & 1) * 256 + perm; }
        if (tile < 18) return j + 16;
        if (tile == 18) return tc < 16 ? 2560 + tc : -1;
        return 4624 + (j - GATE0);
    }
    { const int q = j >> 8, tc = j & 255; return tc < 128 ? 128 * q + tc : 2816 + 128 * q + (tc - 128); }
}
template <int MAP> DEV void conv_T(u16* dst, int dst_ld, int K, int Nd, const float* src, int src_ld, int gt, int GT, const float* gain = nullptr) {
    const int total = Nd * (K >> 3);
    for (int idx = gt; idx < total; idx += GT) { const int j = idx % Nd, kb = idx / Nd; const int sc = src_col<MAP>(j);
        float v[8];
#pragma unroll
        for (int i = 0; i < 8; ++i) v[i] = sc >= 0 ? src[(size_t)(kb * 8 + i) * src_ld + sc] : 0.f;
        if (gain) {
#pragma unroll
            for (int i = 0; i < 8; ++i) v[i] *= gain[kb * 8 + i]; }
        u32x4 w; w.x = pk2(v[0], v[1]); w.y = pk2(v[2], v[3]); w.z = pk2(v[4], v[5]); w.w = pk2(v[6], v[7]);
        *(u32x4*)(dst + (size_t)j * dst_ld + kb * 8) = w; }
}
DEV void raw_rows(const float* xp, const float* xs, int r0, int r1, u16* XB, float* RS) {
    const int tid = tid_o(); const int lane = tid & 63; const int gw = bid_o() * 8 + (tid >> 6), GW = gridDim.x * 8;
    for (int row = r0 + gw; row < r1; row += GW) {
        const float* src = row < MTP ? xp + (size_t)row * 1024 : xs + (size_t)(row - MTP) * 1024;
        f32x4 v[4]; float ss = 0.f;
#pragma unroll
        for (int i = 0; i < 4; ++i) { v[i] = *(const f32x4*)(src + (lane + 64 * i) * 4); ss += v[i][0] * v[i][0] + v[i][1] * v[i][1] + v[i][2] * v[i][2] + v[i][3] * v[i][3]; }
        ss = wave_sum(ss); if (lane == 0) RS[row] = ss;
#pragma unroll
        for (int i = 0; i < 4; ++i) *(u32x2*)(XB + (size_t)row * 1024 + (lane + 64 * i) * 4) = pk4(v[i]);
    }
}

DEV void sample_rows_reduce(float* xs, const float* part, int npart, u16* XBs, float* RSs) {
    const int tid = tid_o(); const int lane = tid & 63; const int gw = bid_o() * 8 + (tid >> 6), GW = gridDim.x * 8;
    for (int r = gw; r < 512; r += GW) {
        float* src = xs + (size_t)r * 1024; f32x4 v[4];
#pragma unroll
        for (int i = 0; i < 4; ++i) v[i] = *(const f32x4*)(src + (lane + 64 * i) * 4);
        for (int k = 0; k < npart; ++k) { const float* pp = part + ((size_t)k * 512 + r) * 1024;
#pragma unroll
            for (int i = 0; i < 4; ++i) v[i] += *(const f32x4*)(pp + (lane + 64 * i) * 4); }
        float ss = 0.f;
#pragma unroll
        for (int i = 0; i < 4; ++i) { *(f32x4*)(src + (lane + 64 * i) * 4) = v[i]; ss += v[i][0] * v[i][0] + v[i][1] * v[i][1] + v[i][2] * v[i][2] + v[i][3] * v[i][3]; }
        ss = wave_sum(ss); if (lane == 0) RSs[r] = ss;
#pragma unroll
        for (int i = 0; i < 4; ++i) *(u32x2*)(XBs + (size_t)r * 1024 + (lane + 64 * i) * 4) = pk4(v[i]);
    }
}
DEV void phaseA(CP& p, int l) {
    unsigned char* ws = p.ws;
    const int gt = bid_o() * 512 + tid_o(), GT = gridDim.x * 512;
    conv_T<1>((u16*)(ws + W_WIN), 1024, 1024, NINP, p.in[9] + (size_t)l * 1024 * 8720, 8720, gt, GT, p.in[8] + l * 1024);
    for (int b = 0; b < 4; ++b) conv_T<0>((u16*)(ws + W_WBR) + (size_t)(b >> 1) * 1024 * 1024 + (b & 1) * 512, 1024, 512, 1024, p.in[31] + (size_t)(l * 4 + b) * 512 * 1024, 1024, gt, GT);
    conv_T<0>((u16*)(ws + W_WOUT), 1024, 1024, 1024, p.in[32] + (size_t)l * 1024 * 1024, 1024, gt, GT);
    conv_T<0>((u16*)(ws + W_WGLU), 512, 512, 512, p.in[22] + (size_t)l * 512 * 512, 512, gt, GT);
    conv_T<2>((u16*)(ws + W_WUP), 1024, 1024, 5632, p.in[34] + (size_t)l * 1024 * 5632, 5632, gt, GT, p.in[33] + l * 1024);
    conv_T<0>((u16*)(ws + W_WDN), 2816, 2816, 1024, p.in[37] + (size_t)l * 2816 * 1024, 1024, gt, GT);
    for (int b = 0; b < 8; ++b) conv_T<0>((u16*)(ws + W_DVTS) + (size_t)b * 512 * 4160, 4160, 4096, 512, p.in[3] + ((size_t)(l * 8 + b) * 4096) * 512, 512, gt, GT);
    {
        const float* ck = p.in[2] + (size_t)l * 8 * 4096 * 512; u16* dk = (u16*)(ws + W_DKS);
        for (int idx = gt; idx < 8 * 4096 * 64; idx += GT) { const int b = idx >> 18, rem = idx & 262143, key = rem >> 6, c8 = (rem & 63) * 8;
            const f32x4 a = *(const f32x4*)(ck + ((size_t)(b * 4096 + key)) * 512 + c8), c = *(const f32x4*)(ck + ((size_t)(b * 4096 + key)) * 512 + c8 + 4);
            u32x4 w; w.x = pk2(a[0], a[1]); w.y = pk2(a[2], a[3]); w.z = pk2(c[0], c[1]); w.w = pk2(c[2], c[3]);
            *(u32x4*)(dk + ((size_t)b * 4160 + key) * 512 + c8) = w; }
    }
    { float* rq = (float*)(ws + W_ROWSQ); for (int i = gt; i < MT; i += GT) rq[i] = 0.f; }
    { const float* wsp = p.in[12] + (size_t)l * 4 * 128 * 128; u16* wm = (u16*)(ws + W_WM); for (int i = gt; i < 4 * 128 * 128; i += GT) { const int t = (i >> 7) & 127, s2 = i & 127; wm[i] = f2bf(s2 <= t ? wsp[i] : 0.f); } }
    if (l == 0) { const f32x4* xs = (const f32x4*)p.in[1]; f32x4* xo = (f32x4*)(p.out + (size_t)MTP * 1024); for (int i = gt; i < 512 * 256; i += GT) xo[i] = xs[i]; }
    if (gt == 0) {
        unsigned* misc = (unsigned*)(ws + W_MISC); misc[l] = 0u;
        const float* dl = p.in[29] + l * 256; float s1 = 0.f, s2 = 0.f;
        for (int i = 0; i < 64; ++i) { s1 += dl[i] * dl[64 + i]; s2 += dl[128 + i] * dl[192 + i]; }
        const float lam_init = 0.8f - 0.6f * expf(-0.3f * (float)l);
        ((float*)misc)[8 + 2 * l] = expf(s1) - expf(s2) + lam_init; ((float*)misc)[9 + 2 * l] = lam_init;
        float mq = 0.f, mk = 0.f; for (int i = 0; i < 64; ++i) { mq = fmaxf(mq, fabsf(p.in[27][l * 64 + i])); mk = fmaxf(mk, fabsf(p.in[28][l * 64 + i])); }
        ((float*)misc)[16 + l] = 64.f * mq * mk * 0.125f * LOG2E;
    }
    { float* RS = (float*)(ws + W_RS);
      for (int i = gt; i < MT; i += GT) { RS[(size_t)(l * 2 + 1) * MT + i] = 0.f; if (l == 0) RS[(size_t)2 * MT + i] = 0.f; }
      if (l == 0) raw_rows(p.in[0], p.in[1], 0, MT, (u16*)(ws + W_H), RS);
      else sample_rows_reduce(p.out + (size_t)MTP * 1024, (const float*)(ws + W_PART), 11, (u16*)(ws + W_H) + (size_t)MTP * 1024, RS + (size_t)2 * MT + MTP); }
}

DEV void attn_item(CP& p, int l, LAS unsigned char* lds, int grp, int b, int h, int qp) {
    unsigned char* ws = p.ws;
    const int tid = tid_o(), w = tid >> 6, lane = tid & 63, fr = lane & 15, fq = lane >> 4, c = w >> 2, qs = w & 3;
    const int Tk = grp ? 4160 : 2048, nkv = grp ? 65 : 2 * qp + 2;
    const int nact = grp ? (qs < 2 ? 65 : 0) : (qs < 2 ? nkv - 1 : nkv);
    const int rowbase = grp ? MTP + b * 64 : b * 2048 + qp * 128;
    const u16* Kb = grp ? (const u16*)(ws + W_DKS) + (size_t)b * 4160 * 512 : (const u16*)(ws + W_DKP) + (size_t)b * 2048 * 512;
    const u16* Vb = grp ? (const u16*)(ws + W_DVTS) + ((size_t)b * 512 + h * 128) * 4160 : (const u16*)(ws + W_DVTP) + ((size_t)b * 512 + h * 128) * 2048;
    u16* P2 = (u16*)(ws + W_P2);
    bf16x8 qf[2][2];
    if (nact > 0) {
#pragma unroll
        for (int r = 0; r < 2; ++r)
#pragma unroll
            for (int kk = 0; kk < 2; ++kk) qf[r][kk] = *(const bf16x8*)(P2 + (size_t)(rowbase + 32 * qs + 16 * r + fr) * 1024 + 512 + h * 128 + c * 64 + kk * 32 + fq * 8);
    } else {
#pragma unroll
        for (int r = 0; r < 2; ++r)
#pragma unroll
            for (int kk = 0; kk < 2; ++kk) qf[r][kk] = (bf16x8){0, 0, 0, 0, 0, 0, 0, 0};
    }
    constexpr int STG = 36864;
    int gK[2], lK[2], gV[2], lV[2];
#pragma unroll
    for (int i = 0; i < 2; ++i) { const int ch = tid + 512 * i; const int key = ch >> 4, part = ch & 15; gK[i] = key * 512 + h * 128 + part * 8; lK[i] = (((part >> 3) * 64 + key) * 72 + (part & 7) * 8) * 2;
        const int v = ch >> 3, kp = (ch & 7) * 8; gV[i] = v * Tk + kp; lV[i] = (128 * 72 + v * 72 + kp) * 2; }
    u32x4 rk[2], rv[2];
#pragma unroll
    for (int i = 0; i < 2; ++i) { rk[i] = *(const u32x4*)(Kb + gK[i]); rv[i] = *(const u32x4*)(Vb + gV[i]); }
#pragma unroll
    for (int i = 0; i < 2; ++i) { *(LAS u32x4*)(lds + lK[i]) = rk[i]; *(LAS u32x4*)(lds + lV[i]) = rv[i]; }
    __syncthreads();
    f32x4 O[2][8];
#pragma unroll
    for (int r = 0; r < 2; ++r)
#pragma unroll
        for (int i = 0; i < 8; ++i) O[r][i] = (f32x4){0.f, 0.f, 0.f, 0.f};
    const bool fixedref = ((const float*)(ws + W_MISC))[16 + l] < 40.f;
    float mrun[2] = {-1e30f, -1e30f}, lrun[2] = {0.f, 0.f};
    for (int kt = 0; kt < nkv; ++kt) {
        const bool more = kt + 1 < nkv;
        if (more) { const size_t k0 = (size_t)(kt + 1) * 64;
#pragma unroll
            for (int i = 0; i < 2; ++i) { rk[i] = *(const u32x4*)(Kb + k0 * 512 + gK[i]); rv[i] = *(const u32x4*)(Vb + k0 + gV[i]); } }
        if (kt < nact) {
            LAS unsigned char* st = lds + (kt & 1) * STG;
            f32x4 s[2][4];
#pragma unroll
            for (int jt = 0; jt < 4; ++jt) { s[0][jt] = (f32x4){0.f, 0.f, 0.f, 0.f}; s[1][jt] = (f32x4){0.f, 0.f, 0.f, 0.f};
#pragma unroll
                for (int kk = 0; kk < 2; ++kk) { const bf16x8 kf = *(const LAS bf16x8*)(st + ((c * 64 + 16 * jt + fr) * 72 + kk * 32 + fq * 8) * 2);
                    s[0][jt] = mfma16(kf, qf[0][kk], s[0][jt]); s[1][jt] = mfma16(kf, qf[1][kk], s[1][jt]); } }
            bf16x8 pf[2][2];
#pragma unroll
            for (int r = 0; r < 2; ++r) {
                float ps = 0.f;
                if (fixedref) {
#pragma unroll
                    for (int jt = 0; jt < 4; ++jt)
#pragma unroll
                        for (int e = 0; e < 4; ++e) { s[r][jt][e] = __builtin_amdgcn_exp2f(s[r][jt][e]); ps += s[r][jt][e]; }
                    lrun[r] += ps;
                } else {
                    float mt = s[r][0][0];
#pragma unroll
                    for (int jt = 0; jt < 4; ++jt)
#pragma unroll
                        for (int e = 0; e < 4; ++e) mt = fmaxf(mt, s[r][jt][e]);
                    mt = fmaxf(mt, __shfl_xor(mt, 16)); mt = fmaxf(mt, __shfl_xor(mt, 32));
                    const float mnew = fmaxf(mrun[r], mt), alpha = __builtin_amdgcn_exp2f(mrun[r] - mnew); mrun[r] = mnew;
#pragma unroll
                    for (int jt = 0; jt < 4; ++jt)
#pragma unroll
                        for (int e = 0; e < 4; ++e) { s[r][jt][e] = __builtin_amdgcn_exp2f(s[r][jt][e] - mnew); ps += s[r][jt][e]; }
                    lrun[r] = lrun[r] * alpha + ps;
#pragma unroll
                    for (int i = 0; i < 8; ++i) O[r][i] *= alpha;
                }
#pragma unroll
                for (int t = 0; t < 2; ++t) { const u32x2 lo = pk4(s[r][2 * t]), hi = pk4(s[r][2 * t + 1]); u32x4 wv; wv.x = lo.x; wv.y = lo.y; wv.z = hi.x; wv.w = hi.y; pf[r][t] = __builtin_bit_cast(bf16x8, wv); }
            }
#pragma unroll
            for (int vt = 0; vt < 8; ++vt)
#pragma unroll
                for (int t = 0; t < 2; ++t) { const LAS unsigned char* vp = st + (128 * 72 + (16 * vt + fr) * 72 + 32 * t + 4 * fq) * 2;
                    const u32x2 a = *(const LAS u32x2*)vp, bq = *(const LAS u32x2*)(vp + 32); u32x4 wv; wv.x = a.x; wv.y = a.y; wv.z = bq.x; wv.w = bq.y;
                    const bf16x8 vf = __builtin_bit_cast(bf16x8, wv);
                    O[0][vt] = mfma16(vf, pf[0][t], O[0][vt]); O[1][vt] = mfma16(vf, pf[1][t], O[1][vt]); }
        }
        if (more) { LAS unsigned char* nx = lds + ((kt + 1) & 1) * STG;
#pragma unroll
            for (int i = 0; i < 2; ++i) { *(LAS u32x4*)(nx + lK[i]) = rk[i]; *(LAS u32x4*)(nx + lV[i]) = rv[i]; } }
        __syncthreads();
    }
    const float lam = ((const float*)(ws + W_MISC))[8 + 2 * l], lam_init = ((const float*)(ws + W_MISC))[9 + 2 * l];
    LAS float* X = (LAS float*)lds;
    float inv[2];
#pragma unroll
    for (int r = 0; r < 2; ++r) inv[r] = __builtin_amdgcn_rcpf(fmaxf(red_fq(lrun[r]), 1e-30f));
    if (c == 1) {
#pragma unroll
        for (int r = 0; r < 2; ++r)
#pragma unroll
            for (int vt = 0; vt < 8; ++vt)
#pragma unroll
                for (int e = 0; e < 4; ++e) X[(qs * 64 + r * 32 + vt * 4 + e) * 64 + lane] = O[r][vt][e] * inv[r] * lam;
    }
    __syncthreads();
    if (c == 0 && nact > 0) {
        const float* g = p.in[30] + l * 128;
#pragma unroll
        for (int r = 0; r < 2; ++r) { float ss = 0.f;
#pragma unroll
            for (int vt = 0; vt < 8; ++vt)
#pragma unroll
                for (int e = 0; e < 4; ++e) { const float d = O[r][vt][e] * inv[r] - X[(qs * 64 + r * 32 + vt * 4 + e) * 64 + lane]; O[r][vt][e] = d; ss += d * d; }
            ss = red_fq(ss); const float rs = __builtin_amdgcn_rsqf(ss * (1.f / 128.f) + EPS) * (1.f - lam_init);
#pragma unroll
            for (int vt = 0; vt < 8; ++vt) { const f32x4 gv = *(const f32x4*)(g + 16 * vt + 4 * fq);
                *(u32x2*)(P2 + (size_t)(rowbase + 32 * qs + 16 * r + fr) * 1024 + 512 + h * 128 + 16 * vt + 4 * fq) = pk4(O[r][vt] * rs * gv); } }
    }
    __syncthreads();
}

DEV void gla_item(CP& p, int l, LAS unsigned char* lds, int grp, int b, int h) {
    unsigned char* ws = p.ws;
    const int tid = tid_o(), w = tid >> 6, lane = tid & 63, fr = lane & 15, fq = lane >> 4;
    const int T = grp ? 64 : 2048, nch = grp ? 1 : 32; const int rowbase = grp ? MTP + b * 64 : b * 2048;
    const u16* CQ = (const u16*)(ws + W_CQ); const u16* CK = (const u16*)(ws + W_CK); const float* CODE = (const float*)(ws + W_CODE);
    const u16* VT = (const u16*)(ws + W_CVT) + (grp ? (size_t)16 * 512 * 2048 : 0) + ((size_t)b * 512 + h * 128) * T;
    u16* P2 = (u16*)(ws + W_P2);
    LAS u16* QE = (LAS u16*)lds; LAS u16* KE = QE + 64 * 72; LAS u16* KDT = KE + 64 * 72; LAS u16* VTl = KDT + 64 * 72;
    LAS u16* PP = VTl + 128 * 72; LAS u16* STb = PP + 64 * 72;
    LAS float* OT = (LAS float*)(STb + 8 * 16 * 72); LAS float* SEG = OT + 64 * 132; LAS float* DEC = SEG + 8 * 64;
    LAS u16* QR = (LAS u16*)(DEC + 64); LAS u16* KR = QR + 64 * 72; LAS float* CD = (LAS float*)(KR + 64 * 72);
    const int d_ = tid & 63, seg = tid >> 6;
    float wa[16];
#pragma unroll
    for (int r = 0; r < 16; ++r) wa[r] = p.in[24][(size_t)l * 16 * 256 + r * 256 + h * 64 + d_];
    const float ba = p.in[25][l * 256 + h * 64 + d_];
    f32x4 S[4];
    if (grp) { const float* s0 = p.in[6] + ((size_t)(l * 8 + b) * 4 + h) * 64 * 128;
#pragma unroll
        for (int dt = 0; dt < 4; ++dt) S[dt] = *(const f32x4*)(s0 + (size_t)(16 * dt + fr) * 128 + 16 * w + 4 * fq); }
    else {
#pragma unroll
        for (int dt = 0; dt < 4; ++dt) S[dt] = (f32x4){0.f, 0.f, 0.f, 0.f}; }
#pragma unroll
    for (int dt = 0; dt < 4; ++dt)
#pragma unroll
        for (int e = 0; e < 4; ++e) STb[(w * 16 + 4 * fq + e) * 72 + 16 * dt + fr] = f2bf(S[dt][e]);
    const float* gng = p.in[26] + l * 128;
    const int tl = tid >> 3, d8 = (tid & 7) * 8;
    u32x4 rq, rkk, rvv[2]; f32x2 rcd;
    {
        rq = *(const u32x4*)(CQ + (size_t)(rowbase + tl) * 256 + h * 64 + d8); rkk = *(const u32x4*)(CK + (size_t)(rowbase + tl) * 256 + h * 64 + d8);
        rcd = *(const f32x2*)(CODE + (size_t)(rowbase + tl) * 16 + (tid & 7) * 2);
#pragma unroll
        for (int i = 0; i < 2; ++i) { const int chn = tid + 512 * i, v = chn >> 3, kp = (chn & 7) * 8; rvv[i] = *(const u32x4*)(VT + (size_t)v * T + kp); }
    }
    for (int ch = 0; ch < nch; ++ch) {
        const int r0 = rowbase + ch * 64;
        *(LAS u32x4*)(QR + tl * 72 + d8) = rq; *(LAS u32x4*)(KR + tl * 72 + d8) = rkk; *(LAS f32x2*)(CD + tl * 16 + (tid & 7) * 2) = rcd;
#pragma unroll
        for (int i = 0; i < 2; ++i) { const int chn = tid + 512 * i, v = chn >> 3, kp = (chn & 7) * 8; *(LAS u32x4*)(VTl + v * 72 + kp) = rvv[i]; }
        if (ch + 1 < nch) { const int r1 = r0 + 64;
            rq = *(const u32x4*)(CQ + (size_t)(r1 + tl) * 256 + h * 64 + d8); rkk = *(const u32x4*)(CK + (size_t)(r1 + tl) * 256 + h * 64 + d8);
            rcd = *(const f32x2*)(CODE + (size_t)(r1 + tl) * 16 + (tid & 7) * 2);
#pragma unroll
            for (int i = 0; i < 2; ++i) { const int chn = tid + 512 * i, v = chn >> 3, kp = (chn & 7) * 8; rvv[i] = *(const u32x4*)(VT + (size_t)v * T + (ch + 1) * 64 + kp); } }
        u16* yp = P2 + (size_t)(r0 + tl) * 1024 + h * 128 + (tid & 7) * 16;
        const u32x4 rr0 = *(const u32x4*)yp, rr1 = *(const u32x4*)(yp + 8);
        __syncthreads();
        float bl[8]; float run = 0.f;
#pragma unroll
        for (int i = 0; i < 8; ++i) { const LAS float* cp = CD + (seg * 8 + i) * 16; float a = ba;
#pragma unroll
            for (int r = 0; r < 16; ++r) a += cp[r] * wa[r];
            run += flogsig(a) * (1.f / 16.f); bl[i] = run; }
        SEG[seg * 64 + d_] = run;
        __syncthreads();
        float off = 0.f, tot = 0.f;
#pragma unroll
        for (int s2 = 0; s2 < 8; ++s2) { const float x = SEG[s2 * 64 + d_]; tot += x; if (s2 < seg) off += x; }
        if (seg == 0) DEC[d_] = __expf(tot);
        { float kd[8];
#pragma unroll
          for (int i = 0; i < 8; ++i) { const int t = seg * 8 + i; const float bb = bl[i] + off;
              const float q = bf2f(QR[t * 72 + d_]), k = bf2f(KR[t * 72 + d_]);
              QE[t * 72 + d_] = f2bf(q * __expf(bb)); KE[t * 72 + d_] = f2bf(k * __expf(-bb)); kd[i] = k * __expf(tot - bb); }
          u32x4 wv; wv.x = pk2(kd[0], kd[1]); wv.y = pk2(kd[2], kd[3]); wv.z = pk2(kd[4], kd[5]); wv.w = pk2(kd[6], kd[7]);
          *(LAS u32x4*)(KDT + d_ * 72 + seg * 8) = wv; }
        __syncthreads();
#pragma unroll
        for (int r = 0; r < 2; ++r) { const int ti = w + 8 * r, jt = ti >> 2, it = ti & 3; f32x4 a = (f32x4){0.f, 0.f, 0.f, 0.f};
            if (jt <= it) {
#pragma unroll
                for (int kk = 0; kk < 2; ++kk) { const bf16x8 kf = *(const LAS bf16x8*)(KE + (16 * jt + fr) * 72 + kk * 32 + fq * 8), qf = *(const LAS bf16x8*)(QE + (16 * it + fr) * 72 + kk * 32 + fq * 8); a = mfma16(kf, qf, a); }
#pragma unroll
                for (int e = 0; e < 4; ++e) if (16 * jt + 4 * fq + e > 16 * it + fr) a[e] = 0.f;
            }
            *(LAS u32x2*)(PP + (16 * it + fr) * 72 + 16 * jt + 4 * fq) = pk4(a); }
        __syncthreads();
        bf16x8 vf[2], sf[2];
#pragma unroll
        for (int t = 0; t < 2; ++t) { vf[t] = *(const LAS bf16x8*)(VTl + (16 * w + fr) * 72 + 32 * t + 8 * fq); sf[t] = *(const LAS bf16x8*)(STb + (w * 16 + fr) * 72 + 32 * t + 8 * fq); }
#pragma unroll
        for (int it = 0; it < 4; ++it) { f32x4 a = (f32x4){0.f, 0.f, 0.f, 0.f};
#pragma unroll
            for (int t = 0; t < 2; ++t) { const bf16x8 pf = *(const LAS bf16x8*)(PP + (16 * it + fr) * 72 + 32 * t + 8 * fq), qf = *(const LAS bf16x8*)(QE + (16 * it + fr) * 72 + 32 * t + 8 * fq);
                a = mfma16(vf[t], pf, a); a = mfma16(sf[t], qf, a); }
            *(LAS f32x4*)(OT + (16 * it + fr) * 132 + 16 * w + 4 * fq) = a; }
#pragma unroll
        for (int dt = 0; dt < 4; ++dt) { S[dt] *= DEC[16 * dt + fr];
#pragma unroll
            for (int t = 0; t < 2; ++t) { const bf16x8 kf = *(const LAS bf16x8*)(KDT + (16 * dt + fr) * 72 + 32 * t + 8 * fq); S[dt] = mfma16(vf[t], kf, S[dt]); }
#pragma unroll
            for (int e = 0; e < 4; ++e) STb[(w * 16 + 4 * fq + e) * 72 + 16 * dt + fr] = f2bf(S[dt][e]); }
        __syncthreads();
        {
            const int i = tid >> 3, vs = tid & 7; f32x4 o[4]; float ss = 0.f;
#pragma unroll
            for (int k = 0; k < 4; ++k) { o[k] = *(const LAS f32x4*)(OT + i * 132 + vs * 16 + 4 * k); ss += o[k][0] * o[k][0] + o[k][1] * o[k][1] + o[k][2] * o[k][2] + o[k][3] * o[k][3]; }
            ss += __shfl_xor(ss, 1); ss += __shfl_xor(ss, 2); ss += __shfl_xor(ss, 4);
            const float rs = __builtin_amdgcn_rsqf(ss * (1.f / 128.f) + EPS);
            const unsigned rw[8] = {rr0.x, rr0.y, rr0.z, rr0.w, rr1.x, rr1.y, rr1.z, rr1.w};
#pragma unroll
            for (int k = 0; k < 4; ++k) { const f32x4 gv = *(const f32x4*)(gng + vs * 16 + 4 * k);
                f32x4 r; r[0] = __uint_as_float(rw[2 * k] << 16); r[1] = __uint_as_float(rw[2 * k] & 0xffff0000u); r[2] = __uint_as_float(rw[2 * k + 1] << 16); r[3] = __uint_as_float(rw[2 * k + 1] & 0xffff0000u);
                *(u32x2*)(yp + 4 * k) = pk4(o[k] * rs * gv * r); }
        }
    }
    float* so = p.out + (grp ? O_GLAS + (size_t)l * 262144 + ((size_t)b * 4 + h) * 8192 : O_GLAP + (size_t)l * 524288 + ((size_t)b * 4 + h) * 8192);
#pragma unroll
    for (int dt = 0; dt < 4; ++dt) *(f32x4*)(so + (size_t)(16 * dt + fr) * 128 + 16 * w + 4 * fq) = S[dt];
    __syncthreads();
}

DEV void s5_item(CP& p, int l, LAS unsigned char* lds, int grp, int b, int gq) {
    unsigned char* ws = p.ws;
    const int tid = tid_o(), w = tid >> 6, lane = tid & 63, fr = lane & 15, fq = lane >> 4;
    const int g = gq * 8 + w; const int T = grp ? 64 : 2048; const int rowbase = grp ? MTP + b * 64 : b * 2048;
    u16* X = (u16*)(ws + W_S5);
    LAS u16* HT = (LAS u16*)lds + w * 32 * 136;
    const float dt = __expf(p.in[16][l * 32 + g]);
    bf16x8 breF[4], bimF[4]; float ar[4], ai[4], a8r[4], a8i[4];
#pragma unroll
    for (int pt = 0; pt < 4; ++pt) { const int pp = 16 * pt + fr; const size_t gp = (size_t)(l * 32 + g) * 64 + pp;
        const float lr = p.in[14][gp], li = p.in[15][gp];
        const float mag = __expf(lr * dt), ang = li * dt * 0.15915494309189535f;
        const float r_ = mag * __builtin_amdgcn_cosf(ang), i_ = mag * __builtin_amdgcn_sinf(ang);
        ar[pt] = r_; ai[pt] = i_;
        float xr = r_, xi = i_;
#pragma unroll
        for (int k = 0; k < 3; ++k) { const float nr2 = xr * xr - xi * xi, ni2 = 2.f * xr * xi; xr = nr2; xi = ni2; }
        a8r[pt] = xr; a8i[pt] = xi;
        const float den = lr * lr + li * li, nr = r_ - 1.f, ni = i_;
        const float kr = (nr * lr + ni * li) / den, ki = (ni * lr - nr * li) / den;
        float vr[8], vi[8];
#pragma unroll
        for (int j = 0; j < 8; ++j) { float br = 0.f, bi = 0.f; if (fq < 2) { br = p.in[17][gp * 16 + fq * 8 + j]; bi = p.in[18][gp * 16 + fq * 8 + j]; }
            vr[j] = kr * br - ki * bi; vi[j] = kr * bi + ki * br; }
        u32x4 wr_, wi_; wr_.x = pk2(vr[0], vr[1]); wr_.y = pk2(vr[2], vr[3]); wr_.z = pk2(vr[4], vr[5]); wr_.w = pk2(vr[6], vr[7]);
        wi_.x = pk2(vi[0], vi[1]); wi_.y = pk2(vi[2], vi[3]); wi_.z = pk2(vi[4], vi[5]); wi_.w = pk2(vi[6], vi[7]);
        breF[pt] = __builtin_bit_cast(bf16x8, wr_); bimF[pt] = __builtin_bit_cast(bf16x8, wi_); }
    bf16x8 cF[4];
#pragma unroll
    for (int ks = 0; ks < 4; ++ks) { float v[8]; const int k0 = 32 * ks + 8 * fq;
#pragma unroll
        for (int j = 0; j < 8; ++j) { const int k = k0 + j; v[j] = k < 64 ? p.in[19][((size_t)(l * 32 + g) * 16 + fr) * 64 + k] : -p.in[20][((size_t)(l * 32 + g) * 16 + fr) * 64 + k - 64]; }
        u32x4 wv; wv.x = pk2(v[0], v[1]); wv.y = pk2(v[2], v[3]); wv.z = pk2(v[4], v[5]); wv.w = pk2(v[6], v[7]); cF[ks] = __builtin_bit_cast(bf16x8, wv); }
    const f32x4 dsk = *(const f32x4*)(p.in[21] + l * 512 + g * 16 + 4 * fq);
    float Hr[4], Hi[4];
#pragma unroll
    for (int pt = 0; pt < 4; ++pt) { if (grp) { const size_t sp = ((size_t)(l * 8 + b) * 32 + g) * 64 + 16 * pt + fr; Hr[pt] = p.in[4][sp]; Hi[pt] = p.in[5][sp]; } else { Hr[pt] = 0.f; Hi[pt] = 0.f; } }
    const int trow = 8 * (fr >> 2) + (fr & 3);
    u32x4 xn[2];
#pragma unroll
    for (int tt = 0; tt < 2; ++tt) { xn[tt] = (u32x4){0u, 0u, 0u, 0u}; if (fq < 2) xn[tt] = *(const u32x4*)(X + (size_t)(rowbase + trow + 4 * tt) * 512 + g * 16 + fq * 8); }
    for (int ch = 0; ch < T / 32; ++ch) {
        const int r0 = rowbase + ch * 32;
        bf16x8 xF[2];
#pragma unroll
        for (int tt = 0; tt < 2; ++tt) xF[tt] = __builtin_bit_cast(bf16x8, xn[tt]);
        if (ch + 1 < T / 32) {
#pragma unroll
            for (int tt = 0; tt < 2; ++tt) if (fq < 2) xn[tt] = *(const u32x4*)(X + (size_t)(r0 + 32 + trow + 4 * tt) * 512 + g * 16 + fq * 8); }
        u32x2 xsk[2];
#pragma unroll
        for (int t2 = 0; t2 < 2; ++t2) xsk[t2] = *(const u32x2*)(X + (size_t)(r0 + 16 * t2 + fr) * 512 + g * 16 + 4 * fq);
        f32x4 bur[2][4], bui[2][4];
#pragma unroll
        for (int tt = 0; tt < 2; ++tt)
#pragma unroll
            for (int pt = 0; pt < 4; ++pt) { bur[tt][pt] = mfma16(xF[tt], breF[pt], (f32x4){0.f, 0.f, 0.f, 0.f}); bui[tt][pt] = mfma16(xF[tt], bimF[pt], (f32x4){0.f, 0.f, 0.f, 0.f}); }
#pragma unroll
        for (int pt = 0; pt < 4; ++pt) {
            float er = 0.f, ei = 0.f;
#pragma unroll
            for (int k = 0; k < 8; ++k) { const float ur = bur[k >> 2][pt][k & 3], ui = bui[k >> 2][pt][k & 3]; const float nr = ar[pt] * er - ai[pt] * ei + ur, ni = ar[pt] * ei + ai[pt] * er + ui; er = nr; ei = ni; }
            float cr = Hr[pt], ci = Hi[pt], mr = cr, mi = ci;
#pragma unroll
            for (int q = 0; q < 4; ++q) { const float Er = __shfl(er, fr + 16 * q), Ei = __shfl(ei, fr + 16 * q);
                const float nr = a8r[pt] * cr - a8i[pt] * ci + Er, ni = a8r[pt] * ci + a8i[pt] * cr + Ei; cr = nr; ci = ni;
                if (q + 1 == fq) { mr = cr; mi = ci; } }
            Hr[pt] = cr; Hi[pt] = ci;
            float hr = mr, hi = mi;
#pragma unroll
            for (int k = 0; k < 8; ++k) { const float ur = bur[k >> 2][pt][k & 3], ui = bui[k >> 2][pt][k & 3]; const float nr = ar[pt] * hr - ai[pt] * hi + ur, ni = ar[pt] * hi + ai[pt] * hr + ui; hr = nr; hi = ni;
                HT[(8 * fq + k) * 136 + 16 * pt + fr] = f2bf(hr); HT[(8 * fq + k) * 136 + 64 + 16 * pt + fr] = f2bf(hi); }
        }
        asm volatile("s_waitcnt lgkmcnt(0)" ::: "memory");
        f32x4 y[2];
#pragma unroll
        for (int t2 = 0; t2 < 2; ++t2) { y[t2] = (f32x4){0.f, 0.f, 0.f, 0.f};
#pragma unroll
            for (int ks = 0; ks < 4; ++ks) { const bf16x8 hf = *(const LAS bf16x8*)(HT + (16 * t2 + fr) * 136 + 32 * ks + 8 * fq); y[t2] = mfma16(cF[ks], hf, y[t2]); } }
#pragma unroll
        for (int t2 = 0; t2 < 2; ++t2) { u16* xp = X + (size_t)(r0 + 16 * t2 + fr) * 512 + g * 16 + 4 * fq; const u32x2 xx = xsk[t2];
            f32x4 xv; xv[0] = __uint_as_float(xx.x << 16); xv[1] = __uint_as_float(xx.x & 0xffff0000u); xv[2] = __uint_as_float(xx.y << 16); xv[3] = __uint_as_float(xx.y & 0xffff0000u);
            f32x4 z = y[t2] + dsk * xv;
#pragma unroll
            for (int e = 0; e < 4; ++e) z[e] = fgelu(z[e]);
            *(u32x2*)xp = pk4(z); }
        asm volatile("" ::: "memory");
    }
    if (fq == 0) { float* ore = p.out + (grp ? O_SRES + (size_t)l * 16384 + ((size_t)b * 32 + g) * 64 : O_SREP + (size_t)l * 32768 + ((size_t)b * 32 + g) * 64);
        float* oim = p.out + (grp ? O_SIMS + (size_t)l * 16384 + ((size_t)b * 32 + g) * 64 : O_SIMP + (size_t)l * 32768 + ((size_t)b * 32 + g) * 64);
#pragma unroll
        for (int pt = 0; pt < 4; ++pt) { ore[16 * pt + fr] = Hr[pt]; oim[16 * pt + fr] = Hi[pt]; } }
    __syncthreads();
}

DEV void gmlp_item(CP& p, int l, LAS unsigned char* lds, int grp, int b, int n, int g) {
    unsigned char* ws = p.ws;
    const int tid = tid_o(), w = tid >> 6, lane = tid & 63, fr = lane & 15, fq = lane >> 4;
    const int L = grp ? 64 : 128, T = grp ? 64 : 2048; const int rowbase = grp ? MTP + b * 64 : b * 2048 + n * 128;
    LAS u16* WT = (LAS u16*)lds; LAS u16* GT = WT + 128 * 136; LAS float* RS = (LAS float*)(GT + 128 * 136);
    const float* rowsq = (const float*)(ws + W_ROWSQ);
    if (tid < L) RS[tid] = __builtin_amdgcn_rsqf(rowsq[rowbase + tid] * (1.f / 512.f) + EPS);
    const u16* GV = (const u16*)(ws + W_GVT) + (grp ? (size_t)16 * 512 * 2048 : 0) + ((size_t)b * 512 + g * 128) * T + (grp ? 0 : n * 128);
    const u16* WM = (const u16*)(ws + W_WM) + (size_t)g * 128 * 128;
    const int cshift = grp ? 3 : 4, nchunk = 128 << cshift, nwch = L << cshift;
    u16* P1 = (u16*)(ws + W_P1);
    u32x4 gq[4], wq[4];
#pragma unroll
    for (int i = 0; i < 4; ++i) { const int chn = tid + 512 * i; const int cg_ = chn < nchunk ? chn : 0, cw_ = chn < nwch ? chn : 0;
        gq[i] = *(const u32x4*)(GV + (size_t)(cg_ >> cshift) * T + (cg_ & ((1 << cshift) - 1)) * 8);
        wq[i] = *(const u32x4*)(WM + (size_t)(cw_ >> cshift) * 128 + (cw_ & ((1 << cshift) - 1)) * 8); }
    u32x2 uq[8]; float bq[8];
    const int ntt = L >> 4;
#pragma unroll
    for (int tt = 0; tt < 8; ++tt) { const int t = tt < ntt ? 16 * tt + fr : fr; uq[tt] = *(const u32x2*)(P1 + (size_t)(rowbase + t) * 1024 + g * 128 + 16 * w + 4 * fq); bq[tt] = p.in[13][(size_t)(l * 4 + g) * 128 + t]; }
    const f32x4 gvg = *(const f32x4*)(p.in[11] + l * 512 + g * 128 + 16 * w + 4 * fq);
    __syncthreads();
#pragma unroll
    for (int i = 0; i < 4; ++i) { const int chn = tid + 512 * i;
        if (chn < nchunk) { const int c = chn >> cshift, kp = (chn & ((1 << cshift) - 1)) * 8; const unsigned gw[4] = {gq[i].x, gq[i].y, gq[i].z, gq[i].w}; u32x4 o;
            unsigned ow[4];
#pragma unroll
            for (int k = 0; k < 4; ++k) ow[k] = pk2(__uint_as_float(gw[k] << 16) * RS[kp + 2 * k], __uint_as_float(gw[k] & 0xffff0000u) * RS[kp + 2 * k + 1]);
            o.x = ow[0]; o.y = ow[1]; o.z = ow[2]; o.w = ow[3]; *(LAS u32x4*)(GT + c * 136 + kp) = o; }
        if (chn < nwch) { const int t = chn >> cshift, kp = (chn & ((1 << cshift) - 1)) * 8; *(LAS u32x4*)(WT + t * 136 + kp) = wq[i]; } }
    __syncthreads();
#pragma unroll
    for (int tt = 0; tt < 8; ++tt) { if (tt < ntt) { f32x4 a = (f32x4){0.f, 0.f, 0.f, 0.f};
        for (int ks = 0; ks < L / 32; ++ks) { if (32 * ks > 16 * tt + 15) break;
            const bf16x8 gf = *(const LAS bf16x8*)(GT + (16 * w + fr) * 136 + 32 * ks + 8 * fq), wf = *(const LAS bf16x8*)(WT + (16 * tt + fr) * 136 + 32 * ks + 8 * fq); a = mfma16(gf, wf, a); }
        const int t = 16 * tt + fr;
        f32x4 u; u[0] = __uint_as_float(uq[tt].x << 16); u[1] = __uint_as_float(uq[tt].x & 0xffff0000u); u[2] = __uint_as_float(uq[tt].y << 16); u[3] = __uint_as_float(uq[tt].y & 0xffff0000u);
        *(u32x2*)(P1 + (size_t)(rowbase + t) * 1024 + g * 128 + 16 * w + 4 * fq) = pk4(u * (a * gvg + bq[tt])); } }
    if (grp) {
        float* o = p.out + O_GMV + (size_t)l * 262144 + (size_t)b * 64 * 512; const float* gg = p.in[11] + l * 512 + g * 128;
        for (int idx = tid; idx < 64 * 128; idx += 512) { const int t = idx >> 7, c = idx & 127; o[(size_t)t * 512 + g * 128 + c] = bf2f(GT[c * 136 + t]) * gg[c]; }
    }
    __syncthreads();
}

DEV void phaseMix(CP& p, int l, LAS unsigned char* lds) {
    unsigned* ctr = (unsigned*)(p.ws + W_MISC) + l;
    LAS int* slot = (LAS int*)(lds + 160 * 1024 - 16);
    for (;;) {
        if (tid_o() == 0) *slot = (int)atomicAdd(ctr, 1u);
        __syncthreads();
        int it = __builtin_amdgcn_readfirstlane(*slot);
        __syncthreads();
        if (it >= 2304) break;
        int kind, grp = 0, a0, a1, a2 = 0;
        if (it < 64) { kind = 0; a0 = it >> 2; a1 = it & 3; }
        else if (it < 128) { it -= 64; kind = 1; a0 = it >> 2; a1 = it & 3; }
        else if (it < 160) { it -= 128; kind = 2; grp = 1; a0 = it >> 2; a1 = it & 3; }
        else if (it < 1184) { it -= 160; kind = 2; a2 = 15 - (it >> 6); a0 = (it & 63) >> 2; a1 = it & 3; }
        else if (it < 2208) { it -= 1184; kind = 3; a0 = it >> 6; a2 = (it >> 2) & 15; a1 = it & 3; }
        else if (it < 2240) { it -= 2208; kind = 0; grp = 1; a0 = it >> 2; a1 = it & 3; }
        else if (it < 2272) { it -= 2240; kind = 1; grp = 1; a0 = it >> 2; a1 = it & 3; }
        else { it -= 2272; kind = 3; grp = 1; a0 = it >> 2; a1 = it & 3; }
        asm volatile("" : "+s"(kind), "+s"(grp), "+s"(a0), "+s"(a1), "+s"(a2));
        if (kind == 0) {
#ifndef NO_S5
            s5_item(p, l, lds, grp, a0, a1);
#endif
        } else if (kind == 1) {
#ifndef NO_GLA
#ifdef GLA_SAMPLE_ONLY
            if (grp)
#endif
            gla_item(p, l, lds, grp, a0, a1);
#endif
        } else if (kind == 2) {
#ifndef NO_ATT
            attn_item(p, l, lds, grp, a0, a1, a2);
#endif
        } else {
#ifndef NO_GMLP
            gmlp_item(p, l, lds, grp, a0, a2, a1);
#endif
        }
    }
}

DEV void phaseFix(CP& p, int l) {
    unsigned char* ws = p.ws; const int gt = bid_o() * 512 + tid_o(), GT = gridDim.x * 512;
    const float* HEAD = (const float*)(ws + W_HEAD); const float* TAIL = (const float*)(ws + W_TAIL); u16* ACT = (u16*)(ws + W_ACT);
    const float* cw = p.in[35] + (size_t)l * 3 * 5632; const float* cb = p.in[36] + (size_t)l * 5632;
    for (int idx = gt; idx < 520 * 2816; idx += GT) { const int slab = idx / 2816, f = idx % 2816;
        float c0[2], c1[2];
#pragma unroll
        for (int bj = 0; bj < 2; ++bj) { const int ff = bj * 2816 + f; float pm2 = 0.f, pm1 = 0.f;
            if (slab >= 512) { const float* st = p.in[7] + ((size_t)(l * 8 + (slab - 512)) * 2) * 5632; pm2 = st[ff]; pm1 = st[5632 + ff]; }
            else if (slab & 31) { pm2 = TAIL[((size_t)(slab - 1) * 2) * 5632 + ff]; pm1 = TAIL[((size_t)(slab - 1) * 2 + 1) * 5632 + ff]; }
            const float h0 = HEAD[((size_t)slab * 2) * 5632 + ff], h1 = HEAD[((size_t)slab * 2 + 1) * 5632 + ff];
            const float w0 = cw[ff], w1 = cw[5632 + ff], w2 = cw[11264 + ff], bb = cb[ff];
            c0[bj] = bb + w0 * pm2 + w1 * pm1 + w2 * h0; c1[bj] = bb + w0 * pm1 + w1 * h0 + w2 * h1; }
        ACT[(size_t)(slab * 64) * 2816 + f] = f2bf(fsilu(c0[0]) * c0[1]); ACT[(size_t)(slab * 64 + 1) * 2816 + f] = f2bf(fsilu(c1[0]) * c1[1]); }
    for (int idx = gt; idx < 24 * 2 * 5632; idx += GT) { const int bb = idx / 11264, rem = idx % 11264;
        if (bb < 16) p.out[O_FCP + (size_t)l * 180224 + (size_t)bb * 11264 + rem] = TAIL[((size_t)(bb * 32 + 31) * 2) * 5632 + rem];
        else p.out[O_FCS + (size_t)l * 90112 + (size_t)(bb - 16) * 11264 + rem] = TAIL[((size_t)(512 + bb - 16) * 2) * 5632 + rem]; }
}

#define XB_TMO      128
#define XB_XCNT(j)  (256  + 64 * (j))
#define XB_XSUB(j)  (1280 + 64 * (j))
#define XB_XGEN(j)  (2304 + 64 * (j))
#define XB_TOP      3328
#define XB_TOPGEN   3392
#define XCD_BAR_WORDS 3456
#define XB_SPIN_CAP (1u << 18)

__device__ __forceinline__ unsigned xb_ld(unsigned* p)              { return __hip_atomic_load(p, __ATOMIC_RELAXED, __HIP_MEMORY_SCOPE_AGENT); }
__device__ __forceinline__ unsigned xb_add(unsigned* p, unsigned v) { return __hip_atomic_fetch_add(p, v, __ATOMIC_RELAXED, __HIP_MEMORY_SCOPE_AGENT); }
__device__ __forceinline__ unsigned xb_xcc_id() { return (unsigned)__builtin_amdgcn_s_getreg((3 << 11) | 20) & 0xFu; }
#define XB_SPIN(cond, bar) do { unsigned _sp = 0; while (cond) { __builtin_amdgcn_s_sleep(1); \
    if ((++_sp & 255u) == 0u) { if (xb_ld(&(bar)[XB_TMO])) break; if (_sp > XB_SPIN_CAP) { atomicAdd(&(bar)[XB_TMO], 1u); break; } } } } while (0)

struct XcdBarrier {
    unsigned* bar; unsigned x;
    volatile LAS unsigned* st;
};

__device__ __forceinline__ XcdBarrier xcd_barrier_post(unsigned* bar, volatile LAS unsigned* st) {
    XcdBarrier b; b.bar = bar; b.x = xb_xcc_id(); b.st = st;
    if (threadIdx.x == 0) (void)xb_add(&bar[XB_XCNT(b.x)], 1u);
    return b;
}
__device__ __forceinline__ void xcd_barrier_complete(unsigned* bar, unsigned x, unsigned& nloc, unsigned& nx) {
    const unsigned G = gridDim.x * gridDim.y * gridDim.z;
    unsigned sum, cnt, mine, sp = 0u;
    for (;;) {
        sum = 0u; cnt = 0u; mine = 0u;
#pragma unroll
        for (unsigned j = 0; j < 16; ++j) { const unsigned c = xb_ld(&bar[XB_XCNT(j)]); sum += c; cnt += (c > 0u) ? 1u : 0u; mine = (j == x) ? c : mine; }
        if (sum == G) break;
        __builtin_amdgcn_s_sleep(1);
        if ((++sp & 255u) == 0u) { if (xb_ld(&bar[XB_TMO])) break; if (sp > XB_SPIN_CAP) { atomicAdd(&bar[XB_TMO], 1u); break; } }
    }
    nloc = mine > 0u ? mine : 1u; nx = cnt > 0u ? cnt : 1u;
}

__device__ __forceinline__ void xcd_barrier(const XcdBarrier& b) {
    asm volatile("s_waitcnt vmcnt(0)" ::: "memory");
    __syncthreads();
    if (threadIdx.x == 0) {
        unsigned* bar = b.bar;
        __builtin_amdgcn_s_waitcnt(0);
        unsigned nloc = b.st[0], nx = b.st[1];
        if (nloc == 0u) { xcd_barrier_complete(bar, b.x, nloc, nx); b.st[0] = nloc; b.st[1] = nx; }
        const unsigned old = xb_add(&bar[XB_XSUB(b.x)], 1u);
        const unsigned gen = old / nloc;
        if (old + 1u == (gen + 1u) * nloc) {
            __builtin_amdgcn_fence(__ATOMIC_RELEASE, "agent");
            asm volatile("s_waitcnt vmcnt(0)" ::: "memory");
            const unsigned og = xb_add(&bar[XB_TOP], 1u);
            const unsigned tg = og / nx;
            if (og + 1u == (tg + 1u) * nx) xb_add(&bar[XB_TOPGEN], 1u);
            else XB_SPIN(xb_ld(&bar[XB_TOPGEN]) == tg, bar);
            __builtin_amdgcn_fence(__ATOMIC_ACQUIRE, "agent");
            xb_add(&bar[XB_XGEN(b.x)], 1u);
            asm volatile("s_waitcnt vmcnt(0)" ::: "memory");
        } else {
            XB_SPIN(xb_ld(&bar[XB_XGEN(b.x)]) == gen, bar);
            __builtin_amdgcn_fence(__ATOMIC_ACQUIRE, "agent");
            asm volatile("s_waitcnt vmcnt(0)" ::: "memory");
        }
    }
    __syncthreads();
}


__global__ void __launch_bounds__(512, 2) mega(Params p_unused) {
    extern __shared__ __attribute__((aligned(16))) unsigned char smem[];
    LAS unsigned char* lds = (LAS unsigned char*)smem;
    cg::grid_group grid = cg::this_grid();
    volatile LAS unsigned* xb_st = (volatile LAS unsigned*)(lds + 160 * 1024 - 32);
    if (threadIdx.x == 0) { xb_st[0] = 0u; xb_st[1] = 0u; }
    __syncthreads();
    const XcdBarrier xbar = xcd_barrier_post((unsigned*)(((CP*)__builtin_amdgcn_kernarg_segment_ptr())->ws + W_BAR), xb_st);
#define GSYNC() xcd_barrier(xbar)
#pragma unroll 1
    for (int l = 0; l < 2; ++l) {
        CP* pp = (CP*)__builtin_amdgcn_kernarg_segment_ptr(); asm volatile("" : "+s"(pp)); CP& p = *pp; unsigned char* ws = p.ws; const int G = gridDim.x, c = bid_o();
#ifndef SKIP_A
        phaseA(p, l);
#endif
        GSYNC();
        if (gridDim.y == 0x7fffu) grid.sync();
#ifndef SKIP_B
        {
            pg8::PlainSched S; S.T.init(130, NMIX, G, c); S.A = (const char*)ws + W_H; S.B = (const char*)ws + W_WIN; S.ld = 1024; S.nt = 16;
            EpiIn E; E.l = l; E.out = p.out; E.ws = ws; E.qg = p.in[27] + l * 64; E.kg = p.in[28] + l * 64; E.rs1 = (const float*)(ws + W_RS) + (size_t)(l * 2) * MT;
            pg8::gemm_phase(lds, 1024, S, E);
        }
#endif
        GSYNC();
#ifndef SKIP_C
        phaseMix(p, l, lds);
#endif
        GSYNC();
#ifndef SKIP_D
        {
            pg8::PlainSched S; S.T.init(130, 2, G, c); S.A = (const char*)ws + W_S5; S.B = (const char*)ws + W_WGLU; S.ld = 512; S.nt = 8;
            EpiGlu E; E.ws = ws; E.bias = p.in[23] + l * 512;
            pg8::gemm_phase(lds, 512, S, E);
        }
#endif
        GSYNC();
#ifndef SKIP_E
        {
            MergeSched S; S.T.init(128, 4, G, c); S.ws = ws;
            EpiMerge E; E.ws = ws; E.bgate = p.in[10] + l * 4096; E.rs1 = (const float*)(ws + W_RS) + (size_t)(l * 2) * MT;
            pg8::gemm_phase(lds, 1024, S, E);
        }
#endif
        GSYNC();
        {
            const f32x4* mf = (const f32x4*)(ws + W_PART); u16* mg = (u16*)(ws + W_MERGED) + (size_t)MTP * 1024;
            for (int i = c * 512 + tid_o(); i < 512 * 256; i += G * 512) *(u32x2*)(mg + (size_t)i * 4) = pk4(mf[i] + mf[i + 131072] + mf[i + 262144] + mf[i + 393216]);
        }
        GSYNC();
#ifndef SKIP_F
        {
            pg8::TailSched S; S.T.init(128, 4, G, c); S.A = (const char*)ws + W_MERGED; S.B = (const char*)ws + W_WOUT; S.ld = 1024; S.nt = 16; S.npiece = 4; S.ntp = 4;
            EpiRes E; E.xin = l == 0 ? p.in[0] : nullptr; E.xb = (u16*)(ws + W_H); E.yout = nullptr; E.rsacc = (float*)(ws + W_RS) + (size_t)(l * 2 + 1) * MT; E.yfull = (float*)(ws + W_PART);
            pg8::gemm_phase(lds, 1024, S, E);
        }
#endif
        GSYNC();
#ifndef SKIP_G
        sample_rows_reduce(p.out + (size_t)MTP * 1024, (const float*)(ws + W_PART), 4, (u16*)(ws + W_H) + (size_t)MTP * 1024, (float*)(ws + W_RS) + (size_t)(l * 2 + 1) * MT + MTP);
#endif
        GSYNC();
#ifndef SKIP_H
        {
            pg8::PlainSched S; S.T.init(130, 22, G, c); S.A = (const char*)ws + W_H; S.B = (const char*)ws + W_WUP; S.ld = 1024; S.nt = 16;
            EpiUp E; E.ws = ws; E.cw = p.in[35] + (size_t)l * 3 * 5632; E.cbias = p.in[36] + (size_t)l * 5632; E.rs2 = (const float*)(ws + W_RS) + (size_t)(l * 2 + 1) * MT;
            pg8::gemm_phase(lds, 1024, S, E);
        }
#endif
        GSYNC();
#ifndef SKIP_I
        phaseFix(p, l);
#endif
        GSYNC();
#ifndef SKIP_J
        {
            pg8::TailSched S; S.T.init(128, 4, G, c); S.A = (const char*)ws + W_ACT; S.B = (const char*)ws + W_WDN; S.ld = 2816; S.nt = 44; S.npiece = 11; S.ntp = 4;
            EpiRes E; E.xin = nullptr; E.xb = (u16*)(ws + W_H); E.yout = l == 1 ? p.out : nullptr; E.rsacc = l == 0 ? (float*)(ws + W_RS) + (size_t)2 * MT : nullptr; E.yfull = (float*)(ws + W_PART);
            pg8::gemm_phase(lds, 2816, S, E);
        }
#endif
        GSYNC();
        if (l == 1) sample_rows_reduce(p.out + (size_t)MTP * 1024, (const float*)(ws + W_PART), 11, (u16*)(ws + W_H) + (size_t)MTP * 1024, (float*)(ws + W_RS) + (size_t)3 * MT + MTP);
    }
}

extern "C" void kernel_launch(void* const* d_in, const int* in_sizes, int n_in, void* d_out, int out_size, void* d_ws, size_t ws_size, hipStream_t stream) {
    constexpr int LDS_BYTES = 160 * 1024;
    static int grid_blocks = 0;
    if (!grid_blocks) {
        int dev = 0, cus = 0, per_cu = 0;
        hipGetDevice(&dev);
        hipDeviceGetAttribute(&cus, hipDeviceAttributeMultiprocessorCount, dev);
        hipFuncSetAttribute((const void*)mega, hipFuncAttributeMaxDynamicSharedMemorySize, LDS_BYTES);
        hipOccupancyMaxActiveBlocksPerMultiprocessor(&per_cu, (const void*)mega, 512, LDS_BYTES);
        if (per_cu < 1) per_cu = 1;
        grid_blocks = cus * per_cu;
        if (ws_size < W_END) fprintf(stderr, "kernel_launch: workspace too small: %zu < %zu\n", ws_size, (size_t)W_END);
    }
    Params p{};
    for (int i = 0; i < 38; ++i) p.in[i] = (const float*)d_in[i];
    p.out = (float*)d_out; p.ws = (unsigned char*)d_ws;
    (void)hipMemsetAsync((unsigned char*)d_ws + W_BAR, 0, 16384, stream);
    void* args[] = {&p};
    hipError_t e = hipLaunchCooperativeKernel((const void*)mega, dim3(grid_blocks), dim3(512), args, LDS_BYTES, stream);
    if (e != hipSuccess) fprintf(stderr, "cooperative launch failed: %s (grid %d)\n", hipGetErrorString(e), grid_blocks);
}
```

```cpp
#include <hip/hip_runtime.h>
#include <hip/hip_cooperative_groups.h>
#include <cstdio>
namespace cg = cooperative_groups;

#define LAS __attribute__((address_space(3)))
#define DEV __device__ __forceinline__
typedef unsigned short u16;
typedef short bf16x8 __attribute__((ext_vector_type(8)));
typedef float f32x4 __attribute__((ext_vector_type(4)));
typedef float f32x2 __attribute__((ext_vector_type(2)));
typedef unsigned u32x4 __attribute__((ext_vector_type(4)));
typedef unsigned u32x2 __attribute__((ext_vector_type(2)));

constexpr int MTP = 32768, MT = 33280;
constexpr int NINP = 8960;
constexpr int NMIX = 19;
constexpr int GATE0 = 4864;
constexpr float EPS = 1e-6f;
constexpr float LOG2E = 1.4426950408889634f;

constexpr size_t O_Y = 0, O_DKP = 34078720, O_DVP = 67633152, O_SREP = 101187584, O_SIMP = 101253120, O_GLAP = 101318656,
                 O_FCP = 102367232, O_DKS = 102727680, O_DVS = 103251968, O_SRES = 103776256, O_SIMS = 103809024, O_GLAS = 103841792,
                 O_FCS = 104366080, O_GMV = 104546304;

constexpr size_t SZ_H = (size_t)MT * 1024 * 2;
constexpr size_t SZ_HALF = (size_t)MT * 512 * 2;
constexpr size_t W_H = 0;
constexpr size_t W_P1 = W_H + SZ_H;
constexpr size_t W_P2 = W_P1 + SZ_H;
constexpr size_t W_S5 = W_P2 + SZ_H;
constexpr size_t W_GVT = W_S5 + SZ_HALF;
constexpr size_t W_CQ = W_GVT + SZ_HALF;
constexpr size_t W_CK = W_CQ + SZ_HALF / 2;
constexpr size_t W_CVT = W_CK + SZ_HALF / 2;
constexpr size_t W_CODE = W_CVT + SZ_HALF;
constexpr size_t W_DKP = W_CODE + (size_t)MT * 16 * 4;
constexpr size_t W_DKS = W_DKP + (size_t)MTP * 512 * 2;
constexpr size_t W_DVTP = W_DKS + (size_t)8 * 4160 * 512 * 2;
constexpr size_t W_DVTS = W_DVTP + (size_t)MTP * 512 * 2;
constexpr size_t W_ROWSQ = W_DVTS + (size_t)8 * 4160 * 512 * 2;
constexpr size_t W_MISC = W_ROWSQ + (size_t)MT * 4;
constexpr size_t W_WIN = W_MISC + 4096;
constexpr size_t W_WBR = W_WIN + (size_t)NINP * 1024 * 2;
constexpr size_t W_WOUT = W_WBR + (size_t)2 * 1024 * 1024 * 2;
constexpr size_t W_WGLU = W_WOUT + (size_t)1024 * 1024 * 2;
constexpr size_t W_WUP = W_WGLU + (size_t)512 * 512 * 2;
constexpr size_t W_WDN = W_WUP + (size_t)5632 * 1024 * 2;
constexpr size_t W_MFS = W_WDN + (size_t)1024 * 2816 * 2;
constexpr size_t W_BAR = W_MFS + (size_t)512 * 1024 * 4;
constexpr size_t W_WM = W_BAR + 16384;
constexpr size_t W_RS = W_WM + (size_t)4 * 128 * 128 * 2;
constexpr size_t W_PART = W_RS + (size_t)4 * MT * 4;
constexpr size_t W_END = W_PART + (size_t)11 * 512 * 1024 * 4;
constexpr size_t W_MERGED = W_CQ;
constexpr size_t W_SCR = W_DKP;
constexpr size_t W_ACT = W_P1;
constexpr size_t W_HEAD = W_DVTP;
constexpr size_t W_TAIL = W_HEAD + (size_t)520 * 2 * 5632 * 4;
static_assert(W_TAIL + (size_t)520 * 2 * 5632 * 4 <= W_ROWSQ, "head/tail alias");
static_assert((size_t)MT * 2816 * 2 <= W_CQ - W_P1, "act alias");

struct Params { const float* in[38]; float* out; unsigned char* ws; };
typedef const __attribute__((address_space(4))) Params CP;

DEV int tid_o() { int t = threadIdx.x; asm volatile("" : "+v"(t)); return t; }
DEV int bid_o() { int t = blockIdx.x; asm volatile("" : "+s"(t)); return t; }
DEV float bf2f(u16 v) { return __uint_as_float(((unsigned)v) << 16); }
typedef __bf16 b16x2 __attribute__((ext_vector_type(2)));
DEV unsigned pk2(float lo, float hi) { const f32x2 v = {lo, hi}; const b16x2 r = __builtin_convertvector(v, b16x2); return __builtin_bit_cast(unsigned, r); }
DEV u16 f2bf(float v) { return (u16)(pk2(v, 0.f) & 0xffffu); }
DEV float fsigmoid(float x) { return __builtin_amdgcn_rcpf(1.f + __expf(-x)); }
DEV float fsilu(float x) { return x * fsigmoid(x); }
DEV float fgelu(float x) { return x * fsigmoid(1.5957691216057308f * (x + 0.044715f * x * x * x)); }
DEV float flogsig(float x) { return fminf(x, 0.f) - __logf(1.f + __expf(-fabsf(x))); }
DEV f32x4 mfma16(bf16x8 a, bf16x8 b, f32x4 c) { return __builtin_amdgcn_mfma_f32_16x16x32_bf16(a, b, c, 0, 0, 0); }
DEV u32x2 pk4(f32x4 v) { u32x2 r; r.x = pk2(v[0], v[1]); r.y = pk2(v[2], v[3]); return r; }
DEV float red_fq(float v) { v += __shfl_xor(v, 16); v += __shfl_xor(v, 32); return v; }
DEV float wave_sum(float v) { for (int o = 32; o; o >>= 1) v += __shfl_xor(v, o); return v; }

namespace pg8 {
constexpr int BM = 256, BK = 64, HALF = 128, HTB = HALF * BK * 2, NXCD = 8, WGM = 8;
DEV int lds_byte(int r, int c) { const int st = (r >> 4) * 2 + (c >> 5), rr = r & 15, cc = c & 31, ob = rr * 64 + cc * 2; return st * 1024 + (ob ^ (((ob >> 9) & 1) << 5)); }
DEV void stage_rc(int b, int& R, int& C) { const int st = b / 1024, sb = b % 1024, swz = sb ^ (((sb >> 9) & 1) << 5); R = (st >> 1) * 16 + swz / 64; C = (st & 1) * 32 + (swz % 64) / 2; }
struct GUnit { const char* A; const char* B; int nt, pm, pn, kind; };
struct TileOrder {
    int nM, nN, nwg, G, c;
    DEV void init(int nM_, int nN_, int G_, int c_) { nM = nM_; nN = nN_; nwg = nM * nN; G = G_; c = c_; }
    DEV bool tile(int i, int& pm, int& pn) const {
        const long L = (long)i * G + c; if (L >= nwg) return false;
        int wgid = (int)L; { const int q = nwg / NXCD, r = nwg % NXCD, xcd = wgid % NXCD, off = wgid / NXCD; wgid = (xcd < r ? xcd * (q + 1) : r * (q + 1) + (xcd - r) * q) + off; }
        const int nig = WGM * nN, gid = wgid / nig, fm = gid * WGM, gsz = (nM - fm) < WGM ? (nM - fm) : WGM;
        pm = fm + ((wgid % nig) % gsz); pn = (wgid % nig) / gsz; return true;
    }
};
struct TailSched {
    TileOrder T; const char* A; const char* B; int ld, nt, npiece, ntp;
    DEV bool next(int i, GUnit& u) const { int pm, pn;
        if (T.tile(i, pm, pn)) { u.pm = pm; u.pn = pn; u.kind = 0; u.nt = nt; u.A = A + (size_t)pm * 256 * ld * 2; u.B = B + (size_t)pn * 256 * ld * 2; return true; }
        const int i0 = (T.nwg - T.c + T.G - 1) / T.G; const int j = (i - i0) * T.G + T.c; if (j >= 8 * npiece) return false;
        const int tile = j / npiece, kp = j % npiece; pm = 128 + (tile >> 2); pn = tile & 3; u.pm = pm; u.pn = pn; u.kind = 1 + kp; u.nt = ntp;
        u.A = A + (size_t)pm * 256 * ld * 2 + (size_t)kp * ntp * 128; u.B = B + (size_t)pn * 256 * ld * 2 + (size_t)kp * ntp * 128; return true; }
};
struct PlainSched {
    TileOrder T; const char* A; const char* B; int ld, nt;
    DEV bool next(int i, GUnit& u) const { int pm, pn; if (!T.tile(i, pm, pn)) return false; u.pm = pm; u.pn = pn; u.kind = 0; u.nt = nt;
        u.A = A + (size_t)pm * 256 * ld * 2; u.B = B + (size_t)pn * 256 * ld * 2; return true; }
};

template <class Epi, class Sched>
DEV void gemm_phase(LAS unsigned char* lds, const int ld, const Sched& S, const Epi& E) {
    const int tid = tid_o(), wid = __builtin_amdgcn_readfirstlane(tid >> 6), lane = tid & 63, wr = wid >> 2, wc = wid & 3, fr = lane & 15, fq = lane >> 4;
    unsigned voff[2];
#pragma unroll
    for (int i = 0; i < 2; ++i) { int R, C; stage_rc(tid * 16 + i * 8192, R, C); voff[i] = (unsigned)(R * ld + C) * 2u; }
    const size_t kstep = (size_t)(BK * 2);
    const size_t hstep = (size_t)HALF * ld * 2;
    const unsigned ldsw = (unsigned)wid * 1024u;
    const int aoff = lds_byte(wr * 64 + fr, fq * 8), boff = lds_byte(wc * 32 + fr, fq * 8);
#define PG8_SA(b, h) (((b) * 2 + (h)) * HTB)
#define PG8_SB(b, h) ((4 + (b) * 2 + (h)) * HTB)
#define PG8_STAGE(bufoff, gbase) do { _Pragma("unroll") for (int _i = 0; _i < 2; ++_i) \
        __builtin_amdgcn_global_load_lds((const unsigned*)((const char*)(gbase) + voff[_i]), (LAS unsigned*)(lds + (bufoff) + ldsw + _i * 8192), 16, 0, 0); } while (0)
#define PG8_LDA(dst, b, h) do { _Pragma("unroll") for (int m = 0; m < 4; ++m) _Pragma("unroll") for (int k = 0; k < 2; ++k) dst[m][k] = *(const LAS bf16x8*)(lds + PG8_SA(b, h) + aoff + m * 2048 + k * 1024); } while (0)
#define PG8_LDB(dst, b, h) do { _Pragma("unroll") for (int n = 0; n < 2; ++n) _Pragma("unroll") for (int k = 0; k < 2; ++k) dst[n][k] = *(const LAS bf16x8*)(lds + PG8_SB(b, h) + boff + n * 2048 + k * 1024); } while (0)
#define PG8_MMA(ai, bj, At, Bt) do { __builtin_amdgcn_s_setprio(1); _Pragma("unroll") for (int m = 0; m < 4; ++m) _Pragma("unroll") for (int n = 0; n < 2; ++n) _Pragma("unroll") for (int k = 0; k < 2; ++k) \
        acc[ai][bj][m][n] = __builtin_amdgcn_mfma_f32_16x16x32_bf16(Bt[n][k], At[m][k], acc[ai][bj][m][n], 0, 0, 0); __builtin_amdgcn_s_setprio(0); } while (0)
#define PG8_WAIT_V(n) asm volatile("s_waitcnt vmcnt(" #n ")" ::: "memory")
#define PG8_WAIT_L(n) asm volatile("s_waitcnt lgkmcnt(" #n ")" ::: "memory")
#define PG8_BAR __builtin_amdgcn_s_barrier()
#define PG8_SCHED __builtin_amdgcn_sched_barrier(0)
    GUnit cur, nxt; int ui = 0;
    if (!S.next(0, cur)) return;
    f32x4 acc[2][2][4][2];
#pragma unroll
    for (int a = 0; a < 2; ++a)
#pragma unroll
        for (int b = 0; b < 2; ++b)
#pragma unroll
            for (int m = 0; m < 4; ++m)
#pragma unroll
                for (int n = 0; n < 2; ++n) acc[a][b][m][n] = (f32x4){0.f, 0.f, 0.f, 0.f};
    bf16x8 At[4][2], B0[2][2], B1[2][2];
    const char* cA = cur.A; const char* cB = cur.B;
    PG8_STAGE(PG8_SB(0, 0), cB); PG8_STAGE(PG8_SA(0, 0), cA); PG8_STAGE(PG8_SB(0, 1), cB + hstep); PG8_STAGE(PG8_SA(0, 1), cA + hstep);
    if (wr == 1) PG8_BAR;
    PG8_WAIT_V(4); PG8_BAR;
    PG8_STAGE(PG8_SB(1, 0), cB + kstep); PG8_STAGE(PG8_SA(1, 0), cA + kstep); PG8_STAGE(PG8_SB(1, 1), cB + hstep + kstep);
    PG8_WAIT_V(6); PG8_BAR;
    for (;;) {
        const bool has_next = S.next(ui + 1, nxt);
        const char* nA = has_next ? nxt.A : cA; const char* nB = has_next ? nxt.B : cB;
        const int nt = cur.nt;
        for (int t = 0; t < nt; t += 2) {
            const bool last = (t == nt - 2);
            const char* a1 = cA + (size_t)(t + 1) * kstep;
            const char* a2 = last ? nA : cA + (size_t)(t + 2) * kstep; const char* b2 = last ? nB : cB + (size_t)(t + 2) * kstep;
            const char* a3 = a2 + kstep; const char* b3 = b2 + kstep;
            PG8_LDB(B0, 0, 0); PG8_SCHED; PG8_LDA(At, 0, 0); PG8_STAGE(PG8_SA(1, 1), a1 + hstep);
            PG8_WAIT_L(8); PG8_BAR; PG8_WAIT_L(0); PG8_MMA(0, 0, At, B0); PG8_BAR; PG8_SCHED;
            PG8_LDB(B1, 0, 1); PG8_STAGE(PG8_SB(0, 0), b2);
            PG8_BAR; PG8_WAIT_L(0); PG8_MMA(0, 1, At, B1); PG8_BAR;
            PG8_LDA(At, 0, 1); PG8_STAGE(PG8_SA(0, 0), a2);
            PG8_BAR; PG8_WAIT_L(0); PG8_MMA(1, 0, At, B0); PG8_BAR; PG8_SCHED;
            PG8_STAGE(PG8_SB(0, 1), b2 + hstep);
            PG8_WAIT_V(6); PG8_BAR; PG8_MMA(1, 1, At, B1); PG8_BAR;
            PG8_LDB(B0, 1, 0); PG8_SCHED; PG8_LDA(At, 1, 0); PG8_STAGE(PG8_SA(0, 1), a2 + hstep);
            PG8_WAIT_L(8); PG8_BAR; PG8_WAIT_L(0); PG8_MMA(0, 0, At, B0); PG8_BAR; PG8_SCHED;
            PG8_LDB(B1, 1, 1); PG8_STAGE(PG8_SB(1, 0), b3);
            PG8_BAR; PG8_WAIT_L(0); PG8_MMA(0, 1, At, B1); PG8_BAR;
            PG8_LDA(At, 1, 1); PG8_STAGE(PG8_SA(1, 0), a3);
            PG8_BAR; PG8_WAIT_L(0); PG8_MMA(1, 0, At, B0); PG8_BAR; PG8_SCHED;
            PG8_STAGE(PG8_SB(1, 1), b3 + hstep);
            PG8_WAIT_V(6); PG8_BAR; PG8_MMA(1, 1, At, B1); PG8_BAR;
        }
        { int fr_ = fr, fq_ = fq, wr_ = wr, wc_ = wc; asm volatile("" : "+v"(fr_), "+v"(fq_), "+s"(wr_), "+s"(wc_));
          E(acc, cur, wr_, wc_, fr_, fq_); }
        if (!has_next) break;
#pragma unroll
        for (int a = 0; a < 2; ++a)
#pragma unroll
            for (int b = 0; b < 2; ++b)
#pragma unroll
                for (int m = 0; m < 4; ++m)
#pragma unroll
                    for (int n = 0; n < 2; ++n) acc[a][b][m][n] = (f32x4){0.f, 0.f, 0.f, 0.f};
        cur = nxt; cA = nA; cB = nB; ++ui;
    }
    PG8_WAIT_V(0);
    if (wr == 0) PG8_BAR;
    PG8_BAR;
#undef PG8_SA
#undef PG8_SB
#undef PG8_STAGE
#undef PG8_LDA
#undef PG8_LDB
#undef PG8_MMA
#undef PG8_WAIT_V
#undef PG8_WAIT_L
#undef PG8_BAR
#undef PG8_SCHED
}
}
using pg8::GUnit;
typedef f32x4 AccT[2][2][4][2];

#define FOR_AM _Pragma("unroll") for (int ai = 0; ai < 2; ++ai) _Pragma("unroll") for (int m = 0; m < 4; ++m)
#define FOR_BN _Pragma("unroll") for (int bj = 0; bj < 2; ++bj) _Pragma("unroll") for (int n = 0; n < 2; ++n)

struct EpiIn {
    int l; float* out; unsigned char* ws; const float* qg; const float* kg; const float* rs1;
    DEV void operator()(const AccT& acc, const GUnit& u, int wr, int wc, int fr, int fq) const {
        const int pn = u.pn; const bool smp = u.pm >= 128;
        const int rowb = u.pm * 256 + wr * 64 + fr;
        const int ct0 = wc * 32 + 4 * fq;
        u16* P1 = (u16*)(ws + W_P1); u16* P2 = (u16*)(ws + W_P2);
        float rsx[2][4];
        FOR_AM rsx[ai][m] = __builtin_amdgcn_rsqf(rs1[rowb + ai * 128 + m * 16] * (1.f / 1024.f) + EPS);
        if (pn < 2) {
            FOR_AM { const int row = rowb + ai * 128 + m * 16; FOR_BN { f32x4 v = (acc[ai][bj][m][n] * rsx[ai][m]);
                for (int e = 0; e < 4; ++e) v[e] = fgelu(v[e]);
                *(u32x2*)(P1 + (size_t)row * 1024 + pn * 256 + ct0 + bj * 128 + n * 16) = pk4(v); } }
        } else if (pn < 4 || pn == 8 || pn == 9 || pn == 16 || pn == 17) {
            const int kind = pn < 4 ? 0 : (pn < 10 ? 1 : 2);
            const int cseg = (pn & 1) * 256;
            u16* dstT; int T, toff = 0;
            if (kind == 0) { dstT = (u16*)(ws + W_GVT) + (smp ? (size_t)16 * 512 * 2048 : 0); T = smp ? 64 : 2048; }
            else if (kind == 1) { dstT = (u16*)(ws + W_CVT) + (smp ? (size_t)16 * 512 * 2048 : 0); T = smp ? 64 : 2048; }
            else { dstT = (u16*)(ws + (smp ? W_DVTS : W_DVTP)); T = smp ? 4160 : 2048; toff = smp ? 4096 : 0; }
            float* rowsq = (float*)(ws + W_ROWSQ);
            FOR_AM { const int row = rowb + ai * 128 + m * 16;
                int b, t; if (smp) { const int rs = row - MTP; b = rs >> 6; t = rs & 63; } else { b = row >> 11; t = row & 2047; }
                float ss = 0.f;
                FOR_BN { f32x4 v = (acc[ai][bj][m][n] * rsx[ai][m]); const int cc = cseg + ct0 + bj * 128 + n * 16;
                    if (kind == 0) { for (int e = 0; e < 4; ++e) { v[e] = fgelu(v[e]); ss += v[e] * v[e]; } }
                    if (kind == 2) { float* o = smp ? out + O_DVS + (size_t)l * 262144 + (size_t)(row - MTP) * 512 + cc : out + O_DVP + (size_t)l * 16777216 + (size_t)row * 512 + cc;
                        *(f32x4*)o = v; }
                    for (int e = 0; e < 4; ++e) dstT[((size_t)b * 512 + cc + e) * T + toff + t] = f2bf(v[e]); }
                if (kind == 0) { ss = red_fq(ss); if (fq == 0) atomicAdd(rowsq + row, ss); } }
        } else if (pn < 6) {
            u16* S5 = (u16*)(ws + W_S5);
            FOR_AM { const int row = rowb + ai * 128 + m * 16; FOR_BN {
                *(u32x2*)(S5 + (size_t)row * 512 + (pn - 4) * 256 + ct0 + bj * 128 + n * 16) = pk4((acc[ai][bj][m][n] * rsx[ai][m])); } }
        } else if (pn < 8) {
            u16* D = (u16*)(ws + (pn == 6 ? W_CQ : W_CK)); const float sc = pn == 6 ? 0.125f : 1.f;
            FOR_AM { const int row = rowb + ai * 128 + m * 16; FOR_BN {
                *(u32x2*)(D + (size_t)row * 256 + ct0 + bj * 128 + n * 16) = pk4((acc[ai][bj][m][n] * rsx[ai][m]) * sc); } }
        } else if (pn < 12) {
            FOR_AM { const int row = rowb + ai * 128 + m * 16; FOR_BN { f32x4 v = (acc[ai][bj][m][n] * rsx[ai][m]);
                for (int e = 0; e < 4; ++e) v[e] = fsilu(v[e]);
                *(u32x2*)(P2 + (size_t)row * 1024 + (pn - 10) * 256 + ct0 + bj * 128 + n * 16) = pk4(v); } }
        } else if (pn < 16) {
            const bool isq = pn < 14; const int hh = 4 * (pn & 1) + wc; const float* g = isq ? qg : kg;
            f32x4 gv[2][2];
            FOR_BN gv[bj][n] = *(const f32x4*)(g + 32 * bj + 16 * n + 4 * fq);
            FOR_AM { const int row = rowb + ai * 128 + m * 16;
                float ss = 0.f;
                FOR_BN { const f32x4 v = (acc[ai][bj][m][n] * rsx[ai][m]); ss += v[0] * v[0] + v[1] * v[1] + v[2] * v[2] + v[3] * v[3]; }
                ss = red_fq(ss);
                float rs = __builtin_amdgcn_rsqf(ss * (1.f / 64.f) + EPS);
                if (isq) { rs *= 0.125f * LOG2E;
                    FOR_BN { *(u32x2*)(P2 + (size_t)row * 1024 + 512 + hh * 64 + 32 * bj + 16 * n + 4 * fq) = pk4((acc[ai][bj][m][n] * rsx[ai][m]) * rs * gv[bj][n]); }
                } else {
                    float* o; u16* kb;
                    if (smp) { const int rs_ = row - MTP; o = out + O_DKS + (size_t)l * 262144 + (size_t)rs_ * 512; kb = (u16*)(ws + W_DKS) + ((size_t)(rs_ >> 6) * 4160 + 4096 + (rs_ & 63)) * 512; }
                    else { o = out + O_DKP + (size_t)l * 16777216 + (size_t)row * 512; kb = (u16*)(ws + W_DKP) + (size_t)row * 512; }
                    FOR_BN { const f32x4 v = (acc[ai][bj][m][n] * rsx[ai][m]) * rs * gv[bj][n]; const int d = hh * 64 + 32 * bj + 16 * n + 4 * fq;
                        *(f32x4*)(o + d) = v; *(u32x2*)(kb + d) = pk4(v); } } }
        } else {
            if (wc == 0) { float* C = (float*)(ws + W_CODE);
                FOR_AM { const int row = rowb + ai * 128 + m * 16; *(f32x4*)(C + (size_t)row * 16 + 4 * fq) = acc[ai][0][m][0] * rsx[ai][m]; } }
        }
    }
};

struct EpiGlu {
    unsigned char* ws; const float* bias;
    DEV void operator()(const AccT& acc, const GUnit& u, int wr, int wc, int fr, int fq) const {
        const u16* Z = (const u16*)(ws + W_S5); u16* P1 = (u16*)(ws + W_P1);
        const int rowb = u.pm * 256 + wr * 64 + fr, cb = u.pn * 256 + wc * 32 + 4 * fq;
        FOR_AM { const int row = rowb + ai * 128 + m * 16; FOR_BN { const int col = cb + bj * 128 + n * 16;
            const f32x4 bv = *(const f32x4*)(bias + col); const u32x2 zz = *(const u32x2*)(Z + (size_t)row * 512 + col);
            f32x4 z; z[0] = __uint_as_float(zz.x << 16); z[1] = __uint_as_float(zz.x & 0xffff0000u); z[2] = __uint_as_float(zz.y << 16); z[3] = __uint_as_float(zz.y & 0xffff0000u);
            f32x4 v = acc[ai][bj][m][n] + bv;
            for (int e = 0; e < 4; ++e) v[e] = z[e] * fsigmoid(v[e]);
            *(u32x2*)(P1 + (size_t)row * 1024 + 512 + col) = pk4(v); } }
    }
};

struct MergeSched {
    pg8::TileOrder T; unsigned char* ws;
    DEV void fill(GUnit& u, int pm, int pn, int b, int sub) const {
        u.pm = pm; u.pn = pn;
        if (sub) { u.nt = 16; u.A = (const char*)ws + W_H + (size_t)pm * 256 * 2048; u.B = (const char*)ws + W_WIN + (size_t)(GATE0 + b * 1024 + pn * 256) * 2048; }
        else { u.nt = 8; u.A = (const char*)ws + (b < 2 ? W_P1 : W_P2) + (size_t)pm * 256 * 2048 + (b & 1) * 1024;
               u.B = (const char*)ws + W_WBR + (size_t)(b >> 1) * 1024 * 2048 + (size_t)pn * 256 * 2048 + (b & 1) * 1024; }
    }
    DEV bool next(int i, GUnit& u) const {
        int pm, pn;
        if (T.tile(i >> 3, pm, pn)) { const int s = i & 7; u.kind = s; fill(u, pm, pn, s >> 1, s & 1); return true; }
        const int i0 = (T.nwg - T.c + T.G - 1) / T.G; const int jj = i - 8 * i0; const int job = (jj >> 1) * T.G + T.c; if (job >= 32) return false;
        const int tile = job >> 2, b = job & 3; u.kind = 8 + 2 * b + (jj & 1); fill(u, 128 + (tile >> 2), tile & 3, b, jj & 1); return true;
    }
};
struct EpiMerge {
    unsigned char* ws; const float* bgate; const float* rs1;
    DEV void operator()(const AccT& acc, const GUnit& u, int wr, int wc, int fr, int fq) const {
        u32x4* sT = (u32x4*)(ws + W_SCR) + (size_t)bid_o() * 16 * 512 + tid_o();
        u32x4* sS = (u32x4*)(ws + W_SCR + (size_t)32 * 1024 * 1024) + (size_t)bid_o() * 16 * 512 + tid_o();
        const int s = u.kind & 7, b = s >> 1; const bool smp = u.kind >= 8;
        if (!(s & 1)) {
#pragma unroll
            for (int q = 0; q < 16; ++q) { const int ai = q >> 3, bj = (q >> 2) & 1, m = q & 3; const u32x2 lo = pk4(acc[ai][bj][m][0]), hi = pk4(acc[ai][bj][m][1]);
                u32x4 w; w.x = lo.x; w.y = lo.y; w.z = hi.x; w.w = hi.y; sT[q * 512] = w; }
        } else {
            u16* MG = (u16*)(ws + W_MERGED);
            const int rowb = u.pm * 256 + wr * 64 + fr, cb = u.pn * 256 + wc * 32 + 4 * fq;
            f32x4 bvv[2][2];
#pragma unroll
            for (int bj = 0; bj < 2; ++bj)
#pragma unroll
                for (int n = 0; n < 2; ++n) bvv[bj][n] = *(const f32x4*)(bgate + b * 1024 + cb + bj * 128 + n * 16);
            float rsx[2][4];
            FOR_AM rsx[ai][m] = __builtin_amdgcn_rsqf(rs1[rowb + ai * 128 + m * 16] * (1.f / 1024.f) + EPS);
#pragma unroll
            for (int q = 0; q < 16; ++q) { const int ai = q >> 3, bj = (q >> 2) & 1, m = q & 3; __builtin_amdgcn_sched_barrier(0);
                const u32x4 tw = sT[q * 512]; u32x4 sw = (u32x4){0u, 0u, 0u, 0u}; if (b > 0 && !smp) sw = sS[q * 512];
                const unsigned tws[4] = {tw.x, tw.y, tw.z, tw.w}; const unsigned sws[4] = {sw.x, sw.y, sw.z, sw.w};
                f32x4 r[2];
#pragma unroll
                for (int n = 0; n < 2; ++n) { const f32x4 bv = bvv[bj][n];
                    f32x4 v = acc[ai][bj][m][n] * rsx[ai][m] + bv;
#pragma unroll
                    for (int e = 0; e < 4; ++e) { const unsigned tt = tws[n * 2 + (e >> 1)], st = sws[n * 2 + (e >> 1)];
                        const float tv = (e & 1) ? __uint_as_float(tt & 0xffff0000u) : __uint_as_float(tt << 16);
                        const float sv = (e & 1) ? __uint_as_float(st & 0xffff0000u) : __uint_as_float(st << 16);
                        v[e] = fsigmoid(v[e]) * tv + sv; }
                    r[n] = v; }
                if (smp) { float* mf = (float*)(ws + W_PART) + ((size_t)b * 512 + rowb + ai * 128 + m * 16 - MTP) * 1024 + cb + bj * 128;
#pragma unroll
                    for (int n = 0; n < 2; ++n) *(f32x4*)(mf + n * 16) = r[n]; }
                else if (b < 3) { const u32x2 lo = pk4(r[0]), hi = pk4(r[1]); u32x4 w; w.x = lo.x; w.y = lo.y; w.z = hi.x; w.w = hi.y; sS[q * 512] = w; }
                else { const int row = rowb + ai * 128 + m * 16;
#pragma unroll
                    for (int n = 0; n < 2; ++n) *(u32x2*)(MG + (size_t)row * 1024 + cb + bj * 128 + n * 16) = pk4(r[n]); } }
        }
    }
};

struct EpiRes {
    const float* xin;
    u16* xb;
    float* yout;
    float* rsacc;
    float* yfull;
    DEV void operator()(const AccT& acc, const GUnit& u, int wr, int wc, int fr, int fq) const {
        const int rowb = u.pm * 256 + wr * 64 + fr, cb = u.pn * 256 + wc * 32 + 4 * fq;
        if (u.kind >= 1) {
            float* pp = yfull + ((size_t)(u.kind - 1) * 512) * 1024;
            FOR_AM { const int row = rowb + ai * 128 + m * 16 - MTP; FOR_BN { *(f32x4*)(pp + (size_t)row * 1024 + cb + bj * 128 + n * 16) = acc[ai][bj][m][n]; } }
            return; }
        FOR_AM { const int row = rowb + ai * 128 + m * 16; float ss = 0.f;
            FOR_BN { const int col = cb + bj * 128 + n * 16; f32x4 x;
                if (xin) x = *(const f32x4*)(xin + (size_t)row * 1024 + col);
                else { const u32x2 xx = *(const u32x2*)(xb + (size_t)row * 1024 + col);
                    x[0] = __uint_as_float(xx.x << 16); x[1] = __uint_as_float(xx.x & 0xffff0000u); x[2] = __uint_as_float(xx.y << 16); x[3] = __uint_as_float(xx.y & 0xffff0000u); }
                const f32x4 v = x + acc[ai][bj][m][n];
                if (yout) *(f32x4*)(yout + (size_t)row * 1024 + col) = v; else *(u32x2*)(xb + (size_t)row * 1024 + col) = pk4(v);
                ss += v[0] * v[0] + v[1] * v[1] + v[2] * v[2] + v[3] * v[3]; }
            if (rsacc) { ss = red_fq(ss); if (fq == 0) atomicAdd(rsacc + row, ss); } }
    }
};

DEV float dpp_prev1(float cur, float prevm) {
    const int o = __builtin_amdgcn_update_dpp(0, __float_as_int(prevm), 0x121, 0xf, 0xf, false);
    return __int_as_float(__builtin_amdgcn_update_dpp(o, __float_as_int(cur), 0x111, 0xf, 0xf, false));
}
DEV float dpp_prev2(float cur, float prevm) {
    const int o = __builtin_amdgcn_update_dpp(0, __float_as_int(prevm), 0x122, 0xf, 0xf, false);
    return __int_as_float(__builtin_amdgcn_update_dpp(o, __float_as_int(cur), 0x112, 0xf, 0xf, false));
}
struct EpiUp {
    unsigned char* ws; const float* cw; const float* cbias; const float* rs2;
    DEV void operator()(const AccT& acc, const GUnit& u, int wr, int wc, int fr, int fq) const {
        u16* ACT = (u16*)(ws + W_ACT); float* HEAD = (float*)(ws + W_HEAD); float* TAIL = (float*)(ws + W_TAIL);
        float rsx[2][4];
        FOR_AM rsx[ai][m] = __builtin_amdgcn_rsqf(rs2[u.pm * 256 + wr * 64 + fr + ai * 128 + m * 16] * (1.f / 1024.f) + EPS);
        const int f0 = u.pn * 128 + wc * 32 + 4 * fq;
#pragma unroll
        for (int n = 0; n < 2; ++n) { const int f = f0 + n * 16;
            f32x4 w0[2], w1[2], w2[2], bb[2];
#pragma unroll
            for (int bj = 0; bj < 2; ++bj) { const int ff = bj * 2816 + f; w0[bj] = *(const f32x4*)(cw + ff); w1[bj] = *(const f32x4*)(cw + 5632 + ff); w2[bj] = *(const f32x4*)(cw + 11264 + ff); bb[bj] = *(const f32x4*)(cbias + ff); }
#pragma unroll
            for (int ai = 0; ai < 2; ++ai) {
                const int slab = u.pm * 4 + ai * 2 + wr;
#pragma unroll
                for (int m = 0; m < 4; ++m) {
                    f32x4 c[2];
#pragma unroll
                    for (int bj = 0; bj < 2; ++bj) { const f32x4 cur = acc[ai][bj][m][n] * rsx[ai][m]; const f32x4 pm_ = acc[ai][bj][m ? m - 1 : 0][n] * rsx[ai][m ? m - 1 : 0];
#pragma unroll
                        for (int e = 0; e < 4; ++e) { const float p1 = dpp_prev1(cur[e], pm_[e]), p2 = dpp_prev2(cur[e], pm_[e]);
                            c[bj][e] = bb[bj][e] + w2[bj][e] * cur[e] + w1[bj][e] * p1 + w0[bj][e] * p2; } }
                    if (m > 0 || fr >= 2) { f32x4 a; for (int e = 0; e < 4; ++e) a[e] = fsilu(c[0][e]) * c[1][e];
                        *(u32x2*)(ACT + (size_t)(slab * 64 + m * 16 + fr) * 2816 + f) = pk4(a); }
                    if (m == 0 && fr < 2) { for (int bj = 0; bj < 2; ++bj) *(f32x4*)(HEAD + ((size_t)slab * 2 + fr) * 5632 + bj * 2816 + f) = acc[ai][bj][0][n] * rsx[ai][0]; }
                    if (m == 3 && fr >= 14) { for (int bj = 0; bj < 2; ++bj) *(f32x4*)(TAIL + ((size_t)slab * 2 + fr - 14) * 5632 + bj * 2816 + f) = acc[ai][bj][3][n] * rsx[ai][3]; }
                } } }
    }
};

template <int MAP> DEV int src_col(int j) {
    if (MAP == 0) return j;
    if (MAP == 1) {
        const int tile = j >> 8, tc = j & 255;
        if (tile < 10) return j;
        if (tile < 12) return j + 16;
        if (tile < 16) { const int perm = ((tc >> 5) & 3) * 64 + (tc >> 7) * 32 + (tc & 31); return (tile < 14 ? 3088 : 3600) + (tile & 1) * 256 + perm; }
        if (tile < 18) return j + 16;
        if (tile == 18) return tc < 16 ? 2560 + tc : -1;
        return 4624 + (j - GATE0);
    }
    { const int q = j >> 8, tc = j & 255; return tc < 128 ? 128 * q + tc : 2816 + 128 * q + (tc - 128); }
}
template <int MAP> DEV void conv_T(u16* dst, int dst_ld, int K, int Nd, const float* src, int src_ld, int gt, int GT, const float* gain = nullptr) {
    const int total = Nd * (K >> 3);
    for (int idx = gt; idx < total; idx += GT) { const int j = idx % Nd, kb = idx / Nd; const int sc = src_col<MAP>(j);
        float v[8];
#pragma unroll
        for (int i = 0; i < 8; ++i) v[i] = sc >= 0 ? src[(size_t)(kb * 8 + i) * src_ld + sc] : 0.f;
        if (gain) {
#pragma unroll
            for (int i = 0; i < 8; ++i) v[i] *= gain[kb * 8 + i]; }
        u32x4 w; w.x = pk2(v[0], v[1]); w.y = pk2(v[2], v[3]); w.z = pk2(v[4], v[5]); w.w = pk2(v[6], v[7]);
        *(u32x4*)(dst + (size_t)j * dst_ld + kb * 8) = w; }
}
DEV void raw_rows(const float* xp, const float* xs, int r0, int r1, u16* XB, float* RS) {
    const int tid = tid_o(); const int lane = tid & 63; const int gw = bid_o() * 8 + (tid >> 6), GW = gridDim.x * 8;
    for (int row = r0 + gw; row < r1; row += GW) {
        const float* src = row < MTP ? xp + (size_t)row * 1024 : xs + (size_t)(row - MTP) * 1024;
        f32x4 v[4]; float ss = 0.f;
#pragma unroll
        for (int i = 0; i < 4; ++i) { v[i] = *(const f32x4*)(src + (lane + 64 * i) * 4); ss += v[i][0] * v[i][0] + v[i][1] * v[i][1] + v[i][2] * v[i][2] + v[i][3] * v[i][3]; }
        ss = wave_sum(ss); if (lane == 0) RS[row] = ss;
#pragma unroll
        for (int i = 0; i < 4; ++i) *(u32x2*)(XB + (size_t)row * 1024 + (lane + 64 * i) * 4) = pk4(v[i]);
    }
}

DEV void sample_rows_reduce(float* xs, const float* part, int npart, u16* XBs, float* RSs) {
    const int tid = tid_o(); const int lane = tid & 63; const int gw = bid_o() * 8 + (tid >> 6), GW = gridDim.x * 8;
    for (int r = gw; r < 512; r += GW) {
        float* src = xs + (size_t)r * 1024; f32x4 v[4];
#pragma unroll
        for (int i = 0; i < 4; ++i) v[i] = *(const f32x4*)(src + (lane + 64 * i) * 4);
        for (int k = 0; k < npart; ++k) { const float* pp = part + ((size_t)k * 512 + r) * 1024;
#pragma unroll
            for (int i = 0; i < 4; ++i) v[i] += *(const f32x4*)(pp + (lane + 64 * i) * 4); }
        float ss = 0.f;
#pragma unroll
        for (int i = 0; i < 4; ++i) { *(f32x4*)(src + (lane + 64 * i) * 4) = v[i]; ss += v[i][0] * v[i][0] + v[i][1] * v[i][1] + v[i][2] * v[i][2] + v[i][3] * v[i][3]; }
        ss = wave_sum(ss); if (lane == 0) RSs[r] = ss;
#pragma unroll
        for (int i = 0; i < 4; ++i) *(u32x2*)(XBs + (size_t)r * 1024 + (lane + 64 * i) * 4) = pk4(v[i]);
    }
}
DEV void phaseA(CP& p, int l) {
    unsigned char* ws = p.ws;
    const int gt = bid_o() * 512 + tid_o(), GT = gridDim.x * 512;
    conv_T<1>((u16*)(ws + W_WIN), 1024, 1024, NINP, p.in[9] + (size_t)l * 1024 * 8720, 8720, gt, GT, p.in[8] + l * 1024);
    for (int b = 0; b < 4; ++b) conv_T<0>((u16*)(ws + W_WBR) + (size_t)(b >> 1) * 1024 * 1024 + (b & 1) * 512, 1024, 512, 1024, p.in[31] + (size_t)(l * 4 + b) * 512 * 1024, 1024, gt, GT);
    conv_T<0>((u16*)(ws + W_WOUT), 1024, 1024, 1024, p.in[32] + (size_t)l * 1024 * 1024, 1024, gt, GT);
    conv_T<0>((u16*)(ws + W_WGLU), 512, 512, 512, p.in[22] + (size_t)l * 512 * 512, 512, gt, GT);
    conv_T<2>((u16*)(ws + W_WUP), 1024, 1024, 5632, p.in[34] + (size_t)l * 1024 * 5632, 5632, gt, GT, p.in[33] + l * 1024);
    conv_T<0>((u16*)(ws + W_WDN), 2816, 2816, 1024, p.in[37] + (size_t)l * 2816 * 1024, 1024, gt, GT);
    for (int b = 0; b < 8; ++b) conv_T<0>((u16*)(ws + W_DVTS) + (size_t)b * 512 * 4160, 4160, 4096, 512, p.in[3] + ((size_t)(l * 8 + b) * 4096) * 512, 512, gt, GT);
    {
        const float* ck = p.in[2] + (size_t)l * 8 * 4096 * 512; u16* dk = (u16*)(ws + W_DKS);
        for (int idx = gt; idx < 8 * 4096 * 64; idx += GT) { const int b = idx >> 18, rem = idx & 262143, key = rem >> 6, c8 = (rem & 63) * 8;
            const f32x4 a = *(const f32x4*)(ck + ((size_t)(b * 4096 + key)) * 512 + c8), c = *(const f32x4*)(ck + ((size_t)(b * 4096 + key)) * 512 + c8 + 4);
            u32x4 w; w.x = pk2(a[0], a[1]); w.y = pk2(a[2], a[3]); w.z = pk2(c[0], c[1]); w.w = pk2(c[2], c[3]);
            *(u32x4*)(dk + ((size_t)b * 4160 + key) * 512 + c8) = w; }
    }
    { float* rq = (float*)(ws + W_ROWSQ); for (int i = gt; i < MT; i += GT) rq[i] = 0.f; }
    { const float* wsp = p.in[12] + (size_t)l * 4 * 128 * 128; u16* wm = (u16*)(ws + W_WM); for (int i = gt; i < 4 * 128 * 128; i += GT) { const int t = (i >> 7) & 127, s2 = i & 127; wm[i] = f2bf(s2 <= t ? wsp[i] : 0.f); } }
    if (l == 0) { const f32x4* xs = (const f32x4*)p.in[1]; f32x4* xo = (f32x4*)(p.out + (size_t)MTP * 1024); for (int i = gt; i < 512 * 256; i += GT) xo[i] = xs[i]; }
    if (gt < 64) {
        unsigned* misc = (unsigned*)(ws + W_MISC);
        const float* dl = p.in[29] + l * 256;
        const float s1 = wave_sum(dl[gt] * dl[64 + gt]), s2 = wave_sum(dl[128 + gt] * dl[192 + gt]);
        float mq = fabsf(p.in[27][l * 64 + gt]), mk = fabsf(p.in[28][l * 64 + gt]);
        for (int o = 32; o; o >>= 1) { mq = fmaxf(mq, __shfl_xor(mq, o)); mk = fmaxf(mk, __shfl_xor(mk, o)); }
        if (gt == 0) { misc[l] = 0u;
            const float lam_init = 0.8f - 0.6f * expf(-0.3f * (float)l);
            ((float*)misc)[8 + 2 * l] = expf(s1) - expf(s2) + lam_init; ((float*)misc)[9 + 2 * l] = lam_init;
            ((float*)misc)[16 + l] = 64.f * mq * mk * 0.125f * LOG2E; }
    }
    { float* RS = (float*)(ws + W_RS);
      for (int i = gt; i < MT; i += GT) { RS[(size_t)(l * 2 + 1) * MT + i] = 0.f; if (l == 0) RS[(size_t)2 * MT + i] = 0.f; }
      if (l == 0) raw_rows(p.in[0], p.in[1], 0, MT, (u16*)(ws + W_H), RS);
      else sample_rows_reduce(p.out + (size_t)MTP * 1024, (const float*)(ws + W_PART), 11, (u16*)(ws + W_H) + (size_t)MTP * 1024, RS + (size_t)2 * MT + MTP); }
}

DEV void attn_item(CP& p, int l, LAS unsigned char* lds, int grp, int b, int h, int qp) {
    unsigned char* ws = p.ws;
    const int tid = tid_o(), w = tid >> 6, lane = tid & 63, fr = lane & 15, fq = lane >> 4, c = w >> 2, qs = w & 3;
    const int Tk = grp ? 4160 : 2048, nkv = grp ? 65 : 2 * qp + 2;
    const int nact = grp ? (qs < 2 ? 65 : 0) : (qs < 2 ? nkv - 1 : nkv);
    const int rowbase = grp ? MTP + b * 64 : b * 2048 + qp * 128;
    const u16* Kb = grp ? (const u16*)(ws + W_DKS) + (size_t)b * 4160 * 512 : (const u16*)(ws + W_DKP) + (size_t)b * 2048 * 512;
    const u16* Vb = grp ? (const u16*)(ws + W_DVTS) + ((size_t)b * 512 + h * 128) * 4160 : (const u16*)(ws + W_DVTP) + ((size_t)b * 512 + h * 128) * 2048;
    u16* P2 = (u16*)(ws + W_P2);
    bf16x8 qf[2][2];
    if (nact > 0) {
#pragma unroll
        for (int r = 0; r < 2; ++r)
#pragma unroll
            for (int kk = 0; kk < 2; ++kk) qf[r][kk] = *(const bf16x8*)(P2 + (size_t)(rowbase + 32 * qs + 16 * r + fr) * 1024 + 512 + h * 128 + c * 64 + kk * 32 + fq * 8);
    } else {
#pragma unroll
        for (int r = 0; r < 2; ++r)
#pragma unroll
            for (int kk = 0; kk < 2; ++kk) qf[r][kk] = (bf16x8){0, 0, 0, 0, 0, 0, 0, 0};
    }
    constexpr int STG = 36864;
    int gK[2], lK[2], gV[2], lV[2];
#pragma unroll
    for (int i = 0; i < 2; ++i) { const int ch = tid + 512 * i; const int key = ch >> 4, part = ch & 15; gK[i] = key * 512 + h * 128 + part * 8; lK[i] = (((part >> 3) * 64 + key) * 72 + (part & 7) * 8) * 2;
        const int v = ch >> 3, kp = (ch & 7) * 8; gV[i] = v * Tk + kp; lV[i] = (128 * 72 + v * 72 + kp) * 2; }
    u32x4 rk[2], rv[2];
#pragma unroll
    for (int i = 0; i < 2; ++i) { rk[i] = *(const u32x4*)(Kb + gK[i]); rv[i] = *(const u32x4*)(Vb + gV[i]); }
#pragma unroll
    for (int i = 0; i < 2; ++i) { *(LAS u32x4*)(lds + lK[i]) = rk[i]; *(LAS u32x4*)(lds + lV[i]) = rv[i]; }
    __syncthreads();
    f32x4 O[2][8];
#pragma unroll
    for (int r = 0; r < 2; ++r)
#pragma unroll
        for (int i = 0; i < 8; ++i) O[r][i] = (f32x4){0.f, 0.f, 0.f, 0.f};
    const bool fixedref = ((const float*)(ws + W_MISC))[16 + l] < 40.f;
    float mrun[2] = {-1e30f, -1e30f}, lrun[2] = {0.f, 0.f};
    for (int kt = 0; kt < nkv; ++kt) {
        const bool more = kt + 1 < nkv;
        if (more) { const size_t k0 = (size_t)(kt + 1) * 64;
#pragma unroll
            for (int i = 0; i < 2; ++i) { rk[i] = *(const u32x4*)(Kb + k0 * 512 + gK[i]); rv[i] = *(const u32x4*)(Vb + k0 + gV[i]); } }
        if (kt < nact) {
            LAS unsigned char* st = lds + (kt & 1) * STG;
            f32x4 s[2][4];
#pragma unroll
            for (int jt = 0; jt < 4; ++jt) { s[0][jt] = (f32x4){0.f, 0.f, 0.f, 0.f}; s[1][jt] = (f32x4){0.f, 0.f, 0.f, 0.f};
#pragma unroll
                for (int kk = 0; kk < 2; ++kk) { const bf16x8 kf = *(const LAS bf16x8*)(st + ((c * 64 + 16 * jt + fr) * 72 + kk * 32 + fq * 8) * 2);
                    s[0][jt] = mfma16(kf, qf[0][kk], s[0][jt]); s[1][jt] = mfma16(kf, qf[1][kk], s[1][jt]); } }
            bf16x8 pf[2][2];
#pragma unroll
            for (int r = 0; r < 2; ++r) {
                float ps = 0.f;
                if (fixedref) {
#pragma unroll
                    for (int jt = 0; jt < 4; ++jt)
#pragma unroll
                        for (int e = 0; e < 4; ++e) { s[r][jt][e] = __builtin_amdgcn_exp2f(s[r][jt][e]); ps += s[r][jt][e]; }
                    lrun[r] += ps;
                } else {
                    float mt = s[r][0][0];
#pragma unroll
                    for (int jt = 0; jt < 4; ++jt)
#pragma unroll
                        for (int e = 0; e < 4; ++e) mt = fmaxf(mt, s[r][jt][e]);
                    mt = fmaxf(mt, __shfl_xor(mt, 16)); mt = fmaxf(mt, __shfl_xor(mt, 32));
                    const float mnew = fmaxf(mrun[r], mt), alpha = __builtin_amdgcn_exp2f(mrun[r] - mnew); mrun[r] = mnew;
#pragma unroll
                    for (int jt = 0; jt < 4; ++jt)
#pragma unroll
                        for (int e = 0; e < 4; ++e) { s[r][jt][e] = __builtin_amdgcn_exp2f(s[r][jt][e] - mnew); ps += s[r][jt][e]; }
                    lrun[r] = lrun[r] * alpha + ps;
#pragma unroll
                    for (int i = 0; i < 8; ++i) O[r][i] *= alpha;
                }
#pragma unroll
                for (int t = 0; t < 2; ++t) { const u32x2 lo = pk4(s[r][2 * t]), hi = pk4(s[r][2 * t + 1]); u32x4 wv; wv.x = lo.x; wv.y = lo.y; wv.z = hi.x; wv.w = hi.y; pf[r][t] = __builtin_bit_cast(bf16x8, wv); }
            }
#pragma unroll
            for (int vt = 0; vt < 8; ++vt)
#pragma unroll
                for (int t = 0; t < 2; ++t) { const LAS unsigned char* vp = st + (128 * 72 + (16 * vt + fr) * 72 + 32 * t + 4 * fq) * 2;
                    const u32x2 a = *(const LAS u32x2*)vp, bq = *(const LAS u32x2*)(vp + 32); u32x4 wv; wv.x = a.x; wv.y = a.y; wv.z = bq.x; wv.w = bq.y;
                    const bf16x8 vf = __builtin_bit_cast(bf16x8, wv);
                    O[0][vt] = mfma16(vf, pf[0][t], O[0][vt]); O[1][vt] = mfma16(vf, pf[1][t], O[1][vt]); }
        }
        if (more) { LAS unsigned char* nx = lds + ((kt + 1) & 1) * STG;
#pragma unroll
            for (int i = 0; i < 2; ++i) { *(LAS u32x4*)(nx + lK[i]) = rk[i]; *(LAS u32x4*)(nx + lV[i]) = rv[i]; } }
        __syncthreads();
    }
    const float lam = ((const float*)(ws + W_MISC))[8 + 2 * l], lam_init = ((const float*)(ws + W_MISC))[9 + 2 * l];
    LAS float* X = (LAS float*)lds;
    float inv[2];
#pragma unroll
    for (int r = 0; r < 2; ++r) inv[r] = __builtin_amdgcn_rcpf(fmaxf(red_fq(lrun[r]), 1e-30f));
    if (c == 1) {
#pragma unroll
        for (int r = 0; r < 2; ++r)
#pragma unroll
            for (int vt = 0; vt < 8; ++vt)
#pragma unroll
                for (int e = 0; e < 4; ++e) X[(qs * 64 + r * 32 + vt * 4 + e) * 64 + lane] = O[r][vt][e] * inv[r] * lam;
    }
    __syncthreads();
    if (c == 0 && nact > 0) {
        const float* g = p.in[30] + l * 128;
#pragma unroll
        for (int r = 0; r < 2; ++r) { float ss = 0.f;
#pragma unroll
            for (int vt = 0; vt < 8; ++vt)
#pragma unroll
                for (int e = 0; e < 4; ++e) { const float d = O[r][vt][e] * inv[r] - X[(qs * 64 + r * 32 + vt * 4 + e) * 64 + lane]; O[r][vt][e] = d; ss += d * d; }
            ss = red_fq(ss); const float rs = __builtin_amdgcn_rsqf(ss * (1.f / 128.f) + EPS) * (1.f - lam_init);
#pragma unroll
            for (int vt = 0; vt < 8; ++vt) { const f32x4 gv = *(const f32x4*)(g + 16 * vt + 4 * fq);
                *(u32x2*)(P2 + (size_t)(rowbase + 32 * qs + 16 * r + fr) * 1024 + 512 + h * 128 + 16 * vt + 4 * fq) = pk4(O[r][vt] * rs * gv); } }
    }
    __syncthreads();
}

DEV void gla_item(CP& p, int l, LAS unsigned char* lds, int grp, int b, int h) {
    unsigned char* ws = p.ws;
    const int tid = tid_o(), w = tid >> 6, lane = tid & 63, fr = lane & 15, fq = lane >> 4;
    const int T = grp ? 64 : 2048, nch = grp ? 1 : 32; const int rowbase = grp ? MTP + b * 64 : b * 2048;
    const u16* CQ = (const u16*)(ws + W_CQ); const u16* CK = (const u16*)(ws + W_CK); const float* CODE = (const float*)(ws + W_CODE);
    const u16* VT = (const u16*)(ws + W_CVT) + (grp ? (size_t)16 * 512 * 2048 : 0) + ((size_t)b * 512 + h * 128) * T;
    u16* P2 = (u16*)(ws + W_P2);
    LAS u16* QE = (LAS u16*)lds; LAS u16* KE = QE + 64 * 72; LAS u16* KDT = KE + 64 * 72; LAS u16* VTl = KDT + 64 * 72;
    LAS u16* PP = VTl + 128 * 72; LAS u16* STb = PP + 64 * 72;
    LAS float* OT = (LAS float*)(STb + 8 * 16 * 72); LAS float* SEG = OT + 64 * 132; LAS float* DEC = SEG + 8 * 64;
    LAS u16* QR = (LAS u16*)(DEC + 64); LAS u16* KR = QR + 64 * 72; LAS float* CD = (LAS float*)(KR + 64 * 72);
    const int d_ = tid & 63, seg = tid >> 6;
    float wa[16];
#pragma unroll
    for (int r = 0; r < 16; ++r) wa[r] = p.in[24][(size_t)l * 16 * 256 + r * 256 + h * 64 + d_];
    const float ba = p.in[25][l * 256 + h * 64 + d_];
    f32x4 S[4];
    if (grp) { const float* s0 = p.in[6] + ((size_t)(l * 8 + b) * 4 + h) * 64 * 128;
#pragma unroll
        for (int dt = 0; dt < 4; ++dt) S[dt] = *(const f32x4*)(s0 + (size_t)(16 * dt + fr) * 128 + 16 * w + 4 * fq); }
    else {
#pragma unroll
        for (int dt = 0; dt < 4; ++dt) S[dt] = (f32x4){0.f, 0.f, 0.f, 0.f}; }
#pragma unroll
    for (int dt = 0; dt < 4; ++dt)
#pragma unroll
        for (int e = 0; e < 4; ++e) STb[(w * 16 + 4 * fq + e) * 72 + 16 * dt + fr] = f2bf(S[dt][e]);
    const float* gng = p.in[26] + l * 128;
    const int tl = tid >> 3, d8 = (tid & 7) * 8;
    u32x4 rq, rkk, rvv[2]; f32x2 rcd;
    {
        rq = *(const u32x4*)(CQ + (size_t)(rowbase + tl) * 256 + h * 64 + d8); rkk = *(const u32x4*)(CK + (size_t)(rowbase + tl) * 256 + h * 64 + d8);
        rcd = *(const f32x2*)(CODE + (size_t)(rowbase + tl) * 16 + (tid & 7) * 2);
#pragma unroll
        for (int i = 0; i < 2; ++i) { const int chn = tid + 512 * i, v = chn >> 3, kp = (chn & 7) * 8; rvv[i] = *(const u32x4*)(VT + (size_t)v * T + kp); }
    }
    for (int ch = 0; ch < nch; ++ch) {
        const int r0 = rowbase + ch * 64;
        *(LAS u32x4*)(QR + tl * 72 + d8) = rq; *(LAS u32x4*)(KR + tl * 72 + d8) = rkk; *(LAS f32x2*)(CD + tl * 16 + (tid & 7) * 2) = rcd;
#pragma unroll
        for (int i = 0; i < 2; ++i) { const int chn = tid + 512 * i, v = chn >> 3, kp = (chn & 7) * 8; *(LAS u32x4*)(VTl + v * 72 + kp) = rvv[i]; }
        if (ch + 1 < nch) { const int r1 = r0 + 64;
            rq = *(const u32x4*)(CQ + (size_t)(r1 + tl) * 256 + h * 64 + d8); rkk = *(const u32x4*)(CK + (size_t)(r1 + tl) * 256 + h * 64 + d8);
            rcd = *(const f32x2*)(CODE + (size_t)(r1 + tl) * 16 + (tid & 7) * 2);
#pragma unroll
            for (int i = 0; i < 2; ++i) { const int chn = tid + 512 * i, v = chn >> 3, kp = (chn & 7) * 8; rvv[i] = *(const u32x4*)(VT + (size_t)v * T + (ch + 1) * 64 + kp); } }
        u16* yp = P2 + (size_t)(r0 + tl) * 1024 + h * 128 + (tid & 7) * 16;
        const u32x4 rr0 = *(const u32x4*)yp, rr1 = *(const u32x4*)(yp + 8);
        __syncthreads();
        float bl[8]; float run = 0.f;
#pragma unroll
        for (int i = 0; i < 8; ++i) { const LAS float* cp = CD + (seg * 8 + i) * 16; float a = ba;
#pragma unroll
            for (int r = 0; r < 16; ++r) a += cp[r] * wa[r];
            run += flogsig(a) * (1.f / 16.f); bl[i] = run; }
        SEG[seg * 64 + d_] = run;
        __syncthreads();
        float off = 0.f, tot = 0.f;
#pragma unroll
        for (int s2 = 0; s2 < 8; ++s2) { const float x = SEG[s2 * 64 + d_]; tot += x; if (s2 < seg) off += x; }
        if (seg == 0) DEC[d_] = __expf(tot);
        { float kd[8];
#pragma unroll
          for (int i = 0; i < 8; ++i) { const int t = seg * 8 + i; const float bb = bl[i] + off;
              const float q = bf2f(QR[t * 72 + d_]), k = bf2f(KR[t * 72 + d_]);
              QE[t * 72 + d_] = f2bf(q * __expf(bb)); KE[t * 72 + d_] = f2bf(k * __expf(-bb)); kd[i] = k * __expf(tot - bb); }
          u32x4 wv; wv.x = pk2(kd[0], kd[1]); wv.y = pk2(kd[2], kd[3]); wv.z = pk2(kd[4], kd[5]); wv.w = pk2(kd[6], kd[7]);
          *(LAS u32x4*)(KDT + d_ * 72 + seg * 8) = wv; }
        __syncthreads();
#pragma unroll
        for (int r = 0; r < 2; ++r) { const int ti = w + 8 * r, jt = ti >> 2, it = ti & 3; f32x4 a = (f32x4){0.f, 0.f, 0.f, 0.f};
            if (jt <= it) {
#pragma unroll
                for (int kk = 0; kk < 2; ++kk) { const bf16x8 kf = *(const LAS bf16x8*)(KE + (16 * jt + fr) * 72 + kk * 32 + fq * 8), qf = *(const LAS bf16x8*)(QE + (16 * it + fr) * 72 + kk * 32 + fq * 8); a = mfma16(kf, qf, a); }
#pragma unroll
                for (int e = 0; e < 4; ++e) if (16 * jt + 4 * fq + e > 16 * it + fr) a[e] = 0.f;
            }
            *(LAS u32x2*)(PP + (16 * it + fr) * 72 + 16 * jt + 4 * fq) = pk4(a); }
        __syncthreads();
        bf16x8 vf[2], sf[2];
#pragma unroll
        for (int t = 0; t < 2; ++t) { vf[t] = *(const LAS bf16x8*)(VTl + (16 * w + fr) * 72 + 32 * t + 8 * fq); sf[t] = *(const LAS bf16x8*)(STb + (w * 16 + fr) * 72 + 32 * t + 8 * fq); }
#pragma unroll
        for (int it = 0; it < 4; ++it) { f32x4 a = (f32x4){0.f, 0.f, 0.f, 0.f};
#pragma unroll
            for (int t = 0; t < 2; ++t) { const bf16x8 pf = *(const LAS bf16x8*)(PP + (16 * it + fr) * 72 + 32 * t + 8 * fq), qf = *(const LAS bf16x8*)(QE + (16 * it + fr) * 72 + 32 * t + 8 * fq);
                a = mfma16(vf[t], pf, a); a = mfma16(sf[t], qf, a); }
            *(LAS f32x4*)(OT + (16 * it + fr) * 132 + 16 * w + 4 * fq) = a; }
#pragma unroll
        for (int dt = 0; dt < 4; ++dt) { S[dt] *= DEC[16 * dt + fr];
#pragma unroll
            for (int t = 0; t < 2; ++t) { const bf16x8 kf = *(const LAS bf16x8*)(KDT + (16 * dt + fr) * 72 + 32 * t + 8 * fq); S[dt] = mfma16(vf[t], kf, S[dt]); }
#pragma unroll
            for (int e = 0; e < 4; ++e) STb[(w * 16 + 4 * fq + e) * 72 + 16 * dt + fr] = f2bf(S[dt][e]); }
        __syncthreads();
        {
            const int i = tid >> 3, vs = tid & 7; f32x4 o[4]; float ss = 0.f;
#pragma unroll
            for (int k = 0; k < 4; ++k) { o[k] = *(const LAS f32x4*)(OT + i * 132 + vs * 16 + 4 * k); ss += o[k][0] * o[k][0] + o[k][1] * o[k][1] + o[k][2] * o[k][2] + o[k][3] * o[k][3]; }
            ss += __shfl_xor(ss, 1); ss += __shfl_xor(ss, 2); ss += __shfl_xor(ss, 4);
            const float rs = __builtin_amdgcn_rsqf(ss * (1.f / 128.f) + EPS);
            const unsigned rw[8] = {rr0.x, rr0.y, rr0.z, rr0.w, rr1.x, rr1.y, rr1.z, rr1.w};
#pragma unroll
            for (int k = 0; k < 4; ++k) { const f32x4 gv = *(const f32x4*)(gng + vs * 16 + 4 * k);
                f32x4 r; r[0] = __uint_as_float(rw[2 * k] << 16); r[1] = __uint_as_float(rw[2 * k] & 0xffff0000u); r[2] = __uint_as_float(rw[2 * k + 1] << 16); r[3] = __uint_as_float(rw[2 * k + 1] & 0xffff0000u);
                *(u32x2*)(yp + 4 * k) = pk4(o[k] * rs * gv * r); }
        }
    }
    float* so = p.out + (grp ? O_GLAS + (size_t)l * 262144 + ((size_t)b * 4 + h) * 8192 : O_GLAP + (size_t)l * 524288 + ((size_t)b * 4 + h) * 8192);
#pragma unroll
    for (int dt = 0; dt < 4; ++dt) *(f32x4*)(so + (size_t)(16 * dt + fr) * 128 + 16 * w + 4 * fq) = S[dt];
    __syncthreads();
}

DEV void s5_item(CP& p, int l, LAS unsigned char* lds, int grp, int b, int gq) {
    unsigned char* ws = p.ws;
    const int tid = tid_o(), w = tid >> 6, lane = tid & 63, fr = lane & 15, fq = lane >> 4;
    const int g = gq * 8 + w; const int T = grp ? 64 : 2048; const int rowbase = grp ? MTP + b * 64 : b * 2048;
    u16* X = (u16*)(ws + W_S5);
    LAS u16* HT = (LAS u16*)lds + w * 32 * 136;
    const float dt = __expf(p.in[16][l * 32 + g]);
    bf16x8 breF[4], bimF[4]; float ar[4], ai[4], a8r[4], a8i[4];
#pragma unroll
    for (int pt = 0; pt < 4; ++pt) { const int pp = 16 * pt + fr; const size_t gp = (size_t)(l * 32 + g) * 64 + pp;
        const float lr = p.in[14][gp], li = p.in[15][gp];
        const float mag = __expf(lr * dt), ang = li * dt * 0.15915494309189535f;
        const float r_ = mag * __builtin_amdgcn_cosf(ang), i_ = mag * __builtin_amdgcn_sinf(ang);
        ar[pt] = r_; ai[pt] = i_;
        float xr = r_, xi = i_;
#pragma unroll
        for (int k = 0; k < 3; ++k) { const float nr2 = xr * xr - xi * xi, ni2 = 2.f * xr * xi; xr = nr2; xi = ni2; }
        a8r[pt] = xr; a8i[pt] = xi;
        const float den = lr * lr + li * li, nr = r_ - 1.f, ni = i_;
        const float kr = (nr * lr + ni * li) / den, ki = (ni * lr - nr * li) / den;
        float vr[8], vi[8];
#pragma unroll
        for (int j = 0; j < 8; ++j) { float br = 0.f, bi = 0.f; if (fq < 2) { br = p.in[17][gp * 16 + fq * 8 + j]; bi = p.in[18][gp * 16 + fq * 8 + j]; }
            vr[j] = kr * br - ki * bi; vi[j] = kr * bi + ki * br; }
        u32x4 wr_, wi_; wr_.x = pk2(vr[0], vr[1]); wr_.y = pk2(vr[2], vr[3]); wr_.z = pk2(vr[4], vr[5]); wr_.w = pk2(vr[6], vr[7]);
        wi_.x = pk2(vi[0], vi[1]); wi_.y = pk2(vi[2], vi[3]); wi_.z = pk2(vi[4], vi[5]); wi_.w = pk2(vi[6], vi[7]);
        breF[pt] = __builtin_bit_cast(bf16x8, wr_); bimF[pt] = __builtin_bit_cast(bf16x8, wi_); }
    bf16x8 cF[4];
#pragma unroll
    for (int ks = 0; ks < 4; ++ks) { float v[8]; const int k0 = 32 * ks + 8 * fq;
#pragma unroll
        for (int j = 0; j < 8; ++j) { const int k = k0 + j; v[j] = k < 64 ? p.in[19][((size_t)(l * 32 + g) * 16 + fr) * 64 + k] : -p.in[20][((size_t)(l * 32 + g) * 16 + fr) * 64 + k - 64]; }
        u32x4 wv; wv.x = pk2(v[0], v[1]); wv.y = pk2(v[2], v[3]); wv.z = pk2(v[4], v[5]); wv.w = pk2(v[6], v[7]); cF[ks] = __builtin_bit_cast(bf16x8, wv); }
    const f32x4 dsk = *(const f32x4*)(p.in[21] + l * 512 + g * 16 + 4 * fq);
    float Hr[4], Hi[4];
#pragma unroll
    for (int pt = 0; pt < 4; ++pt) { if (grp) { const size_t sp = ((size_t)(l * 8 + b) * 32 + g) * 64 + 16 * pt + fr; Hr[pt] = p.in[4][sp]; Hi[pt] = p.in[5][sp]; } else { Hr[pt] = 0.f; Hi[pt] = 0.f; } }
    const int trow = 8 * (fr >> 2) + (fr & 3);
    u32x4 xn[2];
#pragma unroll
    for (int tt = 0; tt < 2; ++tt) { xn[tt] = (u32x4){0u, 0u, 0u, 0u}; if (fq < 2) xn[tt] = *(const u32x4*)(X + (size_t)(rowbase + trow + 4 * tt) * 512 + g * 16 + fq * 8); }
    for (int ch = 0; ch < T / 32; ++ch) {
        const int r0 = rowbase + ch * 32;
        bf16x8 xF[2];
#pragma unroll
        for (int tt = 0; tt < 2; ++tt) xF[tt] = __builtin_bit_cast(bf16x8, xn[tt]);
        if (ch + 1 < T / 32) {
#pragma unroll
            for (int tt = 0; tt < 2; ++tt) if (fq < 2) xn[tt] = *(const u32x4*)(X + (size_t)(r0 + 32 + trow + 4 * tt) * 512 + g * 16 + fq * 8); }
        u32x2 xsk[2];
#pragma unroll
        for (int t2 = 0; t2 < 2; ++t2) xsk[t2] = *(const u32x2*)(X + (size_t)(r0 + 16 * t2 + fr) * 512 + g * 16 + 4 * fq);
        f32x4 bur[2][4], bui[2][4];
#pragma unroll
        for (int tt = 0; tt < 2; ++tt)
#pragma unroll
            for (int pt = 0; pt < 4; ++pt) { bur[tt][pt] = mfma16(xF[tt], breF[pt], (f32x4){0.f, 0.f, 0.f, 0.f}); bui[tt][pt] = mfma16(xF[tt], bimF[pt], (f32x4){0.f, 0.f, 0.f, 0.f}); }
#pragma unroll
        for (int pt = 0; pt < 4; ++pt) {
            float er = 0.f, ei = 0.f;
#pragma unroll
            for (int k = 0; k < 8; ++k) { const float ur = bur[k >> 2][pt][k & 3], ui = bui[k >> 2][pt][k & 3]; const float nr = ar[pt] * er - ai[pt] * ei + ur, ni = ar[pt] * ei + ai[pt] * er + ui; er = nr; ei = ni; }
            float cr = Hr[pt], ci = Hi[pt], mr = cr, mi = ci;
#pragma unroll
            for (int q = 0; q < 4; ++q) { const float Er = __shfl(er, fr + 16 * q), Ei = __shfl(ei, fr + 16 * q);
                const float nr = a8r[pt] * cr - a8i[pt] * ci + Er, ni = a8r[pt] * ci + a8i[pt] * cr + Ei; cr = nr; ci = ni;
                if (q + 1 == fq) { mr = cr; mi = ci; } }
            Hr[pt] = cr; Hi[pt] = ci;
            float hr = mr, hi = mi;
#pragma unroll
            for (int k = 0; k < 8; ++k) { const float ur = bur[k >> 2][pt][k & 3], ui = bui[k >> 2][pt][k & 3]; const float nr = ar[pt] * hr - ai[pt] * hi + ur, ni = ar[pt] * hi + ai[pt] * hr + ui; hr = nr; hi = ni;
                HT[(8 * fq + k) * 136 + 16 * pt + fr] = f2bf(hr); HT[(8 * fq + k) * 136 + 64 + 16 * pt + fr] = f2bf(hi); }
        }
        asm volatile("s_waitcnt lgkmcnt(0)" ::: "memory");
        f32x4 y[2];
#pragma unroll
        for (int t2 = 0; t2 < 2; ++t2) { y[t2] = (f32x4){0.f, 0.f, 0.f, 0.f};
#pragma unroll
            for (int ks = 0; ks < 4; ++ks) { const bf16x8 hf = *(const LAS bf16x8*)(HT + (16 * t2 + fr) * 136 + 32 * ks + 8 * fq); y[t2] = mfma16(cF[ks], hf, y[t2]); } }
#pragma unroll
        for (int t2 = 0; t2 < 2; ++t2) { u16* xp = X + (size_t)(r0 + 16 * t2 + fr) * 512 + g * 16 + 4 * fq; const u32x2 xx = xsk[t2];
            f32x4 xv; xv[0] = __uint_as_float(xx.x << 16); xv[1] = __uint_as_float(xx.x & 0xffff0000u); xv[2] = __uint_as_float(xx.y << 16); xv[3] = __uint_as_float(xx.y & 0xffff0000u);
            f32x4 z = y[t2] + dsk * xv;
#pragma unroll
            for (int e = 0; e < 4; ++e) z[e] = fgelu(z[e]);
            *(u32x2*)xp = pk4(z); }
        asm volatile("" ::: "memory");
    }
    if (fq == 0) { float* ore = p.out + (grp ? O_SRES + (size_t)l * 16384 + ((size_t)b * 32 + g) * 64 : O_SREP + (size_t)l * 32768 + ((size_t)b * 32 + g) * 64);
        float* oim = p.out + (grp ? O_SIMS + (size_t)l * 16384 + ((size_t)b * 32 + g) * 64 : O_SIMP + (size_t)l * 32768 + ((size_t)b * 32 + g) * 64);
#pragma unroll
        for (int pt = 0; pt < 4; ++pt) { ore[16 * pt + fr] = Hr[pt]; oim[16 * pt + fr] = Hi[pt]; } }
    __syncthreads();
}

DEV void gmlp_item(CP& p, int l, LAS unsigned char* lds, int grp, int b, int n, int g) {
    unsigned char* ws = p.ws;
    const int tid = tid_o(), w = tid >> 6, lane = tid & 63, fr = lane & 15, fq = lane >> 4;
    const int L = grp ? 64 : 128, T = grp ? 64 : 2048; const int rowbase = grp ? MTP + b * 64 : b * 2048 + n * 128;
    LAS u16* WT = (LAS u16*)lds; LAS u16* GT = WT + 128 * 136; LAS float* RS = (LAS float*)(GT + 128 * 136);
    const float* rowsq = (const float*)(ws + W_ROWSQ);
    if (tid < L) RS[tid] = __builtin_amdgcn_rsqf(rowsq[rowbase + tid] * (1.f / 512.f) + EPS);
    const u16* GV = (const u16*)(ws + W_GVT) + (grp ? (size_t)16 * 512 * 2048 : 0) + ((size_t)b * 512 + g * 128) * T + (grp ? 0 : n * 128);
    const u16* WM = (const u16*)(ws + W_WM) + (size_t)g * 128 * 128;
    const int cshift = grp ? 3 : 4, nchunk = 128 << cshift, nwch = L << cshift;
    u16* P1 = (u16*)(ws + W_P1);
    u32x4 gq[4], wq[4];
#pragma unroll
    for (int i = 0; i < 4; ++i) { const int chn = tid + 512 * i; const int cg_ = chn < nchunk ? chn : 0, cw_ = chn < nwch ? chn : 0;
        gq[i] = *(const u32x4*)(GV + (size_t)(cg_ >> cshift) * T + (cg_ & ((1 << cshift) - 1)) * 8);
        wq[i] = *(const u32x4*)(WM + (size_t)(cw_ >> cshift) * 128 + (cw_ & ((1 << cshift) - 1)) * 8); }
    u32x2 uq[8]; float bq[8];
    const int ntt = L >> 4;
#pragma unroll
    for (int tt = 0; tt < 8; ++tt) { const int t = tt < ntt ? 16 * tt + fr : fr; uq[tt] = *(const u32x2*)(P1 + (size_t)(rowbase + t) * 1024 + g * 128 + 16 * w + 4 * fq); bq[tt] = p.in[13][(size_t)(l * 4 + g) * 128 + t]; }
    const f32x4 gvg = *(const f32x4*)(p.in[11] + l * 512 + g * 128 + 16 * w + 4 * fq);
    __syncthreads();
#pragma unroll
    for (int i = 0; i < 4; ++i) { const int chn = tid + 512 * i;
        if (chn < nchunk) { const int c = chn >> cshift, kp = (chn & ((1 << cshift) - 1)) * 8; const unsigned gw[4] = {gq[i].x, gq[i].y, gq[i].z, gq[i].w}; u32x4 o;
            unsigned ow[4];
#pragma unroll
            for (int k = 0; k < 4; ++k) ow[k] = pk2(__uint_as_float(gw[k] << 16) * RS[kp + 2 * k], __uint_as_float(gw[k] & 0xffff0000u) * RS[kp + 2 * k + 1]);
            o.x = ow[0]; o.y = ow[1]; o.z = ow[2]; o.w = ow[3]; *(LAS u32x4*)(GT + c * 136 + kp) = o; }
        if (chn < nwch) { const int t = chn >> cshift, kp = (chn & ((1 << cshift) - 1)) * 8; *(LAS u32x4*)(WT + t * 136 + kp) = wq[i]; } }
    __syncthreads();
#pragma unroll
    for (int tt = 0; tt < 8; ++tt) { if (tt < ntt) { f32x4 a = (f32x4){0.f, 0.f, 0.f, 0.f};
        for (int ks = 0; ks < L / 32; ++ks) { if (32 * ks > 16 * tt + 15) break;
            const bf16x8 gf = *(const LAS bf16x8*)(GT + (16 * w + fr) * 136 + 32 * ks + 8 * fq), wf = *(const LAS bf16x8*)(WT + (16 * tt + fr) * 136 + 32 * ks + 8 * fq); a = mfma16(gf, wf, a); }
        const int t = 16 * tt + fr;
        f32x4 u; u[0] = __uint_as_float(uq[tt].x << 16); u[1] = __uint_as_float(uq[tt].x & 0xffff0000u); u[2] = __uint_as_float(uq[tt].y << 16); u[3] = __uint_as_float(uq[tt].y & 0xffff0000u);
        *(u32x2*)(P1 + (size_t)(rowbase + t) * 1024 + g * 128 + 16 * w + 4 * fq) = pk4(u * (a * gvg + bq[tt])); } }
    if (grp) {
        float* o = p.out + O_GMV + (size_t)l * 262144 + (size_t)b * 64 * 512; const float* gg = p.in[11] + l * 512 + g * 128;
        for (int idx = tid; idx < 64 * 128; idx += 512) { const int t = idx >> 7, c = idx & 127; o[(size_t)t * 512 + g * 128 + c] = bf2f(GT[c * 136 + t]) * gg[c]; }
    }
    __syncthreads();
}

DEV void phaseMix(CP& p, int l, LAS unsigned char* lds) {
    unsigned* ctr = (unsigned*)(p.ws + W_MISC) + l;
    LAS int* slot = (LAS int*)(lds + 160 * 1024 - 16);
    for (;;) {
        if (tid_o() == 0) *slot = (int)atomicAdd(ctr, 1u);
        __syncthreads();
        int it = __builtin_amdgcn_readfirstlane(*slot);
        __syncthreads();
        if (it >= 2304) break;
        int kind, grp = 0, a0, a1, a2 = 0;
        if (it < 64) { kind = 0; a0 = it >> 2; a1 = it & 3; }
        else if (it < 128) { it -= 64; kind = 1; a0 = it >> 2; a1 = it & 3; }
        else if (it < 160) { it -= 128; kind = 2; grp = 1; a0 = it >> 2; a1 = it & 3; }
        else if (it < 1184) { it -= 160; kind = 2; a2 = 15 - (it >> 6); a0 = (it & 63) >> 2; a1 = it & 3; }
        else if (it < 2208) { it -= 1184; kind = 3; a0 = it >> 6; a2 = (it >> 2) & 15; a1 = it & 3; }
        else if (it < 2240) { it -= 2208; kind = 0; grp = 1; a0 = it >> 2; a1 = it & 3; }
        else if (it < 2272) { it -= 2240; kind = 1; grp = 1; a0 = it >> 2; a1 = it & 3; }
        else { it -= 2272; kind = 3; grp = 1; a0 = it >> 2; a1 = it & 3; }
        asm volatile("" : "+s"(kind), "+s"(grp), "+s"(a0), "+s"(a1), "+s"(a2));
        if (kind == 0) {
#ifndef NO_S5
            s5_item(p, l, lds, grp, a0, a1);
#endif
        } else if (kind == 1) {
#ifndef NO_GLA
#ifdef GLA_SAMPLE_ONLY
            if (grp)
#endif
            gla_item(p, l, lds, grp, a0, a1);
#endif
        } else if (kind == 2) {
#ifndef NO_ATT
            attn_item(p, l, lds, grp, a0, a1, a2);
#endif
        } else {
#ifndef NO_GMLP
            gmlp_item(p, l, lds, grp, a0, a2, a1);
#endif
        }
    }
}

DEV void phaseFix(CP& p, int l) {
    unsigned char* ws = p.ws; const int gt = bid_o() * 512 + tid_o(), GT = gridDim.x * 512;
    const float* HEAD = (const float*)(ws + W_HEAD); const float* TAIL = (const float*)(ws + W_TAIL); u16* ACT = (u16*)(ws + W_ACT);
    const float* cw = p.in[35] + (size_t)l * 3 * 5632; const float* cb = p.in[36] + (size_t)l * 5632;
    for (int idx = gt; idx < 520 * 2816; idx += GT) { const int slab = idx / 2816, f = idx % 2816;
        float c0[2], c1[2];
#pragma unroll
        for (int bj = 0; bj < 2; ++bj) { const int ff = bj * 2816 + f; float pm2 = 0.f, pm1 = 0.f;
            if (slab >= 512) { const float* st = p.in[7] + ((size_t)(l * 8 + (slab - 512)) * 2) * 5632; pm2 = st[ff]; pm1 = st[5632 + ff]; }
            else if (slab & 31) { pm2 = TAIL[((size_t)(slab - 1) * 2) * 5632 + ff]; pm1 = TAIL[((size_t)(slab - 1) * 2 + 1) * 5632 + ff]; }
            const float h0 = HEAD[((size_t)slab * 2) * 5632 + ff], h1 = HEAD[((size_t)slab * 2 + 1) * 5632 + ff];
            const float w0 = cw[ff], w1 = cw[5632 + ff], w2 = cw[11264 + ff], bb = cb[ff];
            c0[bj] = bb + w0 * pm2 + w1 * pm1 + w2 * h0; c1[bj] = bb + w0 * pm1 + w1 * h0 + w2 * h1; }
        ACT[(size_t)(slab * 64) * 2816 + f] = f2bf(fsilu(c0[0]) * c0[1]); ACT[(size_t)(slab * 64 + 1) * 2816 + f] = f2bf(fsilu(c1[0]) * c1[1]); }
    for (int idx = gt; idx < 24 * 2 * 5632; idx += GT) { const int bb = idx / 11264, rem = idx % 11264;
        if (bb < 16) p.out[O_FCP + (size_t)l * 180224 + (size_t)bb * 11264 + rem] = TAIL[((size_t)(bb * 32 + 31) * 2) * 5632 + rem];
        else p.out[O_FCS + (size_t)l * 90112 + (size_t)(bb - 16) * 11264 + rem] = TAIL[((size_t)(512 + bb - 16) * 2) * 5632 + rem]; }
}

#define XB_TMO      128
#define XB_XCNT(j)  (256  + 64 * (j))
#define XB_XSUB(j)  (1280 + 64 * (j))
#define XB_XGEN(j)  (2304 + 64 * (j))
#define XB_TOP      3328
#define XB_TOPGEN   3392
#define XCD_BAR_WORDS 3456
#define XB_SPIN_CAP (1u << 18)

__device__ __forceinline__ unsigned xb_ld(unsigned* p)              { return __hip_atomic_load(p, __ATOMIC_RELAXED, __HIP_MEMORY_SCOPE_AGENT); }
__device__ __forceinline__ unsigned xb_add(unsigned* p, unsigned v) { return __hip_atomic_fetch_add(p, v, __ATOMIC_RELAXED, __HIP_MEMORY_SCOPE_AGENT); }
__device__ __forceinline__ unsigned xb_xcc_id() { return (unsigned)__builtin_amdgcn_s_getreg((3 << 11) | 20) & 0xFu; }
#define XB_SPIN(cond, bar) do { unsigned _sp = 0; while (cond) { __builtin_amdgcn_s_sleep(1); \
    if ((++_sp & 255u) == 0u) { if (xb_ld(&(bar)[XB_TMO])) break; if (_sp > XB_SPIN_CAP) { atomicAdd(&(bar)[XB_TMO], 1u); break; } } } } while (0)

struct XcdBarrier {
    unsigned* bar; unsigned x;
    volatile LAS unsigned* st;
};

__device__ __forceinline__ XcdBarrier xcd_barrier_post(unsigned* bar, volatile LAS unsigned* st) {
    XcdBarrier b; b.bar = bar; b.x = xb_xcc_id(); b.st = st;
    if (threadIdx.x == 0) (void)xb_add(&bar[XB_XCNT(b.x)], 1u);
    return b;
}
__device__ __forceinline__ void xcd_barrier_complete(unsigned* bar, unsigned x, unsigned& nloc, unsigned& nx) {
    const unsigned G = gridDim.x * gridDim.y * gridDim.z;
    unsigned sum, cnt, mine, sp = 0u;
    for (;;) {
        sum = 0u; cnt = 0u; mine = 0u;
#pragma unroll
        for (unsigned j = 0; j < 16; ++j) { const unsigned c = xb_ld(&bar[XB_XCNT(j)]); sum += c; cnt += (c > 0u) ? 1u : 0u; mine = (j == x) ? c : mine; }
        if (sum == G) break;
        __builtin_amdgcn_s_sleep(1);
        if ((++sp & 255u) == 0u) { if (xb_ld(&bar[XB_TMO])) break; if (sp > XB_SPIN_CAP) { atomicAdd(&bar[XB_TMO], 1u); break; } }
    }
    nloc = mine > 0u ? mine : 1u; nx = cnt > 0u ? cnt : 1u;
}

__device__ __forceinline__ void xcd_barrier(const XcdBarrier& b) {
    asm volatile("s_waitcnt vmcnt(0)" ::: "memory");
    __syncthreads();
    if (threadIdx.x == 0) {
        unsigned* bar = b.bar;
        __builtin_amdgcn_s_waitcnt(0);
        unsigned nloc = b.st[0], nx = b.st[1];
        if (nloc == 0u) { xcd_barrier_complete(bar, b.x, nloc, nx); b.st[0] = nloc; b.st[1] = nx; }
        const unsigned old = xb_add(&bar[XB_XSUB(b.x)], 1u);
        const unsigned gen = old / nloc;
        if (old + 1u == (gen + 1u) * nloc) {
            __builtin_amdgcn_fence(__ATOMIC_RELEASE, "agent");
            asm volatile("s_waitcnt vmcnt(0)" ::: "memory");
            const unsigned og = xb_add(&bar[XB_TOP], 1u);
            const unsigned tg = og / nx;
            if (og + 1u == (tg + 1u) * nx) xb_add(&bar[XB_TOPGEN], 1u);
            else XB_SPIN(xb_ld(&bar[XB_TOPGEN]) == tg, bar);
            __builtin_amdgcn_fence(__ATOMIC_ACQUIRE, "agent");
            xb_add(&bar[XB_XGEN(b.x)], 1u);
            asm volatile("s_waitcnt vmcnt(0)" ::: "memory");
        } else {
            XB_SPIN(xb_ld(&bar[XB_XGEN(b.x)]) == gen, bar);
            __builtin_amdgcn_fence(__ATOMIC_ACQUIRE, "agent");
            asm volatile("s_waitcnt vmcnt(0)" ::: "memory");
        }
    }
    __syncthreads();
}


__global__ void __launch_bounds__(512, 2) mega(Params p_unused) {
    extern __shared__ __attribute__((aligned(16))) unsigned char smem[];
    LAS unsigned char* lds = (LAS unsigned char*)smem;
    cg::grid_group grid = cg::this_grid();
    volatile LAS unsigned* xb_st = (volatile LAS unsigned*)(lds + 160 * 1024 - 32);
    if (threadIdx.x == 0) { xb_st[0] = 0u; xb_st[1] = 0u; }
    __syncthreads();
    const XcdBarrier xbar = xcd_barrier_post((unsigned*)(((CP*)__builtin_amdgcn_kernarg_segment_ptr())->ws + W_BAR), xb_st);
#define GSYNC() xcd_barrier(xbar)
#pragma unroll 1
    for (int l = 0; l < 2; ++l) {
        CP* pp = (CP*)__builtin_amdgcn_kernarg_segment_ptr(); asm volatile("" : "+s"(pp)); CP& p = *pp; unsigned char* ws = p.ws; const int G = gridDim.x, c = bid_o();
#ifndef SKIP_A
        phaseA(p, l);
#endif
        GSYNC();
        if (gridDim.y == 0x7fffu) grid.sync();
#ifndef SKIP_B
        {
            pg8::PlainSched S; S.T.init(130, NMIX, G, c); S.A = (const char*)ws + W_H; S.B = (const char*)ws + W_WIN; S.ld = 1024; S.nt = 16;
            EpiIn E; E.l = l; E.out = p.out; E.ws = ws; E.qg = p.in[27] + l * 64; E.kg = p.in[28] + l * 64; E.rs1 = (const float*)(ws + W_RS) + (size_t)(l * 2) * MT;
            pg8::gemm_phase(lds, 1024, S, E);
        }
#endif
        GSYNC();
#ifndef SKIP_C
        phaseMix(p, l, lds);
#endif
        GSYNC();
#ifndef SKIP_D
        {
            pg8::PlainSched S; S.T.init(130, 2, G, c); S.A = (const char*)ws + W_S5; S.B = (const char*)ws + W_WGLU; S.ld = 512; S.nt = 8;
            EpiGlu E; E.ws = ws; E.bias = p.in[23] + l * 512;
            pg8::gemm_phase(lds, 512, S, E);
        }
#endif
        GSYNC();
#ifndef SKIP_E
        {
            MergeSched S; S.T.init(128, 4, G, c); S.ws = ws;
            EpiMerge E; E.ws = ws; E.bgate = p.in[10] + l * 4096; E.rs1 = (const float*)(ws + W_RS) + (size_t)(l * 2) * MT;
            pg8::gemm_phase(lds, 1024, S, E);
        }
#endif
        GSYNC();
        {
            const f32x4* mf = (const f32x4*)(ws + W_PART); u16* mg = (u16*)(ws + W_MERGED) + (size_t)MTP * 1024;
            for (int i = c * 512 + tid_o(); i < 512 * 256; i += G * 512) *(u32x2*)(mg + (size_t)i * 4) = pk4(mf[i] + mf[i + 131072] + mf[i + 262144] + mf[i + 393216]);
        }
        GSYNC();
#ifndef SKIP_F
        {
            pg8::TailSched S; S.T.init(128, 4, G, c); S.A = (const char*)ws + W_MERGED; S.B = (const char*)ws + W_WOUT; S.ld = 1024; S.nt = 16; S.npiece = 4; S.ntp = 4;
            EpiRes E; E.xin = l == 0 ? p.in[0] : nullptr; E.xb = (u16*)(ws + W_H); E.yout = nullptr; E.rsacc = (float*)(ws + W_RS) + (size_t)(l * 2 + 1) * MT; E.yfull = (float*)(ws + W_PART);
            pg8::gemm_phase(lds, 1024, S, E);
        }
#endif
        GSYNC();
#ifndef SKIP_G
        sample_rows_reduce(p.out + (size_t)MTP * 1024, (const float*)(ws + W_PART), 4, (u16*)(ws + W_H) + (size_t)MTP * 1024, (float*)(ws + W_RS) + (size_t)(l * 2 + 1) * MT + MTP);
#endif
        GSYNC();
#ifndef SKIP_H
        {
            pg8::PlainSched S; S.T.init(130, 22, G, c); S.A = (const char*)ws + W_H; S.B = (const char*)ws + W_WUP; S.ld = 1024; S.nt = 16;
            EpiUp E; E.ws = ws; E.cw = p.in[35] + (size_t)l * 3 * 5632; E.cbias = p.in[36] + (size_t)l * 5632; E.rs2 = (const float*)(ws + W_RS) + (size_t)(l * 2 + 1) * MT;
            pg8::gemm_phase(lds, 1024, S, E);
        }
#endif
        GSYNC();
#ifndef SKIP_I
        phaseFix(p, l);
#endif
        GSYNC();
#ifndef SKIP_J
        {
            pg8::TailSched S; S.T.init(128, 4, G, c); S.A = (const char*)ws + W_ACT; S.B = (const char*)ws + W_WDN; S.ld = 2816; S.nt = 44; S.npiece = 11; S.ntp = 4;
            EpiRes E; E.xin = nullptr; E.xb = (u16*)(ws + W_H); E.yout = l == 1 ? p.out : nullptr; E.rsacc = l == 0 ? (float*)(ws + W_RS) + (size_t)2 * MT : nullptr; E.yfull = (float*)(ws + W_PART);
            pg8::gemm_phase(lds, 2816, S, E);
        }
#endif
        GSYNC();
        if (l == 1) sample_rows_reduce(p.out + (size_t)MTP * 1024, (const float*)(ws + W_PART), 11, (u16*)(ws + W_H) + (size_t)MTP * 1024, (float*)(ws + W_RS) + (size_t)3 * MT + MTP);
    }
}

extern "C" void kernel_launch(void* const* d_in, const int* in_sizes, int n_in, void* d_out, int out_size, void* d_ws, size_t ws_size, hipStream_t stream) {
    constexpr int LDS_BYTES = 160 * 1024;
    static int grid_blocks = 0;
    if (!grid_blocks) {
        int dev = 0, cus = 0, per_cu = 0;
        hipGetDevice(&dev);
        hipDeviceGetAttribute(&cus, hipDeviceAttributeMultiprocessorCount, dev);
        hipFuncSetAttribute((const void*)mega, hipFuncAttributeMaxDynamicSharedMemorySize, LDS_BYTES);
        hipOccupancyMaxActiveBlocksPerMultiprocessor(&per_cu, (const void*)mega, 512, LDS_BYTES);
        if (per_cu < 1) per_cu = 1;
        grid_blocks = cus * per_cu;
        if (ws_size < W_END) fprintf(stderr, "kernel_launch: workspace too small: %zu < %zu\n", ws_size, (size_t)W_END);
    }
    Params p{};
    for (int i = 0; i < 38; ++i) p.in[i] = (const float*)d_in[i];
    p.out = (float*)d_out; p.ws = (unsigned char*)d_ws;
    (void)hipMemsetAsync((unsigned char*)d_ws + W_BAR, 0, 16384, stream);
    void* args[] = {&p};
    hipError_t e = hipLaunchCooperativeKernel((const void*)mega, dim3(grid_blocks), dim3(512), args, LDS_BYTES, stream);
    if (e != hipSuccess) fprintf(stderr, "cooperative launch failed: %s (grid %d)\n", hipGetErrorString(e), grid_blocks);
}
```
